# Optimizing an MI355X kernel written in HIP

```python
import math
import jax, jax.numpy as jnp
from jax import lax
import numpy as np

D_MODEL = 1024
BATCH = 8
SEQ = 2048
DEPTH = 1

M_HEADS = 4
M_HEAD_DIM = D_MODEL // M_HEADS
D_M = M_HEADS * M_HEAD_DIM
QK_CONV = 4
CHUNK = 64
D_C = D_MODEL
CONF_CONV = 31
D_FF = ((8 * D_MODEL // 3 + 255) // 256) * 256
PLE_DIM = 256
EPS = 1e-6
SPLITS = (D_M, 2 * D_M, 3 * D_M, 4 * D_M, 4 * D_M + M_HEADS, 4 * D_M + 2 * M_HEADS, 4 * D_M + 2 * M_HEADS + 2 * D_C)
N_IN = 4 * D_M + 2 * M_HEADS + 2 * D_C + 2 * D_MODEL

kernel_name = 'hybrid_mlstm_conformer_conv_gated_block'


def rmsnorm(x, g):
    xf = x.astype(jnp.float32)
    y = xf * lax.rsqrt(jnp.mean(xf * xf, axis=-1, keepdims=True) + EPS) * g.astype(jnp.float32)
    return y.astype(x.dtype)


def layernorm(x, g, b):
    xf = x.astype(jnp.float32)
    mu = jnp.mean(xf, axis=-1, keepdims=True)
    var = jnp.mean(jnp.square(xf - mu), axis=-1, keepdims=True)
    y = (xf - mu) * lax.rsqrt(var + EPS) * g.astype(jnp.float32) + b.astype(jnp.float32)
    return y.astype(x.dtype)


def causal_dwconv(x, w, b):
    K, C = w.shape
    y = lax.conv_general_dilated(x, w[:, None, :].astype(x.dtype), window_strides=(1,), padding=[(K - 1, 0)], dimension_numbers=('NWC', 'WIO', 'NWC'), feature_group_count=C)
    return y + b.astype(x.dtype)


def mlstm_chunkwise(q, k, v, ig, lf):
    B, S, H, dk = q.shape
    dv = v.shape[-1]
    nc = S // CHUNK
    f32 = jnp.float32

    def to_chunks(t):
        return t.astype(f32).reshape(B, nc, CHUNK, H, -1).transpose(1, 0, 3, 2, 4)

    def gate_chunks(t):
        return t.astype(f32).reshape(B, nc, CHUNK, H).transpose(1, 0, 3, 2)

    causal = jnp.tril(jnp.ones((CHUNK, CHUNK), dtype=bool))

    def step(carry, inp):
        C, n, m = carry
        qc, kc, vc, igc, lfc = inp
        b = jnp.cumsum(lfc, axis=-1)
        D = b[..., :, None] - b[..., None, :] + igc[..., None, :]
        D = jnp.where(causal, D, -jnp.inf)
        inter = b + m[..., None]
        m_t = jnp.maximum(jnp.max(D, axis=-1), inter)
        s = jnp.einsum('bhtd,bhsd->bhts', qc, kc) * jnp.exp(D - m_t[..., None])
        w_inter = jnp.exp(inter - m_t)
        num = jnp.einsum('bhts,bhse->bhte', s, vc) + w_inter[..., None] * jnp.einsum('bhtd,bhde->bhte', qc, C)
        den = jnp.sum(s, axis=-1) + w_inter * jnp.einsum('bhtd,bhd->bht', qc, n)
        h = num / jnp.maximum(jnp.abs(den), jnp.exp(-m_t))[..., None]
        bL = b[..., -1]
        g = bL[..., None] - b + igc
        m_new = jnp.maximum(bL + m, jnp.max(g, axis=-1))
        wk = jnp.exp(g - m_new[..., None])
        decay = jnp.exp(bL + m - m_new)
        C_new = decay[..., None, None] * C + jnp.einsum('bhs,bhsd,bhse->bhde', wk, kc, vc)
        n_new = decay[..., None] * n + jnp.einsum('bhs,bhsd->bhd', wk, kc)
        return (C_new, n_new, m_new), h

    init = (jnp.zeros((B, H, dk, dv), f32), jnp.zeros((B, H, dk), f32), jnp.zeros((B, H), f32))
    _, h = lax.scan(step, init, (to_chunks(q), to_chunks(k), to_chunks(v), gate_chunks(ig), gate_chunks(lf)))
    return h.transpose(1, 0, 3, 2, 4).reshape(B, S, H * dv)


def setup_inputs(seed: int = 0) -> dict:
    key = jax.random.key(seed)
    ks = jax.random.split(key, 32)
    f32 = jnp.float32

    def nrm(k, shape, scale):
        return jax.random.normal(k, shape, f32) * scale

    def gain(k, shape):
        return 1.0 + nrm(k, shape, 0.02)

    b_if = jnp.concatenate([nrm(ks[3], (DEPTH, M_HEADS), 0.1), jnp.linspace(3.0, 6.0, M_HEADS, dtype=f32)[None, :] + nrm(ks[4], (DEPTH, M_HEADS), 0.1)], axis=-1)
    return {
        'x': nrm(ks[0], (BATCH, SEQ, D_MODEL), 1.0),
        'p': nrm(ks[1], (DEPTH, BATCH, SEQ, PLE_DIM), 1.0),
        'norm_mix_g': gain(ks[2], (DEPTH, D_MODEL)),
        'w_in': nrm(ks[5], (DEPTH, D_MODEL, N_IN), D_MODEL ** -0.5),
        'b_if': b_if,
        'conv_qk_w': nrm(ks[6], (DEPTH, QK_CONV, 2 * D_M), QK_CONV ** -0.5),
        'conv_qk_b': nrm(ks[7], (DEPTH, 2 * D_M), 0.02),
        'mh_norm_g': gain(ks[8], (DEPTH, D_M)),
        'conf_conv_w': nrm(ks[9], (DEPTH, CONF_CONV, D_C), CONF_CONV ** -0.5),
        'conf_conv_b': nrm(ks[10], (DEPTH, D_C), 0.02),
        'conf_ln_g': gain(ks[11], (DEPTH, D_C)),
        'conf_ln_b': nrm(ks[12], (DEPTH, D_C), 0.02),
        'w_branch_m': nrm(ks[13], (DEPTH, D_M, D_MODEL), D_M ** -0.5),
        'w_branch_c': nrm(ks[14], (DEPTH, D_C, D_MODEL), D_C ** -0.5),
        'w_out': nrm(ks[15], (DEPTH, D_MODEL, D_MODEL), D_MODEL ** -0.5),
        'norm_ffn_g': gain(ks[16], (DEPTH, D_MODEL)),
        'w_ffn_gate': nrm(ks[17], (DEPTH, D_MODEL, D_FF), D_MODEL ** -0.5),
        'w_ffn_up': nrm(ks[18], (DEPTH, D_MODEL, D_FF), D_MODEL ** -0.5),
        'w_ffn_down': nrm(ks[19], (DEPTH, D_FF, D_MODEL), D_FF ** -0.5),
        'norm_ple_g': gain(ks[20], (DEPTH, D_MODEL)),
        'w_ple_gate': nrm(ks[21], (DEPTH, D_MODEL, D_MODEL), D_MODEL ** -0.5),
        'w_ple_proj': nrm(ks[22], (DEPTH, PLE_DIM, D_MODEL), PLE_DIM ** -0.5),
        'final_g': gain(ks[23], (D_MODEL,)),
    }


def reference(x, p, norm_mix_g, w_in, b_if, conv_qk_w, conv_qk_b, mh_norm_g, conf_conv_w, conf_conv_b, conf_ln_g, conf_ln_b, w_branch_m, w_branch_c, w_out, norm_ffn_g, w_ffn_gate, w_ffn_up, w_ffn_down, norm_ple_g, w_ple_gate, w_ple_proj, final_g):
    B, S, _ = x.shape
    for l in range(DEPTH):
        h = rmsnorm(x, norm_mix_g[l])
        proj = h @ w_in[l]
        q_pre, k_pre, v, o_pre, i_pre, f_pre, conf_in, gate_pre = jnp.split(proj, SPLITS, axis=-1)

        qk = jax.nn.silu(causal_dwconv(jnp.concatenate([q_pre, k_pre], axis=-1), conv_qk_w[l], conv_qk_b[l]))
        q, k = jnp.split(qk, 2, axis=-1)
        q = q.reshape(B, S, M_HEADS, M_HEAD_DIM) * (M_HEAD_DIM ** -0.5)
        k = k.reshape(B, S, M_HEADS, M_HEAD_DIM)
        v = v.reshape(B, S, M_HEADS, M_HEAD_DIM)
        i_b, f_b = jnp.split(b_if[l], 2)
        ig = i_pre.astype(jnp.float32) + i_b.astype(jnp.float32)
        lf = jax.nn.log_sigmoid(f_pre.astype(jnp.float32) + f_b.astype(jnp.float32))
        hm = mlstm_chunkwise(q, k, v, ig, lf).astype(x.dtype)
        hm = rmsnorm(hm.reshape(B, S, M_HEADS, M_HEAD_DIM), mh_norm_g[l].reshape(M_HEADS, M_HEAD_DIM)).reshape(B, S, D_M)
        hm = hm * jax.nn.sigmoid(o_pre)
        branch_m = hm @ w_branch_m[l]

        a, ga = jnp.split(conf_in, 2, axis=-1)
        u = a * jax.nn.sigmoid(ga)
        u = causal_dwconv(u, conf_conv_w[l], conf_conv_b[l])
        u = jax.nn.silu(layernorm(u, conf_ln_g[l], conf_ln_b[l]))
        branch_c = u @ w_branch_c[l]

        g_m, g_c = jnp.split(jax.nn.sigmoid(gate_pre), 2, axis=-1)
        x = x + (g_m * branch_m + g_c * branch_c) @ w_out[l]

        f = rmsnorm(x, norm_ffn_g[l])
        x = x + (jax.nn.silu(f @ w_ffn_gate[l]) * (f @ w_ffn_up[l])) @ w_ffn_down[l]

        gate = jax.nn.sigmoid(rmsnorm(x, norm_ple_g[l]) @ w_ple_gate[l])
        x = x + gate * (p[l].astype(x.dtype) @ w_ple_proj[l])
    return rmsnorm(x, final_g)
```

```cpp
#include <hip/hip_runtime.h>
#include <hip/hip_cooperative_groups.h>
#include <cstdio>
namespace cg = cooperative_groups;

#ifndef MK_MULTI
#define MK_MULTI 0
#endif

#define LAS __attribute__((address_space(3)))
typedef unsigned short bf16_t;
typedef short bf16x8 __attribute__((ext_vector_type(8)));
typedef float f32x4 __attribute__((ext_vector_type(4)));
typedef float f32x2 __attribute__((ext_vector_type(2)));
typedef unsigned u32x4 __attribute__((ext_vector_type(4)));
typedef unsigned u32x2 __attribute__((ext_vector_type(2)));

constexpr int T_ = 16384, D_ = 1024, NIN_ = 8200, DFF_ = 2816, SEQ_ = 2048;
constexpr float EPS_ = 1e-6f;
constexpr int BM = 256, BK = 64, HALF = 128, HTB = HALF * BK * 2, STAGE_BYTES = 8 * HTB;
constexpr int LDS_BYTES = 136 * 1024;
constexpr int NPHASE = 13;

constexpr size_t KiB = 1024, MiB = 1024 * 1024;
constexpr size_t O_WINT = 0, O_WMT = 16 * MiB, O_WCT = 18 * MiB, O_WOT = 20 * MiB, O_WPGT = 22 * MiB, O_WGUT = 24 * MiB, O_WDT = 35 * MiB, O_WPPT = 40 * MiB + 512 * KiB;
constexpr size_t O_IG = 41 * MiB, O_LF = O_IG + 256 * KiB, O_ZERO = O_LF + 256 * KiB;
constexpr size_t O_DENI = O_ZERO, O_HSS = O_DENI + 256 * KiB, O_SSQ1 = O_HSS + 256 * KiB, O_SSQ2 = O_SSQ1 + 64 * KiB, O_SSQ3 = O_SSQ2 + 64 * KiB, O_NSUM = O_SSQ3 + 64 * KiB;
constexpr size_t ZERO_BYTES = 960 * KiB;
constexpr size_t O_DENX = O_ZERO + ZERO_BYTES, O_EBL = O_DENX + 256 * KiB;
constexpr size_t O_BAR = 43 * MiB;
constexpr size_t O_PB = 44 * MiB, O_HB = 52 * MiB, O_S1 = 84 * MiB, O_S2 = 116 * MiB, O_S3 = 148 * MiB, O_S4 = 180 * MiB, O_S5 = 212 * MiB, WS_NEED = 244 * MiB;
constexpr size_t O_PE = O_HB, O_VT = O_S1, O_U = O_S1, O_MERGED = O_S1, O_HID = O_S1, O_WQ = O_S2, O_GMC = O_S2, O_KW = O_S3, O_CINT = O_S3,
                 O_KWT = O_S4, O_HM = O_S4, O_X1B = O_S4, O_SS = O_S5, O_UC = O_S5, O_X2B = O_S5;

struct Params {
    const float* in[23];
    float* out;
    unsigned char* ws;
    int ph_lo, ph_hi;
};

__device__ __forceinline__ unsigned cvt_pk_bf16(float lo, float hi) { unsigned r; asm volatile("v_cvt_pk_bf16_f32 %0, %1, %2" : "=v"(r) : "v"(lo), "v"(hi)); return r; }
__device__ __forceinline__ float bf_lo(unsigned w) { return __uint_as_float(w << 16); }
__device__ __forceinline__ float bf_hi(unsigned w) { return __uint_as_float(w & 0xffff0000u); }
__device__ __forceinline__ float sigm(float x) { return __builtin_amdgcn_rcpf(1.0f + __builtin_amdgcn_exp2f(x * -1.4426950408889634f)); }
__device__ __forceinline__ float silu(float x) { return x * __builtin_amdgcn_rcpf(1.0f + __builtin_amdgcn_exp2f(x * -1.4426950408889634f)); }
__device__ __forceinline__ float wave_sum(float v) {
#pragma unroll
    for (int o = 32; o > 0; o >>= 1) v += __shfl_xor(v, o);
    return v;
}
__device__ __forceinline__ u32x4 pack8(const f32x4 a, const f32x4 b) { u32x4 w; w.x = cvt_pk_bf16(a[0], a[1]); w.y = cvt_pk_bf16(a[2], a[3]); w.z = cvt_pk_bf16(b[0], b[1]); w.w = cvt_pk_bf16(b[2], b[3]); return w; }
__device__ __forceinline__ void unpack8(const u32x4 w, f32x4& a, f32x4& b) { a[0] = bf_lo(w.x); a[1] = bf_hi(w.x); a[2] = bf_lo(w.y); a[3] = bf_hi(w.y); b[0] = bf_lo(w.z); b[1] = bf_hi(w.z); b[2] = bf_lo(w.w); b[3] = bf_hi(w.w); }

__host__ __device__ __forceinline__ int lds_byte(int r, int c) { const int st = (r >> 4) * 2 + (c >> 5), rr = r & 15, cc = c & 31, ob = rr * 64 + cc * 2; return st * 1024 + (ob ^ (((ob >> 9) & 1) << 5)); }
__host__ __device__ __forceinline__ void stage_rc(int b, int& R, int& C) { const int st = b / 1024, sb = b % 1024, swz = sb ^ (((sb >> 9) & 1) << 5); R = (st >> 1) * 16 + swz / 64; C = (st & 1) * 32 + (swz % 64) / 2; }
__host__ __device__ __forceinline__ int perm32(int rho) { const int n = rho >> 4, i = rho & 15; return 8 * (i >> 2) + 4 * n + (i & 3); }

struct Unit { const char* a; const char* b; int pm, pn, kind, cont; };
__device__ __forceinline__ void map_n4(int L, int& pm, int& pn) { const int x = L & 7, k = L >> 3; pm = x * 8 + (k & 7); pn = k >> 3; }

__device__ __forceinline__ void tile_order(int L, int nM, int nN, int& pm, int& pn) {
    const int nwg = nM * nN; int wgid = L;
    { const int q = nwg / 8, r = nwg % 8, xcd = wgid % 8, off = wgid / 8; wgid = (xcd < r ? xcd * (q + 1) : r * (q + 1) + (xcd - r) * q) + off; }
    const int nig = 8 * nN, gid = wgid / nig, fm = gid * 8, gsz = (nM - fm) < 8 ? (nM - fm) : 8;
    pm = fm + ((wgid % nig) % gsz); pn = (wgid % nig) / gsz;
}

template <class Epi, class Sched>
__device__ __forceinline__ void gemm_phase(LAS unsigned char* lds, const int K, const int lda, const int ldb, const Sched& S, const Epi& E) {
    const int tid = threadIdx.x, wid = __builtin_amdgcn_readfirstlane(tid >> 6), lane = tid & 63, wr = wid >> 2, wc = wid & 3, fr = lane & 15, fq = lane >> 4;
    const int nt = K / BK;
    unsigned voffA[2], voffB[2];
#pragma unroll
    for (int i = 0; i < 2; ++i) { int R, C; stage_rc(tid * 16 + i * 8192, R, C); const int Rb = (R & ~31) + perm32(R & 31);
        voffA[i] = (unsigned)(R * lda + C) * 2u; voffB[i] = (unsigned)(Rb * ldb + C) * 2u; }
    const size_t kstep = (size_t)(BK * 2);
    const size_t hstepA = (size_t)HALF * lda * 2, hstepB = (size_t)HALF * ldb * 2;
    const unsigned ldsw = (unsigned)wid * 1024u;
    const int aoff = lds_byte(wr * 64 + fr, fq * 8), boff = lds_byte(wc * 32 + fr, fq * 8);
#define PG8_SA(b, h) (((b) * 2 + (h)) * HTB)
#define PG8_SB(b, h) ((4 + (b) * 2 + (h)) * HTB)
#define PG8_STAGE(bufoff, gbase, voff) do { _Pragma("unroll") for (int _i = 0; _i < 2; ++_i) \
        __builtin_amdgcn_global_load_lds((const unsigned*)((const char*)(gbase) + (voff)[_i]), (LAS unsigned*)(lds + (bufoff) + ldsw + _i * 8192), 16, 0, 0); } while (0)
#define PG8_LDA(dst, b, h) do { _Pragma("unroll") for (int m = 0; m < 4; ++m) _Pragma("unroll") for (int k = 0; k < 2; ++k) dst[m][k] = *(const LAS bf16x8*)(lds + PG8_SA(b, h) + aoff + m * 2048 + k * 1024); } while (0)
#define PG8_LDB(dst, b, h) do { _Pragma("unroll") for (int n = 0; n < 2; ++n) _Pragma("unroll") for (int k = 0; k < 2; ++k) dst[n][k] = *(const LAS bf16x8*)(lds + PG8_SB(b, h) + boff + n * 2048 + k * 1024); } while (0)
#define PG8_MMA(ai, bj, At, Bt) do { __builtin_amdgcn_s_setprio(1); _Pragma("unroll") for (int m = 0; m < 4; ++m) _Pragma("unroll") for (int n = 0; n < 2; ++n) _Pragma("unroll") for (int k = 0; k < 2; ++k) \
        acc[ai][bj][m][n] = __builtin_amdgcn_mfma_f32_16x16x32_bf16(Bt[n][k], At[m][k], acc[ai][bj][m][n], 0, 0, 0); __builtin_amdgcn_s_setprio(0); } while (0)
#define PG8_WAIT_V(n) asm volatile("s_waitcnt vmcnt(" #n ")" ::: "memory")
#define PG8_WAIT_L(n) asm volatile("s_waitcnt lgkmcnt(" #n ")" ::: "memory")
#define PG8_BAR __builtin_amdgcn_s_barrier()
#define PG8_SCHED __builtin_amdgcn_sched_barrier(0)
#define PG8_ZERO() do { _Pragma("unroll") for (int a = 0; a < 2; ++a) _Pragma("unroll") for (int b = 0; b < 2; ++b) _Pragma("unroll") for (int m = 0; m < 4; ++m) _Pragma("unroll") for (int n = 0; n < 2; ++n) acc[a][b][m][n] = (f32x4){0.f, 0.f, 0.f, 0.f}; } while (0)
    Unit cur, nxt; int ui = 0;
    if (!S.next(0, cur)) return;
    E.pre(cur, wr, wc, fr, fq);
    f32x4 acc[2][2][4][2];
    PG8_ZERO();
    bf16x8 At[4][2], B0[2][2], B1[2][2];
    const char* cA = cur.a; const char* cB = cur.b;
    PG8_STAGE(PG8_SB(0, 0), cB, voffB); PG8_STAGE(PG8_SA(0, 0), cA, voffA); PG8_STAGE(PG8_SB(0, 1), cB + hstepB, voffB); PG8_STAGE(PG8_SA(0, 1), cA + hstepA, voffA);
    if (wr == 1) PG8_BAR;
    PG8_WAIT_V(4); PG8_BAR;
    PG8_STAGE(PG8_SB(1, 0), cB + kstep, voffB); PG8_STAGE(PG8_SA(1, 0), cA + kstep, voffA); PG8_STAGE(PG8_SB(1, 1), cB + hstepB + kstep, voffB);
    PG8_WAIT_V(6); PG8_BAR;
    for (;;) {
        const bool has_next = S.next(ui + 1, nxt);
        const char* nA = has_next ? nxt.a : cA; const char* nB = has_next ? nxt.b : cB;
#pragma unroll 1
        for (int t = 0; t < nt; t += 2) {
            const bool last = (t == nt - 2);
            const char* a1 = cA + (size_t)(t + 1) * kstep;
            const char* a2 = last ? nA : cA + (size_t)(t + 2) * kstep; const char* b2 = last ? nB : cB + (size_t)(t + 2) * kstep;
            const char* a3 = a2 + kstep; const char* b3 = b2 + kstep;
            PG8_LDB(B0, 0, 0); PG8_SCHED; PG8_LDA(At, 0, 0); PG8_STAGE(PG8_SA(1, 1), a1 + hstepA, voffA);
            PG8_WAIT_L(8); PG8_BAR; PG8_WAIT_L(0); PG8_MMA(0, 0, At, B0); PG8_BAR; PG8_SCHED;
            PG8_LDB(B1, 0, 1); PG8_STAGE(PG8_SB(0, 0), b2, voffB);
            PG8_BAR; PG8_WAIT_L(0); PG8_MMA(0, 1, At, B1); PG8_BAR;
            PG8_LDA(At, 0, 1); PG8_STAGE(PG8_SA(0, 0), a2, voffA);
            PG8_BAR; PG8_WAIT_L(0); PG8_MMA(1, 0, At, B0); PG8_BAR; PG8_SCHED;
            PG8_STAGE(PG8_SB(0, 1), b2 + hstepB, voffB);
            PG8_WAIT_V(6); PG8_BAR; PG8_MMA(1, 1, At, B1); PG8_BAR;
            PG8_LDB(B0, 1, 0); PG8_SCHED; PG8_LDA(At, 1, 0); PG8_STAGE(PG8_SA(0, 1), a2 + hstepA, voffA);
            PG8_WAIT_L(8); PG8_BAR; PG8_WAIT_L(0); PG8_MMA(0, 0, At, B0); PG8_BAR; PG8_SCHED;
            PG8_LDB(B1, 1, 1); PG8_STAGE(PG8_SB(1, 0), b3, voffB);
            PG8_BAR; PG8_WAIT_L(0); PG8_MMA(0, 1, At, B1); PG8_BAR;
            PG8_LDA(At, 1, 1); PG8_STAGE(PG8_SA(1, 0), a3, voffA);
            PG8_BAR; PG8_WAIT_L(0); PG8_MMA(1, 0, At, B0); PG8_BAR; PG8_SCHED;
            PG8_STAGE(PG8_SB(1, 1), b3 + hstepB, voffB);
            PG8_WAIT_V(6); PG8_BAR; PG8_MMA(1, 1, At, B1); PG8_BAR;
        }
        if (cur.cont) { E.mid(acc, cur, wr, wc, fr, fq); }
        else { if constexpr (!Epi::AFTER_DRAIN) E(acc, cur, wr, wc, fr, fq); if (!has_next) break; PG8_ZERO(); }
        cur = nxt; cA = nA; cB = nB; ++ui;
    }
    PG8_WAIT_V(0);
    if (wr == 0) PG8_BAR;
    PG8_BAR;
    if constexpr (Epi::AFTER_DRAIN) E(acc, cur, wr, wc, fr, fq);
#undef PG8_SA
#undef PG8_SB
#undef PG8_STAGE
#undef PG8_LDA
#undef PG8_LDB
#undef PG8_MMA
#undef PG8_WAIT_V
#undef PG8_WAIT_L
#undef PG8_BAR
#undef PG8_SCHED
#undef PG8_ZERO
}

typedef f32x4 Acc[2][2][4][2];
#define EPI_ROWS(ai, m) _Pragma("unroll") for (int ai = 0; ai < 2; ++ai) _Pragma("unroll") for (int m = 0; m < 4; ++m) if (epi_fence())
__device__ __forceinline__ bool epi_fence() { asm volatile("" ::: "memory"); return true; }
#define EPI_RL(ai, m) ((ai) * 128 + wr * 64 + (m) * 16 + fr)
#define EPI_CL(bj) ((bj) * 128 + wc * 32 + 8 * fq)

struct SchedP1 { const char* hb; const char* wint; int G, c;
    __device__ __forceinline__ bool next(int i, Unit& u) const {
        const int L = i * G + c; if (L >= 768) return false;
        u.cont = 0;
        if (L < 512) { int pm, pn; tile_order(L, 64, 8, pm, pn); u.pm = pm; u.pn = pn; u.kind = 0; u.a = hb + (size_t)pm * 256 * 1024 * 2; u.b = wint + (size_t)pn * 256 * 1024 * 2; }
        else { const int l = L - 512; u.pm = l & 3; u.pn = l >> 2; u.kind = 1; u.a = wint + (size_t)(2048 + u.pm * 256) * 1024 * 2; u.b = hb + (size_t)u.pn * 256 * 1024 * 2; }
        return true; } };
struct EpiP1 { static constexpr bool AFTER_DRAIN = false; bf16_t* qkpre; bf16_t* vt;
    __device__ __forceinline__ void mid(Acc&, const Unit&, int, int, int, int) const {}
    __device__ __forceinline__ void pre(const Unit&, int, int, int, int) const {}
    __device__ __forceinline__ void operator()(Acc& acc, const Unit& u, int wr, int wc, int fr, int fq) const {
        bf16_t* base; int ld;
        if (u.kind == 0) { base = qkpre + (size_t)u.pm * 256 * 2048 + u.pn * 256; ld = 2048; }
        else { const int item = ((u.pn >> 3) * 4 + u.pm) * 8 + (u.pn & 7); base = vt + (size_t)item * 65536; ld = 256; }
        EPI_ROWS(ai, m) { bf16_t* rowp = base + (size_t)EPI_RL(ai, m) * ld + EPI_CL(0);
#pragma unroll
            for (int bj = 0; bj < 2; ++bj) *(u32x4*)(rowp + bj * 128) = pack8(acc[ai][bj][m][0], acc[ai][bj][m][1]); }
    } };

struct SchedP3 { const char* wq; const char* kw; const char* vt; const char* kwt; int G, c;
    __device__ __forceinline__ bool next(int i, Unit& u) const {
        const int L = i * G + c; if (L >= 512) return false;
        u.cont = 0; u.pn = 0;
        if (L < 256) { u.pm = L; u.kind = 0; u.a = wq + (size_t)L * 131072; u.b = kw + (size_t)L * 131072; }
        else { const int it = L - 256; u.pm = it; u.kind = 1; u.a = vt + (size_t)it * 131072; u.b = kwt + (size_t)it * 131072; }
        return true; } };
struct EpiP3 { static constexpr bool AFTER_DRAIN = false; bf16_t* s; bf16_t* lt; float* deni;
    __device__ __forceinline__ void mid(Acc&, const Unit&, int, int, int, int) const {}
    __device__ __forceinline__ void pre(const Unit&, int, int, int, int) const {}
    __device__ __forceinline__ void operator()(Acc& acc, const Unit& u, int wr, int wc, int fr, int fq) const {
        const int item = u.pm;
        if (u.kind == 0) {
            const int b = item >> 5, h = (item >> 3) & 3, sc = item & 7; const int tokb = b * SEQ_ + sc * 256;
            EPI_ROWS(ai, m) { int r = EPI_RL(ai, m); asm volatile("" : "+v"(r)); float rs = 0.f;
#pragma unroll
                for (int bj = 0; bj < 2; ++bj) { const int c0 = EPI_CL(bj); f32x4 v0 = acc[ai][bj][m][0], v1 = acc[ai][bj][m][1];
#pragma unroll
                    for (int j = 0; j < 4; ++j) { v0[j] = (c0 + j <= r) ? v0[j] : 0.f; v1[j] = (c0 + 4 + j <= r) ? v1[j] : 0.f; rs += v0[j] + v1[j]; }
                    *(u32x4*)(s + (size_t)item * 65536 + r * 256 + c0) = pack8(v0, v1); }
                rs += __shfl_xor(rs, 16); rs += __shfl_xor(rs, 32);
                if (fq == 0) unsafeAtomicAdd(deni + (size_t)(tokb + r) * 4 + h, rs); }
        } else {
            EPI_ROWS(ai, m) { bf16_t* rowp = lt + (size_t)item * 65536 + EPI_RL(ai, m) * 256 + EPI_CL(0);
#pragma unroll
                for (int bj = 0; bj < 2; ++bj) *(u32x4*)(rowp + bj * 128) = pack8(acc[ai][bj][m][0], acc[ai][bj][m][1]); }
        }
    } };

struct SchedP5 { const char* s; const char* vt; const char* wq; const char* cint; int G, c;
    __device__ __forceinline__ bool next(int i, Unit& u) const {
        const int item = (i >> 1) * G + c; if (item >= 256) return false;
        u.pm = item; u.pn = 0; u.kind = 0;
        if ((i & 1) == 0) { u.cont = 1; u.a = s + (size_t)item * 131072; u.b = vt + (size_t)item * 131072; }
        else { u.cont = 0; u.a = wq + (size_t)item * 131072; u.b = cint + (size_t)item * 131072; }
        return true; } };
struct EpiP5 { static constexpr bool AFTER_DRAIN = false; bf16_t* hm; const float* deni; const float* denx; float* hss;
    __device__ __forceinline__ void mid(Acc&, const Unit&, int, int, int, int) const {}
    __device__ __forceinline__ void pre(const Unit&, int, int, int, int) const {}
    __device__ __forceinline__ void operator()(Acc& acc, const Unit& u, int wr, int wc, int fr, int fq) const {
        const int item = u.pm; const int b = item >> 5, h = (item >> 3) & 3, sc = item & 7; const int tokb = b * SEQ_ + sc * 256;
        EPI_ROWS(ai, m) { const int t = tokb + EPI_RL(ai, m);
            const float den = deni[(size_t)t * 4 + h] + denx[(size_t)t * 4 + h]; const float inv = __builtin_amdgcn_rcpf(fmaxf(fabsf(den), 1.0f)); float ss = 0.f;
#pragma unroll
            for (int bj = 0; bj < 2; ++bj) { f32x4 v0 = acc[ai][bj][m][0] * inv, v1 = acc[ai][bj][m][1] * inv;
#pragma unroll
                for (int j = 0; j < 4; ++j) ss += v0[j] * v0[j] + v1[j] * v1[j];
                *(u32x4*)(hm + (size_t)t * 1024 + h * 256 + EPI_CL(bj)) = pack8(v0, v1); }
            ss += __shfl_xor(ss, 16); ss += __shfl_xor(ss, 32);
            if (fq == 0) unsafeAtomicAdd(hss + (size_t)t * 4 + h, ss); }
    } };

struct SchedP6 { const char* hb; const char* wint; int G, c;
    __device__ __forceinline__ bool next(int i, Unit& u) const {
        u.cont = 0;
        if (i == 0) { const int item = c; if (item >= 256) return false; const int b = item >> 5, h = (item >> 3) & 3, sc = item & 7;
            u.pm = b * 8 + sc; u.pn = h; u.kind = 0; u.a = hb + (size_t)u.pm * 256 * 1024 * 2; u.b = wint + (size_t)(3072 + h * 256) * 1024 * 2; return true; }
        const int L = (i - 1) * G + c; if (L >= 512) return false;
        int pm, pn; tile_order(L, 64, 8, pm, pn); u.pm = pm; u.pn = pn; u.kind = 1;
        u.a = hb + (size_t)pm * 256 * 1024 * 2; u.b = wint + (size_t)(4096 + pn * 256) * 1024 * 2; return true; } };
struct EpiP6 { static constexpr bool AFTER_DRAIN = false; bf16_t* hm; float* hss; const float* mhg; bf16_t* uu;
    __device__ __forceinline__ void mid(Acc&, const Unit&, int, int, int, int) const {}
    __device__ __forceinline__ void pre(const Unit&, int, int, int, int) const {}
    __device__ __forceinline__ void operator()(Acc& acc, const Unit& u, int wr, int wc, int fr, int fq) const {
        if (u.kind == 0) {
            EPI_ROWS(ai, m) { const int t = u.pm * 256 + EPI_RL(ai, m);
                const float rsn = rsqrtf(__hip_atomic_load(hss + (size_t)t * 4 + u.pn, __ATOMIC_RELAXED, __HIP_MEMORY_SCOPE_AGENT) * (1.0f / 256.0f) + EPS_);
#pragma unroll
                for (int bj = 0; bj < 2; ++bj) { const int c = u.pn * 256 + EPI_CL(bj); bf16_t* ptr = hm + (size_t)t * 1024 + c;
                    f32x4 h0, h1; unpack8(*(const u32x4*)ptr, h0, h1); const f32x4 g0 = *(const f32x4*)(mhg + c), g1 = *(const f32x4*)(mhg + c + 4); f32x4 o0, o1;
#pragma unroll
                    for (int j = 0; j < 4; ++j) { o0[j] = h0[j] * rsn * g0[j] * sigm(acc[ai][bj][m][0][j]); o1[j] = h1[j] * rsn * g1[j] * sigm(acc[ai][bj][m][1][j]); }
                    *(u32x4*)ptr = pack8(o0, o1); } }
        } else {
            EPI_ROWS(ai, m) { const int t = u.pm * 256 + EPI_RL(ai, m); f32x4 o0, o1;
#pragma unroll
                for (int j = 0; j < 4; ++j) { o0[j] = acc[ai][0][m][0][j] * sigm(acc[ai][1][m][0][j]); o1[j] = acc[ai][0][m][1][j] * sigm(acc[ai][1][m][1][j]); }
                *(u32x4*)(uu + (size_t)t * 1024 + u.pn * 128 + wc * 32 + 8 * fq) = pack8(o0, o1); }
        }
    } };

struct SchedP8 { const char* hb; const char* wint; const char* hmg; const char* uc; const char* wmt; const char* wct; int G, c;
    __device__ __forceinline__ bool next(int i, Unit& u) const {
        const int L = (i >> 2) * G + c, r = i & 3; if (L >= 256) return false;
        int pn; map_n4(L, u.pm, pn); u.cont = 0;
        if (r < 2) { u.kind = 2; u.pn = 2 * pn + r; u.a = hb + (size_t)u.pm * 256 * 1024 * 2; u.b = wint + (size_t)(6144 + u.pn * 256) * 1024 * 2; }
        else if (r == 2) { u.kind = 0; u.pn = pn; u.a = hmg + (size_t)u.pm * 256 * 1024 * 2; u.b = wmt + (size_t)pn * 256 * 1024 * 2; }
        else { u.kind = 1; u.pn = pn; u.a = uc + (size_t)u.pm * 256 * 1024 * 2; u.b = wct + (size_t)pn * 256 * 1024 * 2; }
        return true; } };
struct EpiP8 { static constexpr bool AFTER_DRAIN = false; bf16_t* gmc; bf16_t* tmp; bf16_t* merged;
    __device__ __forceinline__ void mid(Acc&, const Unit&, int, int, int, int) const {}
    __device__ __forceinline__ void pre(const Unit&, int, int, int, int) const {}
    __device__ __forceinline__ void operator()(Acc& acc, const Unit& u, int wr, int wc, int fr, int fq) const {
        if (u.kind == 2) {
            EPI_ROWS(ai, m) { const int t = u.pm * 256 + EPI_RL(ai, m); f32x4 r0, r1, c0, c1;
#pragma unroll
                for (int j = 0; j < 4; ++j) { const float e0 = __builtin_amdgcn_exp2f(acc[ai][1][m][0][j] * -1.4426950408889634f), e1 = __builtin_amdgcn_exp2f(acc[ai][1][m][1][j] * -1.4426950408889634f);
                    r0[j] = sigm(acc[ai][0][m][0][j]) * (1.0f + e0); r1[j] = sigm(acc[ai][0][m][1][j]) * (1.0f + e1);
                    c0[j] = __builtin_amdgcn_rcpf(1.0f + e0); c1[j] = __builtin_amdgcn_rcpf(1.0f + e1); }
                bf16_t* ptr = gmc + (size_t)t * 2048 + u.pn * 128 + wc * 32 + 8 * fq;
                *(u32x4*)ptr = pack8(r0, r1); *(u32x4*)(ptr + 1024) = pack8(c0, c1); }
        } else if (u.kind == 0) {
            EPI_ROWS(ai, m) { const int t = u.pm * 256 + EPI_RL(ai, m);
#pragma unroll
                for (int bj = 0; bj < 2; ++bj) { const int c = u.pn * 256 + EPI_CL(bj); f32x4 a0, a1; unpack8(*(const u32x4*)(gmc + (size_t)t * 2048 + c), a0, a1);
                    *(u32x4*)(tmp + (size_t)t * 1024 + c) = pack8(acc[ai][bj][m][0] * a0, acc[ai][bj][m][1] * a1); } }
        } else {
            EPI_ROWS(ai, m) { const int t = u.pm * 256 + EPI_RL(ai, m);
#pragma unroll
                for (int bj = 0; bj < 2; ++bj) { const int c = u.pn * 256 + EPI_CL(bj); f32x4 b0, b1, t0, t1; unpack8(*(const u32x4*)(gmc + (size_t)t * 2048 + 1024 + c), b0, b1);
                    unpack8(*(const u32x4*)(tmp + (size_t)t * 1024 + c), t0, t1);
                    *(u32x4*)(merged + (size_t)t * 1024 + c) = pack8((acc[ai][bj][m][0] + t0) * b0, (acc[ai][bj][m][1] + t1) * b1); } }
        }
    } };

struct SchedN4 { const char* a; const char* bt; size_t astep, bstep; int G, c;
    __device__ __forceinline__ bool next(int i, Unit& u) const {
        const int L = i * G + c; if (L >= 256) return false;
        map_n4(L, u.pm, u.pn); u.kind = 0; u.cont = 0; u.a = a + (size_t)u.pm * astep; u.b = bt + (size_t)u.pn * bstep; return true; } };
struct SchedPE { const char* a; const char* bt; int G, c;
    __device__ __forceinline__ bool next(int i, Unit& u) const {
        const int L = i * G + c; if (L >= 256 || c < 0) return false;
        u.pm = L >> 2; u.pn = L & 3; u.kind = 0; u.cont = 0; u.a = a + (size_t)u.pm * 256 * 256 * 2; u.b = bt + (size_t)u.pn * 256 * 256 * 2; return true; } };
template <bool SRC_BF16> struct EpiRes { static constexpr bool AFTER_DRAIN = false; const void* src; bf16_t* dstb; float* ssq;
    __device__ __forceinline__ void mid(Acc&, const Unit&, int, int, int, int) const {}
    __device__ __forceinline__ void pre(const Unit& u, int wr, int wc, int fr, int fq) const {
        if (!SRC_BF16) {
            EPI_ROWS(ai, m) { const int t = u.pm * 256 + EPI_RL(ai, m);
#pragma unroll
                for (int bj = 0; bj < 2; ++bj) { const float v = *((const float*)src + (size_t)t * 1024 + u.pn * 256 + EPI_CL(bj)); asm volatile("" :: "v"(v)); } }
        }
    }
    __device__ __forceinline__ void operator()(Acc& acc, const Unit& u, int wr, int wc, int fr, int fq) const {
        EPI_ROWS(ai, m) { const int t = u.pm * 256 + EPI_RL(ai, m); float ss = 0.f;
#pragma unroll
            for (int bj = 0; bj < 2; ++bj) { const size_t o = (size_t)t * 1024 + u.pn * 256 + EPI_CL(bj); f32x4 v0, v1;
                if (SRC_BF16) unpack8(*(const u32x4*)((const bf16_t*)src + o), v0, v1); else { v0 = *(const f32x4*)((const float*)src + o); v1 = *(const f32x4*)((const float*)src + o + 4); }
                v0 += acc[ai][bj][m][0]; v1 += acc[ai][bj][m][1];
#pragma unroll
                for (int j = 0; j < 4; ++j) ss += v0[j] * v0[j] + v1[j] * v1[j];
                *(u32x4*)(dstb + o) = pack8(v0, v1); }
            ss += __shfl_xor(ss, 16); ss += __shfl_xor(ss, 32);
            if (fq == 0) unsafeAtomicAdd(ssq + t, ss); }
    } };

struct SchedP10 { const char* x1b; const char* wgut; int G, c;
    __device__ __forceinline__ bool next(int i, Unit& u) const {
        const int L = i * G + c; if (L >= 1408) return false;
        int pm, pn; tile_order(L, 64, 22, pm, pn); u.pm = pm; u.pn = pn; u.kind = 0; u.cont = 0;
        u.a = x1b + (size_t)pm * 256 * 1024 * 2; u.b = wgut + (size_t)pn * 256 * 1024 * 2; return true; } };
struct EpiP10 { static constexpr bool AFTER_DRAIN = false; const float* ssq; bf16_t* hid;
    __device__ __forceinline__ void mid(Acc&, const Unit&, int, int, int, int) const {}
    __device__ __forceinline__ void pre(const Unit&, int, int, int, int) const {}
    __device__ __forceinline__ void operator()(Acc& acc, const Unit& u, int wr, int wc, int fr, int fq) const {
        EPI_ROWS(ai, m) { const int t = u.pm * 256 + EPI_RL(ai, m); const float rs = rsqrtf(ssq[t] * (1.0f / 1024.0f) + EPS_); f32x4 o0, o1;
#pragma unroll
            for (int j = 0; j < 4; ++j) { o0[j] = silu(acc[ai][0][m][0][j] * rs) * (acc[ai][1][m][0][j] * rs); o1[j] = silu(acc[ai][0][m][1][j] * rs) * (acc[ai][1][m][1][j] * rs); }
            *(u32x4*)(hid + (size_t)t * DFF_ + u.pn * 128 + wc * 32 + 8 * fq) = pack8(o0, o1); }
    } };

struct EpiBf { static constexpr bool AFTER_DRAIN = false; bf16_t* o;
    __device__ __forceinline__ void mid(Acc&, const Unit&, int, int, int, int) const {}
    __device__ __forceinline__ void pre(const Unit&, int, int, int, int) const {}
    __device__ __forceinline__ void operator()(Acc& acc, const Unit& u, int wr, int wc, int fr, int fq) const {
        EPI_ROWS(ai, m) { bf16_t* rowp = o + (size_t)(u.pm * 256 + EPI_RL(ai, m)) * 1024 + u.pn * 256 + EPI_CL(0);
#pragma unroll
            for (int bj = 0; bj < 2; ++bj) *(u32x4*)(rowp + bj * 128) = pack8(acc[ai][bj][m][0], acc[ai][bj][m][1]); }
    } };

struct EpiP12 { static constexpr bool AFTER_DRAIN = true; const float* ssq2; const bf16_t* pe; const bf16_t* xin; float* out; float* ssq3; unsigned* done; const float* fg;
    __device__ __forceinline__ void mid(Acc&, const Unit&, int, int, int, int) const {}
    __device__ __forceinline__ void pre(const Unit&, int, int, int, int) const {}
    __device__ __forceinline__ void operator()(Acc& acc, const Unit& u, int wr, int wc, int fr, int fq) const {
        EPI_ROWS(ai, m) { const int t = u.pm * 256 + EPI_RL(ai, m); const float rs = rsqrtf(ssq2[t] * (1.0f / 1024.0f) + EPS_); float ss = 0.f;
#pragma unroll
            for (int bj = 0; bj < 2; ++bj) { const size_t o = (size_t)t * 1024 + u.pn * 256 + EPI_CL(bj); f32x4 p0, p1; unpack8(*(const u32x4*)(pe + o), p0, p1);
                f32x4 v0, v1; unpack8(*(const u32x4*)(xin + o), v0, v1);
#pragma unroll
                for (int j = 0; j < 4; ++j) { v0[j] += sigm(acc[ai][bj][m][0][j] * rs) * p0[j]; v1[j] += sigm(acc[ai][bj][m][1][j] * rs) * p1[j]; ss += v0[j] * v0[j] + v1[j] * v1[j]; }
                acc[ai][bj][m][0] = v0; acc[ai][bj][m][1] = v1; }
            ss += __shfl_xor(ss, 16); ss += __shfl_xor(ss, 32);
            if (fq == 0) unsafeAtomicAdd(ssq3 + t, ss); }
        asm volatile("s_waitcnt vmcnt(0)" ::: "memory");
        unsigned* cnt = done + 64 * u.pm;
        if ((threadIdx.x & 63) == 0) __hip_atomic_fetch_add(cnt, 1u, __ATOMIC_RELAXED, __HIP_MEMORY_SCOPE_AGENT);
        { unsigned sp = 0; while (__hip_atomic_load(cnt, __ATOMIC_RELAXED, __HIP_MEMORY_SCOPE_AGENT) < 32u) { __builtin_amdgcn_s_sleep(1); if (++sp > (1u << 22)) break; } }
        EPI_ROWS(ai, m) { const int t = u.pm * 256 + EPI_RL(ai, m);
            const float rs = rsqrtf(__hip_atomic_load(ssq3 + t, __ATOMIC_RELAXED, __HIP_MEMORY_SCOPE_AGENT) * (1.0f / 1024.0f) + EPS_);
#pragma unroll
            for (int bj = 0; bj < 2; ++bj) { const int cc = u.pn * 256 + EPI_CL(bj); const size_t o = (size_t)t * 1024 + cc;
                const f32x4 g0 = *(const f32x4*)(fg + cc), g1 = *(const f32x4*)(fg + cc + 4);
                *(f32x4*)(out + o) = acc[ai][bj][m][0] * rs * g0; *(f32x4*)(out + o + 4) = acc[ai][bj][m][1] * rs * g1; } }
    } };

struct CvtTile { const float* src; int ld; const float* scale; bf16_t* dst; int dstld; };
__device__ __forceinline__ CvtTile cvt_tile_params(const Params& p, int tl) {
    const int NT0 = 2048, NT4 = NT0 + 1024, NT5 = NT4 + 1408, NT6 = NT5 + 704;
    unsigned char* ws = p.ws; CvtTile t; t.scale = nullptr;
    if (tl < NT0) { const int nb = tl >> 4, kb = tl & 15; const int n0 = nb * 64; int col;
        if (n0 < 4096) col = n0; else if (n0 < 6144) { const int j = (n0 - 4096) >> 8, r = (n0 - 4096) & 255; col = (r < 128) ? (4104 + 128 * j + r) : (5128 + 128 * j + r - 128); }
        else { const int j = (n0 - 6144) >> 8, r = (n0 - 6144) & 255; col = 6152 + ((r < 128) ? (128 * j + r) : (1024 + 128 * j + r - 128)); }
        t.src = p.in[3] + (size_t)kb * 64 * NIN_ + col; t.ld = NIN_; t.dst = (bf16_t*)(ws + O_WINT) + (size_t)n0 * 1024 + kb * 64; t.dstld = 1024; }
    else if (tl < NT4) { const int w = (tl - NT0) >> 8, l = (tl - NT0) & 255; const int nb = l >> 4, kb = l & 15;
        const float* base = w == 0 ? p.in[12] : (w == 1 ? p.in[13] : (w == 2 ? p.in[14] : p.in[20])); const size_t od = w == 0 ? O_WMT : (w == 1 ? O_WCT : (w == 2 ? O_WOT : O_WPGT));
        t.src = base + (size_t)kb * 64 * 1024 + nb * 64; t.ld = 1024; if (w == 3) t.scale = p.in[19] + kb * 64; t.dst = (bf16_t*)(ws + od) + (size_t)nb * 64 * 1024 + kb * 64; t.dstld = 1024; }
    else if (tl < NT5) { const int l = tl - NT4; const int nb = l >> 4, kb = l & 15; const int n0 = nb * 64; const int j = n0 >> 8, r = n0 & 255;
        const float* base = (r < 128) ? p.in[16] : p.in[17]; const int col = 128 * j + (r & 127);
        t.src = base + (size_t)kb * 64 * DFF_ + col; t.ld = DFF_; t.scale = p.in[15] + kb * 64; t.dst = (bf16_t*)(ws + O_WGUT) + (size_t)n0 * 1024 + kb * 64; t.dstld = 1024; }
    else if (tl < NT6) { const int l = tl - NT5; const int nb = l / 44, kb = l % 44;
        t.src = p.in[18] + (size_t)kb * 64 * 1024 + nb * 64; t.ld = 1024; t.dst = (bf16_t*)(ws + O_WDT) + (size_t)nb * 64 * DFF_ + kb * 64; t.dstld = DFF_; }
    else { const int l = tl - NT6; const int nb = l >> 2, kb = l & 3;
        t.src = p.in[21] + (size_t)kb * 64 * 1024 + nb * 64; t.ld = 1024; t.dst = (bf16_t*)(ws + O_WPPT) + (size_t)nb * 64 * 256 + kb * 64; t.dstld = 256; }
    return t;
}
__device__ __forceinline__ void cvt_tile_load(const CvtTile& t, f32x4 (&v)[2]) {
    const int tid = threadIdx.x, kk = tid >> 4, c4 = (tid & 15) * 4;
#pragma unroll
    for (int pss = 0; pss < 2; ++pss) { const int k = kk + pss * 32; v[pss] = *(const f32x4*)(t.src + (size_t)k * t.ld + c4); if (t.scale) v[pss] = v[pss] * t.scale[k]; }
}

template <int LIST> __device__ __forceinline__ int cvt_vtile(int v) {
    if (LIST == 0) return v < 2816 ? v : (v < 4224 ? 3072 + (v - 2816) : 5184 + (v - 4224));
    return v < 256 ? 2816 + v : 4480 + (v - 256);
}
template <int LIST> __device__ __forceinline__ void cvt_weights(const Params& p, unsigned char* sm, int worker, int nworkers) {
    const int tid = threadIdx.x; const int NV = LIST == 0 ? 4288 : 960; const int gs = nworkers;
    float* tl = (float*)sm;
    int t = worker; CvtTile c0{}, c1{}; f32x4 v0[2], v1[2];
    if (t < NV) { c0 = cvt_tile_params(p, cvt_vtile<LIST>(t)); cvt_tile_load(c0, v0); }
    if (t + gs < NV) { c1 = cvt_tile_params(p, cvt_vtile<LIST>(t + gs)); cvt_tile_load(c1, v1); }
    for (; t < NV; t += gs) {
        { const int kk = tid >> 4, c4 = (tid & 15) * 4;
#pragma unroll
            for (int pss = 0; pss < 2; ++pss) { const int k = kk + pss * 32;
#pragma unroll
                for (int j = 0; j < 4; ++j) tl[k * 65 + c4 + j] = v0[pss][j]; } }
        __syncthreads();
        const CvtTile done = c0; c0 = c1; v0[0] = v1[0]; v0[1] = v1[1];
        { const int tn = t + 2 * gs; if (tn < NV) { c1 = cvt_tile_params(p, cvt_vtile<LIST>(tn)); cvt_tile_load(c1, v1); } }
        { const int n = tid >> 3, k8 = (tid & 7) * 8; float e[8];
#pragma unroll
            for (int q = 0; q < 8; ++q) e[q] = tl[(k8 + q) * 65 + n];
            u32x4 w; w.x = cvt_pk_bf16(e[0], e[1]); w.y = cvt_pk_bf16(e[2], e[3]); w.z = cvt_pk_bf16(e[4], e[5]); w.w = cvt_pk_bf16(e[6], e[7]);
            *(u32x4*)(done.dst + (size_t)n * done.dstld + k8) = w; }
        __syncthreads();
    }
}

__device__ __forceinline__ void phase0(const Params& p, unsigned char* sm) {
    unsigned char* ws = p.ws;
    const int tid = threadIdx.x, lane = tid & 63, wid = tid >> 6;
    const size_t gtid = (size_t)blockIdx.x * 512 + tid, gthreads = (size_t)gridDim.x * 512;
    for (size_t i = gtid; i < ZERO_BYTES / 16; i += gthreads) ((u32x4*)(ws + O_ZERO))[i] = (u32x4){0u, 0u, 0u, 0u};
    { const float* pp = p.in[1]; bf16_t* pb = (bf16_t*)(ws + O_PB);
        for (size_t i = gtid; i < (size_t)T_ * 256 / 8; i += gthreads) { const f32x4 a = *(const f32x4*)(pp + i * 8), b = *(const f32x4*)(pp + i * 8 + 4); *(u32x4*)(pb + i * 8) = pack8(a, b); } }
    { const float* x = p.in[0]; const float* g = p.in[2]; const float* win = p.in[3]; const float* bif = p.in[4];
        float* wgT = (float*)sm;
        for (int idx = tid; idx < 8192; idx += 512) { const int k = idx >> 3, j = idx & 7; wgT[j * 1024 + k] = win[(size_t)k * NIN_ + 4096 + j] * g[k]; }
        __syncthreads();
        bf16_t* hb = (bf16_t*)(ws + O_HB); float* ig = (float*)(ws + O_IG); float* lf = (float*)(ws + O_LF);
        const int rstep = gridDim.x * 8; int row = blockIdx.x * 8 + wid;
        f32x4 xn[4];
#pragma unroll
        for (int i = 0; i < 4; ++i) xn[i] = (row < T_) ? *(const f32x4*)(x + (size_t)row * 1024 + i * 256 + lane * 4) : (f32x4){0.f, 0.f, 0.f, 0.f};
        for (; row < T_; row += rstep) {
            f32x4 xv[4]; float ss = 0.f;
#pragma unroll
            for (int i = 0; i < 4; ++i) { xv[i] = xn[i]; ss += xv[i][0] * xv[i][0] + xv[i][1] * xv[i][1] + xv[i][2] * xv[i][2] + xv[i][3] * xv[i][3]; }
            { const int nrow = row + rstep;
                if (nrow < T_) {
#pragma unroll
                    for (int i = 0; i < 4; ++i) xn[i] = *(const f32x4*)(x + (size_t)nrow * 1024 + i * 256 + lane * 4); } }
            ss = wave_sum(ss); const float rs = rsqrtf(ss * (1.0f / 1024.0f) + EPS_);
            float d[8];
#pragma unroll
            for (int j = 0; j < 8; ++j) d[j] = 0.f;
#pragma unroll
            for (int i = 0; i < 4; ++i) { const f32x4 hn = xv[i] * rs; const f32x4 gv = *(const f32x4*)(g + i * 256 + lane * 4); const f32x4 hg = hn * gv;
                u32x2 w; w.x = cvt_pk_bf16(hg[0], hg[1]); w.y = cvt_pk_bf16(hg[2], hg[3]); *(u32x2*)(hb + (size_t)row * 1024 + i * 256 + lane * 4) = w;
#pragma unroll
                for (int j = 0; j < 8; ++j) { const f32x4 wv = *(const f32x4*)(wgT + j * 1024 + i * 256 + lane * 4); d[j] += hn[0] * wv[0] + hn[1] * wv[1] + hn[2] * wv[2] + hn[3] * wv[3]; } }
#pragma unroll
            for (int j = 0; j < 8; ++j) d[j] = wave_sum(d[j]);
            if (lane < 8) { float v = d[0];
#pragma unroll
                for (int j = 1; j < 8; ++j) v = (lane == j) ? d[j] : v;
                v += bif[lane];
                if (lane < 4) ig[(size_t)row * 4 + lane] = v;
                else { const float z = v; lf[(size_t)row * 4 + lane - 4] = fminf(z, 0.f) - log1pf(__expf(-fabsf(z))); } }
        }
        __syncthreads();
    }
    cvt_weights<0>(p, sm, blockIdx.x, gridDim.x);
}

__device__ __forceinline__ void phase2(const Params& p, unsigned char* sm) {
    unsigned char* ws = p.ws;
    const int tid = threadIdx.x, lane = tid & 63, wid = tid >> 6;
    float* rowfac = (float*)sm; float* colfac = rowfac + 256; float* wsum = colfac + 256;
    const float* ig = (const float*)(ws + O_IG); const float* lf = (const float*)(ws + O_LF);
    const bf16_t* qkpre = (const bf16_t*)p.out;
    const float* cw = p.in[5]; const float* cb = p.in[6];
    for (int item = blockIdx.x; item < 256; item += gridDim.x) {
        const int b = item >> 5, h = (item >> 3) & 3, sc = item & 7; const int tokb = b * SEQ_ + sc * 256;
        float v = 0.f, igv = 0.f;
        if (tid < 256) { v = lf[(size_t)(tokb + tid) * 4 + h]; igv = ig[(size_t)(tokb + tid) * 4 + h]; }
#pragma unroll
        for (int o = 1; o < 64; o <<= 1) { const float n = __shfl_up(v, o); if (lane >= o) v += n; }
        if (tid < 256 && lane == 63) wsum[wid] = v;
        __syncthreads();
        if (tid < 256) { float add = 0.f; for (int j = 0; j < wid; ++j) add += wsum[j]; v += add; rowfac[tid] = __expf(v); colfac[tid] = __expf(igv - v);
            if (tid == 255) ((float*)(ws + O_EBL))[item] = __expf(v); }
        __syncthreads();
#pragma unroll 1
        for (int qt = 0; qt < 4; ++qt) {
        const int cp = tid & 127, tg = tid >> 7; const int ch = 2 * cp; const int tl0 = qt * 64 + tg * 16; const int s0 = sc * 256 + tl0;
        { const int col = h * 256 + ch; float x0[19], x1[19];
#pragma unroll
            for (int i = 0; i < 19; ++i) { const int s = s0 - 3 + i; unsigned w = 0u; if (s >= 0) w = *(const unsigned*)(qkpre + (size_t)(b * SEQ_ + s) * 2048 + col); x0[i] = bf_lo(w); x1[i] = bf_hi(w); }
            float w0[4], w1[4];
#pragma unroll
            for (int k = 0; k < 4; ++k) { const f32x2 wv = *(const f32x2*)(cw + (size_t)k * 2048 + col); w0[k] = wv[0]; w1[k] = wv[1]; }
            const f32x2 bv = *(const f32x2*)(cb + col);
            bf16_t* wq = (bf16_t*)(ws + O_WQ) + (size_t)item * 65536;
#pragma unroll
            for (int i = 0; i < 16; ++i) { float y0 = bv[0], y1 = bv[1];
#pragma unroll
                for (int k = 0; k < 4; ++k) { y0 += x0[i + k] * w0[k]; y1 += x1[i + k] * w1[k]; }
                const float f = rowfac[tl0 + i] * 0.0625f;
                *(unsigned*)(wq + (size_t)(tl0 + i) * 256 + ch) = cvt_pk_bf16(silu(y0) * f, silu(y1) * f); } }
        { const int col = 1024 + h * 256 + ch; float x0[19], x1[19];
#pragma unroll
            for (int i = 0; i < 19; ++i) { const int s = s0 - 3 + i; unsigned w = 0u; if (s >= 0) w = *(const unsigned*)(qkpre + (size_t)(b * SEQ_ + s) * 2048 + col); x0[i] = bf_lo(w); x1[i] = bf_hi(w); }
            float w0[4], w1[4];
#pragma unroll
            for (int k = 0; k < 4; ++k) { const f32x2 wv = *(const f32x2*)(cw + (size_t)k * 2048 + col); w0[k] = wv[0]; w1[k] = wv[1]; }
            const f32x2 bv = *(const f32x2*)(cb + col);
            bf16_t* kw = (bf16_t*)(ws + O_KW) + (size_t)item * 65536; bf16_t* kwt = (bf16_t*)(ws + O_KWT) + (size_t)item * 65536;
            float k0[16], k1[16]; float n0 = 0.f, n1 = 0.f;
#pragma unroll
            for (int i = 0; i < 16; ++i) { float y0 = bv[0], y1 = bv[1];
#pragma unroll
                for (int k = 0; k < 4; ++k) { y0 += x0[i + k] * w0[k]; y1 += x1[i + k] * w1[k]; }
                const float f = colfac[tl0 + i]; k0[i] = silu(y0) * f; k1[i] = silu(y1) * f; n0 += k0[i]; n1 += k1[i];
                *(unsigned*)(kw + (size_t)(tl0 + i) * 256 + ch) = cvt_pk_bf16(k0[i], k1[i]); }
            u32x4 a, c;
            a.x = cvt_pk_bf16(k0[0], k0[1]); a.y = cvt_pk_bf16(k0[2], k0[3]); a.z = cvt_pk_bf16(k0[4], k0[5]); a.w = cvt_pk_bf16(k0[6], k0[7]);
            c.x = cvt_pk_bf16(k0[8], k0[9]); c.y = cvt_pk_bf16(k0[10], k0[11]); c.z = cvt_pk_bf16(k0[12], k0[13]); c.w = cvt_pk_bf16(k0[14], k0[15]);
            *(u32x4*)(kwt + (size_t)ch * 256 + tl0) = a; *(u32x4*)(kwt + (size_t)ch * 256 + tl0 + 8) = c;
            a.x = cvt_pk_bf16(k1[0], k1[1]); a.y = cvt_pk_bf16(k1[2], k1[3]); a.z = cvt_pk_bf16(k1[4], k1[5]); a.w = cvt_pk_bf16(k1[6], k1[7]);
            c.x = cvt_pk_bf16(k1[8], k1[9]); c.y = cvt_pk_bf16(k1[10], k1[11]); c.z = cvt_pk_bf16(k1[12], k1[13]); c.w = cvt_pk_bf16(k1[14], k1[15]);
            *(u32x4*)(kwt + (size_t)(ch + 1) * 256 + tl0) = a; *(u32x4*)(kwt + (size_t)(ch + 1) * 256 + tl0 + 8) = c;
            float* nsum = (float*)(ws + O_NSUM) + (size_t)item * 256;
            unsafeAtomicAdd(nsum + ch, n0); unsafeAtomicAdd(nsum + ch + 1, n1); }
        }
        __syncthreads();
    }
}

__device__ __forceinline__ void phase4(const Params& p, unsigned char* sm) {
    unsigned char* ws = p.ws;
    const int tid = threadIdx.x;
    const float* ebl = (const float*)(ws + O_EBL);
    const bf16_t* lt = (const bf16_t*)(p.ws + O_KWT);
    bf16_t* cint = (bf16_t*)(ws + O_CINT);
    const size_t gtid = (size_t)blockIdx.x * 512 + tid, gthreads = (size_t)gridDim.x * 512;
    for (size_t g = gtid; g < (size_t)32 * 16384; g += gthreads) {
        const int bh = (int)(g >> 14), e4 = (int)(g & 16383);
        f32x4 c = {0.f, 0.f, 0.f, 0.f};
        u32x2 lw[7]; float eb[7];
#pragma unroll
        for (int sc = 0; sc < 7; ++sc) { lw[sc] = *(const u32x2*)(lt + (size_t)(bh * 8 + sc) * 65536 + e4 * 4); eb[sc] = ebl[bh * 8 + sc]; }
#pragma unroll
        for (int sc = 0; sc < 8; ++sc) { const int item = bh * 8 + sc;
            u32x2 w; w.x = cvt_pk_bf16(c[0], c[1]); w.y = cvt_pk_bf16(c[2], c[3]); *(u32x2*)(cint + (size_t)item * 65536 + e4 * 4) = w;
            if (sc < 7) { const f32x4 l = {bf_lo(lw[sc].x), bf_hi(lw[sc].x), bf_lo(lw[sc].y), bf_hi(lw[sc].y)}; c = (c + l) * eb[sc]; } }
    }
    float* nin = (float*)sm;
    const float* nsum = (const float*)(ws + O_NSUM);
    float* denx = (float*)(ws + O_DENX);
    for (int item = blockIdx.x; item < 256; item += gridDim.x) {
        const int b = item >> 5, h = (item >> 3) & 3, sc = item & 7; const int tokb = b * SEQ_ + sc * 256; const int bh = item >> 3;
        if (tid < 256) { float eb[7], ns[7];
#pragma unroll
            for (int j = 0; j < 7; ++j) { eb[j] = ebl[bh * 8 + j]; ns[j] = nsum[(size_t)(bh * 8 + j) * 256 + tid]; }
            float nv = 0.f;
#pragma unroll
            for (int j = 0; j < 7; ++j) if (j < sc) nv = eb[j] * (nv + ns[j]);
            nin[tid] = nv; }
        __syncthreads();
        const int tl = tid >> 1, half = tid & 1;
        const bf16_t* wq = (const bf16_t*)(ws + O_WQ) + (size_t)item * 65536 + (size_t)tl * 256 + half * 128;
        float d = 0.f;
#pragma unroll
        for (int i = 0; i < 16; ++i) { f32x4 a0, a1; unpack8(*(const u32x4*)(wq + i * 8), a0, a1); const float* nn = nin + half * 128 + i * 8;
            d += a0[0] * nn[0] + a0[1] * nn[1] + a0[2] * nn[2] + a0[3] * nn[3] + a1[0] * nn[4] + a1[1] * nn[5] + a1[2] * nn[6] + a1[3] * nn[7]; }
        d += __shfl_xor(d, 1);
        if (half == 0) denx[(size_t)(tokb + tl) * 4 + h] = d;
        __syncthreads();
    }
}

__device__ __forceinline__ void phase7(const Params& p, unsigned char* sm) {
    unsigned char* ws = p.ws;
    const int tid = threadIdx.x, lane = tid & 63, wid = tid >> 6;
    const bf16_t* uu = (const bf16_t*)p.out; bf16_t* uc = (bf16_t*)(ws + O_UC);
    const float* cw = p.in[8]; const float* cb = p.in[9]; const float* lg = p.in[10]; const float* lb = p.in[11];
    u32x4 pf[12];
#define P7_LOAD(tile_) do { const int t0_ = (tile_) * 16; const int b_ = t0_ / SEQ_, s0_ = t0_ % SEQ_; \
        _Pragma("unroll") for (int q = 0; q < 12; ++q) { const int idx = tid + q * 512; const int r = idx >> 7, c16 = idx & 127; const int s_ = s0_ - 30 + r; \
            pf[q] = (u32x4){0u, 0u, 0u, 0u}; if (idx < 46 * 128 && s_ >= 0) pf[q] = *(const u32x4*)(uu + (size_t)(b_ * SEQ_ + s_) * 1024 + c16 * 8); } } while (0)
    int tile = blockIdx.x;
    if (tile < 1024) P7_LOAD(tile);
    f32x2 wv[31];
#pragma unroll
    for (int k = 0; k < 31; ++k) wv[k] = *(const f32x2*)(cw + (size_t)k * 1024 + 2 * tid);
    const f32x2 bv = *(const f32x2*)(cb + 2 * tid);
    for (; tile < 1024; tile += gridDim.x) {
        const int t0 = tile * 16;
#pragma unroll
        for (int q = 0; q < 12; ++q) { const int idx = tid + q * 512; const int r = idx >> 7, c16 = idx & 127; if (idx < 46 * 128) *(u32x4*)(sm + r * 2048 + c16 * 16) = pf[q]; }
        __syncthreads();
        f32x2 yy[16];
        {
#pragma unroll
            for (int t = 0; t < 16; ++t) yy[t] = bv;
#pragma unroll
            for (int r = 0; r < 46; ++r) { const unsigned w = *(const unsigned*)(sm + r * 2048 + tid * 4); const f32x2 xx = {bf_lo(w), bf_hi(w)};
#pragma unroll
                for (int t = 0; t < 16; ++t) { const int k = r - t; if (k >= 0 && k <= 30) yy[t] = __builtin_elementwise_fma(wv[k], xx, yy[t]); }
                if ((r & 3) == 3) asm volatile("" ::: "memory"); }
        }
        __syncthreads();
#pragma unroll
        for (int t = 0; t < 16; ++t) *(f32x2*)(sm + t * 4096 + tid * 8) = yy[t];
        { const int tn = tile + gridDim.x; if (tn < 1024) P7_LOAD(tn); }
        __syncthreads();
#pragma unroll 1
        for (int tt = 0; tt < 2; ++tt) { const int t = wid * 2 + tt; f32x4 v[4]; float s1 = 0.f;
#pragma unroll
            for (int i = 0; i < 4; ++i) { v[i] = *(const f32x4*)(sm + t * 4096 + (i * 256 + lane * 4) * 4); s1 += v[i][0] + v[i][1] + v[i][2] + v[i][3]; }
            s1 = wave_sum(s1); const float mu = s1 * (1.0f / 1024.0f); float s2 = 0.f;
#pragma unroll
            for (int i = 0; i < 4; ++i) { v[i] = v[i] - mu; s2 += v[i][0] * v[i][0] + v[i][1] * v[i][1] + v[i][2] * v[i][2] + v[i][3] * v[i][3]; }
            s2 = wave_sum(s2); const float rstd = rsqrtf(s2 * (1.0f / 1024.0f) + EPS_);
#pragma unroll
            for (int i = 0; i < 4; ++i) { const int c = i * 256 + lane * 4; const f32x4 gv = *(const f32x4*)(lg + c), bb = *(const f32x4*)(lb + c); f32x4 z = v[i] * rstd * gv + bb;
                u32x2 w; w.x = cvt_pk_bf16(silu(z[0]), silu(z[1])); w.y = cvt_pk_bf16(silu(z[2]), silu(z[3])); *(u32x2*)(uc + (size_t)(t0 + t) * 1024 + c) = w; } }
        __syncthreads();
    }
#undef P7_LOAD
}

__device__ __forceinline__ void phase13(const Params& p) {
    const float* ssq3 = (const float*)(p.ws + O_SSQ3); const float* fg = p.in[22];
    const size_t gtid = (size_t)blockIdx.x * 512 + threadIdx.x, gthreads = (size_t)gridDim.x * 512;
    for (size_t i = gtid; i < (size_t)T_ * 256; i += gthreads) { const int row = (int)(i >> 8), c = (int)(i & 255) * 4;
        const float rs = rsqrtf(ssq3[row] * (1.0f / 1024.0f) + EPS_); const f32x4 g = *(const f32x4*)(fg + c);
        f32x4 v = *(const f32x4*)(p.out + i * 4); v = v * rs * g; *(f32x4*)(p.out + i * 4) = v; }
}

#define XB_TMO      128
#define XB_XCNT(j)  (256  + 64 * (j))
#define XB_XSUB(j)  (1280 + 64 * (j))
#define XB_XGEN(j)  (2304 + 64 * (j))
#define XB_TOP      3328
#define XB_TOPGEN   3392
#define XCD_BAR_WORDS 3456
#define XB_SPIN_CAP (1u << 18)
__device__ __forceinline__ unsigned xb_ld(unsigned* p)              { return __hip_atomic_load(p, __ATOMIC_RELAXED, __HIP_MEMORY_SCOPE_AGENT); }
__device__ __forceinline__ unsigned xb_add(unsigned* p, unsigned v) { return __hip_atomic_fetch_add(p, v, __ATOMIC_RELAXED, __HIP_MEMORY_SCOPE_AGENT); }
__device__ __forceinline__ unsigned xb_xcc_id() { return (unsigned)__builtin_amdgcn_s_getreg((3 << 11) | 20) & 0xFu; }
#define XB_SPIN(cond, bar) do { unsigned _sp = 0; while (cond) { __builtin_amdgcn_s_sleep(1); \
    if ((++_sp & 255u) == 0u) { if (xb_ld(&(bar)[XB_TMO])) break; if (_sp > XB_SPIN_CAP) { atomicAdd(&(bar)[XB_TMO], 1u); break; } } } } while (0)
struct XcdBarrier { unsigned* bar; unsigned x; volatile LAS unsigned* st; };
__device__ __forceinline__ XcdBarrier xcd_barrier_post(unsigned* bar, volatile LAS unsigned* st) {
    XcdBarrier b; b.bar = bar; b.x = xb_xcc_id(); b.st = st;
    if (threadIdx.x == 0) (void)xb_add(&bar[XB_XCNT(b.x)], 1u);
    return b;
}
__device__ __forceinline__ void xcd_barrier_complete(unsigned* bar, unsigned x, unsigned& nloc, unsigned& nx) {
    const unsigned G = gridDim.x * gridDim.y * gridDim.z;
    unsigned sum, cnt, mine, sp = 0u;
    for (;;) {
        sum = 0u; cnt = 0u; mine = 0u;
#pragma unroll
        for (unsigned j = 0; j < 16; ++j) { const unsigned c = xb_ld(&bar[XB_XCNT(j)]); sum += c; cnt += (c > 0u) ? 1u : 0u; mine = (j == x) ? c : mine; }
        if (sum == G) break;
        __builtin_amdgcn_s_sleep(1);
        if ((++sp & 255u) == 0u) { if (xb_ld(&bar[XB_TMO])) break; if (sp > XB_SPIN_CAP) { atomicAdd(&bar[XB_TMO], 1u); break; } }
    }
    nloc = mine > 0u ? mine : 1u; nx = cnt > 0u ? cnt : 1u;
}
__device__ __forceinline__ void xcd_barrier(const XcdBarrier& b) {
    asm volatile("s_waitcnt vmcnt(0)" ::: "memory");
    __syncthreads();
    if (threadIdx.x == 0) {
        unsigned* bar = b.bar;
        __builtin_amdgcn_s_waitcnt(0);
        unsigned nloc = b.st[0], nx = b.st[1];
        if (nloc == 0u) { xcd_barrier_complete(bar, b.x, nloc, nx); b.st[0] = nloc; b.st[1] = nx; }
        const unsigned old = xb_add(&bar[XB_XSUB(b.x)], 1u);
        const unsigned gen = old / nloc;
        if (old + 1u == (gen + 1u) * nloc) {
            __builtin_amdgcn_fence(__ATOMIC_RELEASE, "agent");
            asm volatile("s_waitcnt vmcnt(0)" ::: "memory");
            const unsigned og = xb_add(&bar[XB_TOP], 1u);
            const unsigned tg = og / nx;
            if (og + 1u == (tg + 1u) * nx) xb_add(&bar[XB_TOPGEN], 1u);
            else XB_SPIN(xb_ld(&bar[XB_TOPGEN]) == tg, bar);
            __builtin_amdgcn_fence(__ATOMIC_ACQUIRE, "agent");
            xb_add(&bar[XB_XGEN(b.x)], 1u);
            asm volatile("s_waitcnt vmcnt(0)" ::: "memory");
        } else {
            XB_SPIN(xb_ld(&bar[XB_XGEN(b.x)]) == gen, bar);
            __builtin_amdgcn_fence(__ATOMIC_ACQUIRE, "agent");
            asm volatile("s_waitcnt vmcnt(0)" ::: "memory");
        }
    }
    __syncthreads();
}

template <bool COOP>
__global__ void __launch_bounds__(512, 2) mk_fwd(Params p) {
    extern __shared__ __attribute__((aligned(16))) unsigned char shm[];
    LAS unsigned char* lds = (LAS unsigned char*)shm;
    unsigned char* ws = p.ws;
    const int G = gridDim.x, c = blockIdx.x;
#ifndef PHMASK
#define PHMASK 0x3fff
#endif
#define PH(k) if (((PHMASK >> (k)) & 1) && p.ph_lo <= (k) && (k) < p.ph_hi)
    XcdBarrier xb{};
    if (COOP) { volatile LAS unsigned* st = (volatile LAS unsigned*)(lds + 131072);
        if (threadIdx.x == 0) { st[0] = 0u; st[1] = 0u; }
        __syncthreads();
        xb = xcd_barrier_post((unsigned*)(ws + O_BAR), st); }
#define SYNC(k) if (COOP) { if (p.ph_lo <= (k) && (k) + 1 < p.ph_hi) { xcd_barrier(xb); } }
    PH(0) phase0(p, shm);
    SYNC(0)
    PH(1) { SchedP1 S{(const char*)(ws + O_HB), (const char*)(ws + O_WINT), G, c}; EpiP1 E{(bf16_t*)p.out, (bf16_t*)(ws + O_VT)}; gemm_phase(lds, 1024, 1024, 1024, S, E); }
    SYNC(1)
    PH(3) { phase2(p, shm);
        asm volatile("s_waitcnt vmcnt(0)" ::: "memory"); __syncthreads();
        SchedP3 S{(const char*)(ws + O_WQ), (const char*)(ws + O_KW), (const char*)(ws + O_VT), (const char*)(ws + O_KWT), G, c};
        EpiP3 E{(bf16_t*)(ws + O_SS), (bf16_t*)(ws + O_KWT), (float*)(ws + O_DENI)}; gemm_phase(lds, 256, 256, 256, S, E); }
    SYNC(3)
    PH(4) phase4(p, shm);
    SYNC(4)
    PH(6) { { SchedP5 S{(const char*)(ws + O_SS), (const char*)(ws + O_VT), (const char*)(ws + O_WQ), (const char*)(ws + O_CINT), G, c};
            EpiP5 E{(bf16_t*)(ws + O_HM), (const float*)(ws + O_DENI), (const float*)(ws + O_DENX), (float*)(ws + O_HSS)}; gemm_phase(lds, 256, 256, 256, S, E); }
        { SchedP6 S{(const char*)(ws + O_HB), (const char*)(ws + O_WINT), G, c};
            EpiP6 E{(bf16_t*)(ws + O_HM), (float*)(ws + O_HSS), p.in[7], (bf16_t*)p.out}; gemm_phase(lds, 1024, 1024, 1024, S, E); } }
    SYNC(6)
    PH(7) phase7(p, shm);
    SYNC(7)
    PH(8) { SchedP8 S{(const char*)(ws + O_HB), (const char*)(ws + O_WINT), (const char*)(ws + O_HM), (const char*)(ws + O_UC), (const char*)(ws + O_WMT), (const char*)(ws + O_WCT), G, c};
        EpiP8 E{(bf16_t*)(ws + O_GMC), (bf16_t*)p.out + (size_t)T_ * 1024, (bf16_t*)(ws + O_MERGED)}; gemm_phase(lds, 1024, 1024, 1024, S, E); }
    SYNC(8)
    PH(9) { SchedN4 S{(const char*)(ws + O_MERGED), (const char*)(ws + O_WOT), (size_t)256 * 1024 * 2, (size_t)256 * 1024 * 2, G, c};
        EpiRes<false> E{p.in[0], (bf16_t*)(ws + O_X1B), (float*)(ws + O_SSQ1)}; gemm_phase(lds, 1024, 1024, 1024, S, E); }
    SYNC(9)
    PH(10) { { SchedP10 S{(const char*)(ws + O_X1B), (const char*)(ws + O_WGUT), G, c}; EpiP10 E{(const float*)(ws + O_SSQ1), (bf16_t*)(ws + O_HID)}; gemm_phase(lds, 1024, 1024, 1024, S, E); }
        { const int h = G >> 1; SchedPE S{(const char*)(ws + O_PB), (const char*)(ws + O_WPPT), h, c - h};
            EpiBf E{(bf16_t*)(ws + O_PE)}; if (c >= h) { gemm_phase(lds, 256, 256, 256, S, E); cvt_weights<1>(p, shm, c - h, h); } } }
    SYNC(10)
    PH(11) { SchedN4 S{(const char*)(ws + O_HID), (const char*)(ws + O_WDT), (size_t)256 * DFF_ * 2, (size_t)256 * DFF_ * 2, G, c};
            EpiRes<true> E{(const void*)(ws + O_X1B), (bf16_t*)(ws + O_X2B), (float*)(ws + O_SSQ2)}; gemm_phase(lds, DFF_, DFF_, DFF_, S, E); }
    SYNC(11)
    PH(12) { SchedN4 S{(const char*)(ws + O_X2B), (const char*)(ws + O_WPGT), (size_t)256 * 1024 * 2, (size_t)256 * 1024 * 2, G, c};
        EpiP12 E{(const float*)(ws + O_SSQ2), (const bf16_t*)(ws + O_PE), (const bf16_t*)(ws + O_X2B), p.out, (float*)(ws + O_SSQ3), (unsigned*)(ws + O_BAR) + XCD_BAR_WORDS, p.in[22]}; gemm_phase(lds, 1024, 1024, 1024, S, E); }
#undef PH
#undef SYNC
}

extern "C" void kernel_launch(void* const* d_in, const int* in_sizes, int n_in, void* d_out, int out_size, void* d_ws, size_t ws_size, hipStream_t stream) {
    static int grid = 0;
    if (grid == 0) {
        if (n_in != 23 || out_size != T_ * D_ || ws_size < WS_NEED) { fprintf(stderr, "kernel_launch: unexpected shapes (n_in %d, out %d, ws %zu)\n", n_in, out_size, ws_size); grid = -1; return; }
        int dev = 0, cus = 0, per_cu = 0;
        hipGetDevice(&dev); hipDeviceGetAttribute(&cus, hipDeviceAttributeMultiprocessorCount, dev);
        hipFuncSetAttribute((const void*)mk_fwd<true>, hipFuncAttributeMaxDynamicSharedMemorySize, LDS_BYTES);
        hipFuncSetAttribute((const void*)mk_fwd<false>, hipFuncAttributeMaxDynamicSharedMemorySize, LDS_BYTES);
        hipOccupancyMaxActiveBlocksPerMultiprocessor(&per_cu, (const void*)mk_fwd<true>, 512, LDS_BYTES);
        if (per_cu < 1) { fprintf(stderr, "kernel_launch: occupancy query reports %d blocks per CU\n", per_cu); per_cu = 1; }
        (void)hipGetLastError();
        grid = cus;
        if (grid != 256) { fprintf(stderr, "kernel_launch: built for a 256-CU device (got %d CUs)\n", cus); grid = -1; return; }
    }
    if (grid < 0) return;
    Params p{};
    for (int i = 0; i < 23; ++i) p.in[i] = (const float*)d_in[i];
    p.out = (float*)d_out; p.ws = (unsigned char*)d_ws;
#if MK_MULTI
#ifndef PROBE_DUP
#define PROBE_DUP -1
#endif
    for (int k = 0; k < NPHASE; ++k) { p.ph_lo = k; p.ph_hi = k + 1; hipLaunchKernelGGL(mk_fwd<false>, dim3(grid), dim3(512), LDS_BYTES, stream, p);
        if (k == PROBE_DUP) hipLaunchKernelGGL(mk_fwd<false>, dim3(grid), dim3(512), LDS_BYTES, stream, p); }
#else
    p.ph_lo = 0; p.ph_hi = NPHASE;
    if (hipMemsetAsync((unsigned char*)d_ws + O_BAR, 0, (XCD_BAR_WORDS + 64 * 64) * 4, stream) != hipSuccess) { fprintf(stderr, "kernel_launch: memset of barrier words failed\n"); return; }
    void* args[] = {&p};
    hipError_t e = hipLaunchCooperativeKernel((const void*)mk_fwd<true>, dim3(grid), dim3(512), args, LDS_BYTES, stream);
    if (e != hipSuccess) fprintf(stderr, "cooperative launch failed: %s (grid %d)\n", hipGetErrorString(e), grid);
#endif
}
```

```cpp
#include <hip/hip_runtime.h>
#include <hip/hip_cooperative_groups.h>
#include <cstdio>
namespace cg = cooperative_groups;

#ifndef MK_MULTI
#define MK_MULTI 0
#endif

#define LAS __attribute__((address_space(3)))
typedef unsigned short bf16_t;
typedef short bf16x8 __attribute__((ext_vector_type(8)));
typedef float f32x4 __attribute__((ext_vector_type(4)));
typedef float f32x2 __attribute__((ext_vector_type(2)));
typedef unsigned u32x4 __attribute__((ext_vector_type(4)));
typedef unsigned u32x2 __attribute__((ext_vector_type(2)));

constexpr int T_ = 16384, D_ = 1024, NIN_ = 8200, DFF_ = 2816, SEQ_ = 2048;
constexpr float EPS_ = 1e-6f;
constexpr int BM = 256, BK = 64, HALF = 128, HTB = HALF * BK * 2, STAGE_BYTES = 8 * HTB;
constexpr int LDS_BYTES = 136 * 1024;
constexpr int NPHASE = 13;

constexpr size_t KiB = 1024, MiB = 1024 * 1024;
constexpr size_t O_WINT = 0, O_WMT = 16 * MiB, O_WCT = 18 * MiB, O_WOT = 20 * MiB, O_WPGT = 22 * MiB, O_WGUT = 24 * MiB, O_WDT = 35 * MiB, O_WPPT = 40 * MiB + 512 * KiB;
constexpr size_t O_IG = 41 * MiB, O_LF = O_IG + 256 * KiB, O_ZERO = O_LF + 256 * KiB;
constexpr size_t O_DENI = O_ZERO, O_HSS = O_DENI + 256 * KiB, O_SSQ1 = O_HSS + 256 * KiB, O_SSQ2 = O_SSQ1 + 64 * KiB, O_SSQ3 = O_SSQ2 + 64 * KiB, O_NSUM = O_SSQ3 + 64 * KiB;
constexpr size_t ZERO_BYTES = 960 * KiB;
constexpr size_t O_DENX = O_ZERO + ZERO_BYTES, O_EBL = O_DENX + 256 * KiB;
constexpr size_t O_BAR = 43 * MiB;
constexpr size_t O_PB = 44 * MiB, O_HB = 52 * MiB, O_S1 = 84 * MiB, O_S2 = 116 * MiB, O_S3 = 148 * MiB, O_S4 = 180 * MiB, O_S5 = 212 * MiB, WS_NEED = 244 * MiB;
constexpr size_t O_PE = O_HB, O_VT = O_S1, O_U = O_S1, O_MERGED = O_S1, O_HID = O_S1, O_WQ = O_S2, O_GMC = O_S2, O_KW = O_S3, O_CINT = O_S3,
                 O_KWT = O_S4, O_HM = O_S4, O_X1B = O_S4, O_SS = O_S5, O_UC = O_S5, O_X2B = O_S5;

struct Params {
    const float* in[23];
    float* out;
    unsigned char* ws;
    int ph_lo, ph_hi;
};

__device__ __forceinline__ unsigned cvt_pk_bf16(float lo, float hi) { unsigned r; asm volatile("v_cvt_pk_bf16_f32 %0, %1, %2" : "=v"(r) : "v"(lo), "v"(hi)); return r; }
__device__ __forceinline__ float bf_lo(unsigned w) { return __uint_as_float(w << 16); }
__device__ __forceinline__ float bf_hi(unsigned w) { return __uint_as_float(w & 0xffff0000u); }
__device__ __forceinline__ float sigm(float x) { return __builtin_amdgcn_rcpf(1.0f + __builtin_amdgcn_exp2f(x * -1.4426950408889634f)); }
__device__ __forceinline__ float silu(float x) { return x * __builtin_amdgcn_rcpf(1.0f + __builtin_amdgcn_exp2f(x * -1.4426950408889634f)); }
__device__ __forceinline__ float wave_sum(float v) {
#pragma unroll
    for (int o = 32; o > 0; o >>= 1) v += __shfl_xor(v, o);
    return v;
}
__device__ __forceinline__ u32x4 pack8(const f32x4 a, const f32x4 b) { u32x4 w; w.x = cvt_pk_bf16(a[0], a[1]); w.y = cvt_pk_bf16(a[2], a[3]); w.z = cvt_pk_bf16(b[0], b[1]); w.w = cvt_pk_bf16(b[2], b[3]); return w; }
__device__ __forceinline__ void unpack8(const u32x4 w, f32x4& a, f32x4& b) { a[0] = bf_lo(w.x); a[1] = bf_hi(w.x); a[2] = bf_lo(w.y); a[3] = bf_hi(w.y); b[0] = bf_lo(w.z); b[1] = bf_hi(w.z); b[2] = bf_lo(w.w); b[3] = bf_hi(w.w); }

__host__ __device__ __forceinline__ int lds_byte(int r, int c) { const int st = (r >> 4) * 2 + (c >> 5), rr = r & 15, cc = c & 31, ob = rr * 64 + cc * 2; return st * 1024 + (ob ^ (((ob >> 9) & 1) << 5)); }
__host__ __device__ __forceinline__ void stage_rc(int b, int& R, int& C) { const int st = b / 1024, sb = b % 1024, swz = sb ^ (((sb >> 9) & 1) << 5); R = (st >> 1) * 16 + swz / 64; C = (st & 1) * 32 + (swz % 64) / 2; }
__host__ __device__ __forceinline__ int perm32(int rho) { const int n = rho >> 4, i = rho & 15; return 8 * (i >> 2) + 4 * n + (i & 3); }

struct Unit { const char* a; const char* b; int pm, pn, kind, cont; };
__device__ __forceinline__ void map_n4(int L, int& pm, int& pn) { const int x = L & 7, k = L >> 3; pm = x * 8 + (k & 7); pn = k >> 3; }

__device__ __forceinline__ void tile_order(int L, int nM, int nN, int& pm, int& pn) {
    const int nwg = nM * nN; int wgid = L;
    { const int q = nwg / 8, r = nwg % 8, xcd = wgid % 8, off = wgid / 8; wgid = (xcd < r ? xcd * (q + 1) : r * (q + 1) + (xcd - r) * q) + off; }
    const int nig = 8 * nN, gid = wgid / nig, fm = gid * 8, gsz = (nM - fm) < 8 ? (nM - fm) : 8;
    pm = fm + ((wgid % nig) % gsz); pn = (wgid % nig) / gsz;
}

template <class Epi, class Sched>
__device__ __forceinline__ void gemm_phase(LAS unsigned char* lds, const int K, const int lda, const int ldb, const Sched& S, const Epi& E) {
    const int tid = threadIdx.x, wid = __builtin_amdgcn_readfirstlane(tid >> 6), lane = tid & 63, wr = wid >> 2, wc = wid & 3, fr = lane & 15, fq = lane >> 4;
    const int nt = K / BK;
    unsigned voffA[2], voffB[2];
#pragma unroll
    for (int i = 0; i < 2; ++i) { int R, C; stage_rc(tid * 16 + i * 8192, R, C); const int Rb = (R & ~31) + perm32(R & 31);
        voffA[i] = (unsigned)(R * lda + C) * 2u; voffB[i] = (unsigned)(Rb * ldb + C) * 2u; }
    const size_t kstep = (size_t)(BK * 2);
    const size_t hstepA = (size_t)HALF * lda * 2, hstepB = (size_t)HALF * ldb * 2;
    const unsigned ldsw = (unsigned)wid * 1024u;
    const int aoff = lds_byte(wr * 64 + fr, fq * 8), boff = lds_byte(wc * 32 + fr, fq * 8);
#define PG8_SA(b, h) (((b) * 2 + (h)) * HTB)
#define PG8_SB(b, h) ((4 + (b) * 2 + (h)) * HTB)
#define PG8_STAGE(bufoff, gbase, voff) do { _Pragma("unroll") for (int _i = 0; _i < 2; ++_i) \
        __builtin_amdgcn_global_load_lds((const unsigned*)((const char*)(gbase) + (voff)[_i]), (LAS unsigned*)(lds + (bufoff) + ldsw + _i * 8192), 16, 0, 0); } while (0)
#define PG8_LDA(dst, b, h) do { _Pragma("unroll") for (int m = 0; m < 4; ++m) _Pragma("unroll") for (int k = 0; k < 2; ++k) dst[m][k] = *(const LAS bf16x8*)(lds + PG8_SA(b, h) + aoff + m * 2048 + k * 1024); } while (0)
#define PG8_LDB(dst, b, h) do { _Pragma("unroll") for (int n = 0; n < 2; ++n) _Pragma("unroll") for (int k = 0; k < 2; ++k) dst[n][k] = *(const LAS bf16x8*)(lds + PG8_SB(b, h) + boff + n * 2048 + k * 1024); } while (0)
#define PG8_MMA(ai, bj, At, Bt) do { __builtin_amdgcn_s_setprio(1); _Pragma("unroll") for (int m = 0; m < 4; ++m) _Pragma("unroll") for (int n = 0; n < 2; ++n) _Pragma("unroll") for (int k = 0; k < 2; ++k) \
        acc[ai][bj][m][n] = __builtin_amdgcn_mfma_f32_16x16x32_bf16(Bt[n][k], At[m][k], acc[ai][bj][m][n], 0, 0, 0); __builtin_amdgcn_s_setprio(0); } while (0)
#define PG8_WAIT_V(n) asm volatile("s_waitcnt vmcnt(" #n ")" ::: "memory")
#define PG8_WAIT_L(n) asm volatile("s_waitcnt lgkmcnt(" #n ")" ::: "memory")
#define PG8_BAR __builtin_amdgcn_s_barrier()
#define PG8_SCHED __builtin_amdgcn_sched_barrier(0)
#define PG8_ZERO() do { _Pragma("unroll") for (int a = 0; a < 2; ++a) _Pragma("unroll") for (int b = 0; b < 2; ++b) _Pragma("unroll") for (int m = 0; m < 4; ++m) _Pragma("unroll") for (int n = 0; n < 2; ++n) acc[a][b][m][n] = (f32x4){0.f, 0.f, 0.f, 0.f}; } while (0)
    Unit cur, nxt; int ui = 0;
    if (!S.next(0, cur)) return;
    E.pre(cur, wr, wc, fr, fq);
    f32x4 acc[2][2][4][2];
    PG8_ZERO();
    bf16x8 At[4][2], B0[2][2], B1[2][2];
    const char* cA = cur.a; const char* cB = cur.b;
    PG8_STAGE(PG8_SB(0, 0), cB, voffB); PG8_STAGE(PG8_SA(0, 0), cA, voffA); PG8_STAGE(PG8_SB(0, 1), cB + hstepB, voffB); PG8_STAGE(PG8_SA(0, 1), cA + hstepA, voffA);
    if (wr == 1) PG8_BAR;
    PG8_WAIT_V(4); PG8_BAR;
    PG8_STAGE(PG8_SB(1, 0), cB + kstep, voffB); PG8_STAGE(PG8_SA(1, 0), cA + kstep, voffA); PG8_STAGE(PG8_SB(1, 1), cB + hstepB + kstep, voffB);
    PG8_WAIT_V(6); PG8_BAR;
    for (;;) {
        const bool has_next = S.next(ui + 1, nxt);
        const char* nA = has_next ? nxt.a : cA; const char* nB = has_next ? nxt.b : cB;
#pragma unroll 1
        for (int t = 0; t < nt; t += 2) {
            const bool last = (t == nt - 2);
            const char* a1 = cA + (size_t)(t + 1) * kstep;
            const char* a2 = last ? nA : cA + (size_t)(t + 2) * kstep; const char* b2 = last ? nB : cB + (size_t)(t + 2) * kstep;
            const char* a3 = a2 + kstep; const char* b3 = b2 + kstep;
            PG8_LDB(B0, 0, 0); PG8_SCHED; PG8_LDA(At, 0, 0); PG8_STAGE(PG8_SA(1, 1), a1 + hstepA, voffA);
            PG8_WAIT_L(8); PG8_BAR; PG8_WAIT_L(0); PG8_MMA(0, 0, At, B0); PG8_BAR; PG8_SCHED;
            PG8_LDB(B1, 0, 1); PG8_STAGE(PG8_SB(0, 0), b2, voffB);
            PG8_BAR; PG8_WAIT_L(0); PG8_MMA(0, 1, At, B1); PG8_BAR;
            PG8_LDA(At, 0, 1); PG8_STAGE(PG8_SA(0, 0), a2, voffA);
            PG8_BAR; PG8_WAIT_L(0); PG8_MMA(1, 0, At, B0); PG8_BAR; PG8_SCHED;
            PG8_STAGE(PG8_SB(0, 1), b2 + hstepB, voffB);
            PG8_WAIT_V(6); PG8_BAR; PG8_MMA(1, 1, At, B1); PG8_BAR;
            PG8_LDB(B0, 1, 0); PG8_SCHED; PG8_LDA(At, 1, 0); PG8_STAGE(PG8_SA(0, 1), a2 + hstepA, voffA);
            PG8_WAIT_L(8); PG8_BAR; PG8_WAIT_L(0); PG8_MMA(0, 0, At, B0); PG8_BAR; PG8_SCHED;
            PG8_LDB(B1, 1, 1); PG8_STAGE(PG8_SB(1, 0), b3, voffB);
            PG8_BAR; PG8_WAIT_L(0); PG8_MMA(0, 1, At, B1); PG8_BAR;
            PG8_LDA(At, 1, 1); PG8_STAGE(PG8_SA(1, 0), a3, voffA);
            PG8_BAR; PG8_WAIT_L(0); PG8_MMA(1, 0, At, B0); PG8_BAR; PG8_SCHED;
            PG8_STAGE(PG8_SB(1, 1), b3 + hstepB, voffB);
            PG8_WAIT_V(6); PG8_BAR; PG8_MMA(1, 1, At, B1); PG8_BAR;
        }
        if (cur.cont) { E.mid(acc, cur, wr, wc, fr, fq); }
        else { if constexpr (!Epi::AFTER_DRAIN) E(acc, cur, wr, wc, fr, fq); if (!has_next) break; PG8_ZERO(); }
        cur = nxt; cA = nA; cB = nB; ++ui;
    }
    PG8_WAIT_V(0);
    if (wr == 0) PG8_BAR;
    PG8_BAR;
    if constexpr (Epi::AFTER_DRAIN) E(acc, cur, wr, wc, fr, fq);
#undef PG8_SA
#undef PG8_SB
#undef PG8_STAGE
#undef PG8_LDA
#undef PG8_LDB
#undef PG8_MMA
#undef PG8_WAIT_V
#undef PG8_WAIT_L
#undef PG8_BAR
#undef PG8_SCHED
#undef PG8_ZERO
}

typedef f32x4 Acc[2][2][4][2];
#define EPI_ROWS(ai, m) _Pragma("unroll") for (int ai = 0; ai < 2; ++ai) _Pragma("unroll") for (int m = 0; m < 4; ++m) if (epi_fence())
__device__ __forceinline__ bool epi_fence() { asm volatile("" ::: "memory"); return true; }
#define EPI_RL(ai, m) ((ai) * 128 + wr * 64 + (m) * 16 + fr)
#define EPI_CL(bj) ((bj) * 128 + wc * 32 + 8 * fq)

struct SchedP1 { const char* hb; const char* wint; int G, c;
    __device__ __forceinline__ bool next(int i, Unit& u) const {
        const int L = i * G + c; if (L >= 768) return false;
        u.cont = 0;
        if (L < 512) { int pm, pn; tile_order(L, 64, 8, pm, pn); u.pm = pm; u.pn = pn; u.kind = 0; u.a = hb + (size_t)pm * 256 * 1024 * 2; u.b = wint + (size_t)pn * 256 * 1024 * 2; }
        else { const int l = L - 512; u.pm = l & 3; u.pn = l >> 2; u.kind = 1; u.a = wint + (size_t)(2048 + u.pm * 256) * 1024 * 2; u.b = hb + (size_t)u.pn * 256 * 1024 * 2; }
        return true; } };
struct EpiP1 { static constexpr bool AFTER_DRAIN = false; bf16_t* qkpre; bf16_t* vt;
    __device__ __forceinline__ void mid(Acc&, const Unit&, int, int, int, int) const {}
    __device__ __forceinline__ void pre(const Unit&, int, int, int, int) const {}
    __device__ __forceinline__ void operator()(Acc& acc, const Unit& u, int wr, int wc, int fr, int fq) const {
        bf16_t* base; int ld;
        if (u.kind == 0) { base = qkpre + (size_t)u.pm * 256 * 2048 + u.pn * 256; ld = 2048; }
        else { const int item = ((u.pn >> 3) * 4 + u.pm) * 8 + (u.pn & 7); base = vt + (size_t)item * 65536; ld = 256; }
        EPI_ROWS(ai, m) { bf16_t* rowp = base + (size_t)EPI_RL(ai, m) * ld + EPI_CL(0);
#pragma unroll
            for (int bj = 0; bj < 2; ++bj) *(u32x4*)(rowp + bj * 128) = pack8(acc[ai][bj][m][0], acc[ai][bj][m][1]); }
    } };

struct SchedP3 { const char* wq; const char* kw; const char* vt; const char* kwt; int G, c;
    __device__ __forceinline__ bool next(int i, Unit& u) const {
        const int L = i * G + c; if (L >= 512) return false;
        u.cont = 0; u.pn = 0;
        if (L < 256) { u.pm = L; u.kind = 0; u.a = wq + (size_t)L * 131072; u.b = kw + (size_t)L * 131072; }
        else { const int it = L - 256; u.pm = it; u.kind = 1; u.a = vt + (size_t)it * 131072; u.b = kwt + (size_t)it * 131072; }
        return true; } };
struct EpiP3 { static constexpr bool AFTER_DRAIN = false; bf16_t* s; bf16_t* lt; float* deni;
    __device__ __forceinline__ void mid(Acc&, const Unit&, int, int, int, int) const {}
    __device__ __forceinline__ void pre(const Unit&, int, int, int, int) const {}
    __device__ __forceinline__ void operator()(Acc& acc, const Unit& u, int wr, int wc, int fr, int fq) const {
        const int item = u.pm;
        if (u.kind == 0) {
            const int b = item >> 5, h = (item >> 3) & 3, sc = item & 7; const int tokb = b * SEQ_ + sc * 256;
            EPI_ROWS(ai, m) { int r = EPI_RL(ai, m); asm volatile("" : "+v"(r)); float rs = 0.f;
#pragma unroll
                for (int bj = 0; bj < 2; ++bj) { const int c0 = EPI_CL(bj); f32x4 v0 = acc[ai][bj][m][0], v1 = acc[ai][bj][m][1];
#pragma unroll
                    for (int j = 0; j < 4; ++j) { v0[j] = (c0 + j <= r) ? v0[j] : 0.f; v1[j] = (c0 + 4 + j <= r) ? v1[j] : 0.f; rs += v0[j] + v1[j]; }
                    *(u32x4*)(s + (size_t)item * 65536 + r * 256 + c0) = pack8(v0, v1); }
                rs += __shfl_xor(rs, 16); rs += __shfl_xor(rs, 32);
                if (fq == 0) unsafeAtomicAdd(deni + (size_t)(tokb + r) * 4 + h, rs); }
        } else {
            EPI_ROWS(ai, m) { bf16_t* rowp = lt + (size_t)item * 65536 + EPI_RL(ai, m) * 256 + EPI_CL(0);
#pragma unroll
                for (int bj = 0; bj < 2; ++bj) *(u32x4*)(rowp + bj * 128) = pack8(acc[ai][bj][m][0], acc[ai][bj][m][1]); }
        }
    } };

struct SchedP5 { const char* s; const char* vt; const char* wq; const char* cint; int G, c;
    __device__ __forceinline__ bool next(int i, Unit& u) const {
        const int item = (i >> 1) * G + c; if (item >= 256) return false;
        u.pm = item; u.pn = 0; u.kind = 0;
        if ((i & 1) == 0) { u.cont = 1; u.a = s + (size_t)item * 131072; u.b = vt + (size_t)item * 131072; }
        else { u.cont = 0; u.a = wq + (size_t)item * 131072; u.b = cint + (size_t)item * 131072; }
        return true; } };
struct EpiP5 { static constexpr bool AFTER_DRAIN = false; bf16_t* hm; const float* deni; const float* denx; float* hss;
    __device__ __forceinline__ void mid(Acc&, const Unit&, int, int, int, int) const {}
    __device__ __forceinline__ void pre(const Unit&, int, int, int, int) const {}
    __device__ __forceinline__ void operator()(Acc& acc, const Unit& u, int wr, int wc, int fr, int fq) const {
        const int item = u.pm; const int b = item >> 5, h = (item >> 3) & 3, sc = item & 7; const int tokb = b * SEQ_ + sc * 256;
        EPI_ROWS(ai, m) { const int t = tokb + EPI_RL(ai, m);
            const float den = deni[(size_t)t * 4 + h] + denx[(size_t)t * 4 + h]; const float inv = __builtin_amdgcn_rcpf(fmaxf(fabsf(den), 1.0f)); float ss = 0.f;
#pragma unroll
            for (int bj = 0; bj < 2; ++bj) { f32x4 v0 = acc[ai][bj][m][0] * inv, v1 = acc[ai][bj][m][1] * inv;
#pragma unroll
                for (int j = 0; j < 4; ++j) ss += v0[j] * v0[j] + v1[j] * v1[j];
                *(u32x4*)(hm + (size_t)t * 1024 + h * 256 + EPI_CL(bj)) = pack8(v0, v1); }
            ss += __shfl_xor(ss, 16); ss += __shfl_xor(ss, 32);
            if (fq == 0) unsafeAtomicAdd(hss + (size_t)t * 4 + h, ss); }
    } };

struct SchedP6 { const char* hb; const char* wint; int G, c;
    __device__ __forceinline__ bool next(int i, Unit& u) const {
        u.cont = 0;
        if (i == 0) { const int item = c; if (item >= 256) return false; const int b = item >> 5, h = (item >> 3) & 3, sc = item & 7;
            u.pm = b * 8 + sc; u.pn = h; u.kind = 0; u.a = hb + (size_t)u.pm * 256 * 1024 * 2; u.b = wint + (size_t)(3072 + h * 256) * 1024 * 2; return true; }
        const int L = (i - 1) * G + c; if (L >= 512) return false;
        int pm, pn; tile_order(L, 64, 8, pm, pn); u.pm = pm; u.pn = pn; u.kind = 1;
        u.a = hb + (size_t)pm * 256 * 1024 * 2; u.b = wint + (size_t)(4096 + pn * 256) * 1024 * 2; return true; } };
struct EpiP6 { static constexpr bool AFTER_DRAIN = false; bf16_t* hm; float* hss; const float* mhg; bf16_t* uu;
    __device__ __forceinline__ void mid(Acc&, const Unit&, int, int, int, int) const {}
    __device__ __forceinline__ void pre(const Unit&, int, int, int, int) const {}
    __device__ __forceinline__ void operator()(Acc& acc, const Unit& u, int wr, int wc, int fr, int fq) const {
        if (u.kind == 0) {
            EPI_ROWS(ai, m) { const int t = u.pm * 256 + EPI_RL(ai, m);
                const float rsn = rsqrtf(__hip_atomic_load(hss + (size_t)t * 4 + u.pn, __ATOMIC_RELAXED, __HIP_MEMORY_SCOPE_AGENT) * (1.0f / 256.0f) + EPS_);
#pragma unroll
                for (int bj = 0; bj < 2; ++bj) { const int c = u.pn * 256 + EPI_CL(bj); bf16_t* ptr = hm + (size_t)t * 1024 + c;
                    f32x4 h0, h1; unpack8(*(const u32x4*)ptr, h0, h1); const f32x4 g0 = *(const f32x4*)(mhg + c), g1 = *(const f32x4*)(mhg + c + 4); f32x4 o0, o1;
#pragma unroll
                    for (int j = 0; j < 4; ++j) { o0[j] = h0[j] * rsn * g0[j] * sigm(acc[ai][bj][m][0][j]); o1[j] = h1[j] * rsn * g1[j] * sigm(acc[ai][bj][m][1][j]); }
                    *(u32x4*)ptr = pack8(o0, o1); } }
        } else {
            EPI_ROWS(ai, m) { const int t = u.pm * 256 + EPI_RL(ai, m); f32x4 o0, o1;
#pragma unroll
                for (int j = 0; j < 4; ++j) { o0[j] = acc[ai][0][m][0][j] * sigm(acc[ai][1][m][0][j]); o1[j] = acc[ai][0][m][1][j] * sigm(acc[ai][1][m][1][j]); }
                *(u32x4*)(uu + (size_t)t * 1024 + u.pn * 128 + wc * 32 + 8 * fq) = pack8(o0, o1); }
        }
    } };

struct SchedP8 { const char* hb; const char* wint; const char* hmg; const char* uc; const char* wmt; const char* wct; int G, c;
    __device__ __forceinline__ bool next(int i, Unit& u) const {
        const int L = (i >> 2) * G + c, r = i & 3; if (L >= 256) return false;
        int pn; map_n4(L, u.pm, pn); u.cont = 0;
        if (r < 2) { u.kind = 2; u.pn = 2 * pn + r; u.a = hb + (size_t)u.pm * 256 * 1024 * 2; u.b = wint + (size_t)(6144 + u.pn * 256) * 1024 * 2; }
        else if (r == 2) { u.kind = 0; u.pn = pn; u.a = hmg + (size_t)u.pm * 256 * 1024 * 2; u.b = wmt + (size_t)pn * 256 * 1024 * 2; }
        else { u.kind = 1; u.pn = pn; u.a = uc + (size_t)u.pm * 256 * 1024 * 2; u.b = wct + (size_t)pn * 256 * 1024 * 2; }
        return true; } };
struct EpiP8 { static constexpr bool AFTER_DRAIN = false; bf16_t* gmc; bf16_t* tmp; bf16_t* merged;
    __device__ __forceinline__ void mid(Acc&, const Unit&, int, int, int, int) const {}
    __device__ __forceinline__ void pre(const Unit&, int, int, int, int) const {}
    __device__ __forceinline__ void operator()(Acc& acc, const Unit& u, int wr, int wc, int fr, int fq) const {
        if (u.kind == 2) {
            EPI_ROWS(ai, m) { const int t = u.pm * 256 + EPI_RL(ai, m); f32x4 r0, r1, c0, c1;
#pragma unroll
                for (int j = 0; j < 4; ++j) { const float e0 = __builtin_amdgcn_exp2f(acc[ai][1][m][0][j] * -1.4426950408889634f), e1 = __builtin_amdgcn_exp2f(acc[ai][1][m][1][j] * -1.4426950408889634f);
                    r0[j] = sigm(acc[ai][0][m][0][j]) * (1.0f + e0); r1[j] = sigm(acc[ai][0][m][1][j]) * (1.0f + e1);
                    c0[j] = __builtin_amdgcn_rcpf(1.0f + e0); c1[j] = __builtin_amdgcn_rcpf(1.0f + e1); }
                bf16_t* ptr = gmc + (size_t)t * 2048 + u.pn * 128 + wc * 32 + 8 * fq;
                *(u32x4*)ptr = pack8(r0, r1); *(u32x4*)(ptr + 1024) = pack8(c0, c1); }
        } else if (u.kind == 0) {
            EPI_ROWS(ai, m) { const int t = u.pm * 256 + EPI_RL(ai, m);
#pragma unroll
                for (int bj = 0; bj < 2; ++bj) { const int c = u.pn * 256 + EPI_CL(bj); f32x4 a0, a1; unpack8(*(const u32x4*)(gmc + (size_t)t * 2048 + c), a0, a1);
                    *(u32x4*)(tmp + (size_t)t * 1024 + c) = pack8(acc[ai][bj][m][0] * a0, acc[ai][bj][m][1] * a1); } }
        } else {
            EPI_ROWS(ai, m) { const int t = u.pm * 256 + EPI_RL(ai, m);
#pragma unroll
                for (int bj = 0; bj < 2; ++bj) { const int c = u.pn * 256 + EPI_CL(bj); f32x4 b0, b1, t0, t1; unpack8(*(const u32x4*)(gmc + (size_t)t * 2048 + 1024 + c), b0, b1);
                    unpack8(*(const u32x4*)(tmp + (size_t)t * 1024 + c), t0, t1);
                    *(u32x4*)(merged + (size_t)t * 1024 + c) = pack8((acc[ai][bj][m][0] + t0) * b0, (acc[ai][bj][m][1] + t1) * b1); } }
        }
    } };

struct SchedN4 { const char* a; const char* bt; size_t astep, bstep; int G, c;
    __device__ __forceinline__ bool next(int i, Unit& u) const {
        const int L = i * G + c; if (L >= 256) return false;
        map_n4(L, u.pm, u.pn); u.kind = 0; u.cont = 0; u.a = a + (size_t)u.pm * astep; u.b = bt + (size_t)u.pn * bstep; return true; } };
struct SchedPE { const char* a; const char* bt; int G, c;
    __device__ __forceinline__ bool next(int i, Unit& u) const {
        const int L = i * G + c; if (L >= 256 || c < 0) return false;
        u.pm = L >> 2; u.pn = L & 3; u.kind = 0; u.cont = 0; u.a = a + (size_t)u.pm * 256 * 256 * 2; u.b = bt + (size_t)u.pn * 256 * 256 * 2; return true; } };
template <bool SRC_BF16> struct EpiRes { static constexpr bool AFTER_DRAIN = false; const void* src; bf16_t* dstb; float* ssq;
    __device__ __forceinline__ void mid(Acc&, const Unit&, int, int, int, int) const {}
    __device__ __forceinline__ void pre(const Unit& u, int wr, int wc, int fr, int fq) const {
        if (!SRC_BF16) {
            EPI_ROWS(ai, m) { const int t = u.pm * 256 + EPI_RL(ai, m);
#pragma unroll
                for (int bj = 0; bj < 2; ++bj) { const float v = *((const float*)src + (size_t)t * 1024 + u.pn * 256 + EPI_CL(bj)); asm volatile("" :: "v"(v)); } }
        }
    }
    __device__ __forceinline__ void operator()(Acc& acc, const Unit& u, int wr, int wc, int fr, int fq) const {
        EPI_ROWS(ai, m) { const int t = u.pm * 256 + EPI_RL(ai, m); float ss = 0.f;
#pragma unroll
            for (int bj = 0; bj < 2; ++bj) { const size_t o = (size_t)t * 1024 + u.pn * 256 + EPI_CL(bj); f32x4 v0, v1;
                if (SRC_BF16) unpack8(*(const u32x4*)((const bf16_t*)src + o), v0, v1); else { v0 = *(const f32x4*)((const float*)src + o); v1 = *(const f32x4*)((const float*)src + o + 4); }
                v0 += acc[ai][bj][m][0]; v1 += acc[ai][bj][m][1];
#pragma unroll
                for (int j = 0; j < 4; ++j) ss += v0[j] * v0[j] + v1[j] * v1[j];
                *(u32x4*)(dstb + o) = pack8(v0, v1); }
            ss += __shfl_xor(ss, 16); ss += __shfl_xor(ss, 32);
            if (fq == 0) unsafeAtomicAdd(ssq + t, ss); }
    } };

struct SchedP10 { const char* x1b; const char* wgut; int G, c;
    __device__ __forceinline__ bool next(int i, Unit& u) const {
        const int L = i * G + c; if (L >= 1408) return false;
        int pm, pn; tile_order(L, 64, 22, pm, pn); u.pm = pm; u.pn = pn; u.kind = 0; u.cont = 0;
        u.a = x1b + (size_t)pm * 256 * 1024 * 2; u.b = wgut + (size_t)pn * 256 * 1024 * 2; return true; } };
struct EpiP10 { static constexpr bool AFTER_DRAIN = false; const float* ssq; bf16_t* hid;
    __device__ __forceinline__ void mid(Acc&, const Unit&, int, int, int, int) const {}
    __device__ __forceinline__ void pre(const Unit&, int, int, int, int) const {}
    __device__ __forceinline__ void operator()(Acc& acc, const Unit& u, int wr, int wc, int fr, int fq) const {
        EPI_ROWS(ai, m) { const int t = u.pm * 256 + EPI_RL(ai, m); const float rs = rsqrtf(ssq[t] * (1.0f / 1024.0f) + EPS_); f32x4 o0, o1;
#pragma unroll
            for (int j = 0; j < 4; ++j) { o0[j] = silu(acc[ai][0][m][0][j] * rs) * (acc[ai][1][m][0][j] * rs); o1[j] = silu(acc[ai][0][m][1][j] * rs) * (acc[ai][1][m][1][j] * rs); }
            *(u32x4*)(hid + (size_t)t * DFF_ + u.pn * 128 + wc * 32 + 8 * fq) = pack8(o0, o1); }
    } };

struct EpiBf { static constexpr bool AFTER_DRAIN = false; bf16_t* o;
    __device__ __forceinline__ void mid(Acc&, const Unit&, int, int, int, int) const {}
    __device__ __forceinline__ void pre(const Unit&, int, int, int, int) const {}
    __device__ __forceinline__ void operator()(Acc& acc, const Unit& u, int wr, int wc, int fr, int fq) const {
        EPI_ROWS(ai, m) { bf16_t* rowp = o + (size_t)(u.pm * 256 + EPI_RL(ai, m)) * 1024 + u.pn * 256 + EPI_CL(0);
#pragma unroll
            for (int bj = 0; bj < 2; ++bj) *(u32x4*)(rowp + bj * 128) = pack8(acc[ai][bj][m][0], acc[ai][bj][m][1]); }
    } };

struct EpiP12 { static constexpr bool AFTER_DRAIN = true; const float* ssq2; const bf16_t* pe; const bf16_t* xin; float* out; float* ssq3; unsigned* done; const float* fg;
    __device__ __forceinline__ void mid(Acc&, const Unit&, int, int, int, int) const {}
    __device__ __forceinline__ void pre(const Unit&, int, int, int, int) const {}
    __device__ __forceinline__ void operator()(Acc& acc, const Unit& u, int wr, int wc, int fr, int fq) const {
        EPI_ROWS(ai, m) { const int t = u.pm * 256 + EPI_RL(ai, m); const float rs = rsqrtf(ssq2[t] * (1.0f / 1024.0f) + EPS_); float ss = 0.f;
#pragma unroll
            for (int bj = 0; bj < 2; ++bj) { const size_t o = (size_t)t * 1024 + u.pn * 256 + EPI_CL(bj); f32x4 p0, p1; unpack8(*(const u32x4*)(pe + o), p0, p1);
                f32x4 v0, v1; unpack8(*(const u32x4*)(xin + o), v0, v1);
#pragma unroll
                for (int j = 0; j < 4; ++j) { v0[j] += sigm(acc[ai][bj][m][0][j] * rs) * p0[j]; v1[j] += sigm(acc[ai][bj][m][1][j] * rs) * p1[j]; ss += v0[j] * v0[j] + v1[j] * v1[j]; }
                acc[ai][bj][m][0] = v0; acc[ai][bj][m][1] = v1; }
            ss += __shfl_xor(ss, 16); ss += __shfl_xor(ss, 32);
            if (fq == 0) unsafeAtomicAdd(ssq3 + t, ss); }
        asm volatile("s_waitcnt vmcnt(0)" ::: "memory");
        unsigned* cnt = done + 64 * u.pm;
        if ((threadIdx.x & 63) == 0) __hip_atomic_fetch_add(cnt, 1u, __ATOMIC_RELAXED, __HIP_MEMORY_SCOPE_AGENT);
        { unsigned sp = 0; while (__hip_atomic_load(cnt, __ATOMIC_RELAXED, __HIP_MEMORY_SCOPE_AGENT) < 32u) { __builtin_amdgcn_s_sleep(1); if (++sp > (1u << 22)) break; } }
        EPI_ROWS(ai, m) { const int t = u.pm * 256 + EPI_RL(ai, m);
            const float rs = rsqrtf(__hip_atomic_load(ssq3 + t, __ATOMIC_RELAXED, __HIP_MEMORY_SCOPE_AGENT) * (1.0f / 1024.0f) + EPS_);
#pragma unroll
            for (int bj = 0; bj < 2; ++bj) { const int cc = u.pn * 256 + EPI_CL(bj); const size_t o = (size_t)t * 1024 + cc;
                const f32x4 g0 = *(const f32x4*)(fg + cc), g1 = *(const f32x4*)(fg + cc + 4);
                *(f32x4*)(out + o) = acc[ai][bj][m][0] * rs * g0; *(f32x4*)(out + o + 4) = acc[ai][bj][m][1] * rs * g1; } }
    } };

struct CvtTile { const float* src; int ld; const float* scale; bf16_t* dst; int dstld; };
__device__ __forceinline__ CvtTile cvt_tile_params(const Params& p, int tl) {
    const int NT0 = 2048, NT4 = NT0 + 1024, NT5 = NT4 + 1408, NT6 = NT5 + 704;
    unsigned char* ws = p.ws; CvtTile t; t.scale = nullptr;
    if (tl < NT0) { const int nb = tl >> 4, kb = tl & 15; const int n0 = nb * 64; int col;
        if (n0 < 4096) col = n0; else if (n0 < 6144) { const int j = (n0 - 4096) >> 8, r = (n0 - 4096) & 255; col = (r < 128) ? (4104 + 128 * j + r) : (5128 + 128 * j + r - 128); }
        else { const int j = (n0 - 6144) >> 8, r = (n0 - 6144) & 255; col = 6152 + ((r < 128) ? (128 * j + r) : (1024 + 128 * j + r - 128)); }
        t.src = p.in[3] + (size_t)kb * 64 * NIN_ + col; t.ld = NIN_; t.dst = (bf16_t*)(ws + O_WINT) + (size_t)n0 * 1024 + kb * 64; t.dstld = 1024; }
    else if (tl < NT4) { const int w = (tl - NT0) >> 8, l = (tl - NT0) & 255; const int nb = l >> 4, kb = l & 15;
        const float* base = w == 0 ? p.in[12] : (w == 1 ? p.in[13] : (w == 2 ? p.in[14] : p.in[20])); const size_t od = w == 0 ? O_WMT : (w == 1 ? O_WCT : (w == 2 ? O_WOT : O_WPGT));
        t.src = base + (size_t)kb * 64 * 1024 + nb * 64; t.ld = 1024; if (w == 3) t.scale = p.in[19] + kb * 64; t.dst = (bf16_t*)(ws + od) + (size_t)nb * 64 * 1024 + kb * 64; t.dstld = 1024; }
    else if (tl < NT5) { const int l = tl - NT4; const int nb = l >> 4, kb = l & 15; const int n0 = nb * 64; const int j = n0 >> 8, r = n0 & 255;
        const float* base = (r < 128) ? p.in[16] : p.in[17]; const int col = 128 * j + (r & 127);
        t.src = base + (size_t)kb * 64 * DFF_ + col; t.ld = DFF_; t.scale = p.in[15] + kb * 64; t.dst = (bf16_t*)(ws + O_WGUT) + (size_t)n0 * 1024 + kb * 64; t.dstld = 1024; }
    else if (tl < NT6) { const int l = tl - NT5; const int nb = l / 44, kb = l % 44;
        t.src = p.in[18] + (size_t)kb * 64 * 1024 + nb * 64; t.ld = 1024; t.dst = (bf16_t*)(ws + O_WDT) + (size_t)nb * 64 * DFF_ + kb * 64; t.dstld = DFF_; }
    else { const int l = tl - NT6; const int nb = l >> 2, kb = l & 3;
        t.src = p.in[21] + (size_t)kb * 64 * 1024 + nb * 64; t.ld = 1024; t.dst = (bf16_t*)(ws + O_WPPT) + (size_t)nb * 64 * 256 + kb * 64; t.dstld = 256; }
    return t;
}
__device__ __forceinline__ void cvt_tile_load(const CvtTile& t, f32x4 (&v)[2]) {
    const int tid = threadIdx.x, kk = tid >> 4, c4 = (tid & 15) * 4;
#pragma unroll
    for (int pss = 0; pss < 2; ++pss) { const int k = kk + pss * 32; v[pss] = __builtin_nontemporal_load((const f32x4*)(t.src + (size_t)k * t.ld + c4)); if (t.scale) v[pss] = v[pss] * t.scale[k]; }
}

__device__ __forceinline__ void phase0(const Params& p, unsigned char* sm) {
    unsigned char* ws = p.ws;
    const int tid = threadIdx.x, lane = tid & 63, wid = tid >> 6;
    const size_t gtid = (size_t)blockIdx.x * 512 + tid, gthreads = (size_t)gridDim.x * 512;
    for (size_t i = gtid; i < ZERO_BYTES / 16; i += gthreads) ((u32x4*)(ws + O_ZERO))[i] = (u32x4){0u, 0u, 0u, 0u};
    { const float* pp = p.in[1]; bf16_t* pb = (bf16_t*)(ws + O_PB);
        for (size_t i = gtid; i < (size_t)T_ * 256 / 8; i += gthreads) { const f32x4 a = __builtin_nontemporal_load((const f32x4*)(pp + i * 8)), b = __builtin_nontemporal_load((const f32x4*)(pp + i * 8 + 4)); *(u32x4*)(pb + i * 8) = pack8(a, b); } }
    { const float* x = p.in[0]; const float* g = p.in[2]; const float* win = p.in[3]; const float* bif = p.in[4];
        float* wgT = (float*)sm;
        for (int idx = tid; idx < 8192; idx += 512) { const int k = idx >> 3, j = idx & 7; wgT[j * 1024 + k] = win[(size_t)k * NIN_ + 4096 + j] * g[k]; }
        __syncthreads();
        bf16_t* hb = (bf16_t*)(ws + O_HB); float* ig = (float*)(ws + O_IG); float* lf = (float*)(ws + O_LF);
        const int rstep = gridDim.x * 8; int row = blockIdx.x * 8 + wid;
        f32x4 xn[4];
#pragma unroll
        for (int i = 0; i < 4; ++i) xn[i] = (row < T_) ? *(const f32x4*)(x + (size_t)row * 1024 + i * 256 + lane * 4) : (f32x4){0.f, 0.f, 0.f, 0.f};
        for (; row < T_; row += rstep) {
            f32x4 xv[4]; float ss = 0.f;
#pragma unroll
            for (int i = 0; i < 4; ++i) { xv[i] = xn[i]; ss += xv[i][0] * xv[i][0] + xv[i][1] * xv[i][1] + xv[i][2] * xv[i][2] + xv[i][3] * xv[i][3]; }
            { const int nrow = row + rstep;
                if (nrow < T_) {
#pragma unroll
                    for (int i = 0; i < 4; ++i) xn[i] = __builtin_nontemporal_load((const f32x4*)(x + (size_t)nrow * 1024 + i * 256 + lane * 4)); } }
            ss = wave_sum(ss); const float rs = rsqrtf(ss * (1.0f / 1024.0f) + EPS_);
            float d[8];
#pragma unroll
            for (int j = 0; j < 8; ++j) d[j] = 0.f;
#pragma unroll
            for (int i = 0; i < 4; ++i) { const f32x4 hn = xv[i] * rs; const f32x4 gv = *(const f32x4*)(g + i * 256 + lane * 4); const f32x4 hg = hn * gv;
                u32x2 w; w.x = cvt_pk_bf16(hg[0], hg[1]); w.y = cvt_pk_bf16(hg[2], hg[3]); *(u32x2*)(hb + (size_t)row * 1024 + i * 256 + lane * 4) = w;
#pragma unroll
                for (int j = 0; j < 8; ++j) { const f32x4 wv = *(const f32x4*)(wgT + j * 1024 + i * 256 + lane * 4); d[j] += hn[0] * wv[0] + hn[1] * wv[1] + hn[2] * wv[2] + hn[3] * wv[3]; } }
#pragma unroll
            for (int j = 0; j < 8; ++j) d[j] = wave_sum(d[j]);
            if (lane < 8) { float v = d[0];
#pragma unroll
                for (int j = 1; j < 8; ++j) v = (lane == j) ? d[j] : v;
                v += bif[lane];
                if (lane < 4) ig[(size_t)row * 4 + lane] = v;
                else { const float z = v; lf[(size_t)row * 4 + lane - 4] = fminf(z, 0.f) - log1pf(__expf(-fabsf(z))); } }
        }
        __syncthreads();
    }
    { const int NTILES = 2048 + 1024 + 1408 + 704 + 64; const int gs = gridDim.x;
        float* tl = (float*)sm;
        int t = blockIdx.x; CvtTile c0{}, c1{}; f32x4 v0[2], v1[2];
        if (t < NTILES) { c0 = cvt_tile_params(p, t); cvt_tile_load(c0, v0); }
        if (t + gs < NTILES) { c1 = cvt_tile_params(p, t + gs); cvt_tile_load(c1, v1); }
        for (; t < NTILES; t += gs) {
            { const int kk = tid >> 4, c4 = (tid & 15) * 4;
#pragma unroll
                for (int pss = 0; pss < 2; ++pss) { const int k = kk + pss * 32;
#pragma unroll
                    for (int j = 0; j < 4; ++j) tl[k * 65 + c4 + j] = v0[pss][j]; } }
            __syncthreads();
            const CvtTile done = c0; c0 = c1; v0[0] = v1[0]; v0[1] = v1[1];
            { const int tn = t + 2 * gs; if (tn < NTILES) { c1 = cvt_tile_params(p, tn); cvt_tile_load(c1, v1); } }
            { const int n = tid >> 3, k8 = (tid & 7) * 8; float e[8];
#pragma unroll
                for (int q = 0; q < 8; ++q) e[q] = tl[(k8 + q) * 65 + n];
                u32x4 w; w.x = cvt_pk_bf16(e[0], e[1]); w.y = cvt_pk_bf16(e[2], e[3]); w.z = cvt_pk_bf16(e[4], e[5]); w.w = cvt_pk_bf16(e[6], e[7]);
                *(u32x4*)(done.dst + (size_t)n * done.dstld + k8) = w; }
            __syncthreads();
        }
    }
}

__device__ __forceinline__ void phase2(const Params& p, unsigned char* sm) {
    unsigned char* ws = p.ws;
    const int tid = threadIdx.x, lane = tid & 63, wid = tid >> 6;
    float* rowfac = (float*)sm; float* colfac = rowfac + 256; float* wsum = colfac + 256;
    const float* ig = (const float*)(ws + O_IG); const float* lf = (const float*)(ws + O_LF);
    const bf16_t* qkpre = (const bf16_t*)p.out;
    const float* cw = p.in[5]; const float* cb = p.in[6];
    for (int item = blockIdx.x; item < 256; item += gridDim.x) {
        const int b = item >> 5, h = (item >> 3) & 3, sc = item & 7; const int tokb = b * SEQ_ + sc * 256;
        float v = 0.f, igv = 0.f;
        if (tid < 256) { v = lf[(size_t)(tokb + tid) * 4 + h]; igv = ig[(size_t)(tokb + tid) * 4 + h]; }
#pragma unroll
        for (int o = 1; o < 64; o <<= 1) { const float n = __shfl_up(v, o); if (lane >= o) v += n; }
        if (tid < 256 && lane == 63) wsum[wid] = v;
        __syncthreads();
        if (tid < 256) { float add = 0.f; for (int j = 0; j < wid; ++j) add += wsum[j]; v += add; rowfac[tid] = __expf(v); colfac[tid] = __expf(igv - v);
            if (tid == 255) ((float*)(ws + O_EBL))[item] = __expf(v); }
        __syncthreads();
#pragma unroll 1
        for (int qt = 0; qt < 4; ++qt) {
        const int cp = tid & 127, tg = tid >> 7; const int ch = 2 * cp; const int tl0 = qt * 64 + tg * 16; const int s0 = sc * 256 + tl0;
        { const int col = h * 256 + ch; float x0[19], x1[19];
#pragma unroll
            for (int i = 0; i < 19; ++i) { const int s = s0 - 3 + i; unsigned w = 0u; if (s >= 0) w = *(const unsigned*)(qkpre + (size_t)(b * SEQ_ + s) * 2048 + col); x0[i] = bf_lo(w); x1[i] = bf_hi(w); }
            float w0[4], w1[4];
#pragma unroll
            for (int k = 0; k < 4; ++k) { const f32x2 wv = *(const f32x2*)(cw + (size_t)k * 2048 + col); w0[k] = wv[0]; w1[k] = wv[1]; }
            const f32x2 bv = *(const f32x2*)(cb + col);
            bf16_t* wq = (bf16_t*)(ws + O_WQ) + (size_t)item * 65536;
#pragma unroll
            for (int i = 0; i < 16; ++i) { float y0 = bv[0], y1 = bv[1];
#pragma unroll
                for (int k = 0; k < 4; ++k) { y0 += x0[i + k] * w0[k]; y1 += x1[i + k] * w1[k]; }
                const float f = rowfac[tl0 + i] * 0.0625f;
                *(unsigned*)(wq + (size_t)(tl0 + i) * 256 + ch) = cvt_pk_bf16(silu(y0) * f, silu(y1) * f); } }
        { const int col = 1024 + h * 256 + ch; float x0[19], x1[19];
#pragma unroll
            for (int i = 0; i < 19; ++i) { const int s = s0 - 3 + i; unsigned w = 0u; if (s >= 0) w = *(const unsigned*)(qkpre + (size_t)(b * SEQ_ + s) * 2048 + col); x0[i] = bf_lo(w); x1[i] = bf_hi(w); }
            float w0[4], w1[4];
#pragma unroll
            for (int k = 0; k < 4; ++k) { const f32x2 wv = *(const f32x2*)(cw + (size_t)k * 2048 + col); w0[k] = wv[0]; w1[k] = wv[1]; }
            const f32x2 bv = *(const f32x2*)(cb + col);
            bf16_t* kw = (bf16_t*)(ws + O_KW) + (size_t)item * 65536; bf16_t* kwt = (bf16_t*)(ws + O_KWT) + (size_t)item * 65536;
            float k0[16], k1[16]; float n0 = 0.f, n1 = 0.f;
#pragma unroll
            for (int i = 0; i < 16; ++i) { float y0 = bv[0], y1 = bv[1];
#pragma unroll
                for (int k = 0; k < 4; ++k) { y0 += x0[i + k] * w0[k]; y1 += x1[i + k] * w1[k]; }
                const float f = colfac[tl0 + i]; k0[i] = silu(y0) * f; k1[i] = silu(y1) * f; n0 += k0[i]; n1 += k1[i];
                *(unsigned*)(kw + (size_t)(tl0 + i) * 256 + ch) = cvt_pk_bf16(k0[i], k1[i]); }
            u32x4 a, c;
            a.x = cvt_pk_bf16(k0[0], k0[1]); a.y = cvt_pk_bf16(k0[2], k0[3]); a.z = cvt_pk_bf16(k0[4], k0[5]); a.w = cvt_pk_bf16(k0[6], k0[7]);
            c.x = cvt_pk_bf16(k0[8], k0[9]); c.y = cvt_pk_bf16(k0[10], k0[11]); c.z = cvt_pk_bf16(k0[12], k0[13]); c.w = cvt_pk_bf16(k0[14], k0[15]);
            *(u32x4*)(kwt + (size_t)ch * 256 + tl0) = a; *(u32x4*)(kwt + (size_t)ch * 256 + tl0 + 8) = c;
            a.x = cvt_pk_bf16(k1[0], k1[1]); a.y = cvt_pk_bf16(k1[2], k1[3]); a.z = cvt_pk_bf16(k1[4], k1[5]); a.w = cvt_pk_bf16(k1[6], k1[7]);
            c.x = cvt_pk_bf16(k1[8], k1[9]); c.y = cvt_pk_bf16(k1[10], k1[11]); c.z = cvt_pk_bf16(k1[12], k1[13]); c.w = cvt_pk_bf16(k1[14], k1[15]);
            *(u32x4*)(kwt + (size_t)(ch + 1) * 256 + tl0) = a; *(u32x4*)(kwt + (size_t)(ch + 1) * 256 + tl0 + 8) = c;
            float* nsum = (float*)(ws + O_NSUM) + (size_t)item * 256;
            unsafeAtomicAdd(nsum + ch, n0); unsafeAtomicAdd(nsum + ch + 1, n1); }
        }
        __syncthreads();
    }
}

__device__ __forceinline__ void phase4(const Params& p, unsigned char* sm) {
    unsigned char* ws = p.ws;
    const int tid = threadIdx.x;
    const float* ebl = (const float*)(ws + O_EBL);
    const bf16_t* lt = (const bf16_t*)(p.ws + O_KWT);
    bf16_t* cint = (bf16_t*)(ws + O_CINT);
    const size_t gtid = (size_t)blockIdx.x * 512 + tid, gthreads = (size_t)gridDim.x * 512;
    for (size_t g = gtid; g < (size_t)32 * 16384; g += gthreads) {
        const int bh = (int)(g >> 14), e4 = (int)(g & 16383);
        f32x4 c = {0.f, 0.f, 0.f, 0.f};
        u32x2 lw[7]; float eb[7];
#pragma unroll
        for (int sc = 0; sc < 7; ++sc) { lw[sc] = *(const u32x2*)(lt + (size_t)(bh * 8 + sc) * 65536 + e4 * 4); eb[sc] = ebl[bh * 8 + sc]; }
#pragma unroll
        for (int sc = 0; sc < 8; ++sc) { const int item = bh * 8 + sc;
            u32x2 w; w.x = cvt_pk_bf16(c[0], c[1]); w.y = cvt_pk_bf16(c[2], c[3]); *(u32x2*)(cint + (size_t)item * 65536 + e4 * 4) = w;
            if (sc < 7) { const f32x4 l = {bf_lo(lw[sc].x), bf_hi(lw[sc].x), bf_lo(lw[sc].y), bf_hi(lw[sc].y)}; c = (c + l) * eb[sc]; } }
    }
    float* nin = (float*)sm;
    const float* nsum = (const float*)(ws + O_NSUM);
    float* denx = (float*)(ws + O_DENX);
    for (int item = blockIdx.x; item < 256; item += gridDim.x) {
        const int b = item >> 5, h = (item >> 3) & 3, sc = item & 7; const int tokb = b * SEQ_ + sc * 256; const int bh = item >> 3;
        if (tid < 256) { float nv = 0.f; for (int j = 0; j < sc; ++j) nv = ebl[bh * 8 + j] * (nv + nsum[(size_t)(bh * 8 + j) * 256 + tid]); nin[tid] = nv; }
        __syncthreads();
        const int tl = tid >> 1, half = tid & 1;
        const bf16_t* wq = (const bf16_t*)(ws + O_WQ) + (size_t)item * 65536 + (size_t)tl * 256 + half * 128;
        float d = 0.f;
#pragma unroll
        for (int i = 0; i < 16; ++i) { f32x4 a0, a1; unpack8(*(const u32x4*)(wq + i * 8), a0, a1); const float* nn = nin + half * 128 + i * 8;
            d += a0[0] * nn[0] + a0[1] * nn[1] + a0[2] * nn[2] + a0[3] * nn[3] + a1[0] * nn[4] + a1[1] * nn[5] + a1[2] * nn[6] + a1[3] * nn[7]; }
        d += __shfl_xor(d, 1);
        if (half == 0) denx[(size_t)(tokb + tl) * 4 + h] = d;
        __syncthreads();
    }
}

__device__ __forceinline__ void phase7(const Params& p, unsigned char* sm) {
    unsigned char* ws = p.ws;
    const int tid = threadIdx.x, lane = tid & 63, wid = tid >> 6;
    const bf16_t* uu = (const bf16_t*)p.out; bf16_t* uc = (bf16_t*)(ws + O_UC);
    const float* cw = p.in[8]; const float* cb = p.in[9]; const float* lg = p.in[10]; const float* lb = p.in[11];
    u32x4 pf[12];
#define P7_LOAD(tile_) do { const int t0_ = (tile_) * 16; const int b_ = t0_ / SEQ_, s0_ = t0_ % SEQ_; \
        _Pragma("unroll") for (int q = 0; q < 12; ++q) { const int idx = tid + q * 512; const int r = idx >> 7, c16 = idx & 127; const int s_ = s0_ - 30 + r; \
            pf[q] = (u32x4){0u, 0u, 0u, 0u}; if (idx < 46 * 128 && s_ >= 0) pf[q] = *(const u32x4*)(uu + (size_t)(b_ * SEQ_ + s_) * 1024 + c16 * 8); } } while (0)
    int tile = blockIdx.x;
    if (tile < 1024) P7_LOAD(tile);
    f32x2 wv[31];
#pragma unroll
    for (int k = 0; k < 31; ++k) wv[k] = *(const f32x2*)(cw + (size_t)k * 1024 + 2 * tid);
    const f32x2 bv = *(const f32x2*)(cb + 2 * tid);
    for (; tile < 1024; tile += gridDim.x) {
        const int t0 = tile * 16;
#pragma unroll
        for (int q = 0; q < 12; ++q) { const int idx = tid + q * 512; const int r = idx >> 7, c16 = idx & 127; if (idx < 46 * 128) *(u32x4*)(sm + r * 2048 + c16 * 16) = pf[q]; }
        __syncthreads();
        f32x2 yy[16];
        {
#pragma unroll
            for (int t = 0; t < 16; ++t) yy[t] = bv;
#pragma unroll
            for (int r = 0; r < 46; ++r) { const unsigned w = *(const unsigned*)(sm + r * 2048 + tid * 4); const f32x2 xx = {bf_lo(w), bf_hi(w)};
#pragma unroll
                for (int t = 0; t < 16; ++t) { const int k = r - t; if (k >= 0 && k <= 30) yy[t] = __builtin_elementwise_fma(wv[k], xx, yy[t]); }
                if ((r & 3) == 3) asm volatile("" ::: "memory"); }
        }
        __syncthreads();
#pragma unroll
        for (int t = 0; t < 16; ++t) *(f32x2*)(sm + t * 4096 + tid * 8) = yy[t];
        { const int tn = tile + gridDim.x; if (tn < 1024) P7_LOAD(tn); }
        __syncthreads();
#pragma unroll 1
        for (int tt = 0; tt < 2; ++tt) { const int t = wid * 2 + tt; f32x4 v[4]; float s1 = 0.f;
#pragma unroll
            for (int i = 0; i < 4; ++i) { v[i] = *(const f32x4*)(sm + t * 4096 + (i * 256 + lane * 4) * 4); s1 += v[i][0] + v[i][1] + v[i][2] + v[i][3]; }
            s1 = wave_sum(s1); const float mu = s1 * (1.0f / 1024.0f); float s2 = 0.f;
#pragma unroll
            for (int i = 0; i < 4; ++i) { v[i] = v[i] - mu; s2 += v[i][0] * v[i][0] + v[i][1] * v[i][1] + v[i][2] * v[i][2] + v[i][3] * v[i][3]; }
            s2 = wave_sum(s2); const float rstd = rsqrtf(s2 * (1.0f / 1024.0f) + EPS_);
#pragma unroll
            for (int i = 0; i < 4; ++i) { const int c = i * 256 + lane * 4; const f32x4 gv = *(const f32x4*)(lg + c), bb = *(const f32x4*)(lb + c); f32x4 z = v[i] * rstd * gv + bb;
                u32x2 w; w.x = cvt_pk_bf16(silu(z[0]), silu(z[1])); w.y = cvt_pk_bf16(silu(z[2]), silu(z[3])); *(u32x2*)(uc + (size_t)(t0 + t) * 1024 + c) = w; } }
        __syncthreads();
    }
#undef P7_LOAD
}

__device__ __forceinline__ void phase13(const Params& p) {
    const float* ssq3 = (const float*)(p.ws + O_SSQ3); const float* fg = p.in[22];
    const size_t gtid = (size_t)blockIdx.x * 512 + threadIdx.x, gthreads = (size_t)gridDim.x * 512;
    for (size_t i = gtid; i < (size_t)T_ * 256; i += gthreads) { const int row = (int)(i >> 8), c = (int)(i & 255) * 4;
        const float rs = rsqrtf(ssq3[row] * (1.0f / 1024.0f) + EPS_); const f32x4 g = *(const f32x4*)(fg + c);
        f32x4 v = *(const f32x4*)(p.out + i * 4); v = v * rs * g; *(f32x4*)(p.out + i * 4) = v; }
}

#define XB_TMO      128
#define XB_XCNT(j)  (256  + 64 * (j))
#define XB_XSUB(j)  (1280 + 64 * (j))
#define XB_XGEN(j)  (2304 + 64 * (j))
#define XB_TOP      3328
#define XB_TOPGEN   3392
#define XCD_BAR_WORDS 3456
#define XB_SPIN_CAP (1u << 18)
__device__ __forceinline__ unsigned xb_ld(unsigned* p)              { return __hip_atomic_load(p, __ATOMIC_RELAXED, __HIP_MEMORY_SCOPE_AGENT); }
__device__ __forceinline__ unsigned xb_add(unsigned* p, unsigned v) { return __hip_atomic_fetch_add(p, v, __ATOMIC_RELAXED, __HIP_MEMORY_SCOPE_AGENT); }
__device__ __forceinline__ unsigned xb_xcc_id() { return (unsigned)__builtin_amdgcn_s_getreg((3 << 11) | 20) & 0xFu; }
#define XB_SPIN(cond, bar) do { unsigned _sp = 0; while (cond) { __builtin_amdgcn_s_sleep(1); \
    if ((++_sp & 255u) == 0u) { if (xb_ld(&(bar)[XB_TMO])) break; if (_sp > XB_SPIN_CAP) { atomicAdd(&(bar)[XB_TMO], 1u); break; } } } } while (0)
struct XcdBarrier { unsigned* bar; unsigned x; volatile LAS unsigned* st; };
__device__ __forceinline__ XcdBarrier xcd_barrier_post(unsigned* bar, volatile LAS unsigned* st) {
    XcdBarrier b; b.bar = bar; b.x = xb_xcc_id(); b.st = st;
    if (threadIdx.x == 0) (void)xb_add(&bar[XB_XCNT(b.x)], 1u);
    return b;
}
__device__ __forceinline__ void xcd_barrier_complete(unsigned* bar, unsigned x, unsigned& nloc, unsigned& nx) {
    const unsigned G = gridDim.x * gridDim.y * gridDim.z;
    unsigned sum, cnt, mine, sp = 0u;
    for (;;) {
        sum = 0u; cnt = 0u; mine = 0u;
#pragma unroll
        for (unsigned j = 0; j < 16; ++j) { const unsigned c = xb_ld(&bar[XB_XCNT(j)]); sum += c; cnt += (c > 0u) ? 1u : 0u; mine = (j == x) ? c : mine; }
        if (sum == G) break;
        __builtin_amdgcn_s_sleep(1);
        if ((++sp & 255u) == 0u) { if (xb_ld(&bar[XB_TMO])) break; if (sp > XB_SPIN_CAP) { atomicAdd(&bar[XB_TMO], 1u); break; } }
    }
    nloc = mine > 0u ? mine : 1u; nx = cnt > 0u ? cnt : 1u;
}
__device__ __forceinline__ void xcd_barrier(const XcdBarrier& b) {
    asm volatile("s_waitcnt vmcnt(0)" ::: "memory");
    __syncthreads();
    if (threadIdx.x == 0) {
        unsigned* bar = b.bar;
        __builtin_amdgcn_s_waitcnt(0);
        unsigned nloc = b.st[0], nx = b.st[1];
        if (nloc == 0u) { xcd_barrier_complete(bar, b.x, nloc, nx); b.st[0] = nloc; b.st[1] = nx; }
        const unsigned old = xb_add(&bar[XB_XSUB(b.x)], 1u);
        const unsigned gen = old / nloc;
        if (old + 1u == (gen + 1u) * nloc) {
            __builtin_amdgcn_fence(__ATOMIC_RELEASE, "agent");
            asm volatile("s_waitcnt vmcnt(0)" ::: "memory");
            const unsigned og = xb_add(&bar[XB_TOP], 1u);
            const unsigned tg = og / nx;
            if (og + 1u == (tg + 1u) * nx) xb_add(&bar[XB_TOPGEN], 1u);
            else XB_SPIN(xb_ld(&bar[XB_TOPGEN]) == tg, bar);
            __builtin_amdgcn_fence(__ATOMIC_ACQUIRE, "agent");
            xb_add(&bar[XB_XGEN(b.x)], 1u);
            asm volatile("s_waitcnt vmcnt(0)" ::: "memory");
        } else {
            XB_SPIN(xb_ld(&bar[XB_XGEN(b.x)]) == gen, bar);
            __builtin_amdgcn_fence(__ATOMIC_ACQUIRE, "agent");
            asm volatile("s_waitcnt vmcnt(0)" ::: "memory");
        }
    }
    __syncthreads();
}

template <bool COOP>
__global__ void __launch_bounds__(512, 2) mk_fwd(Params p) {
    extern __shared__ __attribute__((aligned(16))) unsigned char shm[];
    LAS unsigned char* lds = (LAS unsigned char*)shm;
    unsigned char* ws = p.ws;
    const int G = gridDim.x, c = blockIdx.x;
#ifndef PHMASK
#define PHMASK 0x3fff
#endif
#define PH(k) if (((PHMASK >> (k)) & 1) && p.ph_lo <= (k) && (k) < p.ph_hi)
    XcdBarrier xb{};
    if (COOP) { volatile LAS unsigned* st = (volatile LAS unsigned*)(lds + 131072);
        if (threadIdx.x == 0) { st[0] = 0u; st[1] = 0u; }
        __syncthreads();
        xb = xcd_barrier_post((unsigned*)(ws + O_BAR), st); }
#define SYNC(k) if (COOP) { if (p.ph_lo <= (k) && (k) + 1 < p.ph_hi) { xcd_barrier(xb); } }
    PH(0) phase0(p, shm);
    SYNC(0)
    PH(1) { SchedP1 S{(const char*)(ws + O_HB), (const char*)(ws + O_WINT), G, c}; EpiP1 E{(bf16_t*)p.out, (bf16_t*)(ws + O_VT)}; gemm_phase(lds, 1024, 1024, 1024, S, E); }
    SYNC(1)
    PH(3) { phase2(p, shm);
        asm volatile("s_waitcnt vmcnt(0)" ::: "memory"); __syncthreads();
        SchedP3 S{(const char*)(ws + O_WQ), (const char*)(ws + O_KW), (const char*)(ws + O_VT), (const char*)(ws + O_KWT), G, c};
        EpiP3 E{(bf16_t*)(ws + O_SS), (bf16_t*)(ws + O_KWT), (float*)(ws + O_DENI)}; gemm_phase(lds, 256, 256, 256, S, E); }
    SYNC(3)
    PH(4) phase4(p, shm);
    SYNC(4)
    PH(6) { { SchedP5 S{(const char*)(ws + O_SS), (const char*)(ws + O_VT), (const char*)(ws + O_WQ), (const char*)(ws + O_CINT), G, c};
            EpiP5 E{(bf16_t*)(ws + O_HM), (const float*)(ws + O_DENI), (const float*)(ws + O_DENX), (float*)(ws + O_HSS)}; gemm_phase(lds, 256, 256, 256, S, E); }
        { SchedP6 S{(const char*)(ws + O_HB), (const char*)(ws + O_WINT), G, c};
            EpiP6 E{(bf16_t*)(ws + O_HM), (float*)(ws + O_HSS), p.in[7], (bf16_t*)p.out}; gemm_phase(lds, 1024, 1024, 1024, S, E); } }
    SYNC(6)
    PH(7) phase7(p, shm);
    SYNC(7)
    PH(8) { SchedP8 S{(const char*)(ws + O_HB), (const char*)(ws + O_WINT), (const char*)(ws + O_HM), (const char*)(ws + O_UC), (const char*)(ws + O_WMT), (const char*)(ws + O_WCT), G, c};
        EpiP8 E{(bf16_t*)(ws + O_GMC), (bf16_t*)p.out + (size_t)T_ * 1024, (bf16_t*)(ws + O_MERGED)}; gemm_phase(lds, 1024, 1024, 1024, S, E); }
    SYNC(8)
    PH(9) { SchedN4 S{(const char*)(ws + O_MERGED), (const char*)(ws + O_WOT), (size_t)256 * 1024 * 2, (size_t)256 * 1024 * 2, G, c};
        EpiRes<false> E{p.in[0], (bf16_t*)(ws + O_X1B), (float*)(ws + O_SSQ1)}; gemm_phase(lds, 1024, 1024, 1024, S, E); }
    SYNC(9)
    PH(10) { { SchedP10 S{(const char*)(ws + O_X1B), (const char*)(ws + O_WGUT), G, c}; EpiP10 E{(const float*)(ws + O_SSQ1), (bf16_t*)(ws + O_HID)}; gemm_phase(lds, 1024, 1024, 1024, S, E); }
        { const int h = G >> 1; SchedPE S{(const char*)(ws + O_PB), (const char*)(ws + O_WPPT), h, c - h};
            EpiBf E{(bf16_t*)(ws + O_PE)}; if (c >= h) gemm_phase(lds, 256, 256, 256, S, E); } }
    SYNC(10)
    PH(11) { SchedN4 S{(const char*)(ws + O_HID), (const char*)(ws + O_WDT), (size_t)256 * DFF_ * 2, (size_t)256 * DFF_ * 2, G, c};
            EpiRes<true> E{(const void*)(ws + O_X1B), (bf16_t*)(ws + O_X2B), (float*)(ws + O_SSQ2)}; gemm_phase(lds, DFF_, DFF_, DFF_, S, E); }
    SYNC(11)
    PH(12) { SchedN4 S{(const char*)(ws + O_X2B), (const char*)(ws + O_WPGT), (size_t)256 * 1024 * 2, (size_t)256 * 1024 * 2, G, c};
        EpiP12 E{(const float*)(ws + O_SSQ2), (const bf16_t*)(ws + O_PE), (const bf16_t*)(ws + O_X2B), p.out, (float*)(ws + O_SSQ3), (unsigned*)(ws + O_BAR) + XCD_BAR_WORDS, p.in[22]}; gemm_phase(lds, 1024, 1024, 1024, S, E); }
#undef PH
#undef SYNC
}

extern "C" void kernel_launch(void* const* d_in, const int* in_sizes, int n_in, void* d_out, int out_size, void* d_ws, size_t ws_size, hipStream_t stream) {
    static int grid = 0;
    if (grid == 0) {
        if (n_in != 23 || out_size != T_ * D_ || ws_size < WS_NEED) { fprintf(stderr, "kernel_launch: unexpected shapes (n_in %d, out %d, ws %zu)\n", n_in, out_size, ws_size); grid = -1; return; }
        int dev = 0, cus = 0, per_cu = 0;
        hipGetDevice(&dev); hipDeviceGetAttribute(&cus, hipDeviceAttributeMultiprocessorCount, dev);
        hipFuncSetAttribute((const void*)mk_fwd<true>, hipFuncAttributeMaxDynamicSharedMemorySize, LDS_BYTES);
        hipFuncSetAttribute((const void*)mk_fwd<false>, hipFuncAttributeMaxDynamicSharedMemorySize, LDS_BYTES);
        hipOccupancyMaxActiveBlocksPerMultiprocessor(&per_cu, (const void*)mk_fwd<true>, 512, LDS_BYTES);
        if (per_cu < 1) { fprintf(stderr, "kernel_launch: occupancy query reports %d blocks per CU\n", per_cu); per_cu = 1; }
        (void)hipGetLastError();
        grid = cus;
        if (grid != 256) { fprintf(stderr, "kernel_launch: built for a 256-CU device (got %d CUs)\n", cus); grid = -1; return; }
    }
    if (grid < 0) return;
    Params p{};
    for (int i = 0; i < 23; ++i) p.in[i] = (const float*)d_in[i];
    p.out = (float*)d_out; p.ws = (unsigned char*)d_ws;
#if MK_MULTI
#ifndef PROBE_DUP
#define PROBE_DUP -1
#endif
    for (int k = 0; k < NPHASE; ++k) { p.ph_lo = k; p.ph_hi = k + 1; hipLaunchKernelGGL(mk_fwd<false>, dim3(grid), dim3(512), LDS_BYTES, stream, p);
        if (k == PROBE_DUP) hipLaunchKernelGGL(mk_fwd<false>, dim3(grid), dim3(512), LDS_BYTES, stream, p); }
#else
    p.ph_lo = 0; p.ph_hi = NPHASE;
    if (hipMemsetAsync((unsigned char*)d_ws + O_BAR, 0, (XCD_BAR_WORDS + 64 * 64) * 4, stream) != hipSuccess) { fprintf(stderr, "kernel_launch: memset of barrier words failed\n"); return; }
    void* args[] = {&p};
    hipError_t e = hipLaunchCooperativeKernel((const void*)mk_fwd<true>, dim3(grid), dim3(512), args, LDS_BYTES, stream);
    if (e != hipSuccess) fprintf(stderr, "cooperative launch failed: %s (grid %d)\n", hipGetErrorString(e), grid);
#endif
}
```

```cpp
#include <hip/hip_runtime.h>
#include <hip/hip_cooperative_groups.h>
#include <cstdio>
namespace cg = cooperative_groups;

#ifndef MK_MULTI
#define MK_MULTI 0
#endif

#define LAS __attribute__((address_space(3)))
typedef unsigned short bf16_t;
typedef short bf16x8 __attribute__((ext_vector_type(8)));
typedef float f32x4 __attribute__((ext_vector_type(4)));
typedef float f32x2 __attribute__((ext_vector_type(2)));
typedef unsigned u32x4 __attribute__((ext_vector_type(4)));
typedef unsigned u32x2 __attribute__((ext_vector_type(2)));

constexpr int T_ = 16384, D_ = 1024, NIN_ = 8200, DFF_ = 2816, SEQ_ = 2048;
constexpr float EPS_ = 1e-6f;
constexpr int BM = 256, BK = 64, HALF = 128, HTB = HALF * BK * 2, STAGE_BYTES = 8 * HTB;
constexpr int LDS_BYTES = 136 * 1024;
constexpr int NPHASE = 13;

constexpr size_t KiB = 1024, MiB = 1024 * 1024;
constexpr size_t O_WINT = 0, O_WMT = 16 * MiB, O_WCT = 18 * MiB, O_WOT = 20 * MiB, O_WPGT = 22 * MiB, O_WGUT = 24 * MiB, O_WDT = 35 * MiB, O_WPPT = 40 * MiB + 512 * KiB;
constexpr size_t O_IG = 41 * MiB, O_LF = O_IG + 256 * KiB, O_ZERO = O_LF + 256 * KiB;
constexpr size_t O_DENI = O_ZERO, O_HSS = O_DENI + 256 * KiB, O_SSQ1 = O_HSS + 256 * KiB, O_SSQ2 = O_SSQ1 + 64 * KiB, O_SSQ3 = O_SSQ2 + 64 * KiB, O_NSUM = O_SSQ3 + 64 * KiB;
constexpr size_t ZERO_BYTES = 960 * KiB;
constexpr size_t O_DENX = O_ZERO + ZERO_BYTES, O_EBL = O_DENX + 256 * KiB;
constexpr size_t O_BAR = 43 * MiB;
constexpr size_t O_PB = 44 * MiB, O_HB = 52 * MiB, O_S1 = 84 * MiB, O_S2 = 116 * MiB, O_S3 = 148 * MiB, O_S4 = 180 * MiB, O_S5 = 212 * MiB, WS_NEED = 244 * MiB;
constexpr size_t O_PE = O_HB, O_VT = O_S1, O_U = O_S1, O_MERGED = O_S1, O_HID = O_S1, O_WQ = O_S2, O_GMC = O_S2, O_KW = O_S3, O_CINT = O_S3,
                 O_KWT = O_S4, O_HM = O_S4, O_X1B = O_S4, O_SS = O_S5, O_UC = O_S5, O_X2B = O_S5;

struct Params {
    const float* in[23];
    float* out;
    unsigned char* ws;
    int ph_lo, ph_hi;
};

__device__ __forceinline__ unsigned cvt_pk_bf16(float lo, float hi) { unsigned r; asm volatile("v_cvt_pk_bf16_f32 %0, %1, %2" : "=v"(r) : "v"(lo), "v"(hi)); return r; }
__device__ __forceinline__ float bf_lo(unsigned w) { return __uint_as_float(w << 16); }
__device__ __forceinline__ float bf_hi(unsigned w) { return __uint_as_float(w & 0xffff0000u); }
__device__ __forceinline__ float sigm(float x) { return __builtin_amdgcn_rcpf(1.0f + __builtin_amdgcn_exp2f(x * -1.4426950408889634f)); }
__device__ __forceinline__ float silu(float x) { return x * __builtin_amdgcn_rcpf(1.0f + __builtin_amdgcn_exp2f(x * -1.4426950408889634f)); }
__device__ __forceinline__ float wave_sum(float v) {
#pragma unroll
    for (int o = 32; o > 0; o >>= 1) v += __shfl_xor(v, o);
    return v;
}
__device__ __forceinline__ u32x4 pack8(const f32x4 a, const f32x4 b) { u32x4 w; w.x = cvt_pk_bf16(a[0], a[1]); w.y = cvt_pk_bf16(a[2], a[3]); w.z = cvt_pk_bf16(b[0], b[1]); w.w = cvt_pk_bf16(b[2], b[3]); return w; }
__device__ __forceinline__ void unpack8(const u32x4 w, f32x4& a, f32x4& b) { a[0] = bf_lo(w.x); a[1] = bf_hi(w.x); a[2] = bf_lo(w.y); a[3] = bf_hi(w.y); b[0] = bf_lo(w.z); b[1] = bf_hi(w.z); b[2] = bf_lo(w.w); b[3] = bf_hi(w.w); }

__host__ __device__ __forceinline__ int lds_byte(int r, int c) { const int st = (r >> 4) * 2 + (c >> 5), rr = r & 15, cc = c & 31, ob = rr * 64 + cc * 2; return st * 1024 + (ob ^ (((ob >> 9) & 1) << 5)); }
__host__ __device__ __forceinline__ void stage_rc(int b, int& R, int& C) { const int st = b / 1024, sb = b % 1024, swz = sb ^ (((sb >> 9) & 1) << 5); R = (st >> 1) * 16 + swz / 64; C = (st & 1) * 32 + (swz % 64) / 2; }
__host__ __device__ __forceinline__ int perm32(int rho) { const int n = rho >> 4, i = rho & 15; return 8 * (i >> 2) + 4 * n + (i & 3); }

struct Unit { const char* a; const char* b; int pm, pn, kind, cont; };
__device__ __forceinline__ void map_n4(int L, int& pm, int& pn) { const int x = L & 7, k = L >> 3; pm = x * 8 + (k & 7); pn = k >> 3; }

__device__ __forceinline__ void tile_order(int L, int nM, int nN, int& pm, int& pn) {
    const int nwg = nM * nN; int wgid = L;
    { const int q = nwg / 8, r = nwg % 8, xcd = wgid % 8, off = wgid / 8; wgid = (xcd < r ? xcd * (q + 1) : r * (q + 1) + (xcd - r) * q) + off; }
    const int nig = 8 * nN, gid = wgid / nig, fm = gid * 8, gsz = (nM - fm) < 8 ? (nM - fm) : 8;
    pm = fm + ((wgid % nig) % gsz); pn = (wgid % nig) / gsz;
}

template <class Epi, class Sched>
__device__ __forceinline__ void gemm_phase(LAS unsigned char* lds, const int K, const int lda, const int ldb, const Sched& S, const Epi& E) {
    const int tid = threadIdx.x, wid = __builtin_amdgcn_readfirstlane(tid >> 6), lane = tid & 63, wr = wid >> 2, wc = wid & 3, fr = lane & 15, fq = lane >> 4;
    const int nt = K / BK;
    unsigned voffA[2], voffB[2];
#pragma unroll
    for (int i = 0; i < 2; ++i) { int R, C; stage_rc(tid * 16 + i * 8192, R, C); const int Rb = (R & ~31) + perm32(R & 31);
        voffA[i] = (unsigned)(R * lda + C) * 2u; voffB[i] = (unsigned)(Rb * ldb + C) * 2u; }
    const size_t kstep = (size_t)(BK * 2);
    const size_t hstepA = (size_t)HALF * lda * 2, hstepB = (size_t)HALF * ldb * 2;
    const unsigned ldsw = (unsigned)wid * 1024u;
    const int aoff = lds_byte(wr * 64 + fr, fq * 8), boff = lds_byte(wc * 32 + fr, fq * 8);
#define PG8_SA(b, h) (((b) * 2 + (h)) * HTB)
#define PG8_SB(b, h) ((4 + (b) * 2 + (h)) * HTB)
#define PG8_STAGE(bufoff, gbase, voff) do { _Pragma("unroll") for (int _i = 0; _i < 2; ++_i) \
        __builtin_amdgcn_global_load_lds((const unsigned*)((const char*)(gbase) + (voff)[_i]), (LAS unsigned*)(lds + (bufoff) + ldsw + _i * 8192), 16, 0, 0); } while (0)
#define PG8_LDA(dst, b, h) do { _Pragma("unroll") for (int m = 0; m < 4; ++m) _Pragma("unroll") for (int k = 0; k < 2; ++k) dst[m][k] = *(const LAS bf16x8*)(lds + PG8_SA(b, h) + aoff + m * 2048 + k * 1024); } while (0)
#define PG8_LDB(dst, b, h) do { _Pragma("unroll") for (int n = 0; n < 2; ++n) _Pragma("unroll") for (int k = 0; k < 2; ++k) dst[n][k] = *(const LAS bf16x8*)(lds + PG8_SB(b, h) + boff + n * 2048 + k * 1024); } while (0)
#define PG8_MMA(ai, bj, At, Bt) do { __builtin_amdgcn_s_setprio(1); _Pragma("unroll") for (int m = 0; m < 4; ++m) _Pragma("unroll") for (int n = 0; n < 2; ++n) _Pragma("unroll") for (int k = 0; k < 2; ++k) \
        acc[ai][bj][m][n] = __builtin_amdgcn_mfma_f32_16x16x32_bf16(Bt[n][k], At[m][k], acc[ai][bj][m][n], 0, 0, 0); __builtin_amdgcn_s_setprio(0); } while (0)
#define PG8_WAIT_V(n) asm volatile("s_waitcnt vmcnt(" #n ")" ::: "memory")
#define PG8_WAIT_L(n) asm volatile("s_waitcnt lgkmcnt(" #n ")" ::: "memory")
#define PG8_BAR __builtin_amdgcn_s_barrier()
#define PG8_SCHED __builtin_amdgcn_sched_barrier(0)
#define PG8_ZERO() do { _Pragma("unroll") for (int a = 0; a < 2; ++a) _Pragma("unroll") for (int b = 0; b < 2; ++b) _Pragma("unroll") for (int m = 0; m < 4; ++m) _Pragma("unroll") for (int n = 0; n < 2; ++n) acc[a][b][m][n] = (f32x4){0.f, 0.f, 0.f, 0.f}; } while (0)
    Unit cur, nxt; int ui = 0;
    if (!S.next(0, cur)) return;
    E.pre(cur, wr, wc, fr, fq);
    f32x4 acc[2][2][4][2];
    PG8_ZERO();
    bf16x8 At[4][2], B0[2][2], B1[2][2];
    const char* cA = cur.a; const char* cB = cur.b;
    PG8_STAGE(PG8_SB(0, 0), cB, voffB); PG8_STAGE(PG8_SA(0, 0), cA, voffA); PG8_STAGE(PG8_SB(0, 1), cB + hstepB, voffB); PG8_STAGE(PG8_SA(0, 1), cA + hstepA, voffA);
    if (wr == 1) PG8_BAR;
    PG8_WAIT_V(4); PG8_BAR;
    PG8_STAGE(PG8_SB(1, 0), cB + kstep, voffB); PG8_STAGE(PG8_SA(1, 0), cA + kstep, voffA); PG8_STAGE(PG8_SB(1, 1), cB + hstepB + kstep, voffB);
    PG8_WAIT_V(6); PG8_BAR;
    for (;;) {
        const bool has_next = S.next(ui + 1, nxt);
        const char* nA = has_next ? nxt.a : cA; const char* nB = has_next ? nxt.b : cB;
#pragma unroll 1
        for (int t = 0; t < nt; t += 2) {
            const bool last = (t == nt - 2);
            const char* a1 = cA + (size_t)(t + 1) * kstep;
            const char* a2 = last ? nA : cA + (size_t)(t + 2) * kstep; const char* b2 = last ? nB : cB + (size_t)(t + 2) * kstep;
            const char* a3 = a2 + kstep; const char* b3 = b2 + kstep;
            PG8_LDB(B0, 0, 0); PG8_SCHED; PG8_LDA(At, 0, 0); PG8_STAGE(PG8_SA(1, 1), a1 + hstepA, voffA);
            PG8_WAIT_L(8); PG8_BAR; PG8_WAIT_L(0); PG8_MMA(0, 0, At, B0); PG8_BAR; PG8_SCHED;
            PG8_LDB(B1, 0, 1); PG8_STAGE(PG8_SB(0, 0), b2, voffB);
            PG8_BAR; PG8_WAIT_L(0); PG8_MMA(0, 1, At, B1); PG8_BAR;
            PG8_LDA(At, 0, 1); PG8_STAGE(PG8_SA(0, 0), a2, voffA);
            PG8_BAR; PG8_WAIT_L(0); PG8_MMA(1, 0, At, B0); PG8_BAR; PG8_SCHED;
            PG8_STAGE(PG8_SB(0, 1), b2 + hstepB, voffB);
            PG8_WAIT_V(6); PG8_BAR; PG8_MMA(1, 1, At, B1); PG8_BAR;
            PG8_LDB(B0, 1, 0); PG8_SCHED; PG8_LDA(At, 1, 0); PG8_STAGE(PG8_SA(0, 1), a2 + hstepA, voffA);
            PG8_WAIT_L(8); PG8_BAR; PG8_WAIT_L(0); PG8_MMA(0, 0, At, B0); PG8_BAR; PG8_SCHED;
            PG8_LDB(B1, 1, 1); PG8_STAGE(PG8_SB(1, 0), b3, voffB);
            PG8_BAR; PG8_WAIT_L(0); PG8_MMA(0, 1, At, B1); PG8_BAR;
            PG8_LDA(At, 1, 1); PG8_STAGE(PG8_SA(1, 0), a3, voffA);
            PG8_BAR; PG8_WAIT_L(0); PG8_MMA(1, 0, At, B0); PG8_BAR; PG8_SCHED;
            PG8_STAGE(PG8_SB(1, 1), b3 + hstepB, voffB);
            PG8_WAIT_V(6); PG8_BAR; PG8_MMA(1, 1, At, B1); PG8_BAR;
        }
        if (cur.cont) { E.mid(acc, cur, wr, wc, fr, fq); }
        else { if constexpr (!Epi::AFTER_DRAIN) E(acc, cur, wr, wc, fr, fq); if (!has_next) break; PG8_ZERO(); }
        cur = nxt; cA = nA; cB = nB; ++ui;
    }
    PG8_WAIT_V(0);
    if (wr == 0) PG8_BAR;
    PG8_BAR;
    if constexpr (Epi::AFTER_DRAIN) E(acc, cur, wr, wc, fr, fq);
#undef PG8_SA
#undef PG8_SB
#undef PG8_STAGE
#undef PG8_LDA
#undef PG8_LDB
#undef PG8_MMA
#undef PG8_WAIT_V
#undef PG8_WAIT_L
#undef PG8_BAR
#undef PG8_SCHED
#undef PG8_ZERO
}

typedef f32x4 Acc[2][2][4][2];
#define EPI_ROWS(ai, m) _Pragma("unroll") for (int ai = 0; ai < 2; ++ai) _Pragma("unroll") for (int m = 0; m < 4; ++m) if (epi_fence())
__device__ __forceinline__ bool epi_fence() { asm volatile("" ::: "memory"); return true; }
#define EPI_R8 _Pragma("unroll") for (int r8 = 0; r8 < 8; ++r8)
#define EPI_RL(ai, m) ((ai) * 128 + wr * 64 + (m) * 16 + fr)
#define EPI_CL(bj) ((bj) * 128 + wc * 32 + 8 * fq)

struct SchedP1 { const char* hb; const char* wint; int G, c;
    __device__ __forceinline__ bool next(int i, Unit& u) const {
        const int L = i * G + c; if (L >= 768) return false;
        u.cont = 0;
        if (L < 512) { int pm, pn; tile_order(L, 64, 8, pm, pn); u.pm = pm; u.pn = pn; u.kind = 0; u.a = hb + (size_t)pm * 256 * 1024 * 2; u.b = wint + (size_t)pn * 256 * 1024 * 2; }
        else { const int l = L - 512; u.pm = l & 3; u.pn = l >> 2; u.kind = 1; u.a = wint + (size_t)(2048 + u.pm * 256) * 1024 * 2; u.b = hb + (size_t)u.pn * 256 * 1024 * 2; }
        return true; } };
struct EpiP1 { static constexpr bool AFTER_DRAIN = false; bf16_t* qkpre; bf16_t* vt;
    __device__ __forceinline__ void mid(Acc&, const Unit&, int, int, int, int) const {}
    __device__ __forceinline__ void pre(const Unit&, int, int, int, int) const {}
    __device__ __forceinline__ void operator()(Acc& acc, const Unit& u, int wr, int wc, int fr, int fq) const {
        bf16_t* base; int ld;
        if (u.kind == 0) { base = qkpre + (size_t)u.pm * 256 * 2048 + u.pn * 256; ld = 2048; }
        else { const int item = ((u.pn >> 3) * 4 + u.pm) * 8 + (u.pn & 7); base = vt + (size_t)item * 65536; ld = 256; }
        EPI_ROWS(ai, m) { bf16_t* rowp = base + (size_t)EPI_RL(ai, m) * ld + EPI_CL(0);
#pragma unroll
            for (int bj = 0; bj < 2; ++bj) *(u32x4*)(rowp + bj * 128) = pack8(acc[ai][bj][m][0], acc[ai][bj][m][1]); }
    } };

struct SchedP3 { const char* wq; const char* kw; const char* vt; const char* kwt; int G, c;
    __device__ __forceinline__ bool next(int i, Unit& u) const {
        const int L = i * G + c; if (L >= 512) return false;
        u.cont = 0; u.pn = 0;
        if (L < 256) { u.pm = L; u.kind = 0; u.a = wq + (size_t)L * 131072; u.b = kw + (size_t)L * 131072; }
        else { const int it = L - 256; u.pm = it; u.kind = 1; u.a = vt + (size_t)it * 131072; u.b = kwt + (size_t)it * 131072; }
        return true; } };
struct EpiP3 { static constexpr bool AFTER_DRAIN = false; bf16_t* s; bf16_t* lt; float* deni;
    __device__ __forceinline__ void mid(Acc&, const Unit&, int, int, int, int) const {}
    __device__ __forceinline__ void pre(const Unit&, int, int, int, int) const {}
    __device__ __forceinline__ void operator()(Acc& acc, const Unit& u, int wr, int wc, int fr, int fq) const {
        const int item = u.pm;
        if (u.kind == 0) {
            const int b = item >> 5, h = (item >> 3) & 3, sc = item & 7; const int tokb = b * SEQ_ + sc * 256;
            EPI_ROWS(ai, m) { int r = EPI_RL(ai, m); asm volatile("" : "+v"(r)); float rs = 0.f;
#pragma unroll
                for (int bj = 0; bj < 2; ++bj) { const int c0 = EPI_CL(bj); f32x4 v0 = acc[ai][bj][m][0], v1 = acc[ai][bj][m][1];
#pragma unroll
                    for (int j = 0; j < 4; ++j) { v0[j] = (c0 + j <= r) ? v0[j] : 0.f; v1[j] = (c0 + 4 + j <= r) ? v1[j] : 0.f; rs += v0[j] + v1[j]; }
                    *(u32x4*)(s + (size_t)item * 65536 + r * 256 + c0) = pack8(v0, v1); }
                rs += __shfl_xor(rs, 16); rs += __shfl_xor(rs, 32);
                if (fq == 0) unsafeAtomicAdd(deni + (size_t)(tokb + r) * 4 + h, rs); }
        } else {
            EPI_ROWS(ai, m) { bf16_t* rowp = lt + (size_t)item * 65536 + EPI_RL(ai, m) * 256 + EPI_CL(0);
#pragma unroll
                for (int bj = 0; bj < 2; ++bj) *(u32x4*)(rowp + bj * 128) = pack8(acc[ai][bj][m][0], acc[ai][bj][m][1]); }
        }
    } };

struct SchedP5 { const char* s; const char* vt; const char* wq; const char* cint; int G, c;
    __device__ __forceinline__ bool next(int i, Unit& u) const {
        const int item = (i >> 1) * G + c; if (item >= 256) return false;
        u.pm = item; u.pn = 0; u.kind = 0;
        if ((i & 1) == 0) { u.cont = 1; u.a = s + (size_t)item * 131072; u.b = vt + (size_t)item * 131072; }
        else { u.cont = 0; u.a = wq + (size_t)item * 131072; u.b = cint + (size_t)item * 131072; }
        return true; } };
struct EpiP5 { static constexpr bool AFTER_DRAIN = false; bf16_t* hm; const float* deni; const float* denx; float* hss;
    __device__ __forceinline__ void mid(Acc&, const Unit&, int, int, int, int) const {}
    __device__ __forceinline__ void pre(const Unit&, int, int, int, int) const {}
    __device__ __forceinline__ void operator()(Acc& acc, const Unit& u, int wr, int wc, int fr, int fq) const {
        const int item = u.pm; const int b = item >> 5, h = (item >> 3) & 3, sc = item & 7; const int tokb = b * SEQ_ + sc * 256;
        float dnv[2][4];
#pragma unroll
        for (int ai = 0; ai < 2; ++ai)
#pragma unroll
            for (int m = 0; m < 4; ++m) { const int t = tokb + EPI_RL(ai, m); dnv[ai][m] = deni[(size_t)t * 4 + h] + denx[(size_t)t * 4 + h]; }
        EPI_ROWS(ai, m) { const int t = tokb + EPI_RL(ai, m);
            const float den = dnv[ai][m]; const float inv = __builtin_amdgcn_rcpf(fmaxf(fabsf(den), 1.0f)); float ss = 0.f;
#pragma unroll
            for (int bj = 0; bj < 2; ++bj) { f32x4 v0 = acc[ai][bj][m][0] * inv, v1 = acc[ai][bj][m][1] * inv;
#pragma unroll
                for (int j = 0; j < 4; ++j) ss += v0[j] * v0[j] + v1[j] * v1[j];
                *(u32x4*)(hm + (size_t)t * 1024 + h * 256 + EPI_CL(bj)) = pack8(v0, v1); }
            ss += __shfl_xor(ss, 16); ss += __shfl_xor(ss, 32);
            if (fq == 0) unsafeAtomicAdd(hss + (size_t)t * 4 + h, ss); }
    } };

struct SchedP6 { const char* hb; const char* wint; int G, c;
    __device__ __forceinline__ bool next(int i, Unit& u) const {
        u.cont = 0;
        if (i == 0) { const int item = c; if (item >= 256) return false; const int b = item >> 5, h = (item >> 3) & 3, sc = item & 7;
            u.pm = b * 8 + sc; u.pn = h; u.kind = 0; u.a = hb + (size_t)u.pm * 256 * 1024 * 2; u.b = wint + (size_t)(3072 + h * 256) * 1024 * 2; return true; }
        const int L = (i - 1) * G + c; if (L >= 512) return false;
        int pm, pn; tile_order(L, 64, 8, pm, pn); u.pm = pm; u.pn = pn; u.kind = 1;
        u.a = hb + (size_t)pm * 256 * 1024 * 2; u.b = wint + (size_t)(4096 + pn * 256) * 1024 * 2; return true; } };
struct EpiP6 { static constexpr bool AFTER_DRAIN = false; bf16_t* hm; float* hss; const float* mhg; bf16_t* uu;
    __device__ __forceinline__ void mid(Acc&, const Unit&, int, int, int, int) const {}
    __device__ __forceinline__ void pre(const Unit&, int, int, int, int) const {}
    __device__ __forceinline__ void operator()(Acc& acc, const Unit& u, int wr, int wc, int fr, int fq) const {
        if (u.kind == 0) {
            float hsv[2][4];
#pragma unroll
            for (int ai = 0; ai < 2; ++ai)
#pragma unroll
                for (int m = 0; m < 4; ++m) hsv[ai][m] = __hip_atomic_load(hss + (size_t)(u.pm * 256 + EPI_RL(ai, m)) * 4 + u.pn, __ATOMIC_RELAXED, __HIP_MEMORY_SCOPE_AGENT);
            u32x4 cur[2], nxt[2];
#pragma unroll
            for (int bj = 0; bj < 2; ++bj) cur[bj] = *(const u32x4*)(hm + (size_t)(u.pm * 256 + EPI_RL(0, 0)) * 1024 + u.pn * 256 + EPI_CL(bj));
            EPI_R8 { const int ai = r8 >> 2, m = r8 & 3; const int t = u.pm * 256 + EPI_RL(ai, m);
                if (r8 < 7) { const int tn = u.pm * 256 + EPI_RL((r8 + 1) >> 2, (r8 + 1) & 3);
#pragma unroll
                    for (int bj = 0; bj < 2; ++bj) nxt[bj] = *(const u32x4*)(hm + (size_t)tn * 1024 + u.pn * 256 + EPI_CL(bj)); }
                const float rsn = rsqrtf(hsv[ai][m] * (1.0f / 256.0f) + EPS_);
#pragma unroll
                for (int bj = 0; bj < 2; ++bj) { f32x4 h0, h1; unpack8(cur[bj], h0, h1); f32x4 o0, o1;
#pragma unroll
                    for (int j = 0; j < 4; ++j) { o0[j] = h0[j] * rsn * sigm(acc[ai][bj][m][0][j]); o1[j] = h1[j] * rsn * sigm(acc[ai][bj][m][1][j]); }
                    *(u32x4*)(hm + (size_t)t * 1024 + u.pn * 256 + EPI_CL(bj)) = pack8(o0, o1); }
                cur[0] = nxt[0]; cur[1] = nxt[1]; }
        } else {
            EPI_ROWS(ai, m) { const int t = u.pm * 256 + EPI_RL(ai, m); f32x4 o0, o1;
#pragma unroll
                for (int j = 0; j < 4; ++j) { o0[j] = acc[ai][0][m][0][j] * sigm(acc[ai][1][m][0][j]); o1[j] = acc[ai][0][m][1][j] * sigm(acc[ai][1][m][1][j]); }
                *(u32x4*)(uu + (size_t)t * 1024 + u.pn * 128 + wc * 32 + 8 * fq) = pack8(o0, o1); }
        }
    } };

struct SchedP8 { const char* hb; const char* wint; const char* hmg; const char* uc; const char* wmt; const char* wct; int G, c;
    __device__ __forceinline__ bool next(int i, Unit& u) const {
        const int L = (i >> 2) * G + c, r = i & 3; if (L >= 256) return false;
        int pn; map_n4(L, u.pm, pn); u.cont = 0;
        if (r < 2) { u.kind = 2; u.pn = 2 * pn + r; u.a = hb + (size_t)u.pm * 256 * 1024 * 2; u.b = wint + (size_t)(6144 + u.pn * 256) * 1024 * 2; }
        else if (r == 2) { u.kind = 0; u.pn = pn; u.a = hmg + (size_t)u.pm * 256 * 1024 * 2; u.b = wmt + (size_t)pn * 256 * 1024 * 2; }
        else { u.kind = 1; u.pn = pn; u.a = uc + (size_t)u.pm * 256 * 1024 * 2; u.b = wct + (size_t)pn * 256 * 1024 * 2; }
        return true; } };
struct EpiP8 { static constexpr bool AFTER_DRAIN = false; bf16_t* gmc; bf16_t* tmp; bf16_t* merged;
    __device__ __forceinline__ void mid(Acc&, const Unit&, int, int, int, int) const {}
    __device__ __forceinline__ void pre(const Unit&, int, int, int, int) const {}
    __device__ __forceinline__ void operator()(Acc& acc, const Unit& u, int wr, int wc, int fr, int fq) const {
        if (u.kind == 2) {
            EPI_ROWS(ai, m) { const int t = u.pm * 256 + EPI_RL(ai, m); f32x4 r0, r1, c0, c1;
#pragma unroll
                for (int j = 0; j < 4; ++j) { const float e0 = __builtin_amdgcn_exp2f(acc[ai][1][m][0][j] * -1.4426950408889634f), e1 = __builtin_amdgcn_exp2f(acc[ai][1][m][1][j] * -1.4426950408889634f);
                    r0[j] = sigm(acc[ai][0][m][0][j]) * (1.0f + e0); r1[j] = sigm(acc[ai][0][m][1][j]) * (1.0f + e1);
                    c0[j] = __builtin_amdgcn_rcpf(1.0f + e0); c1[j] = __builtin_amdgcn_rcpf(1.0f + e1); }
                bf16_t* ptr = gmc + (size_t)t * 2048 + u.pn * 128 + wc * 32 + 8 * fq;
                *(u32x4*)ptr = pack8(r0, r1); *(u32x4*)(ptr + 1024) = pack8(c0, c1); }
        } else if (u.kind == 0) {
            u32x4 cur[2], nxt[2];
#pragma unroll
            for (int bj = 0; bj < 2; ++bj) cur[bj] = *(const u32x4*)(gmc + (size_t)(u.pm * 256 + EPI_RL(0, 0)) * 2048 + u.pn * 256 + EPI_CL(bj));
            EPI_R8 { const int ai = r8 >> 2, m = r8 & 3; const int t = u.pm * 256 + EPI_RL(ai, m);
                if (r8 < 7) { const int tn = u.pm * 256 + EPI_RL((r8 + 1) >> 2, (r8 + 1) & 3);
#pragma unroll
                    for (int bj = 0; bj < 2; ++bj) nxt[bj] = *(const u32x4*)(gmc + (size_t)tn * 2048 + u.pn * 256 + EPI_CL(bj)); }
#pragma unroll
                for (int bj = 0; bj < 2; ++bj) { const int c = u.pn * 256 + EPI_CL(bj); f32x4 a0, a1; unpack8(cur[bj], a0, a1);
                    *(u32x4*)(tmp + (size_t)t * 1024 + c) = pack8(acc[ai][bj][m][0] * a0, acc[ai][bj][m][1] * a1); }
                cur[0] = nxt[0]; cur[1] = nxt[1]; }
        } else {
            u32x4 cg[2], ct[2], ng[2], nt2[2];
#pragma unroll
            for (int bj = 0; bj < 2; ++bj) { const int t0 = u.pm * 256 + EPI_RL(0, 0); const int c = u.pn * 256 + EPI_CL(bj);
                cg[bj] = *(const u32x4*)(gmc + (size_t)t0 * 2048 + 1024 + c); ct[bj] = *(const u32x4*)(tmp + (size_t)t0 * 1024 + c); }
            EPI_R8 { const int ai = r8 >> 2, m = r8 & 3; const int t = u.pm * 256 + EPI_RL(ai, m);
                if (r8 < 7) { const int tn = u.pm * 256 + EPI_RL((r8 + 1) >> 2, (r8 + 1) & 3);
#pragma unroll
                    for (int bj = 0; bj < 2; ++bj) { const int c = u.pn * 256 + EPI_CL(bj); ng[bj] = *(const u32x4*)(gmc + (size_t)tn * 2048 + 1024 + c); nt2[bj] = *(const u32x4*)(tmp + (size_t)tn * 1024 + c); } }
#pragma unroll
                for (int bj = 0; bj < 2; ++bj) { const int c = u.pn * 256 + EPI_CL(bj); f32x4 b0, b1, t0, t1; unpack8(cg[bj], b0, b1); unpack8(ct[bj], t0, t1);
                    *(u32x4*)(merged + (size_t)t * 1024 + c) = pack8((acc[ai][bj][m][0] + t0) * b0, (acc[ai][bj][m][1] + t1) * b1); }
                cg[0] = ng[0]; cg[1] = ng[1]; ct[0] = nt2[0]; ct[1] = nt2[1]; }
        }
    } };

struct SchedN4 { const char* a; const char* bt; size_t astep, bstep; int G, c;
    __device__ __forceinline__ bool next(int i, Unit& u) const {
        const int L = i * G + c; if (L >= 256) return false;
        map_n4(L, u.pm, u.pn); u.kind = 0; u.cont = 0; u.a = a + (size_t)u.pm * astep; u.b = bt + (size_t)u.pn * bstep; return true; } };
struct SchedPE { const char* a; const char* bt; int G, c;
    __device__ __forceinline__ bool next(int i, Unit& u) const {
        const int L = i * G + c; if (L >= 256 || c < 0) return false;
        u.pm = L >> 2; u.pn = L & 3; u.kind = 0; u.cont = 0; u.a = a + (size_t)u.pm * 256 * 256 * 2; u.b = bt + (size_t)u.pn * 256 * 256 * 2; return true; } };
template <bool SRC_BF16> struct EpiRes { static constexpr bool AFTER_DRAIN = false; const void* src; bf16_t* dstb; float* ssq;
    __device__ __forceinline__ void mid(Acc&, const Unit&, int, int, int, int) const {}
    __device__ __forceinline__ void pre(const Unit& u, int wr, int wc, int fr, int fq) const {
        if (!SRC_BF16) {
            EPI_ROWS(ai, m) { const int t = u.pm * 256 + EPI_RL(ai, m);
#pragma unroll
                for (int bj = 0; bj < 2; ++bj) { const float v = *((const float*)src + (size_t)t * 1024 + u.pn * 256 + EPI_CL(bj)); asm volatile("" :: "v"(v)); } }
        }
    }
    __device__ __forceinline__ void operator()(Acc& acc, const Unit& u, int wr, int wc, int fr, int fq) const {
        f32x4 cur[2][2], nxt[2][2];
#define ERES_LOAD(dst, t_) do { _Pragma("unroll") for (int bj = 0; bj < 2; ++bj) { const size_t o_ = (size_t)(t_) * 1024 + u.pn * 256 + EPI_CL(bj); \
            if (SRC_BF16) dst[bj][0] = __builtin_bit_cast(f32x4, *(const u32x4*)((const bf16_t*)src + o_)); \
            else { dst[bj][0] = *(const f32x4*)((const float*)src + o_); dst[bj][1] = *(const f32x4*)((const float*)src + o_ + 4); } } } while (0)
        ERES_LOAD(cur, u.pm * 256 + EPI_RL(0, 0));
        EPI_R8 { const int ai = r8 >> 2, m = r8 & 3; const int t = u.pm * 256 + EPI_RL(ai, m); float ss = 0.f;
            if (r8 < 7) ERES_LOAD(nxt, u.pm * 256 + EPI_RL((r8 + 1) >> 2, (r8 + 1) & 3));
#pragma unroll
            for (int bj = 0; bj < 2; ++bj) { const size_t o = (size_t)t * 1024 + u.pn * 256 + EPI_CL(bj); f32x4 v0, v1;
                if (SRC_BF16) unpack8(__builtin_bit_cast(u32x4, cur[bj][0]), v0, v1); else { v0 = cur[bj][0]; v1 = cur[bj][1]; }
                v0 += acc[ai][bj][m][0]; v1 += acc[ai][bj][m][1];
#pragma unroll
                for (int j = 0; j < 4; ++j) ss += v0[j] * v0[j] + v1[j] * v1[j];
                *(u32x4*)(dstb + o) = pack8(v0, v1); }
            ss += __shfl_xor(ss, 16); ss += __shfl_xor(ss, 32);
            if (fq == 0) unsafeAtomicAdd(ssq + t, ss);
#pragma unroll
            for (int bj = 0; bj < 2; ++bj) { cur[bj][0] = nxt[bj][0]; if (!SRC_BF16) cur[bj][1] = nxt[bj][1]; } }
#undef ERES_LOAD
    } };

struct SchedP10 { const char* x1b; const char* wgut; int G, c;
    __device__ __forceinline__ bool next(int i, Unit& u) const {
        const int L = i * G + c; if (L >= 1408) return false;
        int pm, pn; tile_order(L, 64, 22, pm, pn); u.pm = pm; u.pn = pn; u.kind = 0; u.cont = 0;
        u.a = x1b + (size_t)pm * 256 * 1024 * 2; u.b = wgut + (size_t)pn * 256 * 1024 * 2; return true; } };
struct EpiP10 { static constexpr bool AFTER_DRAIN = false; const float* ssq; bf16_t* hid;
    __device__ __forceinline__ void mid(Acc&, const Unit&, int, int, int, int) const {}
    __device__ __forceinline__ void pre(const Unit&, int, int, int, int) const {}
    __device__ __forceinline__ void operator()(Acc& acc, const Unit& u, int wr, int wc, int fr, int fq) const {
        float rsv[2][4];
#pragma unroll
        for (int ai = 0; ai < 2; ++ai)
#pragma unroll
            for (int m = 0; m < 4; ++m) rsv[ai][m] = ssq[u.pm * 256 + EPI_RL(ai, m)];
        EPI_ROWS(ai, m) { const int t = u.pm * 256 + EPI_RL(ai, m); const float rs = rsqrtf(rsv[ai][m] * (1.0f / 1024.0f) + EPS_); f32x4 o0, o1;
#pragma unroll
            for (int j = 0; j < 4; ++j) { o0[j] = silu(acc[ai][0][m][0][j] * rs) * (acc[ai][1][m][0][j] * rs); o1[j] = silu(acc[ai][0][m][1][j] * rs) * (acc[ai][1][m][1][j] * rs); }
            *(u32x4*)(hid + (size_t)t * DFF_ + u.pn * 128 + wc * 32 + 8 * fq) = pack8(o0, o1); }
    } };

struct EpiBf { static constexpr bool AFTER_DRAIN = false; bf16_t* o;
    __device__ __forceinline__ void mid(Acc&, const Unit&, int, int, int, int) const {}
    __device__ __forceinline__ void pre(const Unit&, int, int, int, int) const {}
    __device__ __forceinline__ void operator()(Acc& acc, const Unit& u, int wr, int wc, int fr, int fq) const {
        EPI_ROWS(ai, m) { bf16_t* rowp = o + (size_t)(u.pm * 256 + EPI_RL(ai, m)) * 1024 + u.pn * 256 + EPI_CL(0);
#pragma unroll
            for (int bj = 0; bj < 2; ++bj) *(u32x4*)(rowp + bj * 128) = pack8(acc[ai][bj][m][0], acc[ai][bj][m][1]); }
    } };

struct EpiP12 { static constexpr bool AFTER_DRAIN = true; const float* ssq2; const bf16_t* pe; const bf16_t* xin; float* out; float* ssq3; unsigned* done; const float* fg;
    __device__ __forceinline__ void mid(Acc&, const Unit&, int, int, int, int) const {}
    __device__ __forceinline__ void pre(const Unit&, int, int, int, int) const {}
    __device__ __forceinline__ void operator()(Acc& acc, const Unit& u, int wr, int wc, int fr, int fq) const {
        float rsv[2][4];
#pragma unroll
        for (int ai = 0; ai < 2; ++ai)
#pragma unroll
            for (int m = 0; m < 4; ++m) rsv[ai][m] = ssq2[u.pm * 256 + EPI_RL(ai, m)];
        { u32x4 cx[2], cp[2], nx[2], np[2];
#pragma unroll
            for (int bj = 0; bj < 2; ++bj) { const size_t o = (size_t)(u.pm * 256 + EPI_RL(0, 0)) * 1024 + u.pn * 256 + EPI_CL(bj); cx[bj] = *(const u32x4*)(xin + o); cp[bj] = *(const u32x4*)(pe + o); }
            EPI_R8 { const int ai = r8 >> 2, m = r8 & 3; const int t = u.pm * 256 + EPI_RL(ai, m); const float rs = rsqrtf(rsv[ai][m] * (1.0f / 1024.0f) + EPS_); float ss = 0.f;
                if (r8 < 7) {
#pragma unroll
                    for (int bj = 0; bj < 2; ++bj) { const size_t o = (size_t)(u.pm * 256 + EPI_RL((r8 + 1) >> 2, (r8 + 1) & 3)) * 1024 + u.pn * 256 + EPI_CL(bj); nx[bj] = *(const u32x4*)(xin + o); np[bj] = *(const u32x4*)(pe + o); } }
#pragma unroll
                for (int bj = 0; bj < 2; ++bj) { f32x4 p0, p1, v0, v1; unpack8(cp[bj], p0, p1); unpack8(cx[bj], v0, v1);
#pragma unroll
                    for (int j = 0; j < 4; ++j) { v0[j] += sigm(acc[ai][bj][m][0][j] * rs) * p0[j]; v1[j] += sigm(acc[ai][bj][m][1][j] * rs) * p1[j]; ss += v0[j] * v0[j] + v1[j] * v1[j]; }
                    acc[ai][bj][m][0] = v0; acc[ai][bj][m][1] = v1; }
                ss += __shfl_xor(ss, 16); ss += __shfl_xor(ss, 32);
                if (fq == 0) unsafeAtomicAdd(ssq3 + t, ss);
                cx[0] = nx[0]; cx[1] = nx[1]; cp[0] = np[0]; cp[1] = np[1]; } }
        asm volatile("s_waitcnt vmcnt(0)" ::: "memory");
        unsigned* cnt = done + 64 * u.pm;
        if ((threadIdx.x & 63) == 0) __hip_atomic_fetch_add(cnt, 1u, __ATOMIC_RELAXED, __HIP_MEMORY_SCOPE_AGENT);
        { unsigned sp = 0; while (__hip_atomic_load(cnt, __ATOMIC_RELAXED, __HIP_MEMORY_SCOPE_AGENT) < 32u) { __builtin_amdgcn_s_sleep(1); if (++sp > (1u << 22)) break; } }
#pragma unroll
        for (int ai = 0; ai < 2; ++ai)
#pragma unroll
            for (int m = 0; m < 4; ++m) rsv[ai][m] = __hip_atomic_load(ssq3 + u.pm * 256 + EPI_RL(ai, m), __ATOMIC_RELAXED, __HIP_MEMORY_SCOPE_AGENT);
        f32x4 gv[2][2];
#pragma unroll
        for (int bj = 0; bj < 2; ++bj) { const int cc = u.pn * 256 + EPI_CL(bj); gv[bj][0] = *(const f32x4*)(fg + cc); gv[bj][1] = *(const f32x4*)(fg + cc + 4); }
        EPI_ROWS(ai, m) { const int t = u.pm * 256 + EPI_RL(ai, m);
            const float rs = rsqrtf(rsv[ai][m] * (1.0f / 1024.0f) + EPS_);
#pragma unroll
            for (int bj = 0; bj < 2; ++bj) { const size_t o = (size_t)t * 1024 + u.pn * 256 + EPI_CL(bj);
                *(f32x4*)(out + o) = acc[ai][bj][m][0] * rs * gv[bj][0]; *(f32x4*)(out + o + 4) = acc[ai][bj][m][1] * rs * gv[bj][1]; } }
    } };

struct CvtTile { const float* src; int ld; const float* scale; bf16_t* dst; int dstld; };
__device__ __forceinline__ CvtTile cvt_tile_params(const Params& p, int tl) {
    const int NT0 = 2048, NT4 = NT0 + 1024, NT5 = NT4 + 1408, NT6 = NT5 + 704;
    unsigned char* ws = p.ws; CvtTile t; t.scale = nullptr;
    if (tl < NT0) { const int nb = tl >> 4, kb = tl & 15; const int n0 = nb * 64; int col;
        if (n0 < 4096) col = n0; else if (n0 < 6144) { const int j = (n0 - 4096) >> 8, r = (n0 - 4096) & 255; col = (r < 128) ? (4104 + 128 * j + r) : (5128 + 128 * j + r - 128); }
        else { const int j = (n0 - 6144) >> 8, r = (n0 - 6144) & 255; col = 6152 + ((r < 128) ? (128 * j + r) : (1024 + 128 * j + r - 128)); }
        t.src = p.in[3] + (size_t)kb * 64 * NIN_ + col; t.ld = NIN_; t.dst = (bf16_t*)(ws + O_WINT) + (size_t)n0 * 1024 + kb * 64; t.dstld = 1024; }
    else if (tl < NT4) { const int w = (tl - NT0) >> 8, l = (tl - NT0) & 255; const int nb = l >> 4, kb = l & 15;
        const float* base = w == 0 ? p.in[12] : (w == 1 ? p.in[13] : (w == 2 ? p.in[14] : p.in[20])); const size_t od = w == 0 ? O_WMT : (w == 1 ? O_WCT : (w == 2 ? O_WOT : O_WPGT));
        t.src = base + (size_t)kb * 64 * 1024 + nb * 64; t.ld = 1024; if (w == 3) t.scale = p.in[19] + kb * 64; if (w == 0) t.scale = p.in[7] + kb * 64; t.dst = (bf16_t*)(ws + od) + (size_t)nb * 64 * 1024 + kb * 64; t.dstld = 1024; }
    else if (tl < NT5) { const int l = tl - NT4; const int nb = l >> 4, kb = l & 15; const int n0 = nb * 64; const int j = n0 >> 8, r = n0 & 255;
        const float* base = (r < 128) ? p.in[16] : p.in[17]; const int col = 128 * j + (r & 127);
        t.src = base + (size_t)kb * 64 * DFF_ + col; t.ld = DFF_; t.scale = p.in[15] + kb * 64; t.dst = (bf16_t*)(ws + O_WGUT) + (size_t)n0 * 1024 + kb * 64; t.dstld = 1024; }
    else if (tl < NT6) { const int l = tl - NT5; const int nb = l / 44, kb = l % 44;
        t.src = p.in[18] + (size_t)kb * 64 * 1024 + nb * 64; t.ld = 1024; t.dst = (bf16_t*)(ws + O_WDT) + (size_t)nb * 64 * DFF_ + kb * 64; t.dstld = DFF_; }
    else { const int l = tl - NT6; const int nb = l >> 2, kb = l & 3;
        t.src = p.in[21] + (size_t)kb * 64 * 1024 + nb * 64; t.ld = 1024; t.dst = (bf16_t*)(ws + O_WPPT) + (size_t)nb * 64 * 256 + kb * 64; t.dstld = 256; }
    return t;
}
__device__ __forceinline__ void cvt_tile_load(const CvtTile& t, f32x4 (&v)[2]) {
    const int tid = threadIdx.x, kk = tid >> 4, c4 = (tid & 15) * 4;
#pragma unroll
    for (int pss = 0; pss < 2; ++pss) { const int k = kk + pss * 32; v[pss] = *(const f32x4*)(t.src + (size_t)k * t.ld + c4); if (t.scale) v[pss] = v[pss] * t.scale[k]; }
}

__device__ __forceinline__ void phase0(const Params& p, unsigned char* sm) {
    unsigned char* ws = p.ws;
    const int tid = threadIdx.x, lane = tid & 63, wid = tid >> 6;
    const size_t gtid = (size_t)blockIdx.x * 512 + tid, gthreads = (size_t)gridDim.x * 512;
    for (size_t i = gtid; i < ZERO_BYTES / 16; i += gthreads) ((u32x4*)(ws + O_ZERO))[i] = (u32x4){0u, 0u, 0u, 0u};
    { const float* pp = p.in[1]; bf16_t* pb = (bf16_t*)(ws + O_PB);
        for (size_t i = gtid; i < (size_t)T_ * 256 / 8; i += gthreads) { const f32x4 a = *(const f32x4*)(pp + i * 8), b = *(const f32x4*)(pp + i * 8 + 4); *(u32x4*)(pb + i * 8) = pack8(a, b); } }
    { const float* x = p.in[0]; const float* g = p.in[2]; const float* win = p.in[3]; const float* bif = p.in[4];
        float* wgT = (float*)sm;
        for (int idx = tid; idx < 8192; idx += 512) { const int k = idx >> 3, j = idx & 7; wgT[j * 1024 + k] = win[(size_t)k * NIN_ + 4096 + j] * g[k]; }
        __syncthreads();
        bf16_t* hb = (bf16_t*)(ws + O_HB); float* ig = (float*)(ws + O_IG); float* lf = (float*)(ws + O_LF);
        const int rstep = gridDim.x * 8; int row = blockIdx.x * 8 + wid;
        f32x4 xn[4];
#pragma unroll
        for (int i = 0; i < 4; ++i) xn[i] = (row < T_) ? *(const f32x4*)(x + (size_t)row * 1024 + i * 256 + lane * 4) : (f32x4){0.f, 0.f, 0.f, 0.f};
        for (; row < T_; row += rstep) {
            f32x4 xv[4]; float ss = 0.f;
#pragma unroll
            for (int i = 0; i < 4; ++i) { xv[i] = xn[i]; ss += xv[i][0] * xv[i][0] + xv[i][1] * xv[i][1] + xv[i][2] * xv[i][2] + xv[i][3] * xv[i][3]; }
            { const int nrow = row + rstep;
                if (nrow < T_) {
#pragma unroll
                    for (int i = 0; i < 4; ++i) xn[i] = *(const f32x4*)(x + (size_t)nrow * 1024 + i * 256 + lane * 4); } }
            ss = wave_sum(ss); const float rs = rsqrtf(ss * (1.0f / 1024.0f) + EPS_);
            float d[8];
#pragma unroll
            for (int j = 0; j < 8; ++j) d[j] = 0.f;
#pragma unroll
            for (int i = 0; i < 4; ++i) { const f32x4 hn = xv[i] * rs; const f32x4 gv = *(const f32x4*)(g + i * 256 + lane * 4); const f32x4 hg = hn * gv;
                u32x2 w; w.x = cvt_pk_bf16(hg[0], hg[1]); w.y = cvt_pk_bf16(hg[2], hg[3]); *(u32x2*)(hb + (size_t)row * 1024 + i * 256 + lane * 4) = w;
#pragma unroll
                for (int j = 0; j < 8; ++j) { const f32x4 wv = *(const f32x4*)(wgT + j * 1024 + i * 256 + lane * 4); d[j] += hn[0] * wv[0] + hn[1] * wv[1] + hn[2] * wv[2] + hn[3] * wv[3]; } }
#pragma unroll
            for (int j = 0; j < 8; ++j) d[j] = wave_sum(d[j]);
            if (lane < 8) { float v = d[0];
#pragma unroll
                for (int j = 1; j < 8; ++j) v = (lane == j) ? d[j] : v;
                v += bif[lane];
                if (lane < 4) ig[(size_t)row * 4 + lane] = v;
                else { const float z = v; lf[(size_t)row * 4 + lane - 4] = fminf(z, 0.f) - log1pf(__expf(-fabsf(z))); } }
        }
        __syncthreads();
    }
    { const int NTILES = 2048 + 1024 + 1408 + 704 + 64; const int gs = gridDim.x;
        float* tl = (float*)sm;
        int t = blockIdx.x; CvtTile c0{}, c1{}; f32x4 v0[2], v1[2];
        if (t < NTILES) { c0 = cvt_tile_params(p, t); cvt_tile_load(c0, v0); }
        if (t + gs < NTILES) { c1 = cvt_tile_params(p, t + gs); cvt_tile_load(c1, v1); }
        for (; t < NTILES; t += gs) {
            { const int kk = tid >> 4, c4 = (tid & 15) * 4;
#pragma unroll
                for (int pss = 0; pss < 2; ++pss) { const int k = kk + pss * 32;
#pragma unroll
                    for (int j = 0; j < 4; ++j) tl[k * 65 + c4 + j] = v0[pss][j]; } }
            __syncthreads();
            const CvtTile done = c0; c0 = c1; v0[0] = v1[0]; v0[1] = v1[1];
            { const int tn = t + 2 * gs; if (tn < NTILES) { c1 = cvt_tile_params(p, tn); cvt_tile_load(c1, v1); } }
            { const int n = tid >> 3, k8 = (tid & 7) * 8; float e[8];
#pragma unroll
                for (int q = 0; q < 8; ++q) e[q] = tl[(k8 + q) * 65 + n];
                u32x4 w; w.x = cvt_pk_bf16(e[0], e[1]); w.y = cvt_pk_bf16(e[2], e[3]); w.z = cvt_pk_bf16(e[4], e[5]); w.w = cvt_pk_bf16(e[6], e[7]);
                *(u32x4*)(done.dst + (size_t)n * done.dstld + k8) = w; }
            __syncthreads();
        }
    }
}

__device__ __forceinline__ void phase2(const Params& p, unsigned char* sm) {
    unsigned char* ws = p.ws;
    const int tid = threadIdx.x, lane = tid & 63, wid = tid >> 6;
    float* rowfac = (float*)sm; float* colfac = rowfac + 256; float* wsum = colfac + 256;
    const float* ig = (const float*)(ws + O_IG); const float* lf = (const float*)(ws + O_LF);
    const bf16_t* qkpre = (const bf16_t*)p.out;
    const float* cw = p.in[5]; const float* cb = p.in[6];
    for (int item = blockIdx.x; item < 256; item += gridDim.x) {
        const int b = item >> 5, h = (item >> 3) & 3, sc = item & 7; const int tokb = b * SEQ_ + sc * 256;
        float v = 0.f, igv = 0.f;
        if (tid < 256) { v = lf[(size_t)(tokb + tid) * 4 + h]; igv = ig[(size_t)(tokb + tid) * 4 + h]; }
#pragma unroll
        for (int o = 1; o < 64; o <<= 1) { const float n = __shfl_up(v, o); if (lane >= o) v += n; }
        if (tid < 256 && lane == 63) wsum[wid] = v;
        __syncthreads();
        if (tid < 256) { float add = 0.f; for (int j = 0; j < wid; ++j) add += wsum[j]; v += add; rowfac[tid] = __expf(v); colfac[tid] = __expf(igv - v);
            if (tid == 255) ((float*)(ws + O_EBL))[item] = __expf(v); }
        __syncthreads();
#pragma unroll 1
        for (int qt = 0; qt < 4; ++qt) {
        const int cp = tid & 127, tg = tid >> 7; const int ch = 2 * cp; const int tl0 = qt * 64 + tg * 16; const int s0 = sc * 256 + tl0;
        { const int col = h * 256 + ch; float x0[19], x1[19];
#pragma unroll
            for (int i = 0; i < 19; ++i) { const int s = s0 - 3 + i; unsigned w = 0u; if (s >= 0) w = *(const unsigned*)(qkpre + (size_t)(b * SEQ_ + s) * 2048 + col); x0[i] = bf_lo(w); x1[i] = bf_hi(w); }
            float w0[4], w1[4];
#pragma unroll
            for (int k = 0; k < 4; ++k) { const f32x2 wv = *(const f32x2*)(cw + (size_t)k * 2048 + col); w0[k] = wv[0]; w1[k] = wv[1]; }
            const f32x2 bv = *(const f32x2*)(cb + col);
            bf16_t* wq = (bf16_t*)(ws + O_WQ) + (size_t)item * 65536;
#pragma unroll
            for (int i = 0; i < 16; ++i) { float y0 = bv[0], y1 = bv[1];
#pragma unroll
                for (int k = 0; k < 4; ++k) { y0 += x0[i + k] * w0[k]; y1 += x1[i + k] * w1[k]; }
                const float f = rowfac[tl0 + i] * 0.0625f;
                *(unsigned*)(wq + (size_t)(tl0 + i) * 256 + ch) = cvt_pk_bf16(silu(y0) * f, silu(y1) * f); } }
        { const int col = 1024 + h * 256 + ch; float x0[19], x1[19];
#pragma unroll
            for (int i = 0; i < 19; ++i) { const int s = s0 - 3 + i; unsigned w = 0u; if (s >= 0) w = *(const unsigned*)(qkpre + (size_t)(b * SEQ_ + s) * 2048 + col); x0[i] = bf_lo(w); x1[i] = bf_hi(w); }
            float w0[4], w1[4];
#pragma unroll
            for (int k = 0; k < 4; ++k) { const f32x2 wv = *(const f32x2*)(cw + (size_t)k * 2048 + col); w0[k] = wv[0]; w1[k] = wv[1]; }
            const f32x2 bv = *(const f32x2*)(cb + col);
            bf16_t* kw = (bf16_t*)(ws + O_KW) + (size_t)item * 65536; bf16_t* kwt = (bf16_t*)(ws + O_KWT) + (size_t)item * 65536;
            float k0[16], k1[16]; float n0 = 0.f, n1 = 0.f;
#pragma unroll
            for (int i = 0; i < 16; ++i) { float y0 = bv[0], y1 = bv[1];
#pragma unroll
                for (int k = 0; k < 4; ++k) { y0 += x0[i + k] * w0[k]; y1 += x1[i + k] * w1[k]; }
                const float f = colfac[tl0 + i]; k0[i] = silu(y0) * f; k1[i] = silu(y1) * f; n0 += k0[i]; n1 += k1[i];
                *(unsigned*)(kw + (size_t)(tl0 + i) * 256 + ch) = cvt_pk_bf16(k0[i], k1[i]); }
            u32x4 a, c;
            a.x = cvt_pk_bf16(k0[0], k0[1]); a.y = cvt_pk_bf16(k0[2], k0[3]); a.z = cvt_pk_bf16(k0[4], k0[5]); a.w = cvt_pk_bf16(k0[6], k0[7]);
            c.x = cvt_pk_bf16(k0[8], k0[9]); c.y = cvt_pk_bf16(k0[10], k0[11]); c.z = cvt_pk_bf16(k0[12], k0[13]); c.w = cvt_pk_bf16(k0[14], k0[15]);
            *(u32x4*)(kwt + (size_t)ch * 256 + tl0) = a; *(u32x4*)(kwt + (size_t)ch * 256 + tl0 + 8) = c;
            a.x = cvt_pk_bf16(k1[0], k1[1]); a.y = cvt_pk_bf16(k1[2], k1[3]); a.z = cvt_pk_bf16(k1[4], k1[5]); a.w = cvt_pk_bf16(k1[6], k1[7]);
            c.x = cvt_pk_bf16(k1[8], k1[9]); c.y = cvt_pk_bf16(k1[10], k1[11]); c.z = cvt_pk_bf16(k1[12], k1[13]); c.w = cvt_pk_bf16(k1[14], k1[15]);
            *(u32x4*)(kwt + (size_t)(ch + 1) * 256 + tl0) = a; *(u32x4*)(kwt + (size_t)(ch + 1) * 256 + tl0 + 8) = c;
            float* nsum = (float*)(ws + O_NSUM) + (size_t)item * 256;
            unsafeAtomicAdd(nsum + ch, n0); unsafeAtomicAdd(nsum + ch + 1, n1); }
        }
        __syncthreads();
    }
}

__device__ __forceinline__ void phase4(const Params& p, unsigned char* sm) {
    unsigned char* ws = p.ws;
    const int tid = threadIdx.x;
    const float* ebl = (const float*)(ws + O_EBL);
    const bf16_t* lt = (const bf16_t*)(p.ws + O_KWT);
    bf16_t* cint = (bf16_t*)(ws + O_CINT);
    const size_t gtid = (size_t)blockIdx.x * 512 + tid, gthreads = (size_t)gridDim.x * 512;
    for (size_t g = gtid; g < (size_t)32 * 16384; g += gthreads) {
        const int bh = (int)(g >> 14), e4 = (int)(g & 16383);
        f32x4 c = {0.f, 0.f, 0.f, 0.f};
        u32x2 lw[7]; float eb[7];
#pragma unroll
        for (int sc = 0; sc < 7; ++sc) { lw[sc] = *(const u32x2*)(lt + (size_t)(bh * 8 + sc) * 65536 + e4 * 4); eb[sc] = ebl[bh * 8 + sc]; }
#pragma unroll
        for (int sc = 0; sc < 8; ++sc) { const int item = bh * 8 + sc;
            u32x2 w; w.x = cvt_pk_bf16(c[0], c[1]); w.y = cvt_pk_bf16(c[2], c[3]); *(u32x2*)(cint + (size_t)item * 65536 + e4 * 4) = w;
            if (sc < 7) { const f32x4 l = {bf_lo(lw[sc].x), bf_hi(lw[sc].x), bf_lo(lw[sc].y), bf_hi(lw[sc].y)}; c = (c + l) * eb[sc]; } }
    }
    float* nin = (float*)sm;
    const float* nsum = (const float*)(ws + O_NSUM);
    float* denx = (float*)(ws + O_DENX);
    for (int item = blockIdx.x; item < 256; item += gridDim.x) {
        const int b = item >> 5, h = (item >> 3) & 3, sc = item & 7; const int tokb = b * SEQ_ + sc * 256; const int bh = item >> 3;
        if (tid < 256) { float nv = 0.f; for (int j = 0; j < sc; ++j) nv = ebl[bh * 8 + j] * (nv + nsum[(size_t)(bh * 8 + j) * 256 + tid]); nin[tid] = nv; }
        __syncthreads();
        const int tl = tid >> 1, half = tid & 1;
        const bf16_t* wq = (const bf16_t*)(ws + O_WQ) + (size_t)item * 65536 + (size_t)tl * 256 + half * 128;
        float d = 0.f;
#pragma unroll
        for (int i = 0; i < 16; ++i) { f32x4 a0, a1; unpack8(*(const u32x4*)(wq + i * 8), a0, a1); const float* nn = nin + half * 128 + i * 8;
            d += a0[0] * nn[0] + a0[1] * nn[1] + a0[2] * nn[2] + a0[3] * nn[3] + a1[0] * nn[4] + a1[1] * nn[5] + a1[2] * nn[6] + a1[3] * nn[7]; }
        d += __shfl_xor(d, 1);
        if (half == 0) denx[(size_t)(tokb + tl) * 4 + h] = d;
        __syncthreads();
    }
}

__device__ __forceinline__ void phase7(const Params& p, unsigned char* sm) {
    unsigned char* ws = p.ws;
    const int tid = threadIdx.x, lane = tid & 63, wid = tid >> 6;
    const bf16_t* uu = (const bf16_t*)p.out; bf16_t* uc = (bf16_t*)(ws + O_UC);
    const float* cw = p.in[8]; const float* cb = p.in[9]; const float* lg = p.in[10]; const float* lb = p.in[11];
    u32x4 pf[12];
#define P7_LOAD(tile_) do { const int t0_ = (tile_) * 16; const int b_ = t0_ / SEQ_, s0_ = t0_ % SEQ_; \
        _Pragma("unroll") for (int q = 0; q < 12; ++q) { const int idx = tid + q * 512; const int r = idx >> 7, c16 = idx & 127; const int s_ = s0_ - 30 + r; \
            pf[q] = (u32x4){0u, 0u, 0u, 0u}; if (idx < 46 * 128 && s_ >= 0) pf[q] = *(const u32x4*)(uu + (size_t)(b_ * SEQ_ + s_) * 1024 + c16 * 8); } } while (0)
    int tile = blockIdx.x;
    if (tile < 1024) P7_LOAD(tile);
    f32x2 wv[31];
#pragma unroll
    for (int k = 0; k < 31; ++k) wv[k] = *(const f32x2*)(cw + (size_t)k * 1024 + 2 * tid);
    const f32x2 bv = *(const f32x2*)(cb + 2 * tid);
    for (; tile < 1024; tile += gridDim.x) {
        const int t0 = tile * 16;
#pragma unroll
        for (int q = 0; q < 12; ++q) { const int idx = tid + q * 512; const int r = idx >> 7, c16 = idx & 127; if (idx < 46 * 128) *(u32x4*)(sm + r * 2048 + c16 * 16) = pf[q]; }
        __syncthreads();
        f32x2 yy[16];
        {
#pragma unroll
            for (int t = 0; t < 16; ++t) yy[t] = bv;
#pragma unroll
            for (int r = 0; r < 46; ++r) { const unsigned w = *(const unsigned*)(sm + r * 2048 + tid * 4); const f32x2 xx = {bf_lo(w), bf_hi(w)};
#pragma unroll
                for (int t = 0; t < 16; ++t) { const int k = r - t; if (k >= 0 && k <= 30) yy[t] = __builtin_elementwise_fma(wv[k], xx, yy[t]); }
                if ((r & 3) == 3) asm volatile("" ::: "memory"); }
        }
        __syncthreads();
#pragma unroll
        for (int t = 0; t < 16; ++t) *(f32x2*)(sm + t * 4096 + tid * 8) = yy[t];
        { const int tn = tile + gridDim.x; if (tn < 1024) P7_LOAD(tn); }
        __syncthreads();
#pragma unroll 1
        for (int tt = 0; tt < 2; ++tt) { const int t = wid * 2 + tt; f32x4 v[4]; float s1 = 0.f;
#pragma unroll
            for (int i = 0; i < 4; ++i) { v[i] = *(const f32x4*)(sm + t * 4096 + (i * 256 + lane * 4) * 4); s1 += v[i][0] + v[i][1] + v[i][2] + v[i][3]; }
            s1 = wave_sum(s1); const float mu = s1 * (1.0f / 1024.0f); float s2 = 0.f;
#pragma unroll
            for (int i = 0; i < 4; ++i) { v[i] = v[i] - mu; s2 += v[i][0] * v[i][0] + v[i][1] * v[i][1] + v[i][2] * v[i][2] + v[i][3] * v[i][3]; }
            s2 = wave_sum(s2); const float rstd = rsqrtf(s2 * (1.0f / 1024.0f) + EPS_);
#pragma unroll
            for (int i = 0; i < 4; ++i) { const int c = i * 256 + lane * 4; const f32x4 gv = *(const f32x4*)(lg + c), bb = *(const f32x4*)(lb + c); f32x4 z = v[i] * rstd * gv + bb;
                u32x2 w; w.x = cvt_pk_bf16(silu(z[0]), silu(z[1])); w.y = cvt_pk_bf16(silu(z[2]), silu(z[3])); *(u32x2*)(uc + (size_t)(t0 + t) * 1024 + c) = w; } }
        __syncthreads();
    }
#undef P7_LOAD
}

__device__ __forceinline__ void phase13(const Params& p) {
    const float* ssq3 = (const float*)(p.ws + O_SSQ3); const float* fg = p.in[22];
    const size_t gtid = (size_t)blockIdx.x * 512 + threadIdx.x, gthreads = (size_t)gridDim.x * 512;
    for (size_t i = gtid; i < (size_t)T_ * 256; i += gthreads) { const int row = (int)(i >> 8), c = (int)(i & 255) * 4;
        const float rs = rsqrtf(ssq3[row] * (1.0f / 1024.0f) + EPS_); const f32x4 g = *(const f32x4*)(fg + c);
        f32x4 v = *(const f32x4*)(p.out + i * 4); v = v * rs * g; *(f32x4*)(p.out + i * 4) = v; }
}

#define XB_TMO      128
#define XB_XCNT(j)  (256  + 64 * (j))
#define XB_XSUB(j)  (1280 + 64 * (j))
#define XB_XGEN(j)  (2304 + 64 * (j))
#define XB_TOP      3328
#define XB_TOPGEN   3392
#define XCD_BAR_WORDS 3456
#define XB_SPIN_CAP (1u << 18)
__device__ __forceinline__ unsigned xb_ld(unsigned* p)              { return __hip_atomic_load(p, __ATOMIC_RELAXED, __HIP_MEMORY_SCOPE_AGENT); }
__device__ __forceinline__ unsigned xb_add(unsigned* p, unsigned v) { return __hip_atomic_fetch_add(p, v, __ATOMIC_RELAXED, __HIP_MEMORY_SCOPE_AGENT); }
__device__ __forceinline__ unsigned xb_xcc_id() { return (unsigned)__builtin_amdgcn_s_getreg((3 << 11) | 20) & 0xFu; }
#define XB_SPIN(cond, bar) do { unsigned _sp = 0; while (cond) { __builtin_amdgcn_s_sleep(1); \
    if ((++_sp & 255u) == 0u) { if (xb_ld(&(bar)[XB_TMO])) break; if (_sp > XB_SPIN_CAP) { atomicAdd(&(bar)[XB_TMO], 1u); break; } } } } while (0)
struct XcdBarrier { unsigned* bar; unsigned x; volatile LAS unsigned* st; };
__device__ __forceinline__ XcdBarrier xcd_barrier_post(unsigned* bar, volatile LAS unsigned* st) {
    XcdBarrier b; b.bar = bar; b.x = xb_xcc_id(); b.st = st;
    if (threadIdx.x == 0) (void)xb_add(&bar[XB_XCNT(b.x)], 1u);
    return b;
}
__device__ __forceinline__ void xcd_barrier_complete(unsigned* bar, unsigned x, unsigned& nloc, unsigned& nx) {
    const unsigned G = gridDim.x * gridDim.y * gridDim.z;
    unsigned sum, cnt, mine, sp = 0u;
    for (;;) {
        sum = 0u; cnt = 0u; mine = 0u;
#pragma unroll
        for (unsigned j = 0; j < 16; ++j) { const unsigned c = xb_ld(&bar[XB_XCNT(j)]); sum += c; cnt += (c > 0u) ? 1u : 0u; mine = (j == x) ? c : mine; }
        if (sum == G) break;
        __builtin_amdgcn_s_sleep(1);
        if ((++sp & 255u) == 0u) { if (xb_ld(&bar[XB_TMO])) break; if (sp > XB_SPIN_CAP) { atomicAdd(&bar[XB_TMO], 1u); break; } }
    }
    nloc = mine > 0u ? mine : 1u; nx = cnt > 0u ? cnt : 1u;
}
__device__ __forceinline__ void xcd_barrier(const XcdBarrier& b) {
    asm volatile("s_waitcnt vmcnt(0)" ::: "memory");
    __syncthreads();
    if (threadIdx.x == 0) {
        unsigned* bar = b.bar;
        __builtin_amdgcn_s_waitcnt(0);
        unsigned nloc = b.st[0], nx = b.st[1];
        if (nloc == 0u) { xcd_barrier_complete(bar, b.x, nloc, nx); b.st[0] = nloc; b.st[1] = nx; }
        const unsigned old = xb_add(&bar[XB_XSUB(b.x)], 1u);
        const unsigned gen = old / nloc;
        if (old + 1u == (gen + 1u) * nloc) {
            __builtin_amdgcn_fence(__ATOMIC_RELEASE, "agent");
            asm volatile("s_waitcnt vmcnt(0)" ::: "memory");
            const unsigned og = xb_add(&bar[XB_TOP], 1u);
            const unsigned tg = og / nx;
            if (og + 1u == (tg + 1u) * nx) xb_add(&bar[XB_TOPGEN], 1u);
            else XB_SPIN(xb_ld(&bar[XB_TOPGEN]) == tg, bar);
            __builtin_amdgcn_fence(__ATOMIC_ACQUIRE, "agent");
            xb_add(&bar[XB_XGEN(b.x)], 1u);
            asm volatile("s_waitcnt vmcnt(0)" ::: "memory");
        } else {
            XB_SPIN(xb_ld(&bar[XB_XGEN(b.x)]) == gen, bar);
            __builtin_amdgcn_fence(__ATOMIC_ACQUIRE, "agent");
            asm volatile("s_waitcnt vmcnt(0)" ::: "memory");
        }
    }
    __syncthreads();
}

template <bool COOP>
__global__ void __launch_bounds__(512, 2) mk_fwd(Params p) {
    extern __shared__ __attribute__((aligned(16))) unsigned char shm[];
    LAS unsigned char* lds = (LAS unsigned char*)shm;
    unsigned char* ws = p.ws;
    const int G = gridDim.x, c = blockIdx.x;
#ifndef PHMASK
#define PHMASK 0x3fff
#endif
#define PH(k) if (((PHMASK >> (k)) & 1) && p.ph_lo <= (k) && (k) < p.ph_hi)
    XcdBarrier xb{};
    if (COOP) { volatile LAS unsigned* st = (volatile LAS unsigned*)(lds + 131072);
        if (threadIdx.x == 0) { st[0] = 0u; st[1] = 0u; }
        __syncthreads();
        xb = xcd_barrier_post((unsigned*)(ws + O_BAR), st); }
#define SYNC(k) if (COOP) { if (p.ph_lo <= (k) && (k) + 1 < p.ph_hi) { xcd_barrier(xb); } }
    PH(0) phase0(p, shm);
    SYNC(0)
    PH(1) { SchedP1 S{(const char*)(ws + O_HB), (const char*)(ws + O_WINT), G, c}; EpiP1 E{(bf16_t*)p.out, (bf16_t*)(ws + O_VT)}; gemm_phase(lds, 1024, 1024, 1024, S, E); }
    SYNC(1)
    PH(3) { phase2(p, shm);
        asm volatile("s_waitcnt vmcnt(0)" ::: "memory"); __syncthreads();
        SchedP3 S{(const char*)(ws + O_WQ), (const char*)(ws + O_KW), (const char*)(ws + O_VT), (const char*)(ws + O_KWT), G, c};
        EpiP3 E{(bf16_t*)(ws + O_SS), (bf16_t*)(ws + O_KWT), (float*)(ws + O_DENI)}; gemm_phase(lds, 256, 256, 256, S, E); }
    SYNC(3)
    PH(4) phase4(p, shm);
    SYNC(4)
    PH(6) { { SchedP5 S{(const char*)(ws + O_SS), (const char*)(ws + O_VT), (const char*)(ws + O_WQ), (const char*)(ws + O_CINT), G, c};
            EpiP5 E{(bf16_t*)(ws + O_HM), (const float*)(ws + O_DENI), (const float*)(ws + O_DENX), (float*)(ws + O_HSS)}; gemm_phase(lds, 256, 256, 256, S, E); }
        { SchedP6 S{(const char*)(ws + O_HB), (const char*)(ws + O_WINT), G, c};
            EpiP6 E{(bf16_t*)(ws + O_HM), (float*)(ws + O_HSS), p.in[7], (bf16_t*)p.out}; gemm_phase(lds, 1024, 1024, 1024, S, E); } }
    SYNC(6)
    PH(7) phase7(p, shm);
    SYNC(7)
    PH(8) { SchedP8 S{(const char*)(ws + O_HB), (const char*)(ws + O_WINT), (const char*)(ws + O_HM), (const char*)(ws + O_UC), (const char*)(ws + O_WMT), (const char*)(ws + O_WCT), G, c};
        EpiP8 E{(bf16_t*)(ws + O_GMC), (bf16_t*)p.out + (size_t)T_ * 1024, (bf16_t*)(ws + O_MERGED)}; gemm_phase(lds, 1024, 1024, 1024, S, E); }
    SYNC(8)
    PH(9) { SchedN4 S{(const char*)(ws + O_MERGED), (const char*)(ws + O_WOT), (size_t)256 * 1024 * 2, (size_t)256 * 1024 * 2, G, c};
        EpiRes<false> E{p.in[0], (bf16_t*)(ws + O_X1B), (float*)(ws + O_SSQ1)}; gemm_phase(lds, 1024, 1024, 1024, S, E); }
    SYNC(9)
    PH(10) { { SchedP10 S{(const char*)(ws + O_X1B), (const char*)(ws + O_WGUT), G, c}; EpiP10 E{(const float*)(ws + O_SSQ1), (bf16_t*)(ws + O_HID)}; gemm_phase(lds, 1024, 1024, 1024, S, E); }
        { const int h = G >> 1; SchedPE S{(const char*)(ws + O_PB), (const char*)(ws + O_WPPT), h, c - h};
            EpiBf E{(bf16_t*)(ws + O_PE)}; if (c >= h) gemm_phase(lds, 256, 256, 256, S, E); } }
    SYNC(10)
    PH(11) { SchedN4 S{(const char*)(ws + O_HID), (const char*)(ws + O_WDT), (size_t)256 * DFF_ * 2, (size_t)256 * DFF_ * 2, G, c};
            EpiRes<true> E{(const void*)(ws + O_X1B), (bf16_t*)(ws + O_X2B), (float*)(ws + O_SSQ2)}; gemm_phase(lds, DFF_, DFF_, DFF_, S, E); }
    SYNC(11)
    PH(12) { SchedN4 S{(const char*)(ws + O_X2B), (const char*)(ws + O_WPGT), (size_t)256 * 1024 * 2, (size_t)256 * 1024 * 2, G, c};
        EpiP12 E{(const float*)(ws + O_SSQ2), (const bf16_t*)(ws + O_PE), (const bf16_t*)(ws + O_X2B), p.out, (float*)(ws + O_SSQ3), (unsigned*)(ws + O_BAR) + XCD_BAR_WORDS, p.in[22]}; gemm_phase(lds, 1024, 1024, 1024, S, E); }
#undef PH
#undef SYNC
}

extern "C" void kernel_launch(void* const* d_in, const int* in_sizes, int n_in, void* d_out, int out_size, void* d_ws, size_t ws_size, hipStream_t stream) {
    static int grid = 0;
    if (grid == 0) {
        if (n_in != 23 || out_size != T_ * D_ || ws_size < WS_NEED) { fprintf(stderr, "kernel_launch: unexpected shapes (n_in %d, out %d, ws %zu)\n", n_in, out_size, ws_size); grid = -1; return; }
        int dev = 0, cus = 0, per_cu = 0;
        hipGetDevice(&dev); hipDeviceGetAttribute(&cus, hipDeviceAttributeMultiprocessorCount, dev);
        hipFuncSetAttribute((const void*)mk_fwd<true>, hipFuncAttributeMaxDynamicSharedMemorySize, LDS_BYTES);
        hipFuncSetAttribute((const void*)mk_fwd<false>, hipFuncAttributeMaxDynamicSharedMemorySize, LDS_BYTES);
        hipOccupancyMaxActiveBlocksPerMultiprocessor(&per_cu, (const void*)mk_fwd<true>, 512, LDS_BYTES);
        if (per_cu < 1) { fprintf(stderr, "kernel_launch: occupancy query reports %d blocks per CU\n", per_cu); per_cu = 1; }
        (void)hipGetLastError();
        grid = cus;
        if (grid != 256) { fprintf(stderr, "kernel_launch: built for a 256-CU device (got %d CUs)\n", cus); grid = -1; return; }
    }
    if (grid < 0) return;
    Params p{};
    for (int i = 0; i < 23; ++i) p.in[i] = (const float*)d_in[i];
    p.out = (float*)d_out; p.ws = (unsigned char*)d_ws;
#if MK_MULTI
#ifndef PROBE_DUP
#define PROBE_DUP -1
#endif
    for (int k = 0; k < NPHASE; ++k) { p.ph_lo = k; p.ph_hi = k + 1; hipLaunchKernelGGL(mk_fwd<false>, dim3(grid), dim3(512), LDS_BYTES, stream, p);
        if (k == PROBE_DUP) hipLaunchKernelGGL(mk_fwd<false>, dim3(grid), dim3(512), LDS_BYTES, stream, p); }
#else
    p.ph_lo = 0; p.ph_hi = NPHASE;
    if (hipMemsetAsync((unsigned char*)d_ws + O_BAR, 0, (XCD_BAR_WORDS + 64 * 64) * 4, stream) != hipSuccess) { fprintf(stderr, "kernel_launch: memset of barrier words failed\n"); return; }
    void* args[] = {&p};
    hipError_t e = hipLaunchCooperativeKernel((const void*)mk_fwd<true>, dim3(grid), dim3(512), args, LDS_BYTES, stream);
    if (e != hipSuccess) fprintf(stderr, "cooperative launch failed: %s (grid %d)\n", hipGetErrorString(e), grid);
#endif
}
```

```cpp
#include <hip/hip_runtime.h>
#include <hip/hip_cooperative_groups.h>
#include <cstdio>
namespace cg = cooperative_groups;

#ifndef MK_MULTI
#define MK_MULTI 0
#endif

#define LAS __attribute__((address_space(3)))
typedef unsigned short bf16_t;
typedef short bf16x8 __attribute__((ext_vector_type(8)));
typedef float f32x4 __attribute__((ext_vector_type(4)));
typedef float f32x2 __attribute__((ext_vector_type(2)));
typedef unsigned u32x4 __attribute__((ext_vector_type(4)));
typedef unsigned u32x2 __attribute__((ext_vector_type(2)));

constexpr int T_ = 16384, D_ = 1024, NIN_ = 8200, DFF_ = 2816, SEQ_ = 2048;
constexpr float EPS_ = 1e-6f;
constexpr int BM = 256, BK = 64, HALF = 128, HTB = HALF * BK * 2, STAGE_BYTES = 8 * HTB;
constexpr int LDS_BYTES = 136 * 1024;
constexpr int NPHASE = 13;

constexpr size_t KiB = 1024, MiB = 1024 * 1024;
constexpr size_t O_WINT = 0, O_WMT = 16 * MiB, O_WCT = 18 * MiB, O_WOT = 20 * MiB, O_WPGT = 22 * MiB, O_WGUT = 24 * MiB, O_WDT = 35 * MiB, O_WPPT = 40 * MiB + 512 * KiB;
constexpr size_t O_IG = 41 * MiB, O_LF = O_IG + 256 * KiB, O_ZERO = O_LF + 256 * KiB;
constexpr size_t O_DENI = O_ZERO, O_HSS = O_DENI + 256 * KiB, O_SSQ1 = O_HSS + 256 * KiB, O_SSQ2 = O_SSQ1 + 64 * KiB, O_SSQ3 = O_SSQ2 + 64 * KiB, O_NSUM = O_SSQ3 + 64 * KiB;
constexpr size_t ZERO_BYTES = 960 * KiB;
constexpr size_t O_DENX = O_ZERO + ZERO_BYTES, O_EBL = O_DENX + 256 * KiB;
constexpr size_t O_BAR = 43 * MiB;
constexpr size_t O_PB = 44 * MiB, O_HB = 52 * MiB, O_S1 = 84 * MiB, O_S2 = 116 * MiB, O_S3 = 148 * MiB, O_S4 = 180 * MiB, O_S5 = 212 * MiB, WS_NEED = 244 * MiB;
constexpr size_t O_PE = O_HB, O_VT = O_S1, O_U = O_S1, O_MERGED = O_S1, O_HID = O_S1, O_WQ = O_S2, O_GMC = O_S2, O_KW = O_S3, O_CINT = O_S3,
                 O_KWT = O_S4, O_HM = O_S4, O_X1B = O_S4, O_SS = O_S5, O_UC = O_S5, O_X2B = O_S5;

struct Params {
    const float* in[23];
    float* out;
    unsigned char* ws;
    int ph_lo, ph_hi;
};

__device__ __forceinline__ unsigned cvt_pk_bf16(float lo, float hi) { unsigned r; asm volatile("v_cvt_pk_bf16_f32 %0, %1, %2" : "=v"(r) : "v"(lo), "v"(hi)); return r; }
__device__ __forceinline__ float bf_lo(unsigned w) { return __uint_as_float(w << 16); }
__device__ __forceinline__ float bf_hi(unsigned w) { return __uint_as_float(w & 0xffff0000u); }
__device__ __forceinline__ float sigm(float x) { return __builtin_amdgcn_rcpf(1.0f + __builtin_amdgcn_exp2f(x * -1.4426950408889634f)); }
__device__ __forceinline__ float silu(float x) { return x * __builtin_amdgcn_rcpf(1.0f + __builtin_amdgcn_exp2f(x * -1.4426950408889634f)); }
__device__ __forceinline__ float wave_sum(float v) {
#pragma unroll
    for (int o = 32; o > 0; o >>= 1) v += __shfl_xor(v, o);
    return v;
}
__device__ __forceinline__ u32x4 pack8(const f32x4 a, const f32x4 b) { u32x4 w; w.x = cvt_pk_bf16(a[0], a[1]); w.y = cvt_pk_bf16(a[2], a[3]); w.z = cvt_pk_bf16(b[0], b[1]); w.w = cvt_pk_bf16(b[2], b[3]); return w; }
__device__ __forceinline__ void unpack8(const u32x4 w, f32x4& a, f32x4& b) { a[0] = bf_lo(w.x); a[1] = bf_hi(w.x); a[2] = bf_lo(w.y); a[3] = bf_hi(w.y); b[0] = bf_lo(w.z); b[1] = bf_hi(w.z); b[2] = bf_lo(w.w); b[3] = bf_hi(w.w); }

__host__ __device__ __forceinline__ int lds_byte(int r, int c) { const int st = (r >> 4) * 2 + (c >> 5), rr = r & 15, cc = c & 31, ob = rr * 64 + cc * 2; return st * 1024 + (ob ^ (((ob >> 9) & 1) << 5)); }
__host__ __device__ __forceinline__ void stage_rc(int b, int& R, int& C) { const int st = b / 1024, sb = b % 1024, swz = sb ^ (((sb >> 9) & 1) << 5); R = (st >> 1) * 16 + swz / 64; C = (st & 1) * 32 + (swz % 64) / 2; }
__host__ __device__ __forceinline__ int perm32(int rho) { const int n = rho >> 4, i = rho & 15; return 8 * (i >> 2) + 4 * n + (i & 3); }

struct Unit { const char* a; const char* b; int pm, pn, kind, cont; };
__device__ __forceinline__ void map_n4(int L, int& pm, int& pn) { const int x = L & 7, k = L >> 3; pm = x * 8 + (k & 7); pn = k >> 3; }

__device__ __forceinline__ void tile_order(int L, int nM, int nN, int& pm, int& pn) {
    const int nwg = nM * nN; int wgid = L;
    { const int q = nwg / 8, r = nwg % 8, xcd = wgid % 8, off = wgid / 8; wgid = (xcd < r ? xcd * (q + 1) : r * (q + 1) + (xcd - r) * q) + off; }
    const int nig = 8 * nN, gid = wgid / nig, fm = gid * 8, gsz = (nM - fm) < 8 ? (nM - fm) : 8;
    pm = fm + ((wgid % nig) % gsz); pn = (wgid % nig) / gsz;
}

template <class Epi, class Sched>
__device__ __forceinline__ void gemm_phase(LAS unsigned char* lds, const int K, const int lda, const int ldb, const Sched& S, const Epi& E) {
    const int tid = threadIdx.x, wid = __builtin_amdgcn_readfirstlane(tid >> 6), lane = tid & 63, wr = wid >> 2, wc = wid & 3, fr = lane & 15, fq = lane >> 4;
    const int nt = K / BK;
    unsigned voffA[2], voffB[2];
#pragma unroll
    for (int i = 0; i < 2; ++i) { int R, C; stage_rc(tid * 16 + i * 8192, R, C); const int Rb = (R & ~31) + perm32(R & 31);
        voffA[i] = (unsigned)(R * lda + C) * 2u; voffB[i] = (unsigned)(Rb * ldb + C) * 2u; }
    const size_t kstep = (size_t)(BK * 2);
    const size_t hstepA = (size_t)HALF * lda * 2, hstepB = (size_t)HALF * ldb * 2;
    const unsigned ldsw = (unsigned)wid * 1024u;
    const int aoff = lds_byte(wr * 64 + fr, fq * 8), boff = lds_byte(wc * 32 + fr, fq * 8);
#define PG8_SA(b, h) (((b) * 2 + (h)) * HTB)
#define PG8_SB(b, h) ((4 + (b) * 2 + (h)) * HTB)
#define PG8_STAGE(bufoff, gbase, voff) do { _Pragma("unroll") for (int _i = 0; _i < 2; ++_i) \
        __builtin_amdgcn_global_load_lds((const unsigned*)((const char*)(gbase) + (voff)[_i]), (LAS unsigned*)(lds + (bufoff) + ldsw + _i * 8192), 16, 0, 0); } while (0)
#define PG8_LDA(dst, b, h) do { _Pragma("unroll") for (int m = 0; m < 4; ++m) _Pragma("unroll") for (int k = 0; k < 2; ++k) dst[m][k] = *(const LAS bf16x8*)(lds + PG8_SA(b, h) + aoff + m * 2048 + k * 1024); } while (0)
#define PG8_LDB(dst, b, h) do { _Pragma("unroll") for (int n = 0; n < 2; ++n) _Pragma("unroll") for (int k = 0; k < 2; ++k) dst[n][k] = *(const LAS bf16x8*)(lds + PG8_SB(b, h) + boff + n * 2048 + k * 1024); } while (0)
#define PG8_MMA(ai, bj, At, Bt) do { __builtin_amdgcn_s_setprio(1); _Pragma("unroll") for (int m = 0; m < 4; ++m) _Pragma("unroll") for (int n = 0; n < 2; ++n) _Pragma("unroll") for (int k = 0; k < 2; ++k) \
        acc[ai][bj][m][n] = __builtin_amdgcn_mfma_f32_16x16x32_bf16(Bt[n][k], At[m][k], acc[ai][bj][m][n], 0, 0, 0); __builtin_amdgcn_s_setprio(0); } while (0)
#define PG8_WAIT_V(n) asm volatile("s_waitcnt vmcnt(" #n ")" ::: "memory")
#define PG8_WAIT_L(n) asm volatile("s_waitcnt lgkmcnt(" #n ")" ::: "memory")
#define PG8_BAR __builtin_amdgcn_s_barrier()
#define PG8_SCHED __builtin_amdgcn_sched_barrier(0)
#define PG8_ZERO() do { _Pragma("unroll") for (int a = 0; a < 2; ++a) _Pragma("unroll") for (int b = 0; b < 2; ++b) _Pragma("unroll") for (int m = 0; m < 4; ++m) _Pragma("unroll") for (int n = 0; n < 2; ++n) acc[a][b][m][n] = (f32x4){0.f, 0.f, 0.f, 0.f}; } while (0)
    Unit cur, nxt; int ui = 0;
    if (!S.next(0, cur)) return;
    E.pre(cur, wr, wc, fr, fq);
    f32x4 acc[2][2][4][2];
    PG8_ZERO();
    bf16x8 At[4][2], B0[2][2], B1[2][2];
    const char* cA = cur.a; const char* cB = cur.b;
    PG8_STAGE(PG8_SB(0, 0), cB, voffB); PG8_STAGE(PG8_SA(0, 0), cA, voffA); PG8_STAGE(PG8_SB(0, 1), cB + hstepB, voffB); PG8_STAGE(PG8_SA(0, 1), cA + hstepA, voffA);
    if (wr == 1) PG8_BAR;
    PG8_WAIT_V(4); PG8_BAR;
    PG8_STAGE(PG8_SB(1, 0), cB + kstep, voffB); PG8_STAGE(PG8_SA(1, 0), cA + kstep, voffA); PG8_STAGE(PG8_SB(1, 1), cB + hstepB + kstep, voffB);
    PG8_WAIT_V(6); PG8_BAR;
    for (;;) {
        const bool has_next = S.next(ui + 1, nxt);
        const char* nA = has_next ? nxt.a : cA; const char* nB = has_next ? nxt.b : cB;
#pragma unroll 1
        for (int t = 0; t < nt; t += 2) {
            const bool last = (t == nt - 2);
            const char* a1 = cA + (size_t)(t + 1) * kstep;
            const char* a2 = last ? nA : cA + (size_t)(t + 2) * kstep; const char* b2 = last ? nB : cB + (size_t)(t + 2) * kstep;
            const char* a3 = a2 + kstep; const char* b3 = b2 + kstep;
            PG8_LDB(B0, 0, 0); PG8_SCHED; PG8_LDA(At, 0, 0); PG8_STAGE(PG8_SA(1, 1), a1 + hstepA, voffA);
            PG8_WAIT_L(8); PG8_BAR; PG8_WAIT_L(0); PG8_MMA(0, 0, At, B0); PG8_BAR; PG8_SCHED;
            PG8_LDB(B1, 0, 1); PG8_STAGE(PG8_SB(0, 0), b2, voffB);
            PG8_BAR; PG8_WAIT_L(0); PG8_MMA(0, 1, At, B1); PG8_BAR;
            PG8_LDA(At, 0, 1); PG8_STAGE(PG8_SA(0, 0), a2, voffA);
            PG8_BAR; PG8_WAIT_L(0); PG8_MMA(1, 0, At, B0); PG8_BAR; PG8_SCHED;
            PG8_STAGE(PG8_SB(0, 1), b2 + hstepB, voffB);
            PG8_WAIT_V(6); PG8_BAR; PG8_MMA(1, 1, At, B1); PG8_BAR;
            PG8_LDB(B0, 1, 0); PG8_SCHED; PG8_LDA(At, 1, 0); PG8_STAGE(PG8_SA(0, 1), a2 + hstepA, voffA);
            PG8_WAIT_L(8); PG8_BAR; PG8_WAIT_L(0); PG8_MMA(0, 0, At, B0); PG8_BAR; PG8_SCHED;
            PG8_LDB(B1, 1, 1); PG8_STAGE(PG8_SB(1, 0), b3, voffB);
            PG8_BAR; PG8_WAIT_L(0); PG8_MMA(0, 1, At, B1); PG8_BAR;
            PG8_LDA(At, 1, 1); PG8_STAGE(PG8_SA(1, 0), a3, voffA);
            PG8_BAR; PG8_WAIT_L(0); PG8_MMA(1, 0, At, B0); PG8_BAR; PG8_SCHED;
            PG8_STAGE(PG8_SB(1, 1), b3 + hstepB, voffB);
            PG8_WAIT_V(6); PG8_BAR; PG8_MMA(1, 1, At, B1); PG8_BAR;
        }
        if (cur.cont) { E.mid(acc, cur, wr, wc, fr, fq); }
        else { if constexpr (!Epi::AFTER_DRAIN) E(acc, cur, wr, wc, fr, fq); if (!has_next) break; PG8_ZERO(); }
        cur = nxt; cA = nA; cB = nB; ++ui;
    }
    PG8_WAIT_V(0);
    if (wr == 0) PG8_BAR;
    PG8_BAR;
    if constexpr (Epi::AFTER_DRAIN) E(acc, cur, wr, wc, fr, fq);
#undef PG8_SA
#undef PG8_SB
#undef PG8_STAGE
#undef PG8_LDA
#undef PG8_LDB
#undef PG8_MMA
#undef PG8_WAIT_V
#undef PG8_WAIT_L
#undef PG8_BAR
#undef PG8_SCHED
#undef PG8_ZERO
}

typedef f32x4 Acc[2][2][4][2];
#define EPI_ROWS(ai, m) _Pragma("unroll") for (int ai = 0; ai < 2; ++ai) _Pragma("unroll") for (int m = 0; m < 4; ++m) if (epi_fence())
__device__ __forceinline__ bool epi_fence() { asm volatile("" ::: "memory"); return true; }
#define EPI_R8 _Pragma("unroll") for (int r8 = 0; r8 < 8; ++r8)
#define EPI_RL(ai, m) ((ai) * 128 + wr * 64 + (m) * 16 + fr)
#define EPI_CL(bj) ((bj) * 128 + wc * 32 + 8 * fq)

struct SchedP1 { const char* hb; const char* wint; int G, c;
    __device__ __forceinline__ bool next(int i, Unit& u) const {
        const int L = i * G + c; if (L >= 768) return false;
        u.cont = 0;
        if (L < 512) { int pm, pn; tile_order(L, 64, 8, pm, pn); u.pm = pm; u.pn = pn; u.kind = 0; u.a = hb + (size_t)pm * 256 * 1024 * 2; u.b = wint + (size_t)pn * 256 * 1024 * 2; }
        else { const int l = L - 512; u.pm = l & 3; u.pn = l >> 2; u.kind = 1; u.a = wint + (size_t)(2048 + u.pm * 256) * 1024 * 2; u.b = hb + (size_t)u.pn * 256 * 1024 * 2; }
        return true; } };
struct EpiP1 { static constexpr bool AFTER_DRAIN = false; bf16_t* qkpre; bf16_t* vt;
    __device__ __forceinline__ void mid(Acc&, const Unit&, int, int, int, int) const {}
    __device__ __forceinline__ void pre(const Unit&, int, int, int, int) const {}
    __device__ __forceinline__ void operator()(Acc& acc, const Unit& u, int wr, int wc, int fr, int fq) const {
        bf16_t* base; int ld;
        if (u.kind == 0) { base = qkpre + (size_t)u.pm * 256 * 2048 + u.pn * 256; ld = 2048; }
        else { const int item = ((u.pn >> 3) * 4 + u.pm) * 8 + (u.pn & 7); base = vt + (size_t)item * 65536; ld = 256; }
        EPI_ROWS(ai, m) { bf16_t* rowp = base + (size_t)EPI_RL(ai, m) * ld + EPI_CL(0);
#pragma unroll
            for (int bj = 0; bj < 2; ++bj) *(u32x4*)(rowp + bj * 128) = pack8(acc[ai][bj][m][0], acc[ai][bj][m][1]); }
    } };

struct SchedP3 { const char* wq; const char* kw; const char* vt; const char* kwt; int G, c;
    __device__ __forceinline__ bool next(int i, Unit& u) const {
        const int L = i * G + c; if (L >= 512) return false;
        u.cont = 0; u.pn = 0;
        if (L < 256) { u.pm = L; u.kind = 0; u.a = wq + (size_t)L * 131072; u.b = kw + (size_t)L * 131072; }
        else { const int it = L - 256; u.pm = it; u.kind = 1; u.a = vt + (size_t)it * 131072; u.b = kwt + (size_t)it * 131072; }
        return true; } };
struct EpiP3 { static constexpr bool AFTER_DRAIN = false; bf16_t* s; bf16_t* lt; float* deni;
    __device__ __forceinline__ void mid(Acc&, const Unit&, int, int, int, int) const {}
    __device__ __forceinline__ void pre(const Unit&, int, int, int, int) const {}
    __device__ __forceinline__ void operator()(Acc& acc, const Unit& u, int wr, int wc, int fr, int fq) const {
        const int item = u.pm;
        if (u.kind == 0) {
            const int b = item >> 5, h = (item >> 3) & 3, sc = item & 7; const int tokb = b * SEQ_ + sc * 256;
            EPI_ROWS(ai, m) { int r = EPI_RL(ai, m); asm volatile("" : "+v"(r)); float rs = 0.f;
#pragma unroll
                for (int bj = 0; bj < 2; ++bj) { const int c0 = EPI_CL(bj); f32x4 v0 = acc[ai][bj][m][0], v1 = acc[ai][bj][m][1];
#pragma unroll
                    for (int j = 0; j < 4; ++j) { v0[j] = (c0 + j <= r) ? v0[j] : 0.f; v1[j] = (c0 + 4 + j <= r) ? v1[j] : 0.f; rs += v0[j] + v1[j]; }
                    *(u32x4*)(s + (size_t)item * 65536 + r * 256 + c0) = pack8(v0, v1); }
                rs += __shfl_xor(rs, 16); rs += __shfl_xor(rs, 32);
                if (fq == 0) unsafeAtomicAdd(deni + (size_t)(tokb + r) * 4 + h, rs); }
        } else {
            EPI_ROWS(ai, m) { bf16_t* rowp = lt + (size_t)item * 65536 + EPI_RL(ai, m) * 256 + EPI_CL(0);
#pragma unroll
                for (int bj = 0; bj < 2; ++bj) *(u32x4*)(rowp + bj * 128) = pack8(acc[ai][bj][m][0], acc[ai][bj][m][1]); }
        }
    } };

struct SchedP5 { const char* s; const char* vt; const char* wq; const char* cint; int G, c;
    __device__ __forceinline__ bool next(int i, Unit& u) const {
        const int item = (i >> 1) * G + c; if (item >= 256) return false;
        u.pm = item; u.pn = 0; u.kind = 0;
        if ((i & 1) == 0) { u.cont = 1; u.a = s + (size_t)item * 131072; u.b = vt + (size_t)item * 131072; }
        else { u.cont = 0; u.a = wq + (size_t)item * 131072; u.b = cint + (size_t)item * 131072; }
        return true; } };
struct EpiP5 { static constexpr bool AFTER_DRAIN = false; bf16_t* hm; const float* deni; const float* denx; float* hss;
    __device__ __forceinline__ void mid(Acc&, const Unit&, int, int, int, int) const {}
    __device__ __forceinline__ void pre(const Unit&, int, int, int, int) const {}
    __device__ __forceinline__ void operator()(Acc& acc, const Unit& u, int wr, int wc, int fr, int fq) const {
        const int item = u.pm; const int b = item >> 5, h = (item >> 3) & 3, sc = item & 7; const int tokb = b * SEQ_ + sc * 256;
        float dnv[2][4];
#pragma unroll
        for (int ai = 0; ai < 2; ++ai)
#pragma unroll
            for (int m = 0; m < 4; ++m) { const int t = tokb + EPI_RL(ai, m); dnv[ai][m] = deni[(size_t)t * 4 + h] + denx[(size_t)t * 4 + h]; }
        EPI_ROWS(ai, m) { const int t = tokb + EPI_RL(ai, m);
            const float den = dnv[ai][m]; const float inv = __builtin_amdgcn_rcpf(fmaxf(fabsf(den), 1.0f)); float ss = 0.f;
#pragma unroll
            for (int bj = 0; bj < 2; ++bj) { f32x4 v0 = acc[ai][bj][m][0] * inv, v1 = acc[ai][bj][m][1] * inv;
#pragma unroll
                for (int j = 0; j < 4; ++j) ss += v0[j] * v0[j] + v1[j] * v1[j];
                *(u32x4*)(hm + (size_t)t * 1024 + h * 256 + EPI_CL(bj)) = pack8(v0, v1); }
            ss += __shfl_xor(ss, 16); ss += __shfl_xor(ss, 32);
            if (fq == 0) unsafeAtomicAdd(hss + (size_t)t * 4 + h, ss); }
    } };

struct SchedP6 { const char* hb; const char* wint; int G, c;
    __device__ __forceinline__ bool next(int i, Unit& u) const {
        u.cont = 0;
        if (i == 0) { const int item = c; if (item >= 256) return false; const int b = item >> 5, h = (item >> 3) & 3, sc = item & 7;
            u.pm = b * 8 + sc; u.pn = h; u.kind = 0; u.a = hb + (size_t)u.pm * 256 * 1024 * 2; u.b = wint + (size_t)(3072 + h * 256) * 1024 * 2; return true; }
        const int L = (i - 1) * G + c; if (L >= 512) return false;
        int pm, pn; tile_order(L, 64, 8, pm, pn); u.pm = pm; u.pn = pn; u.kind = 1;
        u.a = hb + (size_t)pm * 256 * 1024 * 2; u.b = wint + (size_t)(4096 + pn * 256) * 1024 * 2; return true; } };
struct EpiP6 { static constexpr bool AFTER_DRAIN = false; bf16_t* hm; float* hss; const float* mhg; bf16_t* uu;
    __device__ __forceinline__ void mid(Acc&, const Unit&, int, int, int, int) const {}
    __device__ __forceinline__ void pre(const Unit&, int, int, int, int) const {}
    __device__ __forceinline__ void operator()(Acc& acc, const Unit& u, int wr, int wc, int fr, int fq) const {
        if (u.kind == 0) {
            float hsv[2][4];
#pragma unroll
            for (int ai = 0; ai < 2; ++ai)
#pragma unroll
                for (int m = 0; m < 4; ++m) hsv[ai][m] = __hip_atomic_load(hss + (size_t)(u.pm * 256 + EPI_RL(ai, m)) * 4 + u.pn, __ATOMIC_RELAXED, __HIP_MEMORY_SCOPE_AGENT);
            u32x4 cur[2], nxt[2];
#pragma unroll
            for (int bj = 0; bj < 2; ++bj) cur[bj] = *(const u32x4*)(hm + (size_t)(u.pm * 256 + EPI_RL(0, 0)) * 1024 + u.pn * 256 + EPI_CL(bj));
            EPI_R8 { const int ai = r8 >> 2, m = r8 & 3; const int t = u.pm * 256 + EPI_RL(ai, m);
                if (r8 < 7) { const int tn = u.pm * 256 + EPI_RL((r8 + 1) >> 2, (r8 + 1) & 3);
#pragma unroll
                    for (int bj = 0; bj < 2; ++bj) nxt[bj] = *(const u32x4*)(hm + (size_t)tn * 1024 + u.pn * 256 + EPI_CL(bj)); }
                const float rsn = rsqrtf(hsv[ai][m] * (1.0f / 256.0f) + EPS_);
#pragma unroll
                for (int bj = 0; bj < 2; ++bj) { f32x4 h0, h1; unpack8(cur[bj], h0, h1); f32x4 o0, o1;
#pragma unroll
                    for (int j = 0; j < 4; ++j) { o0[j] = h0[j] * rsn * sigm(acc[ai][bj][m][0][j]); o1[j] = h1[j] * rsn * sigm(acc[ai][bj][m][1][j]); }
                    *(u32x4*)(hm + (size_t)t * 1024 + u.pn * 256 + EPI_CL(bj)) = pack8(o0, o1); }
                cur[0] = nxt[0]; cur[1] = nxt[1]; }
        } else {
            EPI_ROWS(ai, m) { const int t = u.pm * 256 + EPI_RL(ai, m); f32x4 o0, o1;
#pragma unroll
                for (int j = 0; j < 4; ++j) { o0[j] = acc[ai][0][m][0][j] * sigm(acc[ai][1][m][0][j]); o1[j] = acc[ai][0][m][1][j] * sigm(acc[ai][1][m][1][j]); }
                *(u32x4*)(uu + (size_t)t * 1024 + u.pn * 128 + wc * 32 + 8 * fq) = pack8(o0, o1); }
        }
    } };

struct SchedP8 { const char* hb; const char* wint; const char* hmg; const char* uc; const char* wmt; const char* wct; int G, c;
    __device__ __forceinline__ bool next(int i, Unit& u) const {
        const int L = (i >> 2) * G + c, r = i & 3; if (L >= 256) return false;
        int pn; map_n4(L, u.pm, pn); u.cont = 0;
        if (r < 2) { u.kind = 2; u.pn = 2 * pn + r; u.a = hb + (size_t)u.pm * 256 * 1024 * 2; u.b = wint + (size_t)(6144 + u.pn * 256) * 1024 * 2; }
        else if (r == 2) { u.kind = 0; u.pn = pn; u.a = hmg + (size_t)u.pm * 256 * 1024 * 2; u.b = wmt + (size_t)pn * 256 * 1024 * 2; }
        else { u.kind = 1; u.pn = pn; u.a = uc + (size_t)u.pm * 256 * 1024 * 2; u.b = wct + (size_t)pn * 256 * 1024 * 2; }
        return true; } };
struct EpiP8 { static constexpr bool AFTER_DRAIN = false; bf16_t* gmc; bf16_t* tmp; bf16_t* merged;
    __device__ __forceinline__ void mid(Acc&, const Unit&, int, int, int, int) const {}
    __device__ __forceinline__ void pre(const Unit&, int, int, int, int) const {}
    __device__ __forceinline__ void operator()(Acc& acc, const Unit& u, int wr, int wc, int fr, int fq) const {
        if (u.kind == 2) {
            EPI_ROWS(ai, m) { const int t = u.pm * 256 + EPI_RL(ai, m); f32x4 r0, r1, c0, c1;
#pragma unroll
                for (int j = 0; j < 4; ++j) { const float e0 = __builtin_amdgcn_exp2f(acc[ai][1][m][0][j] * -1.4426950408889634f), e1 = __builtin_amdgcn_exp2f(acc[ai][1][m][1][j] * -1.4426950408889634f);
                    r0[j] = sigm(acc[ai][0][m][0][j]) * (1.0f + e0); r1[j] = sigm(acc[ai][0][m][1][j]) * (1.0f + e1);
                    c0[j] = __builtin_amdgcn_rcpf(1.0f + e0); c1[j] = __builtin_amdgcn_rcpf(1.0f + e1); }
                bf16_t* ptr = gmc + (size_t)t * 2048 + u.pn * 128 + wc * 32 + 8 * fq;
                *(u32x4*)ptr = pack8(r0, r1); *(u32x4*)(ptr + 1024) = pack8(c0, c1); }
        } else if (u.kind == 0) {
            u32x4 cur[2], nxt[2];
#pragma unroll
            for (int bj = 0; bj < 2; ++bj) cur[bj] = *(const u32x4*)(gmc + (size_t)(u.pm * 256 + EPI_RL(0, 0)) * 2048 + u.pn * 256 + EPI_CL(bj));
            EPI_R8 { const int ai = r8 >> 2, m = r8 & 3; const int t = u.pm * 256 + EPI_RL(ai, m);
                if (r8 < 7) { const int tn = u.pm * 256 + EPI_RL((r8 + 1) >> 2, (r8 + 1) & 3);
#pragma unroll
                    for (int bj = 0; bj < 2; ++bj) nxt[bj] = *(const u32x4*)(gmc + (size_t)tn * 2048 + u.pn * 256 + EPI_CL(bj)); }
#pragma unroll
                for (int bj = 0; bj < 2; ++bj) { const int c = u.pn * 256 + EPI_CL(bj); f32x4 a0, a1; unpack8(cur[bj], a0, a1);
                    *(u32x4*)(tmp + (size_t)t * 1024 + c) = pack8(acc[ai][bj][m][0] * a0, acc[ai][bj][m][1] * a1); }
                cur[0] = nxt[0]; cur[1] = nxt[1]; }
        } else {
            u32x4 cg[2], ct[2], ng[2], nt2[2];
#pragma unroll
            for (int bj = 0; bj < 2; ++bj) { const int t0 = u.pm * 256 + EPI_RL(0, 0); const int c = u.pn * 256 + EPI_CL(bj);
                cg[bj] = *(const u32x4*)(gmc + (size_t)t0 * 2048 + 1024 + c); ct[bj] = *(const u32x4*)(tmp + (size_t)t0 * 1024 + c); }
            EPI_R8 { const int ai = r8 >> 2, m = r8 & 3; const int t = u.pm * 256 + EPI_RL(ai, m);
                if (r8 < 7) { const int tn = u.pm * 256 + EPI_RL((r8 + 1) >> 2, (r8 + 1) & 3);
#pragma unroll
                    for (int bj = 0; bj < 2; ++bj) { const int c = u.pn * 256 + EPI_CL(bj); ng[bj] = *(const u32x4*)(gmc + (size_t)tn * 2048 + 1024 + c); nt2[bj] = *(const u32x4*)(tmp + (size_t)tn * 1024 + c); } }
#pragma unroll
                for (int bj = 0; bj < 2; ++bj) { const int c = u.pn * 256 + EPI_CL(bj); f32x4 b0, b1, t0, t1; unpack8(cg[bj], b0, b1); unpack8(ct[bj], t0, t1);
                    *(u32x4*)(merged + (size_t)t * 1024 + c) = pack8((acc[ai][bj][m][0] + t0) * b0, (acc[ai][bj][m][1] + t1) * b1); }
                cg[0] = ng[0]; cg[1] = ng[1]; ct[0] = nt2[0]; ct[1] = nt2[1]; }
        }
    } };

struct SchedN4 { const char* a; const char* bt; size_t astep, bstep; int G, c;
    __device__ __forceinline__ bool next(int i, Unit& u) const {
        const int L = i * G + c; if (L >= 256) return false;
        map_n4(L, u.pm, u.pn); u.kind = 0; u.cont = 0; u.a = a + (size_t)u.pm * astep; u.b = bt + (size_t)u.pn * bstep; return true; } };
struct SchedPE { const char* a; const char* bt; int G, c;
    __device__ __forceinline__ bool next(int i, Unit& u) const {
        const int L = i * G + c; if (L >= 256 || c < 0) return false;
        u.pm = L >> 2; u.pn = L & 3; u.kind = 0; u.cont = 0; u.a = a + (size_t)u.pm * 256 * 256 * 2; u.b = bt + (size_t)u.pn * 256 * 256 * 2; return true; } };
template <bool SRC_BF16> struct EpiRes { static constexpr bool AFTER_DRAIN = false; const void* src; bf16_t* dstb; float* ssq;
    __device__ __forceinline__ void mid(Acc&, const Unit&, int, int, int, int) const {}
    __device__ __forceinline__ void pre(const Unit& u, int wr, int wc, int fr, int fq) const {
        if (!SRC_BF16) {
            EPI_ROWS(ai, m) { const int t = u.pm * 256 + EPI_RL(ai, m);
#pragma unroll
                for (int bj = 0; bj < 2; ++bj) { const float v = *((const float*)src + (size_t)t * 1024 + u.pn * 256 + EPI_CL(bj)); asm volatile("" :: "v"(v)); } }
        }
    }
    __device__ __forceinline__ void operator()(Acc& acc, const Unit& u, int wr, int wc, int fr, int fq) const {
        f32x4 cur[2][2], nxt[2][2];
#define ERES_LOAD(dst, t_) do { _Pragma("unroll") for (int bj = 0; bj < 2; ++bj) { const size_t o_ = (size_t)(t_) * 1024 + u.pn * 256 + EPI_CL(bj); \
            if (SRC_BF16) dst[bj][0] = __builtin_bit_cast(f32x4, *(const u32x4*)((const bf16_t*)src + o_)); \
            else { dst[bj][0] = *(const f32x4*)((const float*)src + o_); dst[bj][1] = *(const f32x4*)((const float*)src + o_ + 4); } } } while (0)
        ERES_LOAD(cur, u.pm * 256 + EPI_RL(0, 0));
        EPI_R8 { const int ai = r8 >> 2, m = r8 & 3; const int t = u.pm * 256 + EPI_RL(ai, m); float ss = 0.f;
            if (r8 < 7) ERES_LOAD(nxt, u.pm * 256 + EPI_RL((r8 + 1) >> 2, (r8 + 1) & 3));
#pragma unroll
            for (int bj = 0; bj < 2; ++bj) { const size_t o = (size_t)t * 1024 + u.pn * 256 + EPI_CL(bj); f32x4 v0, v1;
                if (SRC_BF16) unpack8(__builtin_bit_cast(u32x4, cur[bj][0]), v0, v1); else { v0 = cur[bj][0]; v1 = cur[bj][1]; }
                v0 += acc[ai][bj][m][0]; v1 += acc[ai][bj][m][1];
#pragma unroll
                for (int j = 0; j < 4; ++j) ss += v0[j] * v0[j] + v1[j] * v1[j];
                *(u32x4*)(dstb + o) = pack8(v0, v1); }
            ss += __shfl_xor(ss, 16); ss += __shfl_xor(ss, 32);
            if (fq == 0) unsafeAtomicAdd(ssq + t, ss);
#pragma unroll
            for (int bj = 0; bj < 2; ++bj) { cur[bj][0] = nxt[bj][0]; if (!SRC_BF16) cur[bj][1] = nxt[bj][1]; } }
#undef ERES_LOAD
    } };

struct SchedP10 { const char* x1b; const char* wgut; int G, c;
    __device__ __forceinline__ bool next(int i, Unit& u) const {
        const int L = i * G + c; if (L >= 1408) return false;
        int pm, pn; tile_order(L, 64, 22, pm, pn); u.pm = pm; u.pn = pn; u.kind = 0; u.cont = 0;
        u.a = x1b + (size_t)pm * 256 * 1024 * 2; u.b = wgut + (size_t)pn * 256 * 1024 * 2; return true; } };
struct EpiP10 { static constexpr bool AFTER_DRAIN = false; const float* ssq; bf16_t* hid;
    __device__ __forceinline__ void mid(Acc&, const Unit&, int, int, int, int) const {}
    __device__ __forceinline__ void pre(const Unit&, int, int, int, int) const {}
    __device__ __forceinline__ void operator()(Acc& acc, const Unit& u, int wr, int wc, int fr, int fq) const {
        float rsv[2][4];
#pragma unroll
        for (int ai = 0; ai < 2; ++ai)
#pragma unroll
            for (int m = 0; m < 4; ++m) rsv[ai][m] = ssq[u.pm * 256 + EPI_RL(ai, m)];
        EPI_ROWS(ai, m) { const int t = u.pm * 256 + EPI_RL(ai, m); const float rs = rsqrtf(rsv[ai][m] * (1.0f / 1024.0f) + EPS_); f32x4 o0, o1;
#pragma unroll
            for (int j = 0; j < 4; ++j) { o0[j] = silu(acc[ai][0][m][0][j] * rs) * (acc[ai][1][m][0][j] * rs); o1[j] = silu(acc[ai][0][m][1][j] * rs) * (acc[ai][1][m][1][j] * rs); }
            *(u32x4*)(hid + (size_t)t * DFF_ + u.pn * 128 + wc * 32 + 8 * fq) = pack8(o0, o1); }
    } };

struct EpiBf { static constexpr bool AFTER_DRAIN = false; bf16_t* o;
    __device__ __forceinline__ void mid(Acc&, const Unit&, int, int, int, int) const {}
    __device__ __forceinline__ void pre(const Unit&, int, int, int, int) const {}
    __device__ __forceinline__ void operator()(Acc& acc, const Unit& u, int wr, int wc, int fr, int fq) const {
        EPI_ROWS(ai, m) { bf16_t* rowp = o + (size_t)(u.pm * 256 + EPI_RL(ai, m)) * 1024 + u.pn * 256 + EPI_CL(0);
#pragma unroll
            for (int bj = 0; bj < 2; ++bj) *(u32x4*)(rowp + bj * 128) = pack8(acc[ai][bj][m][0], acc[ai][bj][m][1]); }
    } };

struct EpiP12 { static constexpr bool AFTER_DRAIN = true; const float* ssq2; const bf16_t* pe; const bf16_t* xin; float* out; float* ssq3; unsigned* done; const float* fg;
    __device__ __forceinline__ void mid(Acc&, const Unit&, int, int, int, int) const {}
    __device__ __forceinline__ void pre(const Unit&, int, int, int, int) const {}
    __device__ __forceinline__ void operator()(Acc& acc, const Unit& u, int wr, int wc, int fr, int fq) const {
        float rsv[2][4];
#pragma unroll
        for (int ai = 0; ai < 2; ++ai)
#pragma unroll
            for (int m = 0; m < 4; ++m) rsv[ai][m] = ssq2[u.pm * 256 + EPI_RL(ai, m)];
        { u32x4 cx[2], cp[2], nx[2], np[2];
#pragma unroll
            for (int bj = 0; bj < 2; ++bj) { const size_t o = (size_t)(u.pm * 256 + EPI_RL(0, 0)) * 1024 + u.pn * 256 + EPI_CL(bj); cx[bj] = *(const u32x4*)(xin + o); cp[bj] = *(const u32x4*)(pe + o); }
            EPI_R8 { const int ai = r8 >> 2, m = r8 & 3; const int t = u.pm * 256 + EPI_RL(ai, m); const float rs = rsqrtf(rsv[ai][m] * (1.0f / 1024.0f) + EPS_); float ss = 0.f;
                if (r8 < 7) {
#pragma unroll
                    for (int bj = 0; bj < 2; ++bj) { const size_t o = (size_t)(u.pm * 256 + EPI_RL((r8 + 1) >> 2, (r8 + 1) & 3)) * 1024 + u.pn * 256 + EPI_CL(bj); nx[bj] = *(const u32x4*)(xin + o); np[bj] = *(const u32x4*)(pe + o); } }
#pragma unroll
                for (int bj = 0; bj < 2; ++bj) { f32x4 p0, p1, v0, v1; unpack8(cp[bj], p0, p1); unpack8(cx[bj], v0, v1);
#pragma unroll
                    for (int j = 0; j < 4; ++j) { v0[j] += sigm(acc[ai][bj][m][0][j] * rs) * p0[j]; v1[j] += sigm(acc[ai][bj][m][1][j] * rs) * p1[j]; ss += v0[j] * v0[j] + v1[j] * v1[j]; }
                    acc[ai][bj][m][0] = v0; acc[ai][bj][m][1] = v1; }
                ss += __shfl_xor(ss, 16); ss += __shfl_xor(ss, 32);
                if (fq == 0) unsafeAtomicAdd(ssq3 + t, ss);
                cx[0] = nx[0]; cx[1] = nx[1]; cp[0] = np[0]; cp[1] = np[1]; } }
        asm volatile("s_waitcnt vmcnt(0)" ::: "memory");
        unsigned* cnt = done + 64 * u.pm;
        if ((threadIdx.x & 63) == 0) __hip_atomic_fetch_add(cnt, 1u, __ATOMIC_RELAXED, __HIP_MEMORY_SCOPE_AGENT);
        { unsigned sp = 0; while (__hip_atomic_load(cnt, __ATOMIC_RELAXED, __HIP_MEMORY_SCOPE_AGENT) < 32u) { __builtin_amdgcn_s_sleep(1); if (++sp > (1u << 22)) break; } }
#pragma unroll
        for (int ai = 0; ai < 2; ++ai)
#pragma unroll
            for (int m = 0; m < 4; ++m) rsv[ai][m] = __hip_atomic_load(ssq3 + u.pm * 256 + EPI_RL(ai, m), __ATOMIC_RELAXED, __HIP_MEMORY_SCOPE_AGENT);
        f32x4 gv[2][2];
#pragma unroll
        for (int bj = 0; bj < 2; ++bj) { const int cc = u.pn * 256 + EPI_CL(bj); gv[bj][0] = *(const f32x4*)(fg + cc); gv[bj][1] = *(const f32x4*)(fg + cc + 4); }
        EPI_ROWS(ai, m) { const int t = u.pm * 256 + EPI_RL(ai, m);
            const float rs = rsqrtf(rsv[ai][m] * (1.0f / 1024.0f) + EPS_);
#pragma unroll
            for (int bj = 0; bj < 2; ++bj) { const size_t o = (size_t)t * 1024 + u.pn * 256 + EPI_CL(bj);
                *(f32x4*)(out + o) = acc[ai][bj][m][0] * rs * gv[bj][0]; *(f32x4*)(out + o + 4) = acc[ai][bj][m][1] * rs * gv[bj][1]; } }
    } };

struct CvtTile { const float* src; int ld; const float* scale; bf16_t* dst; int dstld; };
__device__ __forceinline__ CvtTile cvt_tile_params(const Params& p, int tl) {
    const int NT0 = 2048, NT4 = NT0 + 1024, NT5 = NT4 + 1408, NT6 = NT5 + 704;
    unsigned char* ws = p.ws; CvtTile t; t.scale = nullptr;
    if (tl < NT0) { const int nb = tl >> 4, kb = tl & 15; const int n0 = nb * 64; int col;
        if (n0 < 4096) col = n0; else if (n0 < 6144) { const int j = (n0 - 4096) >> 8, r = (n0 - 4096) & 255; col = (r < 128) ? (4104 + 128 * j + r) : (5128 + 128 * j + r - 128); }
        else { const int j = (n0 - 6144) >> 8, r = (n0 - 6144) & 255; col = 6152 + ((r < 128) ? (128 * j + r) : (1024 + 128 * j + r - 128)); }
        t.src = p.in[3] + (size_t)kb * 64 * NIN_ + col; t.ld = NIN_; t.dst = (bf16_t*)(ws + O_WINT) + (size_t)n0 * 1024 + kb * 64; t.dstld = 1024; }
    else if (tl < NT4) { const int w = (tl - NT0) >> 8, l = (tl - NT0) & 255; const int nb = l >> 4, kb = l & 15;
        const float* base = w == 0 ? p.in[12] : (w == 1 ? p.in[13] : (w == 2 ? p.in[14] : p.in[20])); const size_t od = w == 0 ? O_WMT : (w == 1 ? O_WCT : (w == 2 ? O_WOT : O_WPGT));
        t.src = base + (size_t)kb * 64 * 1024 + nb * 64; t.ld = 1024; if (w == 3) t.scale = p.in[19] + kb * 64; if (w == 0) t.scale = p.in[7] + kb * 64; t.dst = (bf16_t*)(ws + od) + (size_t)nb * 64 * 1024 + kb * 64; t.dstld = 1024; }
    else if (tl < NT5) { const int l = tl - NT4; const int nb = l >> 4, kb = l & 15; const int n0 = nb * 64; const int j = n0 >> 8, r = n0 & 255;
        const float* base = (r < 128) ? p.in[16] : p.in[17]; const int col = 128 * j + (r & 127);
        t.src = base + (size_t)kb * 64 * DFF_ + col; t.ld = DFF_; t.scale = p.in[15] + kb * 64; t.dst = (bf16_t*)(ws + O_WGUT) + (size_t)n0 * 1024 + kb * 64; t.dstld = 1024; }
    else if (tl < NT6) { const int l = tl - NT5; const int nb = l / 44, kb = l % 44;
        t.src = p.in[18] + (size_t)kb * 64 * 1024 + nb * 64; t.ld = 1024; t.dst = (bf16_t*)(ws + O_WDT) + (size_t)nb * 64 * DFF_ + kb * 64; t.dstld = DFF_; }
    else { const int l = tl - NT6; const int nb = l >> 2, kb = l & 3;
        t.src = p.in[21] + (size_t)kb * 64 * 1024 + nb * 64; t.ld = 1024; t.dst = (bf16_t*)(ws + O_WPPT) + (size_t)nb * 64 * 256 + kb * 64; t.dstld = 256; }
    return t;
}
__device__ __forceinline__ void cvt_tile_load(const CvtTile& t, f32x4 (&v)[2]) {
    const int tid = threadIdx.x, kk = tid >> 4, c4 = (tid & 15) * 4;
#pragma unroll
    for (int pss = 0; pss < 2; ++pss) { const int k = kk + pss * 32; v[pss] = *(const f32x4*)(t.src + (size_t)k * t.ld + c4); if (t.scale) v[pss] = v[pss] * t.scale[k]; }
}

__device__ __forceinline__ void phase0(const Params& p, unsigned char* sm) {
    unsigned char* ws = p.ws;
    const int tid = threadIdx.x, lane = tid & 63, wid = tid >> 6;
    const size_t gtid = (size_t)blockIdx.x * 512 + tid, gthreads = (size_t)gridDim.x * 512;
    for (size_t i = gtid; i < ZERO_BYTES / 16; i += gthreads) ((u32x4*)(ws + O_ZERO))[i] = (u32x4){0u, 0u, 0u, 0u};
    { const float* pp = p.in[1]; bf16_t* pb = (bf16_t*)(ws + O_PB);
        for (size_t i = gtid; i < (size_t)T_ * 256 / 8; i += gthreads) { const f32x4 a = *(const f32x4*)(pp + i * 8), b = *(const f32x4*)(pp + i * 8 + 4); *(u32x4*)(pb + i * 8) = pack8(a, b); } }
    { const float* x = p.in[0]; const float* g = p.in[2]; const float* win = p.in[3]; const float* bif = p.in[4];
        float* wgT = (float*)sm;
        for (int idx = tid; idx < 8192; idx += 512) { const int k = idx >> 3, j = idx & 7; wgT[j * 1024 + k] = win[(size_t)k * NIN_ + 4096 + j] * g[k]; }
        __syncthreads();
        bf16_t* hb = (bf16_t*)(ws + O_HB); float* ig = (float*)(ws + O_IG); float* lf = (float*)(ws + O_LF);
        const int rstep = gridDim.x * 8; int row = blockIdx.x * 8 + wid;
        f32x4 xn[4];
#pragma unroll
        for (int i = 0; i < 4; ++i) xn[i] = (row < T_) ? *(const f32x4*)(x + (size_t)row * 1024 + i * 256 + lane * 4) : (f32x4){0.f, 0.f, 0.f, 0.f};
        for (; row < T_; row += rstep) {
            f32x4 xv[4]; float ss = 0.f;
#pragma unroll
            for (int i = 0; i < 4; ++i) { xv[i] = xn[i]; ss += xv[i][0] * xv[i][0] + xv[i][1] * xv[i][1] + xv[i][2] * xv[i][2] + xv[i][3] * xv[i][3]; }
            { const int nrow = row + rstep;
                if (nrow < T_) {
#pragma unroll
                    for (int i = 0; i < 4; ++i) xn[i] = *(const f32x4*)(x + (size_t)nrow * 1024 + i * 256 + lane * 4); } }
            ss = wave_sum(ss); const float rs = rsqrtf(ss * (1.0f / 1024.0f) + EPS_);
            float d[8];
#pragma unroll
            for (int j = 0; j < 8; ++j) d[j] = 0.f;
#pragma unroll
            for (int i = 0; i < 4; ++i) { const f32x4 hn = xv[i] * rs; const f32x4 gv = *(const f32x4*)(g + i * 256 + lane * 4); const f32x4 hg = hn * gv;
                u32x2 w; w.x = cvt_pk_bf16(hg[0], hg[1]); w.y = cvt_pk_bf16(hg[2], hg[3]); *(u32x2*)(hb + (size_t)row * 1024 + i * 256 + lane * 4) = w;
#pragma unroll
                for (int j = 0; j < 8; ++j) { const f32x4 wv = *(const f32x4*)(wgT + j * 1024 + i * 256 + lane * 4); d[j] += hn[0] * wv[0] + hn[1] * wv[1] + hn[2] * wv[2] + hn[3] * wv[3]; } }
#pragma unroll
            for (int j = 0; j < 8; ++j) d[j] = wave_sum(d[j]);
            if (lane < 8) { float v = d[0];
#pragma unroll
                for (int j = 1; j < 8; ++j) v = (lane == j) ? d[j] : v;
                v += bif[lane];
                if (lane < 4) ig[(size_t)row * 4 + lane] = v;
                else { const float z = v; lf[(size_t)row * 4 + lane - 4] = fminf(z, 0.f) - log1pf(__expf(-fabsf(z))); } }
        }
        __syncthreads();
    }
    { const int NTILES = 2048 + 1024 + 1408 + 704 + 64; const int gs = gridDim.x;
        float* tl = (float*)sm;
        int t = blockIdx.x; CvtTile c0{}, c1{}; f32x4 v0[2], v1[2];
        if (t < NTILES) { c0 = cvt_tile_params(p, t); cvt_tile_load(c0, v0); }
        if (t + gs < NTILES) { c1 = cvt_tile_params(p, t + gs); cvt_tile_load(c1, v1); }
        for (; t < NTILES; t += gs) {
            { const int kk = tid >> 4, c4 = (tid & 15) * 4;
#pragma unroll
                for (int pss = 0; pss < 2; ++pss) { const int k = kk + pss * 32;
#pragma unroll
                    for (int j = 0; j < 4; ++j) tl[k * 65 + c4 + j] = v0[pss][j]; } }
            __syncthreads();
            const CvtTile done = c0; c0 = c1; v0[0] = v1[0]; v0[1] = v1[1];
            { const int tn = t + 2 * gs; if (tn < NTILES) { c1 = cvt_tile_params(p, tn); cvt_tile_load(c1, v1); } }
            { const int n = tid >> 3, k8 = (tid & 7) * 8; float e[8];
#pragma unroll
                for (int q = 0; q < 8; ++q) e[q] = tl[(k8 + q) * 65 + n];
                u32x4 w; w.x = cvt_pk_bf16(e[0], e[1]); w.y = cvt_pk_bf16(e[2], e[3]); w.z = cvt_pk_bf16(e[4], e[5]); w.w = cvt_pk_bf16(e[6], e[7]);
                *(u32x4*)(done.dst + (size_t)n * done.dstld + k8) = w; }
            __syncthreads();
        }
    }
}

__device__ __forceinline__ void phase2(const Params& p, unsigned char* sm) {
    unsigned char* ws = p.ws;
    const int tid = threadIdx.x, lane = tid & 63, wid = tid >> 6;
    float* rowfac = (float*)sm; float* colfac = rowfac + 256; float* wsum = colfac + 256;
    const float* ig = (const float*)(ws + O_IG); const float* lf = (const float*)(ws + O_LF);
    const bf16_t* qkpre = (const bf16_t*)p.out;
    const float* cw = p.in[5]; const float* cb = p.in[6];
    for (int item = blockIdx.x; item < 256; item += gridDim.x) {
        const int b = item >> 5, h = (item >> 3) & 3, sc = item & 7; const int tokb = b * SEQ_ + sc * 256;
        float v = 0.f, igv = 0.f;
        if (tid < 256) { v = lf[(size_t)(tokb + tid) * 4 + h]; igv = ig[(size_t)(tokb + tid) * 4 + h]; }
#pragma unroll
        for (int o = 1; o < 64; o <<= 1) { const float n = __shfl_up(v, o); if (lane >= o) v += n; }
        if (tid < 256 && lane == 63) wsum[wid] = v;
        __syncthreads();
        if (tid < 256) { float add = 0.f; for (int j = 0; j < wid; ++j) add += wsum[j]; v += add; rowfac[tid] = __expf(v); colfac[tid] = __expf(igv - v);
            if (tid == 255) ((float*)(ws + O_EBL))[item] = __expf(v); }
        __syncthreads();
#pragma unroll 1
        for (int qt = 0; qt < 4; ++qt) {
        const int cp = tid & 127, tg = tid >> 7; const int ch = 2 * cp; const int tl0 = qt * 64 + tg * 16; const int s0 = sc * 256 + tl0;
        { const int col = h * 256 + ch; float x0[19], x1[19];
#pragma unroll
            for (int i = 0; i < 19; ++i) { const int s = s0 - 3 + i; unsigned w = 0u; if (s >= 0) w = *(const unsigned*)(qkpre + (size_t)(b * SEQ_ + s) * 2048 + col); x0[i] = bf_lo(w); x1[i] = bf_hi(w); }
            float w0[4], w1[4];
#pragma unroll
            for (int k = 0; k < 4; ++k) { const f32x2 wv = *(const f32x2*)(cw + (size_t)k * 2048 + col); w0[k] = wv[0]; w1[k] = wv[1]; }
            const f32x2 bv = *(const f32x2*)(cb + col);
            bf16_t* wq = (bf16_t*)(ws + O_WQ) + (size_t)item * 65536;
#pragma unroll
            for (int i = 0; i < 16; ++i) { float y0 = bv[0], y1 = bv[1];
#pragma unroll
                for (int k = 0; k < 4; ++k) { y0 += x0[i + k] * w0[k]; y1 += x1[i + k] * w1[k]; }
                const float f = rowfac[tl0 + i] * 0.0625f;
                *(unsigned*)(wq + (size_t)(tl0 + i) * 256 + ch) = cvt_pk_bf16(silu(y0) * f, silu(y1) * f); } }
        { const int col = 1024 + h * 256 + ch; float x0[19], x1[19];
#pragma unroll
            for (int i = 0; i < 19; ++i) { const int s = s0 - 3 + i; unsigned w = 0u; if (s >= 0) w = *(const unsigned*)(qkpre + (size_t)(b * SEQ_ + s) * 2048 + col); x0[i] = bf_lo(w); x1[i] = bf_hi(w); }
            float w0[4], w1[4];
#pragma unroll
            for (int k = 0; k < 4; ++k) { const f32x2 wv = *(const f32x2*)(cw + (size_t)k * 2048 + col); w0[k] = wv[0]; w1[k] = wv[1]; }
            const f32x2 bv = *(const f32x2*)(cb + col);
            bf16_t* kw = (bf16_t*)(ws + O_KW) + (size_t)item * 65536; bf16_t* kwt = (bf16_t*)(ws + O_KWT) + (size_t)item * 65536;
            float k0[16], k1[16]; float n0 = 0.f, n1 = 0.f;
#pragma unroll
            for (int i = 0; i < 16; ++i) { float y0 = bv[0], y1 = bv[1];
#pragma unroll
                for (int k = 0; k < 4; ++k) { y0 += x0[i + k] * w0[k]; y1 += x1[i + k] * w1[k]; }
                const float f = colfac[tl0 + i]; k0[i] = silu(y0) * f; k1[i] = silu(y1) * f; n0 += k0[i]; n1 += k1[i];
                *(unsigned*)(kw + (size_t)(tl0 + i) * 256 + ch) = cvt_pk_bf16(k0[i], k1[i]); }
            u32x4 a, c;
            a.x = cvt_pk_bf16(k0[0], k0[1]); a.y = cvt_pk_bf16(k0[2], k0[3]); a.z = cvt_pk_bf16(k0[4], k0[5]); a.w = cvt_pk_bf16(k0[6], k0[7]);
            c.x = cvt_pk_bf16(k0[8], k0[9]); c.y = cvt_pk_bf16(k0[10], k0[11]); c.z = cvt_pk_bf16(k0[12], k0[13]); c.w = cvt_pk_bf16(k0[14], k0[15]);
            *(u32x4*)(kwt + (size_t)ch * 256 + tl0) = a; *(u32x4*)(kwt + (size_t)ch * 256 + tl0 + 8) = c;
            a.x = cvt_pk_bf16(k1[0], k1[1]); a.y = cvt_pk_bf16(k1[2], k1[3]); a.z = cvt_pk_bf16(k1[4], k1[5]); a.w = cvt_pk_bf16(k1[6], k1[7]);
            c.x = cvt_pk_bf16(k1[8], k1[9]); c.y = cvt_pk_bf16(k1[10], k1[11]); c.z = cvt_pk_bf16(k1[12], k1[13]); c.w = cvt_pk_bf16(k1[14], k1[15]);
            *(u32x4*)(kwt + (size_t)(ch + 1) * 256 + tl0) = a; *(u32x4*)(kwt + (size_t)(ch + 1) * 256 + tl0 + 8) = c;
            float* nsum = (float*)(ws + O_NSUM) + (size_t)item * 256;
            unsafeAtomicAdd(nsum + ch, n0); unsafeAtomicAdd(nsum + ch + 1, n1); }
        }
        __syncthreads();
    }
}

__device__ __forceinline__ void phase4(const Params& p, unsigned char* sm) {
    unsigned char* ws = p.ws;
    const int tid = threadIdx.x;
    const float* ebl = (const float*)(ws + O_EBL);
    const bf16_t* lt = (const bf16_t*)(p.ws + O_KWT);
    bf16_t* cint = (bf16_t*)(ws + O_CINT);
    const size_t gtid = (size_t)blockIdx.x * 512 + tid, gthreads = (size_t)gridDim.x * 512;
#pragma unroll 2
    for (size_t g = gtid; g < (size_t)32 * 16384; g += gthreads) {
        const int bh = (int)(g >> 14), e4 = (int)(g & 16383);
        f32x4 c = {0.f, 0.f, 0.f, 0.f};
        u32x2 lw[7]; float eb[7];
#pragma unroll
        for (int sc = 0; sc < 7; ++sc) { lw[sc] = *(const u32x2*)(lt + (size_t)(bh * 8 + sc) * 65536 + e4 * 4); eb[sc] = ebl[bh * 8 + sc]; }
#pragma unroll
        for (int sc = 0; sc < 8; ++sc) { const int item = bh * 8 + sc;
            u32x2 w; w.x = cvt_pk_bf16(c[0], c[1]); w.y = cvt_pk_bf16(c[2], c[3]); *(u32x2*)(cint + (size_t)item * 65536 + e4 * 4) = w;
            if (sc < 7) { const f32x4 l = {bf_lo(lw[sc].x), bf_hi(lw[sc].x), bf_lo(lw[sc].y), bf_hi(lw[sc].y)}; c = (c + l) * eb[sc]; } }
    }
    float* nin = (float*)sm;
    const float* nsum = (const float*)(ws + O_NSUM);
    float* denx = (float*)(ws + O_DENX);
    for (int item = blockIdx.x; item < 256; item += gridDim.x) {
        const int b = item >> 5, h = (item >> 3) & 3, sc = item & 7; const int tokb = b * SEQ_ + sc * 256; const int bh = item >> 3;
        if (tid < 256) { float eb[7], ns[7];
#pragma unroll
            for (int j = 0; j < 7; ++j) { eb[j] = ebl[bh * 8 + j]; ns[j] = nsum[(size_t)(bh * 8 + j) * 256 + tid]; }
            float nv = 0.f;
#pragma unroll
            for (int j = 0; j < 7; ++j) if (j < sc) nv = eb[j] * (nv + ns[j]);
            nin[tid] = nv; }
        __syncthreads();
        const int tl = tid >> 1, half = tid & 1;
        const bf16_t* wq = (const bf16_t*)(ws + O_WQ) + (size_t)item * 65536 + (size_t)tl * 256 + half * 128;
        float d = 0.f;
#pragma unroll
        for (int i = 0; i < 16; ++i) { f32x4 a0, a1; unpack8(*(const u32x4*)(wq + i * 8), a0, a1); const float* nn = nin + half * 128 + i * 8;
            d += a0[0] * nn[0] + a0[1] * nn[1] + a0[2] * nn[2] + a0[3] * nn[3] + a1[0] * nn[4] + a1[1] * nn[5] + a1[2] * nn[6] + a1[3] * nn[7]; }
        d += __shfl_xor(d, 1);
        if (half == 0) denx[(size_t)(tokb + tl) * 4 + h] = d;
        __syncthreads();
    }
}

__device__ __forceinline__ void phase7(const Params& p, unsigned char* sm) {
    unsigned char* ws = p.ws;
    const int tid = threadIdx.x, lane = tid & 63, wid = tid >> 6;
    const bf16_t* uu = (const bf16_t*)p.out; bf16_t* uc = (bf16_t*)(ws + O_UC);
    const float* cw = p.in[8]; const float* cb = p.in[9]; const float* lg = p.in[10]; const float* lb = p.in[11];
    u32x4 pf[12];
#define P7_LOAD(tile_) do { const int t0_ = (tile_) * 16; const int b_ = t0_ / SEQ_, s0_ = t0_ % SEQ_; \
        _Pragma("unroll") for (int q = 0; q < 12; ++q) { const int idx = tid + q * 512; const int r = idx >> 7, c16 = idx & 127; const int s_ = s0_ - 30 + r; \
            pf[q] = (u32x4){0u, 0u, 0u, 0u}; if (idx < 46 * 128 && s_ >= 0) pf[q] = *(const u32x4*)(uu + (size_t)(b_ * SEQ_ + s_) * 1024 + c16 * 8); } } while (0)
    int tile = blockIdx.x;
    if (tile < 1024) P7_LOAD(tile);
    f32x2 wv[31];
#pragma unroll
    for (int k = 0; k < 31; ++k) wv[k] = *(const f32x2*)(cw + (size_t)k * 1024 + 2 * tid);
    const f32x2 bv = *(const f32x2*)(cb + 2 * tid);
    f32x4 lgv[4], lbv[4];
#pragma unroll
    for (int i = 0; i < 4; ++i) { lgv[i] = *(const f32x4*)(lg + i * 256 + lane * 4); lbv[i] = *(const f32x4*)(lb + i * 256 + lane * 4); }
    for (; tile < 1024; tile += gridDim.x) {
        const int t0 = tile * 16;
#pragma unroll
        for (int q = 0; q < 12; ++q) { const int idx = tid + q * 512; const int r = idx >> 7, c16 = idx & 127; if (idx < 46 * 128) *(u32x4*)(sm + r * 2048 + c16 * 16) = pf[q]; }
        __syncthreads();
        f32x2 yy[16];
        {
#pragma unroll
            for (int t = 0; t < 16; ++t) yy[t] = bv;
#pragma unroll
            for (int r = 0; r < 46; ++r) { const unsigned w = *(const unsigned*)(sm + r * 2048 + tid * 4); const f32x2 xx = {bf_lo(w), bf_hi(w)};
#pragma unroll
                for (int t = 0; t < 16; ++t) { const int k = r - t; if (k >= 0 && k <= 30) yy[t] = __builtin_elementwise_fma(wv[k], xx, yy[t]); }
                if ((r & 3) == 3) asm volatile("" ::: "memory"); }
        }
        __syncthreads();
#pragma unroll
        for (int t = 0; t < 16; ++t) *(f32x2*)(sm + t * 4096 + tid * 8) = yy[t];
        { const int tn = tile + gridDim.x; if (tn < 1024) P7_LOAD(tn); }
        __syncthreads();
#pragma unroll 1
        for (int tt = 0; tt < 2; ++tt) { const int t = wid * 2 + tt; f32x4 v[4]; float s1 = 0.f;
#pragma unroll
            for (int i = 0; i < 4; ++i) { v[i] = *(const f32x4*)(sm + t * 4096 + (i * 256 + lane * 4) * 4); s1 += v[i][0] + v[i][1] + v[i][2] + v[i][3]; }
            s1 = wave_sum(s1); const float mu = s1 * (1.0f / 1024.0f); float s2 = 0.f;
#pragma unroll
            for (int i = 0; i < 4; ++i) { v[i] = v[i] - mu; s2 += v[i][0] * v[i][0] + v[i][1] * v[i][1] + v[i][2] * v[i][2] + v[i][3] * v[i][3]; }
            s2 = wave_sum(s2); const float rstd = rsqrtf(s2 * (1.0f / 1024.0f) + EPS_);
#pragma unroll
            for (int i = 0; i < 4; ++i) { const int c = i * 256 + lane * 4; f32x4 z = v[i] * rstd * lgv[i] + lbv[i];
                u32x2 w; w.x = cvt_pk_bf16(silu(z[0]), silu(z[1])); w.y = cvt_pk_bf16(silu(z[2]), silu(z[3])); *(u32x2*)(uc + (size_t)(t0 + t) * 1024 + c) = w; } }
        __syncthreads();
    }
#undef P7_LOAD
}

__device__ __forceinline__ void phase13(const Params& p) {
    const float* ssq3 = (const float*)(p.ws + O_SSQ3); const float* fg = p.in[22];
    const size_t gtid = (size_t)blockIdx.x * 512 + threadIdx.x, gthreads = (size_t)gridDim.x * 512;
    for (size_t i = gtid; i < (size_t)T_ * 256; i += gthreads) { const int row = (int)(i >> 8), c = (int)(i & 255) * 4;
        const float rs = rsqrtf(ssq3[row] * (1.0f / 1024.0f) + EPS_); const f32x4 g = *(const f32x4*)(fg + c);
        f32x4 v = *(const f32x4*)(p.out + i * 4); v = v * rs * g; *(f32x4*)(p.out + i * 4) = v; }
}

#define XB_TMO      128
#define XB_XCNT(j)  (256  + 64 * (j))
#define XB_XSUB(j)  (1280 + 64 * (j))
#define XB_XGEN(j)  (2304 + 64 * (j))
#define XB_TOP      3328
#define XB_TOPGEN   3392
#define XCD_BAR_WORDS 3456
#define XB_SPIN_CAP (1u << 18)
__device__ __forceinline__ unsigned xb_ld(unsigned* p)              { return __hip_atomic_load(p, __ATOMIC_RELAXED, __HIP_MEMORY_SCOPE_AGENT); }
__device__ __forceinline__ unsigned xb_add(unsigned* p, unsigned v) { return __hip_atomic_fetch_add(p, v, __ATOMIC_RELAXED, __HIP_MEMORY_SCOPE_AGENT); }
__device__ __forceinline__ unsigned xb_xcc_id() { return (unsigned)__builtin_amdgcn_s_getreg((3 << 11) | 20) & 0xFu; }
#define XB_SPIN(cond, bar) do { unsigned _sp = 0; while (cond) { __builtin_amdgcn_s_sleep(1); \
    if ((++_sp & 255u) == 0u) { if (xb_ld(&(bar)[XB_TMO])) break; if (_sp > XB_SPIN_CAP) { atomicAdd(&(bar)[XB_TMO], 1u); break; } } } } while (0)
struct XcdBarrier { unsigned* bar; unsigned x; volatile LAS unsigned* st; };
__device__ __forceinline__ XcdBarrier xcd_barrier_post(unsigned* bar, volatile LAS unsigned* st) {
    XcdBarrier b; b.bar = bar; b.x = xb_xcc_id(); b.st = st;
    if (threadIdx.x == 0) (void)xb_add(&bar[XB_XCNT(b.x)], 1u);
    return b;
}
__device__ __forceinline__ void xcd_barrier_complete(unsigned* bar, unsigned x, unsigned& nloc, unsigned& nx) {
    const unsigned G = gridDim.x * gridDim.y * gridDim.z;
    unsigned sum, cnt, mine, sp = 0u;
    for (;;) {
        sum = 0u; cnt = 0u; mine = 0u;
#pragma unroll
        for (unsigned j = 0; j < 16; ++j) { const unsigned c = xb_ld(&bar[XB_XCNT(j)]); sum += c; cnt += (c > 0u) ? 1u : 0u; mine = (j == x) ? c : mine; }
        if (sum == G) break;
        __builtin_amdgcn_s_sleep(1);
        if ((++sp & 255u) == 0u) { if (xb_ld(&bar[XB_TMO])) break; if (sp > XB_SPIN_CAP) { atomicAdd(&bar[XB_TMO], 1u); break; } }
    }
    nloc = mine > 0u ? mine : 1u; nx = cnt > 0u ? cnt : 1u;
}
__device__ __forceinline__ void xcd_barrier(const XcdBarrier& b) {
    asm volatile("s_waitcnt vmcnt(0)" ::: "memory");
    __syncthreads();
    if (threadIdx.x == 0) {
        unsigned* bar = b.bar;
        __builtin_amdgcn_s_waitcnt(0);
        unsigned nloc = b.st[0], nx = b.st[1];
        if (nloc == 0u) { xcd_barrier_complete(bar, b.x, nloc, nx); b.st[0] = nloc; b.st[1] = nx; }
        const unsigned old = xb_add(&bar[XB_XSUB(b.x)], 1u);
        const unsigned gen = old / nloc;
        if (old + 1u == (gen + 1u) * nloc) {
            __builtin_amdgcn_fence(__ATOMIC_RELEASE, "agent");
            asm volatile("s_waitcnt vmcnt(0)" ::: "memory");
            const unsigned og = xb_add(&bar[XB_TOP], 1u);
            const unsigned tg = og / nx;
            if (og + 1u == (tg + 1u) * nx) xb_add(&bar[XB_TOPGEN], 1u);
            else XB_SPIN(xb_ld(&bar[XB_TOPGEN]) == tg, bar);
            __builtin_amdgcn_fence(__ATOMIC_ACQUIRE, "agent");
            xb_add(&bar[XB_XGEN(b.x)], 1u);
            asm volatile("s_waitcnt vmcnt(0)" ::: "memory");
        } else {
            XB_SPIN(xb_ld(&bar[XB_XGEN(b.x)]) == gen, bar);
            __builtin_amdgcn_fence(__ATOMIC_ACQUIRE, "agent");
            asm volatile("s_waitcnt vmcnt(0)" ::: "memory");
        }
    }
    __syncthreads();
}

template <bool COOP>
__global__ void __launch_bounds__(512, 2) mk_fwd(Params p) {
    extern __shared__ __attribute__((aligned(16))) unsigned char shm[];
    LAS unsigned char* lds = (LAS unsigned char*)shm;
    unsigned char* ws = p.ws;
    const int G = gridDim.x, c = blockIdx.x;
#ifndef PHMASK
#define PHMASK 0x3fff
#endif
#define PH(k) if (((PHMASK >> (k)) & 1) && p.ph_lo <= (k) && (k) < p.ph_hi)
    XcdBarrier xb{};
    if (COOP) { volatile LAS unsigned* st = (volatile LAS unsigned*)(lds + 131072);
        if (threadIdx.x == 0) { st[0] = 0u; st[1] = 0u; }
        __syncthreads();
        xb = xcd_barrier_post((unsigned*)(ws + O_BAR), st); }
#define SYNC(k) if (COOP) { if (p.ph_lo <= (k) && (k) + 1 < p.ph_hi) { xcd_barrier(xb); } }
    PH(0) phase0(p, shm);
    SYNC(0)
    PH(1) { SchedP1 S{(const char*)(ws + O_HB), (const char*)(ws + O_WINT), G, c}; EpiP1 E{(bf16_t*)p.out, (bf16_t*)(ws + O_VT)}; gemm_phase(lds, 1024, 1024, 1024, S, E); }
    SYNC(1)
    PH(3) { phase2(p, shm);
        asm volatile("s_waitcnt vmcnt(0)" ::: "memory"); __syncthreads();
        SchedP3 S{(const char*)(ws + O_WQ), (const char*)(ws + O_KW), (const char*)(ws + O_VT), (const char*)(ws + O_KWT), G, c};
        EpiP3 E{(bf16_t*)(ws + O_SS), (bf16_t*)(ws + O_KWT), (float*)(ws + O_DENI)}; gemm_phase(lds, 256, 256, 256, S, E); }
    SYNC(3)
    PH(4) phase4(p, shm);
    SYNC(4)
    PH(6) { { SchedP5 S{(const char*)(ws + O_SS), (const char*)(ws + O_VT), (const char*)(ws + O_WQ), (const char*)(ws + O_CINT), G, c};
            EpiP5 E{(bf16_t*)(ws + O_HM), (const float*)(ws + O_DENI), (const float*)(ws + O_DENX), (float*)(ws + O_HSS)}; gemm_phase(lds, 256, 256, 256, S, E); }
        { SchedP6 S{(const char*)(ws + O_HB), (const char*)(ws + O_WINT), G, c};
            EpiP6 E{(bf16_t*)(ws + O_HM), (float*)(ws + O_HSS), p.in[7], (bf16_t*)p.out}; gemm_phase(lds, 1024, 1024, 1024, S, E); } }
    SYNC(6)
    PH(7) phase7(p, shm);
    SYNC(7)
    PH(8) { SchedP8 S{(const char*)(ws + O_HB), (const char*)(ws + O_WINT), (const char*)(ws + O_HM), (const char*)(ws + O_UC), (const char*)(ws + O_WMT), (const char*)(ws + O_WCT), G, c};
        EpiP8 E{(bf16_t*)(ws + O_GMC), (bf16_t*)p.out + (size_t)T_ * 1024, (bf16_t*)(ws + O_MERGED)}; gemm_phase(lds, 1024, 1024, 1024, S, E); }
    SYNC(8)
    PH(9) { SchedN4 S{(const char*)(ws + O_MERGED), (const char*)(ws + O_WOT), (size_t)256 * 1024 * 2, (size_t)256 * 1024 * 2, G, c};
        EpiRes<false> E{p.in[0], (bf16_t*)(ws + O_X1B), (float*)(ws + O_SSQ1)}; gemm_phase(lds, 1024, 1024, 1024, S, E); }
    SYNC(9)
    PH(10) { { SchedP10 S{(const char*)(ws + O_X1B), (const char*)(ws + O_WGUT), G, c}; EpiP10 E{(const float*)(ws + O_SSQ1), (bf16_t*)(ws + O_HID)}; gemm_phase(lds, 1024, 1024, 1024, S, E); }
        { const int h = G >> 1; SchedPE S{(const char*)(ws + O_PB), (const char*)(ws + O_WPPT), h, c - h};
            EpiBf E{(bf16_t*)(ws + O_PE)}; if (c >= h) gemm_phase(lds, 256, 256, 256, S, E); } }
    SYNC(10)
    PH(11) { SchedN4 S{(const char*)(ws + O_HID), (const char*)(ws + O_WDT), (size_t)256 * DFF_ * 2, (size_t)256 * DFF_ * 2, G, c};
            EpiRes<true> E{(const void*)(ws + O_X1B), (bf16_t*)(ws + O_X2B), (float*)(ws + O_SSQ2)}; gemm_phase(lds, DFF_, DFF_, DFF_, S, E); }
    SYNC(11)
    PH(12) { SchedN4 S{(const char*)(ws + O_X2B), (const char*)(ws + O_WPGT), (size_t)256 * 1024 * 2, (size_t)256 * 1024 * 2, G, c};
        EpiP12 E{(const float*)(ws + O_SSQ2), (const bf16_t*)(ws + O_PE), (const bf16_t*)(ws + O_X2B), p.out, (float*)(ws + O_SSQ3), (unsigned*)(ws + O_BAR) + XCD_BAR_WORDS, p.in[22]}; gemm_phase(lds, 1024, 1024, 1024, S, E); }
#undef PH
#undef SYNC
}

extern "C" void kernel_launch(void* const* d_in, const int* in_sizes, int n_in, void* d_out, int out_size, void* d_ws, size_t ws_size, hipStream_t stream) {
    static int grid = 0;
    if (grid == 0) {
        if (n_in != 23 || out_size != T_ * D_ || ws_size < WS_NEED) { fprintf(stderr, "kernel_launch: unexpected shapes (n_in %d, out %d, ws %zu)\n", n_in, out_size, ws_size); grid = -1; return; }
        int dev = 0, cus = 0, per_cu = 0;
        hipGetDevice(&dev); hipDeviceGetAttribute(&cus, hipDeviceAttributeMultiprocessorCount, dev);
        hipFuncSetAttribute((const void*)mk_fwd<true>, hipFuncAttributeMaxDynamicSharedMemorySize, LDS_BYTES);
        hipFuncSetAttribute((const void*)mk_fwd<false>, hipFuncAttributeMaxDynamicSharedMemorySize, LDS_BYTES);
        hipOccupancyMaxActiveBlocksPerMultiprocessor(&per_cu, (const void*)mk_fwd<true>, 512, LDS_BYTES);
        if (per_cu < 1) { fprintf(stderr, "kernel_launch: occupancy query reports %d blocks per CU\n", per_cu); per_cu = 1; }
        (void)hipGetLastError();
        grid = cus;
        if (grid != 256) { fprintf(stderr, "kernel_launch: built for a 256-CU device (got %d CUs)\n", cus); grid = -1; return; }
    }
    if (grid < 0) return;
    Params p{};
    for (int i = 0; i < 23; ++i) p.in[i] = (const float*)d_in[i];
    p.out = (float*)d_out; p.ws = (unsigned char*)d_ws;
#if MK_MULTI
#ifndef PROBE_DUP
#define PROBE_DUP -1
#endif
    for (int k = 0; k < NPHASE; ++k) { p.ph_lo = k; p.ph_hi = k + 1; hipLaunchKernelGGL(mk_fwd<false>, dim3(grid), dim3(512), LDS_BYTES, stream, p);
        if (k == PROBE_DUP) hipLaunchKernelGGL(mk_fwd<false>, dim3(grid), dim3(512), LDS_BYTES, stream, p); }
#else
    p.ph_lo = 0; p.ph_hi = NPHASE;
    if (hipMemsetAsync((unsigned char*)d_ws + O_BAR, 0, (XCD_BAR_WORDS + 64 * 64) * 4, stream) != hipSuccess) { fprintf(stderr, "kernel_launch: memset of barrier words failed\n"); return; }
    void* args[] = {&p};
    hipError_t e = hipLaunchCooperativeKernel((const void*)mk_fwd<true>, dim3(grid), dim3(512), args, LDS_BYTES, stream);
    if (e != hipSuccess) fprintf(stderr, "cooperative launch failed: %s (grid %d)\n", hipGetErrorString(e), grid);
#endif
}
```

```cpp
#include <hip/hip_runtime.h>
#include <hip/hip_cooperative_groups.h>
#include <cstdio>
namespace cg = cooperative_groups;

#ifndef MK_MULTI
#define MK_MULTI 0
#endif

#define LAS __attribute__((address_space(3)))
typedef unsigned short bf16_t;
typedef short bf16x8 __attribute__((ext_vector_type(8)));
typedef float f32x4 __attribute__((ext_vector_type(4)));
typedef float f32x2 __attribute__((ext_vector_type(2)));
typedef unsigned u32x4 __attribute__((ext_vector_type(4)));
typedef unsigned u32x2 __attribute__((ext_vector_type(2)));

constexpr int T_ = 16384, D_ = 1024, NIN_ = 8200, DFF_ = 2816, SEQ_ = 2048;
constexpr float EPS_ = 1e-6f;
constexpr int BM = 256, BK = 64, HALF = 128, HTB = HALF * BK * 2, STAGE_BYTES = 8 * HTB;
constexpr int LDS_BYTES = 136 * 1024;
constexpr int NPHASE = 13;

constexpr size_t KiB = 1024, MiB = 1024 * 1024;
constexpr size_t O_WINT = 0, O_WMT = 16 * MiB, O_WCT = 18 * MiB, O_WOT = 20 * MiB, O_WPGT = 22 * MiB, O_WGUT = 24 * MiB, O_WDT = 35 * MiB, O_WPPT = 40 * MiB + 512 * KiB;
constexpr size_t O_IG = 41 * MiB, O_LF = O_IG + 256 * KiB, O_ZERO = O_LF + 256 * KiB;
constexpr size_t O_DENI = O_ZERO, O_HSS = O_DENI + 256 * KiB, O_SSQ1 = O_HSS + 256 * KiB, O_SSQ2 = O_SSQ1 + 64 * KiB, O_SSQ3 = O_SSQ2 + 64 * KiB, O_NSUM = O_SSQ3 + 64 * KiB;
constexpr size_t ZERO_BYTES = 960 * KiB;
constexpr size_t O_DENX = O_ZERO + ZERO_BYTES, O_EBL = O_DENX + 256 * KiB;
constexpr size_t O_BAR = 43 * MiB;
constexpr size_t O_PB = 44 * MiB, O_HB = 52 * MiB, O_S1 = 84 * MiB, O_S2 = 116 * MiB, O_S3 = 148 * MiB, O_S4 = 180 * MiB, O_S5 = 212 * MiB, WS_NEED = 244 * MiB;
constexpr size_t O_PE = O_HB, O_VT = O_S1, O_U = O_S1, O_MERGED = O_S1, O_HID = O_S1, O_WQ = O_S2, O_GMC = O_S2, O_KW = O_S3, O_CINT = O_S3,
                 O_KWT = O_S4, O_HM = O_S4, O_X1B = O_S4, O_SS = O_S5, O_UC = O_S5, O_X2B = O_S5;

struct Params {
    const float* in[23];
    float* out;
    unsigned char* ws;
    int ph_lo, ph_hi;
};

__device__ __forceinline__ unsigned cvt_pk_bf16(float lo, float hi) { unsigned r; asm volatile("v_cvt_pk_bf16_f32 %0, %1, %2" : "=v"(r) : "v"(lo), "v"(hi)); return r; }
__device__ __forceinline__ float bf_lo(unsigned w) { return __uint_as_float(w << 16); }
__device__ __forceinline__ float bf_hi(unsigned w) { return __uint_as_float(w & 0xffff0000u); }
__device__ __forceinline__ float sigm(float x) { return __builtin_amdgcn_rcpf(1.0f + __builtin_amdgcn_exp2f(x * -1.4426950408889634f)); }
__device__ __forceinline__ float silu(float x) { return x * __builtin_amdgcn_rcpf(1.0f + __builtin_amdgcn_exp2f(x * -1.4426950408889634f)); }
__device__ __forceinline__ float wave_sum(float v) {
#pragma unroll
    for (int o = 32; o > 0; o >>= 1) v += __shfl_xor(v, o);
    return v;
}
__device__ __forceinline__ u32x4 pack8(const f32x4 a, const f32x4 b) { u32x4 w; w.x = cvt_pk_bf16(a[0], a[1]); w.y = cvt_pk_bf16(a[2], a[3]); w.z = cvt_pk_bf16(b[0], b[1]); w.w = cvt_pk_bf16(b[2], b[3]); return w; }
__device__ __forceinline__ void unpack8(const u32x4 w, f32x4& a, f32x4& b) { a[0] = bf_lo(w.x); a[1] = bf_hi(w.x); a[2] = bf_lo(w.y); a[3] = bf_hi(w.y); b[0] = bf_lo(w.z); b[1] = bf_hi(w.z); b[2] = bf_lo(w.w); b[3] = bf_hi(w.w); }

__host__ __device__ __forceinline__ int lds_byte(int r, int c) { const int st = (r >> 4) * 2 + (c >> 5), rr = r & 15, cc = c & 31, ob = rr * 64 + cc * 2; return st * 1024 + (ob ^ (((ob >> 9) & 1) << 5)); }
__host__ __device__ __forceinline__ void stage_rc(int b, int& R, int& C) { const int st = b / 1024, sb = b % 1024, swz = sb ^ (((sb >> 9) & 1) << 5); R = (st >> 1) * 16 + swz / 64; C = (st & 1) * 32 + (swz % 64) / 2; }
__host__ __device__ __forceinline__ int perm32(int rho) { const int n = rho >> 4, i = rho & 15; return 8 * (i >> 2) + 4 * n + (i & 3); }

struct Unit { const char* a; const char* b; int pm, pn, kind, cont; };
__device__ __forceinline__ void map_n4(int L, int& pm, int& pn) { const int x = L & 7, k = L >> 3; pm = x * 8 + (k & 7); pn = k >> 3; }

__device__ __forceinline__ void tile_order(int L, int nM, int nN, int& pm, int& pn) {
    const int nwg = nM * nN; int wgid = L;
    { const int q = nwg / 8, r = nwg % 8, xcd = wgid % 8, off = wgid / 8; wgid = (xcd < r ? xcd * (q + 1) : r * (q + 1) + (xcd - r) * q) + off; }
    const int nig = 8 * nN, gid = wgid / nig, fm = gid * 8, gsz = (nM - fm) < 8 ? (nM - fm) : 8;
    pm = fm + ((wgid % nig) % gsz); pn = (wgid % nig) / gsz;
}

template <class Epi, class Sched>
__device__ __forceinline__ void gemm_phase(LAS unsigned char* lds, const int K, const int lda, const int ldb, const Sched& S, const Epi& E) {
    const int tid = threadIdx.x, wid = __builtin_amdgcn_readfirstlane(tid >> 6), lane = tid & 63, wr = wid >> 2, wc = wid & 3, fr = lane & 15, fq = lane >> 4;
    const int nt = K / BK;
    unsigned voffA[2], voffB[2];
#pragma unroll
    for (int i = 0; i < 2; ++i) { int R, C; stage_rc(tid * 16 + i * 8192, R, C); const int Rb = (R & ~31) + perm32(R & 31);
        voffA[i] = (unsigned)(R * lda + C) * 2u; voffB[i] = (unsigned)(Rb * ldb + C) * 2u; }
    const size_t kstep = (size_t)(BK * 2);
    const size_t hstepA = (size_t)HALF * lda * 2, hstepB = (size_t)HALF * ldb * 2;
    const unsigned ldsw = (unsigned)wid * 1024u;
    const int aoff = lds_byte(wr * 64 + fr, fq * 8), boff = lds_byte(wc * 32 + fr, fq * 8);
#define PG8_SA(b, h) (((b) * 2 + (h)) * HTB)
#define PG8_SB(b, h) ((4 + (b) * 2 + (h)) * HTB)
#define PG8_STAGE(bufoff, gbase, voff) do { _Pragma("unroll") for (int _i = 0; _i < 2; ++_i) \
        __builtin_amdgcn_global_load_lds((const unsigned*)((const char*)(gbase) + (voff)[_i]), (LAS unsigned*)(lds + (bufoff) + ldsw + _i * 8192), 16, 0, 0); } while (0)
#define PG8_LDA(dst, b, h) do { _Pragma("unroll") for (int m = 0; m < 4; ++m) _Pragma("unroll") for (int k = 0; k < 2; ++k) dst[m][k] = *(const LAS bf16x8*)(lds + PG8_SA(b, h) + aoff + m * 2048 + k * 1024); } while (0)
#define PG8_LDB(dst, b, h) do { _Pragma("unroll") for (int n = 0; n < 2; ++n) _Pragma("unroll") for (int k = 0; k < 2; ++k) dst[n][k] = *(const LAS bf16x8*)(lds + PG8_SB(b, h) + boff + n * 2048 + k * 1024); } while (0)
#define PG8_MMA(ai, bj, At, Bt) do { __builtin_amdgcn_s_setprio(1); _Pragma("unroll") for (int m = 0; m < 4; ++m) _Pragma("unroll") for (int n = 0; n < 2; ++n) _Pragma("unroll") for (int k = 0; k < 2; ++k) \
        acc[ai][bj][m][n] = __builtin_amdgcn_mfma_f32_16x16x32_bf16(Bt[n][k], At[m][k], acc[ai][bj][m][n], 0, 0, 0); __builtin_amdgcn_s_setprio(0); } while (0)
#define PG8_WAIT_V(n) asm volatile("s_waitcnt vmcnt(" #n ")" ::: "memory")
#define PG8_WAIT_L(n) asm volatile("s_waitcnt lgkmcnt(" #n ")" ::: "memory")
#define PG8_BAR __builtin_amdgcn_s_barrier()
#define PG8_SCHED __builtin_amdgcn_sched_barrier(0)
#define PG8_ZERO() do { _Pragma("unroll") for (int a = 0; a < 2; ++a) _Pragma("unroll") for (int b = 0; b < 2; ++b) _Pragma("unroll") for (int m = 0; m < 4; ++m) _Pragma("unroll") for (int n = 0; n < 2; ++n) acc[a][b][m][n] = (f32x4){0.f, 0.f, 0.f, 0.f}; } while (0)
    Unit cur, nxt; int ui = 0;
    if (!S.next(0, cur)) return;
    E.pre(cur, wr, wc, fr, fq);
    f32x4 acc[2][2][4][2];
    PG8_ZERO();
    bf16x8 At[4][2], B0[2][2], B1[2][2];
    const char* cA = cur.a; const char* cB = cur.b;
    PG8_STAGE(PG8_SB(0, 0), cB, voffB); PG8_STAGE(PG8_SA(0, 0), cA, voffA); PG8_STAGE(PG8_SB(0, 1), cB + hstepB, voffB); PG8_STAGE(PG8_SA(0, 1), cA + hstepA, voffA);
    if (wr == 1) PG8_BAR;
    PG8_WAIT_V(4); PG8_BAR;
    PG8_STAGE(PG8_SB(1, 0), cB + kstep, voffB); PG8_STAGE(PG8_SA(1, 0), cA + kstep, voffA); PG8_STAGE(PG8_SB(1, 1), cB + hstepB + kstep, voffB);
    PG8_WAIT_V(6); PG8_BAR;
    for (;;) {
        const bool has_next = S.next(ui + 1, nxt);
        const char* nA = has_next ? nxt.a : cA; const char* nB = has_next ? nxt.b : cB;
#pragma unroll 1
        for (int t = 0; t < nt; t += 2) {
            const bool last = (t == nt - 2);
            const char* a1 = cA + (size_t)(t + 1) * kstep;
            const char* a2 = last ? nA : cA + (size_t)(t + 2) * kstep; const char* b2 = last ? nB : cB + (size_t)(t + 2) * kstep;
            const char* a3 = a2 + kstep; const char* b3 = b2 + kstep;
            PG8_LDB(B0, 0, 0); PG8_SCHED; PG8_LDA(At, 0, 0); PG8_STAGE(PG8_SA(1, 1), a1 + hstepA, voffA);
            PG8_WAIT_L(8); PG8_BAR; PG8_WAIT_L(0); PG8_MMA(0, 0, At, B0); PG8_BAR; PG8_SCHED;
            PG8_LDB(B1, 0, 1); PG8_STAGE(PG8_SB(0, 0), b2, voffB);
            PG8_BAR; PG8_WAIT_L(0); PG8_MMA(0, 1, At, B1); PG8_BAR;
            PG8_LDA(At, 0, 1); PG8_STAGE(PG8_SA(0, 0), a2, voffA);
            PG8_BAR; PG8_WAIT_L(0); PG8_MMA(1, 0, At, B0); PG8_BAR; PG8_SCHED;
            PG8_STAGE(PG8_SB(0, 1), b2 + hstepB, voffB);
            PG8_WAIT_V(6); PG8_BAR; PG8_MMA(1, 1, At, B1); PG8_BAR;
            PG8_LDB(B0, 1, 0); PG8_SCHED; PG8_LDA(At, 1, 0); PG8_STAGE(PG8_SA(0, 1), a2 + hstepA, voffA);
            PG8_WAIT_L(8); PG8_BAR; PG8_WAIT_L(0); PG8_MMA(0, 0, At, B0); PG8_BAR; PG8_SCHED;
            PG8_LDB(B1, 1, 1); PG8_STAGE(PG8_SB(1, 0), b3, voffB);
            PG8_BAR; PG8_WAIT_L(0); PG8_MMA(0, 1, At, B1); PG8_BAR;
            PG8_LDA(At, 1, 1); PG8_STAGE(PG8_SA(1, 0), a3, voffA);
            PG8_BAR; PG8_WAIT_L(0); PG8_MMA(1, 0, At, B0); PG8_BAR; PG8_SCHED;
            PG8_STAGE(PG8_SB(1, 1), b3 + hstepB, voffB);
            PG8_WAIT_V(6); PG8_BAR; PG8_MMA(1, 1, At, B1); PG8_BAR;
        }
        if (cur.cont) { E.mid(acc, cur, wr, wc, fr, fq); }
        else { if constexpr (!Epi::AFTER_DRAIN) E(acc, cur, wr, wc, fr, fq); if (!has_next) break; PG8_ZERO(); }
        cur = nxt; cA = nA; cB = nB; ++ui;
    }
    PG8_WAIT_V(0);
    if (wr == 0) PG8_BAR;
    PG8_BAR;
    if constexpr (Epi::AFTER_DRAIN) E(acc, cur, wr, wc, fr, fq);
#undef PG8_SA
#undef PG8_SB
#undef PG8_STAGE
#undef PG8_LDA
#undef PG8_LDB
#undef PG8_MMA
#undef PG8_WAIT_V
#undef PG8_WAIT_L
#undef PG8_BAR
#undef PG8_SCHED
#undef PG8_ZERO
}

typedef f32x4 Acc[2][2][4][2];
#define EPI_ROWS(ai, m) _Pragma("unroll") for (int ai = 0; ai < 2; ++ai) _Pragma("unroll") for (int m = 0; m < 4; ++m) if (epi_fence())
__device__ __forceinline__ bool epi_fence() { asm volatile("" ::: "memory"); return true; }
#define EPI_R8 _Pragma("unroll") for (int r8 = 0; r8 < 8; ++r8)
#define EPI_RL(ai, m) ((ai) * 128 + wr * 64 + (m) * 16 + fr)
#define EPI_CL(bj) ((bj) * 128 + wc * 32 + 8 * fq)

struct SchedP1 { const char* hb; const char* wint; int G, c;
    __device__ __forceinline__ bool next(int i, Unit& u) const {
        const int L = i * G + c; if (L >= 768) return false;
        u.cont = 0;
        if (L < 512) { int pm, pn; tile_order(L, 64, 8, pm, pn); u.pm = pm; u.pn = pn; u.kind = 0; u.a = hb + (size_t)pm * 256 * 1024 * 2; u.b = wint + (size_t)pn * 256 * 1024 * 2; }
        else { const int l = L - 512; u.pm = l & 3; u.pn = l >> 2; u.kind = 1; u.a = wint + (size_t)(2048 + u.pm * 256) * 1024 * 2; u.b = hb + (size_t)u.pn * 256 * 1024 * 2; }
        return true; } };
struct EpiP1 { static constexpr bool AFTER_DRAIN = false; bf16_t* qkpre; bf16_t* vt;
    __device__ __forceinline__ void mid(Acc&, const Unit&, int, int, int, int) const {}
    __device__ __forceinline__ void pre(const Unit&, int, int, int, int) const {}
    __device__ __forceinline__ void operator()(Acc& acc, const Unit& u, int wr, int wc, int fr, int fq) const {
        bf16_t* base; int ld;
        if (u.kind == 0) { base = qkpre + (size_t)u.pm * 256 * 2048 + u.pn * 256; ld = 2048; }
        else { const int item = ((u.pn >> 3) * 4 + u.pm) * 8 + (u.pn & 7); base = vt + (size_t)item * 65536; ld = 256; }
        EPI_ROWS(ai, m) { bf16_t* rowp = base + (size_t)EPI_RL(ai, m) * ld + EPI_CL(0);
#pragma unroll
            for (int bj = 0; bj < 2; ++bj) *(u32x4*)(rowp + bj * 128) = pack8(acc[ai][bj][m][0], acc[ai][bj][m][1]); }
    } };

struct SchedP3 { const char* wq; const char* kw; const char* vt; const char* kwt; int G, c;
    __device__ __forceinline__ bool next(int i, Unit& u) const {
        const int L = i * G + c; if (L >= 512) return false;
        u.cont = 0; u.pn = 0;
        if (L < 256) { u.pm = L; u.kind = 0; u.a = wq + (size_t)L * 131072; u.b = kw + (size_t)L * 131072; }
        else { const int it = L - 256; u.pm = it; u.kind = 1; u.a = vt + (size_t)it * 131072; u.b = kwt + (size_t)it * 131072; }
        return true; } };
struct EpiP3 { static constexpr bool AFTER_DRAIN = false; bf16_t* s; bf16_t* lt; float* deni;
    __device__ __forceinline__ void mid(Acc&, const Unit&, int, int, int, int) const {}
    __device__ __forceinline__ void pre(const Unit&, int, int, int, int) const {}
    __device__ __forceinline__ void operator()(Acc& acc, const Unit& u, int wr, int wc, int fr, int fq) const {
        const int item = u.pm;
        if (u.kind == 0) {
            const int b = item >> 5, h = (item >> 3) & 3, sc = item & 7; const int tokb = b * SEQ_ + sc * 256;
            EPI_ROWS(ai, m) { int r = EPI_RL(ai, m); asm volatile("" : "+v"(r)); float rs = 0.f;
#pragma unroll
                for (int bj = 0; bj < 2; ++bj) { const int c0 = EPI_CL(bj); f32x4 v0 = acc[ai][bj][m][0], v1 = acc[ai][bj][m][1];
#pragma unroll
                    for (int j = 0; j < 4; ++j) { v0[j] = (c0 + j <= r) ? v0[j] : 0.f; v1[j] = (c0 + 4 + j <= r) ? v1[j] : 0.f; rs += v0[j] + v1[j]; }
                    *(u32x4*)(s + (size_t)item * 65536 + r * 256 + c0) = pack8(v0, v1); }
                rs += __shfl_xor(rs, 16); rs += __shfl_xor(rs, 32);
                if (fq == 0) unsafeAtomicAdd(deni + (size_t)(tokb + r) * 4 + h, rs); }
        } else {
            EPI_ROWS(ai, m) { bf16_t* rowp = lt + (size_t)item * 65536 + EPI_RL(ai, m) * 256 + EPI_CL(0);
#pragma unroll
                for (int bj = 0; bj < 2; ++bj) *(u32x4*)(rowp + bj * 128) = pack8(acc[ai][bj][m][0], acc[ai][bj][m][1]); }
        }
    } };

struct SchedP5 { const char* s; const char* vt; const char* wq; const char* cint; int G, c;
    __device__ __forceinline__ bool next(int i, Unit& u) const {
        const int item = (i >> 1) * G + c; if (item >= 256) return false;
        u.pm = item; u.pn = 0; u.kind = 0;
        if ((i & 1) == 0) { u.cont = 1; u.a = s + (size_t)item * 131072; u.b = vt + (size_t)item * 131072; }
        else { u.cont = 0; u.a = wq + (size_t)item * 131072; u.b = cint + (size_t)item * 131072; }
        return true; } };
struct EpiP5 { static constexpr bool AFTER_DRAIN = false; bf16_t* hm; const float* deni; const float* denx; float* hss;
    __device__ __forceinline__ void mid(Acc&, const Unit&, int, int, int, int) const {}
    __device__ __forceinline__ void pre(const Unit&, int, int, int, int) const {}
    __device__ __forceinline__ void operator()(Acc& acc, const Unit& u, int wr, int wc, int fr, int fq) const {
        const int item = u.pm; const int b = item >> 5, h = (item >> 3) & 3, sc = item & 7; const int tokb = b * SEQ_ + sc * 256;
        float dnv[2][4];
#pragma unroll
        for (int ai = 0; ai < 2; ++ai)
#pragma unroll
            for (int m = 0; m < 4; ++m) { const int t = tokb + EPI_RL(ai, m); dnv[ai][m] = deni[(size_t)t * 4 + h] + denx[(size_t)t * 4 + h]; }
        EPI_ROWS(ai, m) { const int t = tokb + EPI_RL(ai, m);
            const float den = dnv[ai][m]; const float inv = __builtin_amdgcn_rcpf(fmaxf(fabsf(den), 1.0f)); float ss = 0.f;
#pragma unroll
            for (int bj = 0; bj < 2; ++bj) { f32x4 v0 = acc[ai][bj][m][0] * inv, v1 = acc[ai][bj][m][1] * inv;
#pragma unroll
                for (int j = 0; j < 4; ++j) ss += v0[j] * v0[j] + v1[j] * v1[j];
                *(u32x4*)(hm + (size_t)t * 1024 + h * 256 + EPI_CL(bj)) = pack8(v0, v1); }
            ss += __shfl_xor(ss, 16); ss += __shfl_xor(ss, 32);
            if (fq == 0) unsafeAtomicAdd(hss + (size_t)t * 4 + h, ss); }
    } };

struct SchedP6 { const char* hb; const char* wint; int G, c;
    __device__ __forceinline__ bool next(int i, Unit& u) const {
        u.cont = 0;
        if (i == 0) { const int item = c; if (item >= 256) return false; const int b = item >> 5, h = (item >> 3) & 3, sc = item & 7;
            u.pm = b * 8 + sc; u.pn = h; u.kind = 0; u.a = hb + (size_t)u.pm * 256 * 1024 * 2; u.b = wint + (size_t)(3072 + h * 256) * 1024 * 2; return true; }
        const int L = (i - 1) * G + c; if (L >= 512) return false;
        int pm, pn; tile_order(L, 64, 8, pm, pn); u.pm = pm; u.pn = pn; u.kind = 1;
        u.a = hb + (size_t)pm * 256 * 1024 * 2; u.b = wint + (size_t)(4096 + pn * 256) * 1024 * 2; return true; } };
struct EpiP6 { static constexpr bool AFTER_DRAIN = false; bf16_t* hm; float* hss; const float* mhg; bf16_t* uu;
    __device__ __forceinline__ void mid(Acc&, const Unit&, int, int, int, int) const {}
    __device__ __forceinline__ void pre(const Unit&, int, int, int, int) const {}
    __device__ __forceinline__ void operator()(Acc& acc, const Unit& u, int wr, int wc, int fr, int fq) const {
        if (u.kind == 0) {
            float hsv[2][4];
#pragma unroll
            for (int ai = 0; ai < 2; ++ai)
#pragma unroll
                for (int m = 0; m < 4; ++m) hsv[ai][m] = __hip_atomic_load(hss + (size_t)(u.pm * 256 + EPI_RL(ai, m)) * 4 + u.pn, __ATOMIC_RELAXED, __HIP_MEMORY_SCOPE_AGENT);
            u32x4 cur[2], nxt[2];
#pragma unroll
            for (int bj = 0; bj < 2; ++bj) cur[bj] = *(const u32x4*)(hm + (size_t)(u.pm * 256 + EPI_RL(0, 0)) * 1024 + u.pn * 256 + EPI_CL(bj));
            EPI_R8 { const int ai = r8 >> 2, m = r8 & 3; const int t = u.pm * 256 + EPI_RL(ai, m);
                if (r8 < 7) { const int tn = u.pm * 256 + EPI_RL((r8 + 1) >> 2, (r8 + 1) & 3);
#pragma unroll
                    for (int bj = 0; bj < 2; ++bj) nxt[bj] = *(const u32x4*)(hm + (size_t)tn * 1024 + u.pn * 256 + EPI_CL(bj)); }
                const float rsn = rsqrtf(hsv[ai][m] * (1.0f / 256.0f) + EPS_);
#pragma unroll
                for (int bj = 0; bj < 2; ++bj) { f32x4 h0, h1; unpack8(cur[bj], h0, h1); f32x4 o0, o1;
#pragma unroll
                    for (int j = 0; j < 4; ++j) { o0[j] = h0[j] * rsn * sigm(acc[ai][bj][m][0][j]); o1[j] = h1[j] * rsn * sigm(acc[ai][bj][m][1][j]); }
                    *(u32x4*)(hm + (size_t)t * 1024 + u.pn * 256 + EPI_CL(bj)) = pack8(o0, o1); }
                cur[0] = nxt[0]; cur[1] = nxt[1]; }
        } else {
            EPI_ROWS(ai, m) { const int t = u.pm * 256 + EPI_RL(ai, m); f32x4 o0, o1;
#pragma unroll
                for (int j = 0; j < 4; ++j) { o0[j] = acc[ai][0][m][0][j] * sigm(acc[ai][1][m][0][j]); o1[j] = acc[ai][0][m][1][j] * sigm(acc[ai][1][m][1][j]); }
                *(u32x4*)(uu + (size_t)t * 1024 + u.pn * 128 + wc * 32 + 8 * fq) = pack8(o0, o1); }
        }
    } };

struct SchedP8 { const char* hb; const char* wint; const char* hmg; const char* uc; const char* wmt; const char* wct; int G, c;
    __device__ __forceinline__ bool next(int i, Unit& u) const {
        const int L = (i >> 2) * G + c, r = i & 3; if (L >= 256) return false;
        int pn; map_n4(L, u.pm, pn); u.cont = 0;
        if (r < 2) { u.kind = 2; u.pn = 2 * pn + r; u.a = hb + (size_t)u.pm * 256 * 1024 * 2; u.b = wint + (size_t)(6144 + u.pn * 256) * 1024 * 2; }
        else if (r == 2) { u.kind = 0; u.pn = pn; u.a = hmg + (size_t)u.pm * 256 * 1024 * 2; u.b = wmt + (size_t)pn * 256 * 1024 * 2; }
        else { u.kind = 1; u.pn = pn; u.a = uc + (size_t)u.pm * 256 * 1024 * 2; u.b = wct + (size_t)pn * 256 * 1024 * 2; }
        return true; } };
struct EpiP8 { static constexpr bool AFTER_DRAIN = false; bf16_t* gmc; bf16_t* tmp; bf16_t* merged;
    __device__ __forceinline__ void mid(Acc&, const Unit&, int, int, int, int) const {}
    __device__ __forceinline__ void pre(const Unit&, int, int, int, int) const {}
    __device__ __forceinline__ void operator()(Acc& acc, const Unit& u, int wr, int wc, int fr, int fq) const {
        if (u.kind == 2) {
            EPI_ROWS(ai, m) { const int t = u.pm * 256 + EPI_RL(ai, m); f32x4 r0, r1, c0, c1;
#pragma unroll
                for (int j = 0; j < 4; ++j) { const float e0 = __builtin_amdgcn_exp2f(acc[ai][1][m][0][j] * -1.4426950408889634f), e1 = __builtin_amdgcn_exp2f(acc[ai][1][m][1][j] * -1.4426950408889634f);
                    r0[j] = sigm(acc[ai][0][m][0][j]) * (1.0f + e0); r1[j] = sigm(acc[ai][0][m][1][j]) * (1.0f + e1);
                    c0[j] = __builtin_amdgcn_rcpf(1.0f + e0); c1[j] = __builtin_amdgcn_rcpf(1.0f + e1); }
                bf16_t* ptr = gmc + (size_t)t * 2048 + u.pn * 128 + wc * 32 + 8 * fq;
                *(u32x4*)ptr = pack8(r0, r1); *(u32x4*)(ptr + 1024) = pack8(c0, c1); }
        } else if (u.kind == 0) {
            u32x4 cur[2], nxt[2];
#pragma unroll
            for (int bj = 0; bj < 2; ++bj) cur[bj] = *(const u32x4*)(gmc + (size_t)(u.pm * 256 + EPI_RL(0, 0)) * 2048 + u.pn * 256 + EPI_CL(bj));
            EPI_R8 { const int ai = r8 >> 2, m = r8 & 3; const int t = u.pm * 256 + EPI_RL(ai, m);
                if (r8 < 7) { const int tn = u.pm * 256 + EPI_RL((r8 + 1) >> 2, (r8 + 1) & 3);
#pragma unroll
                    for (int bj = 0; bj < 2; ++bj) nxt[bj] = *(const u32x4*)(gmc + (size_t)tn * 2048 + u.pn * 256 + EPI_CL(bj)); }
#pragma unroll
                for (int bj = 0; bj < 2; ++bj) { const int c = u.pn * 256 + EPI_CL(bj); f32x4 a0, a1; unpack8(cur[bj], a0, a1);
                    *(u32x4*)(tmp + (size_t)t * 1024 + c) = pack8(acc[ai][bj][m][0] * a0, acc[ai][bj][m][1] * a1); }
                cur[0] = nxt[0]; cur[1] = nxt[1]; }
        } else {
            u32x4 cg[2], ct[2], ng[2], nt2[2];
#pragma unroll
            for (int bj = 0; bj < 2; ++bj) { const int t0 = u.pm * 256 + EPI_RL(0, 0); const int c = u.pn * 256 + EPI_CL(bj);
                cg[bj] = *(const u32x4*)(gmc + (size_t)t0 * 2048 + 1024 + c); ct[bj] = *(const u32x4*)(tmp + (size_t)t0 * 1024 + c); }
            EPI_R8 { const int ai = r8 >> 2, m = r8 & 3; const int t = u.pm * 256 + EPI_RL(ai, m);
                if (r8 < 7) { const int tn = u.pm * 256 + EPI_RL((r8 + 1) >> 2, (r8 + 1) & 3);
#pragma unroll
                    for (int bj = 0; bj < 2; ++bj) { const int c = u.pn * 256 + EPI_CL(bj); ng[bj] = *(const u32x4*)(gmc + (size_t)tn * 2048 + 1024 + c); nt2[bj] = *(const u32x4*)(tmp + (size_t)tn * 1024 + c); } }
#pragma unroll
                for (int bj = 0; bj < 2; ++bj) { const int c = u.pn * 256 + EPI_CL(bj); f32x4 b0, b1, t0, t1; unpack8(cg[bj], b0, b1); unpack8(ct[bj], t0, t1);
                    *(u32x4*)(merged + (size_t)t * 1024 + c) = pack8((acc[ai][bj][m][0] + t0) * b0, (acc[ai][bj][m][1] + t1) * b1); }
                cg[0] = ng[0]; cg[1] = ng[1]; ct[0] = nt2[0]; ct[1] = nt2[1]; }
        }
    } };

struct SchedN4 { const char* a; const char* bt; size_t astep, bstep; int G, c;
    __device__ __forceinline__ bool next(int i, Unit& u) const {
        const int L = i * G + c; if (L >= 256) return false;
        map_n4(L, u.pm, u.pn); u.kind = 0; u.cont = 0; u.a = a + (size_t)u.pm * astep; u.b = bt + (size_t)u.pn * bstep; return true; } };
struct SchedPE { const char* a; const char* bt; int G, c;
    __device__ __forceinline__ bool next(int i, Unit& u) const {
        const int L = i * G + c; if (L >= 256 || c < 0) return false;
        u.pm = L >> 2; u.pn = L & 3; u.kind = 0; u.cont = 0; u.a = a + (size_t)u.pm * 256 * 256 * 2; u.b = bt + (size_t)u.pn * 256 * 256 * 2; return true; } };
template <bool SRC_BF16> struct EpiRes { static constexpr bool AFTER_DRAIN = false; const void* src; bf16_t* dstb; float* ssq;
    __device__ __forceinline__ void mid(Acc&, const Unit&, int, int, int, int) const {}
    __device__ __forceinline__ void pre(const Unit& u, int wr, int wc, int fr, int fq) const {
        if (!SRC_BF16) {
            EPI_ROWS(ai, m) { const int t = u.pm * 256 + EPI_RL(ai, m);
#pragma unroll
                for (int bj = 0; bj < 2; ++bj) { const float v = *((const float*)src + (size_t)t * 1024 + u.pn * 256 + EPI_CL(bj)); asm volatile("" :: "v"(v)); } }
        }
    }
    __device__ __forceinline__ void operator()(Acc& acc, const Unit& u, int wr, int wc, int fr, int fq) const {
        f32x4 rb[3][2][2];
#define ERES_LOAD(dst, t_) do { _Pragma("unroll") for (int bj = 0; bj < 2; ++bj) { const size_t o_ = (size_t)(t_) * 1024 + u.pn * 256 + EPI_CL(bj); \
            if (SRC_BF16) dst[bj][0] = __builtin_bit_cast(f32x4, *(const u32x4*)((const bf16_t*)src + o_)); \
            else { dst[bj][0] = *(const f32x4*)((const float*)src + o_); dst[bj][1] = *(const f32x4*)((const float*)src + o_ + 4); } } } while (0)
        ERES_LOAD(rb[0], u.pm * 256 + EPI_RL(0, 0)); ERES_LOAD(rb[1], u.pm * 256 + EPI_RL(0, 1));
        EPI_R8 { const int ai = r8 >> 2, m = r8 & 3; const int t = u.pm * 256 + EPI_RL(ai, m); float ss = 0.f;
            if (r8 < 6) ERES_LOAD(rb[(r8 + 2) % 3], u.pm * 256 + EPI_RL((r8 + 2) >> 2, (r8 + 2) & 3));
#pragma unroll
            for (int bj = 0; bj < 2; ++bj) { const size_t o = (size_t)t * 1024 + u.pn * 256 + EPI_CL(bj); f32x4 v0, v1;
                if (SRC_BF16) unpack8(__builtin_bit_cast(u32x4, rb[r8 % 3][bj][0]), v0, v1); else { v0 = rb[r8 % 3][bj][0]; v1 = rb[r8 % 3][bj][1]; }
                v0 += acc[ai][bj][m][0]; v1 += acc[ai][bj][m][1];
#pragma unroll
                for (int j = 0; j < 4; ++j) ss += v0[j] * v0[j] + v1[j] * v1[j];
                *(u32x4*)(dstb + o) = pack8(v0, v1); }
            ss += __shfl_xor(ss, 16); ss += __shfl_xor(ss, 32);
            if (fq == 0) unsafeAtomicAdd(ssq + t, ss); }
#undef ERES_LOAD
    } };

struct SchedP10 { const char* x1b; const char* wgut; int G, c;
    __device__ __forceinline__ bool next(int i, Unit& u) const {
        const int L = i * G + c; if (L >= 1408) return false;
        int pm, pn; tile_order(L, 64, 22, pm, pn); u.pm = pm; u.pn = pn; u.kind = 0; u.cont = 0;
        u.a = x1b + (size_t)pm * 256 * 1024 * 2; u.b = wgut + (size_t)pn * 256 * 1024 * 2; return true; } };
struct EpiP10 { static constexpr bool AFTER_DRAIN = false; const float* ssq; bf16_t* hid;
    __device__ __forceinline__ void mid(Acc&, const Unit&, int, int, int, int) const {}
    __device__ __forceinline__ void pre(const Unit&, int, int, int, int) const {}
    __device__ __forceinline__ void operator()(Acc& acc, const Unit& u, int wr, int wc, int fr, int fq) const {
        float rsv[2][4];
#pragma unroll
        for (int ai = 0; ai < 2; ++ai)
#pragma unroll
            for (int m = 0; m < 4; ++m) rsv[ai][m] = ssq[u.pm * 256 + EPI_RL(ai, m)];
        EPI_ROWS(ai, m) { const int t = u.pm * 256 + EPI_RL(ai, m); const float rs = rsqrtf(rsv[ai][m] * (1.0f / 1024.0f) + EPS_); f32x4 o0, o1;
#pragma unroll
            for (int j = 0; j < 4; ++j) { o0[j] = silu(acc[ai][0][m][0][j] * rs) * (acc[ai][1][m][0][j] * rs); o1[j] = silu(acc[ai][0][m][1][j] * rs) * (acc[ai][1][m][1][j] * rs); }
            *(u32x4*)(hid + (size_t)t * DFF_ + u.pn * 128 + wc * 32 + 8 * fq) = pack8(o0, o1); }
    } };

struct EpiBf { static constexpr bool AFTER_DRAIN = false; bf16_t* o;
    __device__ __forceinline__ void mid(Acc&, const Unit&, int, int, int, int) const {}
    __device__ __forceinline__ void pre(const Unit&, int, int, int, int) const {}
    __device__ __forceinline__ void operator()(Acc& acc, const Unit& u, int wr, int wc, int fr, int fq) const {
        EPI_ROWS(ai, m) { bf16_t* rowp = o + (size_t)(u.pm * 256 + EPI_RL(ai, m)) * 1024 + u.pn * 256 + EPI_CL(0);
#pragma unroll
            for (int bj = 0; bj < 2; ++bj) *(u32x4*)(rowp + bj * 128) = pack8(acc[ai][bj][m][0], acc[ai][bj][m][1]); }
    } };

struct EpiP12 { static constexpr bool AFTER_DRAIN = true; const float* ssq2; const bf16_t* pe; const bf16_t* xin; float* out; float* ssq3; unsigned* done; const float* fg;
    __device__ __forceinline__ void mid(Acc&, const Unit&, int, int, int, int) const {}
    __device__ __forceinline__ void pre(const Unit&, int, int, int, int) const {}
    __device__ __forceinline__ void operator()(Acc& acc, const Unit& u, int wr, int wc, int fr, int fq) const {
        float rsv[2][4];
#pragma unroll
        for (int ai = 0; ai < 2; ++ai)
#pragma unroll
            for (int m = 0; m < 4; ++m) rsv[ai][m] = ssq2[u.pm * 256 + EPI_RL(ai, m)];
        { u32x4 cx[2], cp[2], nx[2], np[2];
#pragma unroll
            for (int bj = 0; bj < 2; ++bj) { const size_t o = (size_t)(u.pm * 256 + EPI_RL(0, 0)) * 1024 + u.pn * 256 + EPI_CL(bj); cx[bj] = *(const u32x4*)(xin + o); cp[bj] = *(const u32x4*)(pe + o); }
            EPI_R8 { const int ai = r8 >> 2, m = r8 & 3; const int t = u.pm * 256 + EPI_RL(ai, m); const float rs = rsqrtf(rsv[ai][m] * (1.0f / 1024.0f) + EPS_); float ss = 0.f;
                if (r8 < 7) {
#pragma unroll
                    for (int bj = 0; bj < 2; ++bj) { const size_t o = (size_t)(u.pm * 256 + EPI_RL((r8 + 1) >> 2, (r8 + 1) & 3)) * 1024 + u.pn * 256 + EPI_CL(bj); nx[bj] = *(const u32x4*)(xin + o); np[bj] = *(const u32x4*)(pe + o); } }
#pragma unroll
                for (int bj = 0; bj < 2; ++bj) { f32x4 p0, p1, v0, v1; unpack8(cp[bj], p0, p1); unpack8(cx[bj], v0, v1);
#pragma unroll
                    for (int j = 0; j < 4; ++j) { v0[j] += sigm(acc[ai][bj][m][0][j] * rs) * p0[j]; v1[j] += sigm(acc[ai][bj][m][1][j] * rs) * p1[j]; ss += v0[j] * v0[j] + v1[j] * v1[j]; }
                    acc[ai][bj][m][0] = v0; acc[ai][bj][m][1] = v1; }
                ss += __shfl_xor(ss, 16); ss += __shfl_xor(ss, 32);
                if (fq == 0) unsafeAtomicAdd(ssq3 + t, ss);
                cx[0] = nx[0]; cx[1] = nx[1]; cp[0] = np[0]; cp[1] = np[1]; } }
        asm volatile("s_waitcnt vmcnt(0)" ::: "memory");
        unsigned* cnt = done + 64 * u.pm;
        if ((threadIdx.x & 63) == 0) __hip_atomic_fetch_add(cnt, 1u, __ATOMIC_RELAXED, __HIP_MEMORY_SCOPE_AGENT);
        { unsigned sp = 0; while (__hip_atomic_load(cnt, __ATOMIC_RELAXED, __HIP_MEMORY_SCOPE_AGENT) < 32u) { __builtin_amdgcn_s_sleep(1); if (++sp > (1u << 22)) break; } }
#pragma unroll
        for (int ai = 0; ai < 2; ++ai)
#pragma unroll
            for (int m = 0; m < 4; ++m) rsv[ai][m] = __hip_atomic_load(ssq3 + u.pm * 256 + EPI_RL(ai, m), __ATOMIC_RELAXED, __HIP_MEMORY_SCOPE_AGENT);
        f32x4 gv[2][2];
#pragma unroll
        for (int bj = 0; bj < 2; ++bj) { const int cc = u.pn * 256 + EPI_CL(bj); gv[bj][0] = *(const f32x4*)(fg + cc); gv[bj][1] = *(const f32x4*)(fg + cc + 4); }
        EPI_ROWS(ai, m) { const int t = u.pm * 256 + EPI_RL(ai, m);
            const float rs = rsqrtf(rsv[ai][m] * (1.0f / 1024.0f) + EPS_);
#pragma unroll
            for (int bj = 0; bj < 2; ++bj) { const size_t o = (size_t)t * 1024 + u.pn * 256 + EPI_CL(bj);
                *(f32x4*)(out + o) = acc[ai][bj][m][0] * rs * gv[bj][0]; *(f32x4*)(out + o + 4) = acc[ai][bj][m][1] * rs * gv[bj][1]; } }
    } };

struct CvtTile { const float* src; int ld; const float* scale; bf16_t* dst; int dstld; };
__device__ __forceinline__ CvtTile cvt_tile_params(const Params& p, int tl) {
    const int NT0 = 2048, NT4 = NT0 + 1024, NT5 = NT4 + 1408, NT6 = NT5 + 704;
    unsigned char* ws = p.ws; CvtTile t; t.scale = nullptr;
    if (tl < NT0) { const int nb = tl >> 4, kb = tl & 15; const int n0 = nb * 64; int col;
        if (n0 < 4096) col = n0; else if (n0 < 6144) { const int j = (n0 - 4096) >> 8, r = (n0 - 4096) & 255; col = (r < 128) ? (4104 + 128 * j + r) : (5128 + 128 * j + r - 128); }
        else { const int j = (n0 - 6144) >> 8, r = (n0 - 6144) & 255; col = 6152 + ((r < 128) ? (128 * j + r) : (1024 + 128 * j + r - 128)); }
        t.src = p.in[3] + (size_t)kb * 64 * NIN_ + col; t.ld = NIN_; t.dst = (bf16_t*)(ws + O_WINT) + (size_t)n0 * 1024 + kb * 64; t.dstld = 1024; }
    else if (tl < NT4) { const int w = (tl - NT0) >> 8, l = (tl - NT0) & 255; const int nb = l >> 4, kb = l & 15;
        const float* base = w == 0 ? p.in[12] : (w == 1 ? p.in[13] : (w == 2 ? p.in[14] : p.in[20])); const size_t od = w == 0 ? O_WMT : (w == 1 ? O_WCT : (w == 2 ? O_WOT : O_WPGT));
        t.src = base + (size_t)kb * 64 * 1024 + nb * 64; t.ld = 1024; if (w == 3) t.scale = p.in[19] + kb * 64; if (w == 0) t.scale = p.in[7] + kb * 64; t.dst = (bf16_t*)(ws + od) + (size_t)nb * 64 * 1024 + kb * 64; t.dstld = 1024; }
    else if (tl < NT5) { const int l = tl - NT4; const int nb = l >> 4, kb = l & 15; const int n0 = nb * 64; const int j = n0 >> 8, r = n0 & 255;
        const float* base = (r < 128) ? p.in[16] : p.in[17]; const int col = 128 * j + (r & 127);
        t.src = base + (size_t)kb * 64 * DFF_ + col; t.ld = DFF_; t.scale = p.in[15] + kb * 64; t.dst = (bf16_t*)(ws + O_WGUT) + (size_t)n0 * 1024 + kb * 64; t.dstld = 1024; }
    else if (tl < NT6) { const int l = tl - NT5; const int nb = l / 44, kb = l % 44;
        t.src = p.in[18] + (size_t)kb * 64 * 1024 + nb * 64; t.ld = 1024; t.dst = (bf16_t*)(ws + O_WDT) + (size_t)nb * 64 * DFF_ + kb * 64; t.dstld = DFF_; }
    else { const int l = tl - NT6; const int nb = l >> 2, kb = l & 3;
        t.src = p.in[21] + (size_t)kb * 64 * 1024 + nb * 64; t.ld = 1024; t.dst = (bf16_t*)(ws + O_WPPT) + (size_t)nb * 64 * 256 + kb * 64; t.dstld = 256; }
    return t;
}
__device__ __forceinline__ void cvt_tile_load(const CvtTile& t, f32x4 (&v)[2]) {
    const int tid = threadIdx.x, kk = tid >> 4, c4 = (tid & 15) * 4;
#pragma unroll
    for (int pss = 0; pss < 2; ++pss) { const int k = kk + pss * 32; v[pss] = *(const f32x4*)(t.src + (size_t)k * t.ld + c4); if (t.scale) v[pss] = v[pss] * t.scale[k]; }
}

__device__ __forceinline__ void phase0(const Params& p, unsigned char* sm) {
    unsigned char* ws = p.ws;
    const int tid = threadIdx.x, lane = tid & 63, wid = tid >> 6;
    const size_t gtid = (size_t)blockIdx.x * 512 + tid, gthreads = (size_t)gridDim.x * 512;
    for (size_t i = gtid; i < ZERO_BYTES / 16; i += gthreads) ((u32x4*)(ws + O_ZERO))[i] = (u32x4){0u, 0u, 0u, 0u};
    { const float* pp = p.in[1]; bf16_t* pb = (bf16_t*)(ws + O_PB);
        for (size_t i = gtid; i < (size_t)T_ * 256 / 8; i += gthreads) { const f32x4 a = *(const f32x4*)(pp + i * 8), b = *(const f32x4*)(pp + i * 8 + 4); *(u32x4*)(pb + i * 8) = pack8(a, b); } }
    { const float* x = p.in[0]; const float* g = p.in[2]; const float* win = p.in[3]; const float* bif = p.in[4];
        float* wgT = (float*)sm;
        for (int idx = tid; idx < 8192; idx += 512) { const int k = idx >> 3, j = idx & 7; wgT[j * 1024 + k] = win[(size_t)k * NIN_ + 4096 + j] * g[k]; }
        __syncthreads();
        bf16_t* hb = (bf16_t*)(ws + O_HB); float* ig = (float*)(ws + O_IG); float* lf = (float*)(ws + O_LF);
        const int rstep = gridDim.x * 8; int row = blockIdx.x * 8 + wid;
        f32x4 xn[4];
#pragma unroll
        for (int i = 0; i < 4; ++i) xn[i] = (row < T_) ? *(const f32x4*)(x + (size_t)row * 1024 + i * 256 + lane * 4) : (f32x4){0.f, 0.f, 0.f, 0.f};
        for (; row < T_; row += rstep) {
            f32x4 xv[4]; float ss = 0.f;
#pragma unroll
            for (int i = 0; i < 4; ++i) { xv[i] = xn[i]; ss += xv[i][0] * xv[i][0] + xv[i][1] * xv[i][1] + xv[i][2] * xv[i][2] + xv[i][3] * xv[i][3]; }
            { const int nrow = row + rstep;
                if (nrow < T_) {
#pragma unroll
                    for (int i = 0; i < 4; ++i) xn[i] = *(const f32x4*)(x + (size_t)nrow * 1024 + i * 256 + lane * 4); } }
            ss = wave_sum(ss); const float rs = rsqrtf(ss * (1.0f / 1024.0f) + EPS_);
            float d[8];
#pragma unroll
            for (int j = 0; j < 8; ++j) d[j] = 0.f;
#pragma unroll
            for (int i = 0; i < 4; ++i) { const f32x4 hn = xv[i] * rs; const f32x4 gv = *(const f32x4*)(g + i * 256 + lane * 4); const f32x4 hg = hn * gv;
                u32x2 w; w.x = cvt_pk_bf16(hg[0], hg[1]); w.y = cvt_pk_bf16(hg[2], hg[3]); *(u32x2*)(hb + (size_t)row * 1024 + i * 256 + lane * 4) = w;
#pragma unroll
                for (int j = 0; j < 8; ++j) { const f32x4 wv = *(const f32x4*)(wgT + j * 1024 + i * 256 + lane * 4); d[j] += hn[0] * wv[0] + hn[1] * wv[1] + hn[2] * wv[2] + hn[3] * wv[3]; } }
#pragma unroll
            for (int j = 0; j < 8; ++j) d[j] = wave_sum(d[j]);
            if (lane < 8) { float v = d[0];
#pragma unroll
                for (int j = 1; j < 8; ++j) v = (lane == j) ? d[j] : v;
                v += bif[lane];
                if (lane < 4) ig[(size_t)row * 4 + lane] = v;
                else { const float z = v; lf[(size_t)row * 4 + lane - 4] = fminf(z, 0.f) - log1pf(__expf(-fabsf(z))); } }
        }
        __syncthreads();
    }
    { const int NTILES = 2048 + 1024 + 1408 + 704 + 64; const int gs = gridDim.x;
        float* tl = (float*)sm;
        int t = blockIdx.x; CvtTile c0{}, c1{}; f32x4 v0[2], v1[2];
        if (t < NTILES) { c0 = cvt_tile_params(p, t); cvt_tile_load(c0, v0); }
        if (t + gs < NTILES) { c1 = cvt_tile_params(p, t + gs); cvt_tile_load(c1, v1); }
        for (; t < NTILES; t += gs) {
            { const int kk = tid >> 4, c4 = (tid & 15) * 4;
#pragma unroll
                for (int pss = 0; pss < 2; ++pss) { const int k = kk + pss * 32;
#pragma unroll
                    for (int j = 0; j < 4; ++j) tl[k * 65 + c4 + j] = v0[pss][j]; } }
            __syncthreads();
            const CvtTile done = c0; c0 = c1; v0[0] = v1[0]; v0[1] = v1[1];
            { const int tn = t + 2 * gs; if (tn < NTILES) { c1 = cvt_tile_params(p, tn); cvt_tile_load(c1, v1); } }
            { const int n = tid >> 3, k8 = (tid & 7) * 8; float e[8];
#pragma unroll
                for (int q = 0; q < 8; ++q) e[q] = tl[(k8 + q) * 65 + n];
                u32x4 w; w.x = cvt_pk_bf16(e[0], e[1]); w.y = cvt_pk_bf16(e[2], e[3]); w.z = cvt_pk_bf16(e[4], e[5]); w.w = cvt_pk_bf16(e[6], e[7]);
                *(u32x4*)(done.dst + (size_t)n * done.dstld + k8) = w; }
            __syncthreads();
        }
    }
}

__device__ __forceinline__ void phase2(const Params& p, unsigned char* sm) {
    unsigned char* ws = p.ws;
    const int tid = threadIdx.x, lane = tid & 63, wid = tid >> 6;
    float* rowfac = (float*)sm; float* colfac = rowfac + 256; float* wsum = colfac + 256;
    const float* ig = (const float*)(ws + O_IG); const float* lf = (const float*)(ws + O_LF);
    const bf16_t* qkpre = (const bf16_t*)p.out;
    const float* cw = p.in[5]; const float* cb = p.in[6];
    for (int item = blockIdx.x; item < 256; item += gridDim.x) {
        const int b = item >> 5, h = (item >> 3) & 3, sc = item & 7; const int tokb = b * SEQ_ + sc * 256;
        float v = 0.f, igv = 0.f;
        if (tid < 256) { v = lf[(size_t)(tokb + tid) * 4 + h]; igv = ig[(size_t)(tokb + tid) * 4 + h]; }
#pragma unroll
        for (int o = 1; o < 64; o <<= 1) { const float n = __shfl_up(v, o); if (lane >= o) v += n; }
        if (tid < 256 && lane == 63) wsum[wid] = v;
        __syncthreads();
        if (tid < 256) { float add = 0.f; for (int j = 0; j < wid; ++j) add += wsum[j]; v += add; rowfac[tid] = __expf(v); colfac[tid] = __expf(igv - v);
            if (tid == 255) ((float*)(ws + O_EBL))[item] = __expf(v); }
        __syncthreads();
#pragma unroll 1
        for (int qt = 0; qt < 4; ++qt) {
        const int cp = tid & 127, tg = tid >> 7; const int ch = 2 * cp; const int tl0 = qt * 64 + tg * 16; const int s0 = sc * 256 + tl0;
        { const int col = h * 256 + ch; float x0[19], x1[19];
#pragma unroll
            for (int i = 0; i < 19; ++i) { const int s = s0 - 3 + i; unsigned w = 0u; if (s >= 0) w = *(const unsigned*)(qkpre + (size_t)(b * SEQ_ + s) * 2048 + col); x0[i] = bf_lo(w); x1[i] = bf_hi(w); }
            float w0[4], w1[4];
#pragma unroll
            for (int k = 0; k < 4; ++k) { const f32x2 wv = *(const f32x2*)(cw + (size_t)k * 2048 + col); w0[k] = wv[0]; w1[k] = wv[1]; }
            const f32x2 bv = *(const f32x2*)(cb + col);
            bf16_t* wq = (bf16_t*)(ws + O_WQ) + (size_t)item * 65536;
#pragma unroll
            for (int i = 0; i < 16; ++i) { float y0 = bv[0], y1 = bv[1];
#pragma unroll
                for (int k = 0; k < 4; ++k) { y0 += x0[i + k] * w0[k]; y1 += x1[i + k] * w1[k]; }
                const float f = rowfac[tl0 + i] * 0.0625f;
                *(unsigned*)(wq + (size_t)(tl0 + i) * 256 + ch) = cvt_pk_bf16(silu(y0) * f, silu(y1) * f); } }
        { const int col = 1024 + h * 256 + ch; float x0[19], x1[19];
#pragma unroll
            for (int i = 0; i < 19; ++i) { const int s = s0 - 3 + i; unsigned w = 0u; if (s >= 0) w = *(const unsigned*)(qkpre + (size_t)(b * SEQ_ + s) * 2048 + col); x0[i] = bf_lo(w); x1[i] = bf_hi(w); }
            float w0[4], w1[4];
#pragma unroll
            for (int k = 0; k < 4; ++k) { const f32x2 wv = *(const f32x2*)(cw + (size_t)k * 2048 + col); w0[k] = wv[0]; w1[k] = wv[1]; }
            const f32x2 bv = *(const f32x2*)(cb + col);
            bf16_t* kw = (bf16_t*)(ws + O_KW) + (size_t)item * 65536; bf16_t* kwt = (bf16_t*)(ws + O_KWT) + (size_t)item * 65536;
            float k0[16], k1[16]; float n0 = 0.f, n1 = 0.f;
#pragma unroll
            for (int i = 0; i < 16; ++i) { float y0 = bv[0], y1 = bv[1];
#pragma unroll
                for (int k = 0; k < 4; ++k) { y0 += x0[i + k] * w0[k]; y1 += x1[i + k] * w1[k]; }
                const float f = colfac[tl0 + i]; k0[i] = silu(y0) * f; k1[i] = silu(y1) * f; n0 += k0[i]; n1 += k1[i];
                *(unsigned*)(kw + (size_t)(tl0 + i) * 256 + ch) = cvt_pk_bf16(k0[i], k1[i]); }
            u32x4 a, c;
            a.x = cvt_pk_bf16(k0[0], k0[1]); a.y = cvt_pk_bf16(k0[2], k0[3]); a.z = cvt_pk_bf16(k0[4], k0[5]); a.w = cvt_pk_bf16(k0[6], k0[7]);
            c.x = cvt_pk_bf16(k0[8], k0[9]); c.y = cvt_pk_bf16(k0[10], k0[11]); c.z = cvt_pk_bf16(k0[12], k0[13]); c.w = cvt_pk_bf16(k0[14], k0[15]);
            *(u32x4*)(kwt + (size_t)ch * 256 + tl0) = a; *(u32x4*)(kwt + (size_t)ch * 256 + tl0 + 8) = c;
            a.x = cvt_pk_bf16(k1[0], k1[1]); a.y = cvt_pk_bf16(k1[2], k1[3]); a.z = cvt_pk_bf16(k1[4], k1[5]); a.w = cvt_pk_bf16(k1[6], k1[7]);
            c.x = cvt_pk_bf16(k1[8], k1[9]); c.y = cvt_pk_bf16(k1[10], k1[11]); c.z = cvt_pk_bf16(k1[12], k1[13]); c.w = cvt_pk_bf16(k1[14], k1[15]);
            *(u32x4*)(kwt + (size_t)(ch + 1) * 256 + tl0) = a; *(u32x4*)(kwt + (size_t)(ch + 1) * 256 + tl0 + 8) = c;
            float* nsum = (float*)(ws + O_NSUM) + (size_t)item * 256;
            unsafeAtomicAdd(nsum + ch, n0); unsafeAtomicAdd(nsum + ch + 1, n1); }
        }
        __syncthreads();
    }
}

__device__ __forceinline__ void phase4(const Params& p, unsigned char* sm) {
    unsigned char* ws = p.ws;
    const int tid = threadIdx.x;
    const float* ebl = (const float*)(ws + O_EBL);
    const bf16_t* lt = (const bf16_t*)(p.ws + O_KWT);
    bf16_t* cint = (bf16_t*)(ws + O_CINT);
    const size_t gtid = (size_t)blockIdx.x * 512 + tid, gthreads = (size_t)gridDim.x * 512;
#pragma unroll 2
    for (size_t g = gtid; g < (size_t)32 * 16384; g += gthreads) {
        const int bh = (int)(g >> 14), e4 = (int)(g & 16383);
        f32x4 c = {0.f, 0.f, 0.f, 0.f};
        u32x2 lw[7]; float eb[7];
#pragma unroll
        for (int sc = 0; sc < 7; ++sc) { lw[sc] = *(const u32x2*)(lt + (size_t)(bh * 8 + sc) * 65536 + e4 * 4); eb[sc] = ebl[bh * 8 + sc]; }
#pragma unroll
        for (int sc = 0; sc < 8; ++sc) { const int item = bh * 8 + sc;
            u32x2 w; w.x = cvt_pk_bf16(c[0], c[1]); w.y = cvt_pk_bf16(c[2], c[3]); *(u32x2*)(cint + (size_t)item * 65536 + e4 * 4) = w;
            if (sc < 7) { const f32x4 l = {bf_lo(lw[sc].x), bf_hi(lw[sc].x), bf_lo(lw[sc].y), bf_hi(lw[sc].y)}; c = (c + l) * eb[sc]; } }
    }
    float* nin = (float*)sm;
    const float* nsum = (const float*)(ws + O_NSUM);
    float* denx = (float*)(ws + O_DENX);
    for (int item = blockIdx.x; item < 256; item += gridDim.x) {
        const int b = item >> 5, h = (item >> 3) & 3, sc = item & 7; const int tokb = b * SEQ_ + sc * 256; const int bh = item >> 3;
        if (tid < 256) { float eb[7], ns[7];
#pragma unroll
            for (int j = 0; j < 7; ++j) { eb[j] = ebl[bh * 8 + j]; ns[j] = nsum[(size_t)(bh * 8 + j) * 256 + tid]; }
            float nv = 0.f;
#pragma unroll
            for (int j = 0; j < 7; ++j) if (j < sc) nv = eb[j] * (nv + ns[j]);
            nin[tid] = nv; }
        __syncthreads();
        const int tl = tid >> 1, half = tid & 1;
        const bf16_t* wq = (const bf16_t*)(ws + O_WQ) + (size_t)item * 65536 + (size_t)tl * 256 + half * 128;
        float d = 0.f;
#pragma unroll
        for (int i = 0; i < 16; ++i) { f32x4 a0, a1; unpack8(*(const u32x4*)(wq + i * 8), a0, a1); const float* nn = nin + half * 128 + i * 8;
            d += a0[0] * nn[0] + a0[1] * nn[1] + a0[2] * nn[2] + a0[3] * nn[3] + a1[0] * nn[4] + a1[1] * nn[5] + a1[2] * nn[6] + a1[3] * nn[7]; }
        d += __shfl_xor(d, 1);
        if (half == 0) denx[(size_t)(tokb + tl) * 4 + h] = d;
        __syncthreads();
    }
}

__device__ __forceinline__ void phase7(const Params& p, unsigned char* sm) {
    unsigned char* ws = p.ws;
    const int tid = threadIdx.x, lane = tid & 63, wid = tid >> 6;
    const bf16_t* uu = (const bf16_t*)p.out; bf16_t* uc = (bf16_t*)(ws + O_UC);
    const float* cw = p.in[8]; const float* cb = p.in[9]; const float* lg = p.in[10]; const float* lb = p.in[11];
    u32x4 pf[12];
#define P7_LOAD(tile_) do { const int t0_ = (tile_) * 16; const int b_ = t0_ / SEQ_, s0_ = t0_ % SEQ_; \
        _Pragma("unroll") for (int q = 0; q < 12; ++q) { const int idx = tid + q * 512; const int r = idx >> 7, c16 = idx & 127; const int s_ = s0_ - 30 + r; \
            pf[q] = (u32x4){0u, 0u, 0u, 0u}; if (idx < 46 * 128 && s_ >= 0) pf[q] = *(const u32x4*)(uu + (size_t)(b_ * SEQ_ + s_) * 1024 + c16 * 8); } } while (0)
    int tile = blockIdx.x;
    if (tile < 1024) P7_LOAD(tile);
    f32x2 wv[31];
#pragma unroll
    for (int k = 0; k < 31; ++k) wv[k] = *(const f32x2*)(cw + (size_t)k * 1024 + 2 * tid);
    const f32x2 bv = *(const f32x2*)(cb + 2 * tid);
    f32x4 lgv[4], lbv[4];
#pragma unroll
    for (int i = 0; i < 4; ++i) { lgv[i] = *(const f32x4*)(lg + i * 256 + lane * 4); lbv[i] = *(const f32x4*)(lb + i * 256 + lane * 4); }
    for (; tile < 1024; tile += gridDim.x) {
        const int t0 = tile * 16;
#pragma unroll
        for (int q = 0; q < 12; ++q) { const int idx = tid + q * 512; const int r = idx >> 7, c16 = idx & 127; if (idx < 46 * 128) *(u32x4*)(sm + r * 2048 + c16 * 16) = pf[q]; }
        __syncthreads();
        f32x2 yy[16];
        {
#pragma unroll
            for (int t = 0; t < 16; ++t) yy[t] = bv;
#pragma unroll
            for (int r = 0; r < 46; ++r) { const unsigned w = *(const unsigned*)(sm + r * 2048 + tid * 4); const f32x2 xx = {bf_lo(w), bf_hi(w)};
#pragma unroll
                for (int t = 0; t < 16; ++t) { const int k = r - t; if (k >= 0 && k <= 30) yy[t] = __builtin_elementwise_fma(wv[k], xx, yy[t]); }
                if ((r & 3) == 3) asm volatile("" ::: "memory"); }
        }
        __syncthreads();
#pragma unroll
        for (int t = 0; t < 16; ++t) *(f32x2*)(sm + t * 4096 + tid * 8) = yy[t];
        { const int tn = tile + gridDim.x; if (tn < 1024) P7_LOAD(tn); }
        __syncthreads();
#pragma unroll
        for (int tt = 0; tt < 2; ++tt) { const int t = wid * 2 + tt; f32x4 v[4]; float s1 = 0.f;
#pragma unroll
            for (int i = 0; i < 4; ++i) { v[i] = *(const f32x4*)(sm + t * 4096 + (i * 256 + lane * 4) * 4); s1 += v[i][0] + v[i][1] + v[i][2] + v[i][3]; }
            s1 = wave_sum(s1); const float mu = s1 * (1.0f / 1024.0f); float s2 = 0.f;
#pragma unroll
            for (int i = 0; i < 4; ++i) { v[i] = v[i] - mu; s2 += v[i][0] * v[i][0] + v[i][1] * v[i][1] + v[i][2] * v[i][2] + v[i][3] * v[i][3]; }
            s2 = wave_sum(s2); const float rstd = rsqrtf(s2 * (1.0f / 1024.0f) + EPS_);
#pragma unroll
            for (int i = 0; i < 4; ++i) { const int c = i * 256 + lane * 4; f32x4 z = v[i] * rstd * lgv[i] + lbv[i];
                u32x2 w; w.x = cvt_pk_bf16(silu(z[0]), silu(z[1])); w.y = cvt_pk_bf16(silu(z[2]), silu(z[3])); *(u32x2*)(uc + (size_t)(t0 + t) * 1024 + c) = w; } }
        __syncthreads();
    }
#undef P7_LOAD
}

__device__ __forceinline__ void phase13(const Params& p) {
    const float* ssq3 = (const float*)(p.ws + O_SSQ3); const float* fg = p.in[22];
    const size_t gtid = (size_t)blockIdx.x * 512 + threadIdx.x, gthreads = (size_t)gridDim.x * 512;
    for (size_t i = gtid; i < (size_t)T_ * 256; i += gthreads) { const int row = (int)(i >> 8), c = (int)(i & 255) * 4;
        const float rs = rsqrtf(ssq3[row] * (1.0f / 1024.0f) + EPS_); const f32x4 g = *(const f32x4*)(fg + c);
        f32x4 v = *(const f32x4*)(p.out + i * 4); v = v * rs * g; *(f32x4*)(p.out + i * 4) = v; }
}

#define XB_TMO      128
#define XB_XCNT(j)  (256  + 64 * (j))
#define XB_XSUB(j)  (1280 + 64 * (j))
#define XB_XGEN(j)  (2304 + 64 * (j))
#define XB_TOP      3328
#define XB_TOPGEN   3392
#define XCD_BAR_WORDS 3456
#define XB_SPIN_CAP (1u << 18)
__device__ __forceinline__ unsigned xb_ld(unsigned* p)              { return __hip_atomic_load(p, __ATOMIC_RELAXED, __HIP_MEMORY_SCOPE_AGENT); }
__device__ __forceinline__ unsigned xb_add(unsigned* p, unsigned v) { return __hip_atomic_fetch_add(p, v, __ATOMIC_RELAXED, __HIP_MEMORY_SCOPE_AGENT); }
__device__ __forceinline__ unsigned xb_xcc_id() { return (unsigned)__builtin_amdgcn_s_getreg((3 << 11) | 20) & 0xFu; }
#define XB_SPIN(cond, bar) do { unsigned _sp = 0; while (cond) { __builtin_amdgcn_s_sleep(1); \
    if ((++_sp & 255u) == 0u) { if (xb_ld(&(bar)[XB_TMO])) break; if (_sp > XB_SPIN_CAP) { atomicAdd(&(bar)[XB_TMO], 1u); break; } } } } while (0)
struct XcdBarrier { unsigned* bar; unsigned x; volatile LAS unsigned* st; };
__device__ __forceinline__ XcdBarrier xcd_barrier_post(unsigned* bar, volatile LAS unsigned* st) {
    XcdBarrier b; b.bar = bar; b.x = xb_xcc_id(); b.st = st;
    if (threadIdx.x == 0) (void)xb_add(&bar[XB_XCNT(b.x)], 1u);
    return b;
}
__device__ __forceinline__ void xcd_barrier_complete(unsigned* bar, unsigned x, unsigned& nloc, unsigned& nx) {
    const unsigned G = gridDim.x * gridDim.y * gridDim.z;
    unsigned sum, cnt, mine, sp = 0u;
    for (;;) {
        sum = 0u; cnt = 0u; mine = 0u;
#pragma unroll
        for (unsigned j = 0; j < 16; ++j) { const unsigned c = xb_ld(&bar[XB_XCNT(j)]); sum += c; cnt += (c > 0u) ? 1u : 0u; mine = (j == x) ? c : mine; }
        if (sum == G) break;
        __builtin_amdgcn_s_sleep(1);
        if ((++sp & 255u) == 0u) { if (xb_ld(&bar[XB_TMO])) break; if (sp > XB_SPIN_CAP) { atomicAdd(&bar[XB_TMO], 1u); break; } }
    }
    nloc = mine > 0u ? mine : 1u; nx = cnt > 0u ? cnt : 1u;
}
__device__ __forceinline__ void xcd_barrier(const XcdBarrier& b) {
    asm volatile("s_waitcnt vmcnt(0)" ::: "memory");
    __syncthreads();
    if (threadIdx.x == 0) {
        unsigned* bar = b.bar;
        __builtin_amdgcn_s_waitcnt(0);
        unsigned nloc = b.st[0], nx = b.st[1];
        if (nloc == 0u) { xcd_barrier_complete(bar, b.x, nloc, nx); b.st[0] = nloc; b.st[1] = nx; }
        const unsigned old = xb_add(&bar[XB_XSUB(b.x)], 1u);
        const unsigned gen = old / nloc;
        if (old + 1u == (gen + 1u) * nloc) {
            __builtin_amdgcn_fence(__ATOMIC_RELEASE, "agent");
            asm volatile("s_waitcnt vmcnt(0)" ::: "memory");
            const unsigned og = xb_add(&bar[XB_TOP], 1u);
            const unsigned tg = og / nx;
            if (og + 1u == (tg + 1u) * nx) xb_add(&bar[XB_TOPGEN], 1u);
            else XB_SPIN(xb_ld(&bar[XB_TOPGEN]) == tg, bar);
            __builtin_amdgcn_fence(__ATOMIC_ACQUIRE, "agent");
            xb_add(&bar[XB_XGEN(b.x)], 1u);
            asm volatile("s_waitcnt vmcnt(0)" ::: "memory");
        } else {
            XB_SPIN(xb_ld(&bar[XB_XGEN(b.x)]) == gen, bar);
            __builtin_amdgcn_fence(__ATOMIC_ACQUIRE, "agent");
            asm volatile("s_waitcnt vmcnt(0)" ::: "memory");
        }
    }
    __syncthreads();
}

template <bool COOP>
__global__ void __launch_bounds__(512, 2) mk_fwd(Params p) {
    extern __shared__ __attribute__((aligned(16))) unsigned char shm[];
    LAS unsigned char* lds = (LAS unsigned char*)shm;
    unsigned char* ws = p.ws;
    const int G = gridDim.x, c = blockIdx.x;
#ifndef PHMASK
#define PHMASK 0x3fff
#endif
#define PH(k) if (((PHMASK >> (k)) & 1) && p.ph_lo <= (k) && (k) < p.ph_hi)
    XcdBarrier xb{};
    if (COOP) { volatile LAS unsigned* st = (volatile LAS unsigned*)(lds + 131072);
        if (threadIdx.x == 0) { st[0] = 0u; st[1] = 0u; }
        __syncthreads();
        xb = xcd_barrier_post((unsigned*)(ws + O_BAR), st); }
#define SYNC(k) if (COOP) { if (p.ph_lo <= (k) && (k) + 1 < p.ph_hi) { xcd_barrier(xb); } }
    PH(0) phase0(p, shm);
    SYNC(0)
    PH(1) { SchedP1 S{(const char*)(ws + O_HB), (const char*)(ws + O_WINT), G, c}; EpiP1 E{(bf16_t*)p.out, (bf16_t*)(ws + O_VT)}; gemm_phase(lds, 1024, 1024, 1024, S, E); }
    SYNC(1)
    PH(3) { phase2(p, shm);
        asm volatile("s_waitcnt vmcnt(0)" ::: "memory"); __syncthreads();
        SchedP3 S{(const char*)(ws + O_WQ), (const char*)(ws + O_KW), (const char*)(ws + O_VT), (const char*)(ws + O_KWT), G, c};
        EpiP3 E{(bf16_t*)(ws + O_SS), (bf16_t*)(ws + O_KWT), (float*)(ws + O_DENI)}; gemm_phase(lds, 256, 256, 256, S, E); }
    SYNC(3)
    PH(4) phase4(p, shm);
    SYNC(4)
    PH(6) { { SchedP5 S{(const char*)(ws + O_SS), (const char*)(ws + O_VT), (const char*)(ws + O_WQ), (const char*)(ws + O_CINT), G, c};
            EpiP5 E{(bf16_t*)(ws + O_HM), (const float*)(ws + O_DENI), (const float*)(ws + O_DENX), (float*)(ws + O_HSS)}; gemm_phase(lds, 256, 256, 256, S, E); }
        { SchedP6 S{(const char*)(ws + O_HB), (const char*)(ws + O_WINT), G, c};
            EpiP6 E{(bf16_t*)(ws + O_HM), (float*)(ws + O_HSS), p.in[7], (bf16_t*)p.out}; gemm_phase(lds, 1024, 1024, 1024, S, E); } }
    SYNC(6)
    PH(7) phase7(p, shm);
    SYNC(7)
    PH(8) { SchedP8 S{(const char*)(ws + O_HB), (const char*)(ws + O_WINT), (const char*)(ws + O_HM), (const char*)(ws + O_UC), (const char*)(ws + O_WMT), (const char*)(ws + O_WCT), G, c};
        EpiP8 E{(bf16_t*)(ws + O_GMC), (bf16_t*)p.out + (size_t)T_ * 1024, (bf16_t*)(ws + O_MERGED)}; gemm_phase(lds, 1024, 1024, 1024, S, E); }
    SYNC(8)
    PH(9) { SchedN4 S{(const char*)(ws + O_MERGED), (const char*)(ws + O_WOT), (size_t)256 * 1024 * 2, (size_t)256 * 1024 * 2, G, c};
        EpiRes<false> E{p.in[0], (bf16_t*)(ws + O_X1B), (float*)(ws + O_SSQ1)}; gemm_phase(lds, 1024, 1024, 1024, S, E); }
    SYNC(9)
    PH(10) { { SchedP10 S{(const char*)(ws + O_X1B), (const char*)(ws + O_WGUT), G, c}; EpiP10 E{(const float*)(ws + O_SSQ1), (bf16_t*)(ws + O_HID)}; gemm_phase(lds, 1024, 1024, 1024, S, E); }
        { const int h = G >> 1; SchedPE S{(const char*)(ws + O_PB), (const char*)(ws + O_WPPT), h, c - h};
            EpiBf E{(bf16_t*)(ws + O_PE)}; if (c >= h) gemm_phase(lds, 256, 256, 256, S, E); } }
    SYNC(10)
    PH(11) { SchedN4 S{(const char*)(ws + O_HID), (const char*)(ws + O_WDT), (size_t)256 * DFF_ * 2, (size_t)256 * DFF_ * 2, G, c};
            EpiRes<true> E{(const void*)(ws + O_X1B), (bf16_t*)(ws + O_X2B), (float*)(ws + O_SSQ2)}; gemm_phase(lds, DFF_, DFF_, DFF_, S, E); }
    SYNC(11)
    PH(12) { SchedN4 S{(const char*)(ws + O_X2B), (const char*)(ws + O_WPGT), (size_t)256 * 1024 * 2, (size_t)256 * 1024 * 2, G, c};
        EpiP12 E{(const float*)(ws + O_SSQ2), (const bf16_t*)(ws + O_PE), (const bf16_t*)(ws + O_X2B), p.out, (float*)(ws + O_SSQ3), (unsigned*)(ws + O_BAR) + XCD_BAR_WORDS, p.in[22]}; gemm_phase(lds, 1024, 1024, 1024, S, E); }
#undef PH
#undef SYNC
}

extern "C" void kernel_launch(void* const* d_in, const int* in_sizes, int n_in, void* d_out, int out_size, void* d_ws, size_t ws_size, hipStream_t stream) {
    static int grid = 0;
    if (grid == 0) {
        if (n_in != 23 || out_size != T_ * D_ || ws_size < WS_NEED) { fprintf(stderr, "kernel_launch: unexpected shapes (n_in %d, out %d, ws %zu)\n", n_in, out_size, ws_size); grid = -1; return; }
        int dev = 0, cus = 0, per_cu = 0;
        hipGetDevice(&dev); hipDeviceGetAttribute(&cus, hipDeviceAttributeMultiprocessorCount, dev);
        hipFuncSetAttribute((const void*)mk_fwd<true>, hipFuncAttributeMaxDynamicSharedMemorySize, LDS_BYTES);
        hipFuncSetAttribute((const void*)mk_fwd<false>, hipFuncAttributeMaxDynamicSharedMemorySize, LDS_BYTES);
        hipOccupancyMaxActiveBlocksPerMultiprocessor(&per_cu, (const void*)mk_fwd<true>, 512, LDS_BYTES);
        if (per_cu < 1) { fprintf(stderr, "kernel_launch: occupancy query reports %d blocks per CU\n", per_cu); per_cu = 1; }
        (void)hipGetLastError();
        grid = cus;
        if (grid != 256) { fprintf(stderr, "kernel_launch: built for a 256-CU device (got %d CUs)\n", cus); grid = -1; return; }
    }
    if (grid < 0) return;
    Params p{};
    for (int i = 0; i < 23; ++i) p.in[i] = (const float*)d_in[i];
    p.out = (float*)d_out; p.ws = (unsigned char*)d_ws;
#if MK_MULTI
#ifndef PROBE_DUP
#define PROBE_DUP -1
#endif
    for (int k = 0; k < NPHASE; ++k) { p.ph_lo = k; p.ph_hi = k + 1; hipLaunchKernelGGL(mk_fwd<false>, dim3(grid), dim3(512), LDS_BYTES, stream, p);
        if (k == PROBE_DUP) hipLaunchKernelGGL(mk_fwd<false>, dim3(grid), dim3(512), LDS_BYTES, stream, p); }
#else
    p.ph_lo = 0; p.ph_hi = NPHASE;
    if (hipMemsetAsync((unsigned char*)d_ws + O_BAR, 0, (XCD_BAR_WORDS + 64 * 64) * 4, stream) != hipSuccess) { fprintf(stderr, "kernel_launch: memset of barrier words failed\n"); return; }
    void* args[] = {&p};
    hipError_t e = hipLaunchCooperativeKernel((const void*)mk_fwd<true>, dim3(grid), dim3(512), args, LDS_BYTES, stream);
    if (e != hipSuccess) fprintf(stderr, "cooperative launch failed: %s (grid %d)\n", hipGetErrorString(e), grid);
#endif
}
```

```cpp
#include <hip/hip_runtime.h>
#include <hip/hip_cooperative_groups.h>
#include <cstdio>
namespace cg = cooperative_groups;

#ifndef MK_MULTI
#define MK_MULTI 0
#endif

#define LAS __attribute__((address_space(3)))
typedef unsigned short bf16_t;
typedef short bf16x8 __attribute__((ext_vector_type(8)));
typedef float f32x4 __attribute__((ext_vector_type(4)));
typedef float f32x2 __attribute__((ext_vector_type(2)));
typedef unsigned u32x4 __attribute__((ext_vector_type(4)));
typedef unsigned u32x2 __attribute__((ext_vector_type(2)));

constexpr int T_ = 16384, D_ = 1024, NIN_ = 8200, DFF_ = 2816, SEQ_ = 2048;
constexpr float EPS_ = 1e-6f;
constexpr int BM = 256, BK = 64, HALF = 128, HTB = HALF * BK * 2, STAGE_BYTES = 8 * HTB;
constexpr int LDS_BYTES = 136 * 1024;
constexpr int NPHASE = 13;

constexpr size_t KiB = 1024, MiB = 1024 * 1024;
constexpr size_t O_WINT = 0, O_WMT = 16 * MiB, O_WCT = 18 * MiB, O_WOT = 20 * MiB, O_WPGT = 22 * MiB, O_WGUT = 24 * MiB, O_WDT = 35 * MiB, O_WPPT = 40 * MiB + 512 * KiB;
constexpr size_t O_IG = 41 * MiB, O_LF = O_IG + 256 * KiB, O_ZERO = O_LF + 256 * KiB;
constexpr size_t O_DENI = O_ZERO, O_HSS = O_DENI + 256 * KiB, O_SSQ1 = O_HSS + 256 * KiB, O_SSQ2 = O_SSQ1 + 64 * KiB, O_SSQ3 = O_SSQ2 + 64 * KiB, O_NSUM = O_SSQ3 + 64 * KiB;
constexpr size_t ZERO_BYTES = 960 * KiB;
constexpr size_t O_DENX = O_ZERO + ZERO_BYTES, O_EBL = O_DENX + 256 * KiB;
constexpr size_t O_RS = O_EBL + 4 * KiB;
constexpr size_t O_BAR = 43 * MiB;
constexpr size_t O_PB = 44 * MiB, O_HB = 52 * MiB, O_S1 = 84 * MiB, O_S2 = 116 * MiB, O_S3 = 148 * MiB, O_S4 = 180 * MiB, O_S5 = 212 * MiB, WS_NEED = 244 * MiB;
constexpr size_t O_PE = O_HB, O_VT = O_S1, O_U = O_S1, O_MERGED = O_S1, O_HID = O_S1, O_WQ = O_S2, O_GMC = O_S2, O_KW = O_S3, O_CINT = O_S3,
                 O_KWT = O_S4, O_HM = O_S4, O_X1B = O_S4, O_SS = O_S5, O_UC = O_S5, O_X2B = O_S5;

struct Params {
    const float* in[23];
    float* out;
    unsigned char* ws;
    int ph_lo, ph_hi;
};

__device__ __forceinline__ unsigned cvt_pk_bf16(float lo, float hi) { unsigned r; asm volatile("v_cvt_pk_bf16_f32 %0, %1, %2" : "=v"(r) : "v"(lo), "v"(hi)); return r; }
__device__ __forceinline__ float bf_lo(unsigned w) { return __uint_as_float(w << 16); }
__device__ __forceinline__ float bf_hi(unsigned w) { return __uint_as_float(w & 0xffff0000u); }
__device__ __forceinline__ float sigm(float x) { return __builtin_amdgcn_rcpf(1.0f + __builtin_amdgcn_exp2f(x * -1.4426950408889634f)); }
__device__ __forceinline__ float silu(float x) { return x * __builtin_amdgcn_rcpf(1.0f + __builtin_amdgcn_exp2f(x * -1.4426950408889634f)); }
__device__ __forceinline__ float wave_sum(float v) {
#pragma unroll
    for (int o = 32; o > 0; o >>= 1) v += __shfl_xor(v, o);
    return v;
}
__device__ __forceinline__ u32x4 pack8(const f32x4 a, const f32x4 b) { u32x4 w; w.x = cvt_pk_bf16(a[0], a[1]); w.y = cvt_pk_bf16(a[2], a[3]); w.z = cvt_pk_bf16(b[0], b[1]); w.w = cvt_pk_bf16(b[2], b[3]); return w; }
__device__ __forceinline__ void unpack8(const u32x4 w, f32x4& a, f32x4& b) { a[0] = bf_lo(w.x); a[1] = bf_hi(w.x); a[2] = bf_lo(w.y); a[3] = bf_hi(w.y); b[0] = bf_lo(w.z); b[1] = bf_hi(w.z); b[2] = bf_lo(w.w); b[3] = bf_hi(w.w); }

__host__ __device__ __forceinline__ int lds_byte(int r, int c) { const int st = (r >> 4) * 2 + (c >> 5), rr = r & 15, cc = c & 31, ob = rr * 64 + cc * 2; return st * 1024 + (ob ^ (((ob >> 9) & 1) << 5)); }
__host__ __device__ __forceinline__ void stage_rc(int b, int& R, int& C) { const int st = b / 1024, sb = b % 1024, swz = sb ^ (((sb >> 9) & 1) << 5); R = (st >> 1) * 16 + swz / 64; C = (st & 1) * 32 + (swz % 64) / 2; }
__host__ __device__ __forceinline__ int perm32(int rho) { const int n = rho >> 4, i = rho & 15; return 8 * (i >> 2) + 4 * n + (i & 3); }

struct Unit { const char* a; const char* b; int pm, pn, kind, cont; };
__device__ __forceinline__ void map_n4(int L, int& pm, int& pn) { const int x = L & 7, k = L >> 3; pm = x * 8 + (k & 7); pn = k >> 3; }

__device__ __forceinline__ void tile_order(int L, int nM, int nN, int& pm, int& pn) {
    const int nwg = nM * nN; int wgid = L;
    { const int q = nwg / 8, r = nwg % 8, xcd = wgid % 8, off = wgid / 8; wgid = (xcd < r ? xcd * (q + 1) : r * (q + 1) + (xcd - r) * q) + off; }
    const int nig = 8 * nN, gid = wgid / nig, fm = gid * 8, gsz = (nM - fm) < 8 ? (nM - fm) : 8;
    pm = fm + ((wgid % nig) % gsz); pn = (wgid % nig) / gsz;
}

template <class Epi, class Sched>
__device__ __forceinline__ void gemm_phase(LAS unsigned char* lds, const int K, const int lda, const int ldb, const Sched& S, const Epi& E) {
    const int tid = threadIdx.x, wid = __builtin_amdgcn_readfirstlane(tid >> 6), lane = tid & 63, wr = wid >> 2, wc = wid & 3, fr = lane & 15, fq = lane >> 4;
    const int nt = K / BK;
    unsigned voffA[2], voffB[2];
#pragma unroll
    for (int i = 0; i < 2; ++i) { int R, C; stage_rc(tid * 16 + i * 8192, R, C); const int Rb = (R & ~31) + perm32(R & 31);
        voffA[i] = (unsigned)(R * lda + C) * 2u; voffB[i] = (unsigned)(Rb * ldb + C) * 2u; }
    const size_t kstep = (size_t)(BK * 2);
    const size_t hstepA = (size_t)HALF * lda * 2, hstepB = (size_t)HALF * ldb * 2;
    const unsigned ldsw = (unsigned)wid * 1024u;
    const int aoff = lds_byte(wr * 64 + fr, fq * 8), boff = lds_byte(wc * 32 + fr, fq * 8);
#define PG8_SA(b, h) (((b) * 2 + (h)) * HTB)
#define PG8_SB(b, h) ((4 + (b) * 2 + (h)) * HTB)
#define PG8_STAGE(bufoff, gbase, voff) do { _Pragma("unroll") for (int _i = 0; _i < 2; ++_i) \
        __builtin_amdgcn_global_load_lds((const unsigned*)((const char*)(gbase) + (voff)[_i]), (LAS unsigned*)(lds + (bufoff) + ldsw + _i * 8192), 16, 0, 0); } while (0)
#define PG8_LDA(dst, b, h) do { _Pragma("unroll") for (int m = 0; m < 4; ++m) _Pragma("unroll") for (int k = 0; k < 2; ++k) dst[m][k] = *(const LAS bf16x8*)(lds + PG8_SA(b, h) + aoff + m * 2048 + k * 1024); } while (0)
#define PG8_LDB(dst, b, h) do { _Pragma("unroll") for (int n = 0; n < 2; ++n) _Pragma("unroll") for (int k = 0; k < 2; ++k) dst[n][k] = *(const LAS bf16x8*)(lds + PG8_SB(b, h) + boff + n * 2048 + k * 1024); } while (0)
#define PG8_MMA(ai, bj, At, Bt) do { __builtin_amdgcn_s_setprio(1); _Pragma("unroll") for (int m = 0; m < 4; ++m) _Pragma("unroll") for (int n = 0; n < 2; ++n) _Pragma("unroll") for (int k = 0; k < 2; ++k) \
        acc[ai][bj][m][n] = __builtin_amdgcn_mfma_f32_16x16x32_bf16(Bt[n][k], At[m][k], acc[ai][bj][m][n], 0, 0, 0); __builtin_amdgcn_s_setprio(0); } while (0)
#define PG8_WAIT_V(n) asm volatile("s_waitcnt vmcnt(" #n ")" ::: "memory")
#define PG8_WAIT_L(n) asm volatile("s_waitcnt lgkmcnt(" #n ")" ::: "memory")
#define PG8_BAR __builtin_amdgcn_s_barrier()
#define PG8_SCHED __builtin_amdgcn_sched_barrier(0)
#define PG8_ZERO() do { _Pragma("unroll") for (int a = 0; a < 2; ++a) _Pragma("unroll") for (int b = 0; b < 2; ++b) _Pragma("unroll") for (int m = 0; m < 4; ++m) _Pragma("unroll") for (int n = 0; n < 2; ++n) acc[a][b][m][n] = (f32x4){0.f, 0.f, 0.f, 0.f}; } while (0)
    Unit cur, nxt; int ui = 0;
    if (!S.next(0, cur)) return;
    E.pre(cur, wr, wc, fr, fq);
    f32x4 acc[2][2][4][2];
    PG8_ZERO();
    bf16x8 At[4][2], B0[2][2], B1[2][2];
    const char* cA = cur.a; const char* cB = cur.b;
    PG8_STAGE(PG8_SB(0, 0), cB, voffB); PG8_STAGE(PG8_SA(0, 0), cA, voffA); PG8_STAGE(PG8_SB(0, 1), cB + hstepB, voffB); PG8_STAGE(PG8_SA(0, 1), cA + hstepA, voffA);
    if (wr == 1) PG8_BAR;
    PG8_WAIT_V(4); PG8_BAR;
    PG8_STAGE(PG8_SB(1, 0), cB + kstep, voffB); PG8_STAGE(PG8_SA(1, 0), cA + kstep, voffA); PG8_STAGE(PG8_SB(1, 1), cB + hstepB + kstep, voffB);
    PG8_WAIT_V(6); PG8_BAR;
    for (;;) {
        const bool has_next = S.next(ui + 1, nxt);
        const char* nA = has_next ? nxt.a : cA; const char* nB = has_next ? nxt.b : cB;
#pragma unroll 1
        for (int t = 0; t < nt; t += 2) {
            const bool last = (t == nt - 2);
            const char* a1 = cA + (size_t)(t + 1) * kstep;
            const char* a2 = last ? nA : cA + (size_t)(t + 2) * kstep; const char* b2 = last ? nB : cB + (size_t)(t + 2) * kstep;
            const char* a3 = a2 + kstep; const char* b3 = b2 + kstep;
            PG8_LDB(B0, 0, 0); PG8_SCHED; PG8_LDA(At, 0, 0); PG8_STAGE(PG8_SA(1, 1), a1 + hstepA, voffA);
            PG8_WAIT_L(8); PG8_BAR; PG8_WAIT_L(0); PG8_MMA(0, 0, At, B0); PG8_BAR; PG8_SCHED;
            PG8_LDB(B1, 0, 1); PG8_STAGE(PG8_SB(0, 0), b2, voffB);
            PG8_BAR; PG8_WAIT_L(0); PG8_MMA(0, 1, At, B1); PG8_BAR;
            PG8_LDA(At, 0, 1); PG8_STAGE(PG8_SA(0, 0), a2, voffA);
            PG8_BAR; PG8_WAIT_L(0); PG8_MMA(1, 0, At, B0); PG8_BAR; PG8_SCHED;
            PG8_STAGE(PG8_SB(0, 1), b2 + hstepB, voffB);
            PG8_WAIT_V(6); PG8_BAR; PG8_MMA(1, 1, At, B1); PG8_BAR;
            PG8_LDB(B0, 1, 0); PG8_SCHED; PG8_LDA(At, 1, 0); PG8_STAGE(PG8_SA(0, 1), a2 + hstepA, voffA);
            PG8_WAIT_L(8); PG8_BAR; PG8_WAIT_L(0); PG8_MMA(0, 0, At, B0); PG8_BAR; PG8_SCHED;
            PG8_LDB(B1, 1, 1); PG8_STAGE(PG8_SB(1, 0), b3, voffB);
            PG8_BAR; PG8_WAIT_L(0); PG8_MMA(0, 1, At, B1); PG8_BAR;
            PG8_LDA(At, 1, 1); PG8_STAGE(PG8_SA(1, 0), a3, voffA);
            PG8_BAR; PG8_WAIT_L(0); PG8_MMA(1, 0, At, B0); PG8_BAR; PG8_SCHED;
            PG8_STAGE(PG8_SB(1, 1), b3 + hstepB, voffB);
            PG8_WAIT_V(6); PG8_BAR; PG8_MMA(1, 1, At, B1); PG8_BAR;
        }
        if (cur.cont) { E.mid(acc, cur, wr, wc, fr, fq); }
        else { if constexpr (!Epi::AFTER_DRAIN) E(acc, cur, wr, wc, fr, fq); if (!has_next) break; PG8_ZERO(); }
        cur = nxt; cA = nA; cB = nB; ++ui;
    }
    PG8_WAIT_V(0);
    if (wr == 0) PG8_BAR;
    PG8_BAR;
    if constexpr (Epi::AFTER_DRAIN) E(acc, cur, wr, wc, fr, fq);
#undef PG8_SA
#undef PG8_SB
#undef PG8_STAGE
#undef PG8_LDA
#undef PG8_LDB
#undef PG8_MMA
#undef PG8_WAIT_V
#undef PG8_WAIT_L
#undef PG8_BAR
#undef PG8_SCHED
#undef PG8_ZERO
}

typedef f32x4 Acc[2][2][4][2];
#define EPI_ROWS(ai, m) _Pragma("unroll") for (int ai = 0; ai < 2; ++ai) _Pragma("unroll") for (int m = 0; m < 4; ++m) if (epi_fence())
__device__ __forceinline__ bool epi_fence() { asm volatile("" ::: "memory"); return true; }
#define EPI_R8 _Pragma("unroll") for (int r8 = 0; r8 < 8; ++r8)
#define EPI_RL(ai, m) ((ai) * 128 + wr * 64 + (m) * 16 + fr)
#define EPI_CL(bj) ((bj) * 128 + wc * 32 + 8 * fq)

struct SchedP1 { const char* hb; const char* wint; int G, c;
    __device__ __forceinline__ bool next(int i, Unit& u) const {
        const int L = i * G + c; if (L >= 768) return false;
        u.cont = 0;
        if (L < 512) { int pm, pn; tile_order(L, 64, 8, pm, pn); u.pm = pm; u.pn = pn; u.kind = 0; u.a = hb + (size_t)pm * 256 * 1024 * 2; u.b = wint + (size_t)pn * 256 * 1024 * 2; }
        else { const int l = L - 512; u.pm = l & 3; u.pn = l >> 2; u.kind = 1; u.a = wint + (size_t)(2048 + u.pm * 256) * 1024 * 2; u.b = hb + (size_t)u.pn * 256 * 1024 * 2; }
        return true; } };
struct EpiP1 { static constexpr bool AFTER_DRAIN = false; bf16_t* qkpre; bf16_t* vt; const float* rsb;
    __device__ __forceinline__ void mid(Acc&, const Unit&, int, int, int, int) const {}
    __device__ __forceinline__ void pre(const Unit&, int, int, int, int) const {}
    __device__ __forceinline__ void operator()(Acc& acc, const Unit& u, int wr, int wc, int fr, int fq) const {
        if (u.kind == 0) {
            bf16_t* base = qkpre + (size_t)u.pm * 256 * 2048 + u.pn * 256; float rv[2][4];
#pragma unroll
            for (int ai = 0; ai < 2; ++ai)
#pragma unroll
                for (int m = 0; m < 4; ++m) rv[ai][m] = rsb[u.pm * 256 + EPI_RL(ai, m)];
            EPI_ROWS(ai, m) { bf16_t* rowp = base + (size_t)EPI_RL(ai, m) * 2048 + EPI_CL(0);
#pragma unroll
                for (int bj = 0; bj < 2; ++bj) *(u32x4*)(rowp + bj * 128) = pack8(acc[ai][bj][m][0] * rv[ai][m], acc[ai][bj][m][1] * rv[ai][m]); }
        } else {
            const int item = ((u.pn >> 3) * 4 + u.pm) * 8 + (u.pn & 7); bf16_t* base = vt + (size_t)item * 65536; f32x4 cv[2][2];
#pragma unroll
            for (int bj = 0; bj < 2; ++bj) { cv[bj][0] = *(const f32x4*)(rsb + u.pn * 256 + EPI_CL(bj)); cv[bj][1] = *(const f32x4*)(rsb + u.pn * 256 + EPI_CL(bj) + 4); }
            EPI_ROWS(ai, m) { bf16_t* rowp = base + (size_t)EPI_RL(ai, m) * 256 + EPI_CL(0);
#pragma unroll
                for (int bj = 0; bj < 2; ++bj) *(u32x4*)(rowp + bj * 128) = pack8(acc[ai][bj][m][0] * cv[bj][0], acc[ai][bj][m][1] * cv[bj][1]); }
        }
    } };

struct SchedP3 { const char* wq; const char* kw; const char* vt; const char* kwt; int G, c;
    __device__ __forceinline__ bool next(int i, Unit& u) const {
        const int L = i * G + c; if (L >= 512) return false;
        u.cont = 0; u.pn = 0;
        if (L < 256) { u.pm = L; u.kind = 0; u.a = wq + (size_t)L * 131072; u.b = kw + (size_t)L * 131072; }
        else { const int it = L - 256; u.pm = it; u.kind = 1; u.a = vt + (size_t)it * 131072; u.b = kwt + (size_t)it * 131072; }
        return true; } };
struct EpiP3 { static constexpr bool AFTER_DRAIN = false; bf16_t* s; bf16_t* lt; float* deni;
    __device__ __forceinline__ void mid(Acc&, const Unit&, int, int, int, int) const {}
    __device__ __forceinline__ void pre(const Unit&, int, int, int, int) const {}
    __device__ __forceinline__ void operator()(Acc& acc, const Unit& u, int wr, int wc, int fr, int fq) const {
        const int item = u.pm;
        if (u.kind == 0) {
            const int b = item >> 5, h = (item >> 3) & 3, sc = item & 7; const int tokb = b * SEQ_ + sc * 256;
            EPI_ROWS(ai, m) { int r = EPI_RL(ai, m); asm volatile("" : "+v"(r)); float rs = 0.f;
#pragma unroll
                for (int bj = 0; bj < 2; ++bj) { const int c0 = EPI_CL(bj); f32x4 v0 = acc[ai][bj][m][0], v1 = acc[ai][bj][m][1];
#pragma unroll
                    for (int j = 0; j < 4; ++j) { v0[j] = (c0 + j <= r) ? v0[j] : 0.f; v1[j] = (c0 + 4 + j <= r) ? v1[j] : 0.f; rs += v0[j] + v1[j]; }
                    *(u32x4*)(s + (size_t)item * 65536 + r * 256 + c0) = pack8(v0, v1); }
                rs += __shfl_xor(rs, 16); rs += __shfl_xor(rs, 32);
                if (fq == 0) unsafeAtomicAdd(deni + (size_t)(tokb + r) * 4 + h, rs); }
        } else {
            EPI_ROWS(ai, m) { bf16_t* rowp = lt + (size_t)item * 65536 + EPI_RL(ai, m) * 256 + EPI_CL(0);
#pragma unroll
                for (int bj = 0; bj < 2; ++bj) *(u32x4*)(rowp + bj * 128) = pack8(acc[ai][bj][m][0], acc[ai][bj][m][1]); }
        }
    } };

struct SchedP5 { const char* s; const char* vt; const char* wq; const char* cint; int G, c;
    __device__ __forceinline__ bool next(int i, Unit& u) const {
        const int item = (i >> 1) * G + c; if (item >= 256) return false;
        u.pm = item; u.pn = 0; u.kind = 0;
        if ((i & 1) == 0) { u.cont = 1; u.a = s + (size_t)item * 131072; u.b = vt + (size_t)item * 131072; }
        else { u.cont = 0; u.a = wq + (size_t)item * 131072; u.b = cint + (size_t)item * 131072; }
        return true; } };
struct EpiP5 { static constexpr bool AFTER_DRAIN = false; bf16_t* hm; const float* deni; const float* denx; float* hss;
    __device__ __forceinline__ void mid(Acc&, const Unit&, int, int, int, int) const {}
    __device__ __forceinline__ void pre(const Unit&, int, int, int, int) const {}
    __device__ __forceinline__ void operator()(Acc& acc, const Unit& u, int wr, int wc, int fr, int fq) const {
        const int item = u.pm; const int b = item >> 5, h = (item >> 3) & 3, sc = item & 7; const int tokb = b * SEQ_ + sc * 256;
        float dnv[2][4];
#pragma unroll
        for (int ai = 0; ai < 2; ++ai)
#pragma unroll
            for (int m = 0; m < 4; ++m) { const int t = tokb + EPI_RL(ai, m); dnv[ai][m] = deni[(size_t)t * 4 + h] + denx[(size_t)t * 4 + h]; }
        EPI_ROWS(ai, m) { const int t = tokb + EPI_RL(ai, m);
            const float den = dnv[ai][m]; const float inv = __builtin_amdgcn_rcpf(fmaxf(fabsf(den), 1.0f)); float ss = 0.f;
#pragma unroll
            for (int bj = 0; bj < 2; ++bj) { f32x4 v0 = acc[ai][bj][m][0] * inv, v1 = acc[ai][bj][m][1] * inv;
#pragma unroll
                for (int j = 0; j < 4; ++j) ss += v0[j] * v0[j] + v1[j] * v1[j];
                *(u32x4*)(hm + (size_t)t * 1024 + h * 256 + EPI_CL(bj)) = pack8(v0, v1); }
            ss += __shfl_xor(ss, 16); ss += __shfl_xor(ss, 32);
            if (fq == 0) unsafeAtomicAdd(hss + (size_t)t * 4 + h, ss); }
    } };

struct SchedP6 { const char* hb; const char* wint; int G, c;
    __device__ __forceinline__ bool next(int i, Unit& u) const {
        u.cont = 0;
        if (i == 0) { const int item = c; if (item >= 256) return false; const int b = item >> 5, h = (item >> 3) & 3, sc = item & 7;
            u.pm = b * 8 + sc; u.pn = h; u.kind = 0; u.a = hb + (size_t)u.pm * 256 * 1024 * 2; u.b = wint + (size_t)(3072 + h * 256) * 1024 * 2; return true; }
        const int L = (i - 1) * G + c; if (L >= 512) return false;
        int pm, pn; tile_order(L, 64, 8, pm, pn); u.pm = pm; u.pn = pn; u.kind = 1;
        u.a = hb + (size_t)pm * 256 * 1024 * 2; u.b = wint + (size_t)(4096 + pn * 256) * 1024 * 2; return true; } };
struct EpiP6 { static constexpr bool AFTER_DRAIN = false; bf16_t* hm; float* hss; const float* rsb; bf16_t* uu;
    __device__ __forceinline__ void mid(Acc&, const Unit&, int, int, int, int) const {}
    __device__ __forceinline__ void pre(const Unit&, int, int, int, int) const {}
    __device__ __forceinline__ void operator()(Acc& acc, const Unit& u, int wr, int wc, int fr, int fq) const {
        if (u.kind == 0) {
            float hsv[2][4], rxv[2][4];
#pragma unroll
            for (int ai = 0; ai < 2; ++ai)
#pragma unroll
                for (int m = 0; m < 4; ++m) rxv[ai][m] = rsb[u.pm * 256 + EPI_RL(ai, m)];
#pragma unroll
            for (int ai = 0; ai < 2; ++ai)
#pragma unroll
                for (int m = 0; m < 4; ++m) hsv[ai][m] = __hip_atomic_load(hss + (size_t)(u.pm * 256 + EPI_RL(ai, m)) * 4 + u.pn, __ATOMIC_RELAXED, __HIP_MEMORY_SCOPE_AGENT);
            u32x4 cur[2], nxt[2];
#pragma unroll
            for (int bj = 0; bj < 2; ++bj) cur[bj] = *(const u32x4*)(hm + (size_t)(u.pm * 256 + EPI_RL(0, 0)) * 1024 + u.pn * 256 + EPI_CL(bj));
            EPI_R8 { const int ai = r8 >> 2, m = r8 & 3; const int t = u.pm * 256 + EPI_RL(ai, m);
                if (r8 < 7) { const int tn = u.pm * 256 + EPI_RL((r8 + 1) >> 2, (r8 + 1) & 3);
#pragma unroll
                    for (int bj = 0; bj < 2; ++bj) nxt[bj] = *(const u32x4*)(hm + (size_t)tn * 1024 + u.pn * 256 + EPI_CL(bj)); }
                const float rsn = rsqrtf(hsv[ai][m] * (1.0f / 256.0f) + EPS_); const float rx = rxv[ai][m];
#pragma unroll
                for (int bj = 0; bj < 2; ++bj) { f32x4 h0, h1; unpack8(cur[bj], h0, h1); f32x4 o0, o1;
#pragma unroll
                    for (int j = 0; j < 4; ++j) { o0[j] = h0[j] * rsn * sigm(acc[ai][bj][m][0][j] * rx); o1[j] = h1[j] * rsn * sigm(acc[ai][bj][m][1][j] * rx); }
                    *(u32x4*)(hm + (size_t)t * 1024 + u.pn * 256 + EPI_CL(bj)) = pack8(o0, o1); }
                cur[0] = nxt[0]; cur[1] = nxt[1]; }
        } else {
            float rxv[2][4];
#pragma unroll
            for (int ai = 0; ai < 2; ++ai)
#pragma unroll
                for (int m = 0; m < 4; ++m) rxv[ai][m] = rsb[u.pm * 256 + EPI_RL(ai, m)];
            EPI_ROWS(ai, m) { const int t = u.pm * 256 + EPI_RL(ai, m); const float rx = rxv[ai][m]; f32x4 o0, o1;
#pragma unroll
                for (int j = 0; j < 4; ++j) { o0[j] = acc[ai][0][m][0][j] * rx * sigm(acc[ai][1][m][0][j] * rx); o1[j] = acc[ai][0][m][1][j] * rx * sigm(acc[ai][1][m][1][j] * rx); }
                *(u32x4*)(uu + (size_t)t * 1024 + u.pn * 128 + wc * 32 + 8 * fq) = pack8(o0, o1); }
        }
    } };

struct SchedP8 { const char* hb; const char* wint; const char* hmg; const char* uc; const char* wmt; const char* wct; int G, c;
    __device__ __forceinline__ bool next(int i, Unit& u) const {
        const int L = (i >> 2) * G + c, r = i & 3; if (L >= 256) return false;
        int pn; map_n4(L, u.pm, pn); u.cont = 0;
        if (r < 2) { u.kind = 2; u.pn = 2 * pn + r; u.a = hb + (size_t)u.pm * 256 * 1024 * 2; u.b = wint + (size_t)(6144 + u.pn * 256) * 1024 * 2; }
        else if (r == 2) { u.kind = 0; u.pn = pn; u.a = hmg + (size_t)u.pm * 256 * 1024 * 2; u.b = wmt + (size_t)pn * 256 * 1024 * 2; }
        else { u.kind = 1; u.pn = pn; u.a = uc + (size_t)u.pm * 256 * 1024 * 2; u.b = wct + (size_t)pn * 256 * 1024 * 2; }
        return true; } };
struct EpiP8 { static constexpr bool AFTER_DRAIN = false; bf16_t* gmc; bf16_t* tmp; bf16_t* merged; const float* rsb;
    __device__ __forceinline__ void mid(Acc&, const Unit&, int, int, int, int) const {}
    __device__ __forceinline__ void pre(const Unit&, int, int, int, int) const {}
    __device__ __forceinline__ void operator()(Acc& acc, const Unit& u, int wr, int wc, int fr, int fq) const {
        if (u.kind == 2) {
            float rxv[2][4];
#pragma unroll
            for (int ai = 0; ai < 2; ++ai)
#pragma unroll
                for (int m = 0; m < 4; ++m) rxv[ai][m] = rsb[u.pm * 256 + EPI_RL(ai, m)];
            EPI_ROWS(ai, m) { const int t = u.pm * 256 + EPI_RL(ai, m); const float rx = rxv[ai][m], rxe = rx * -1.4426950408889634f; f32x4 r0, r1, c0, c1;
#pragma unroll
                for (int j = 0; j < 4; ++j) { const float e0 = __builtin_amdgcn_exp2f(acc[ai][1][m][0][j] * rxe), e1 = __builtin_amdgcn_exp2f(acc[ai][1][m][1][j] * rxe);
                    r0[j] = sigm(acc[ai][0][m][0][j] * rx) * (1.0f + e0); r1[j] = sigm(acc[ai][0][m][1][j] * rx) * (1.0f + e1);
                    c0[j] = __builtin_amdgcn_rcpf(1.0f + e0); c1[j] = __builtin_amdgcn_rcpf(1.0f + e1); }
                bf16_t* ptr = gmc + (size_t)t * 2048 + u.pn * 128 + wc * 32 + 8 * fq;
                *(u32x4*)ptr = pack8(r0, r1); *(u32x4*)(ptr + 1024) = pack8(c0, c1); }
        } else if (u.kind == 0) {
            u32x4 cur[2], nxt[2];
#pragma unroll
            for (int bj = 0; bj < 2; ++bj) cur[bj] = *(const u32x4*)(gmc + (size_t)(u.pm * 256 + EPI_RL(0, 0)) * 2048 + u.pn * 256 + EPI_CL(bj));
            EPI_R8 { const int ai = r8 >> 2, m = r8 & 3; const int t = u.pm * 256 + EPI_RL(ai, m);
                if (r8 < 7) { const int tn = u.pm * 256 + EPI_RL((r8 + 1) >> 2, (r8 + 1) & 3);
#pragma unroll
                    for (int bj = 0; bj < 2; ++bj) nxt[bj] = *(const u32x4*)(gmc + (size_t)tn * 2048 + u.pn * 256 + EPI_CL(bj)); }
#pragma unroll
                for (int bj = 0; bj < 2; ++bj) { const int c = u.pn * 256 + EPI_CL(bj); f32x4 a0, a1; unpack8(cur[bj], a0, a1);
                    *(u32x4*)(tmp + (size_t)t * 1024 + c) = pack8(acc[ai][bj][m][0] * a0, acc[ai][bj][m][1] * a1); }
                cur[0] = nxt[0]; cur[1] = nxt[1]; }
        } else {
            u32x4 cg[2], ct[2], ng[2], nt2[2];
#pragma unroll
            for (int bj = 0; bj < 2; ++bj) { const int t0 = u.pm * 256 + EPI_RL(0, 0); const int c = u.pn * 256 + EPI_CL(bj);
                cg[bj] = *(const u32x4*)(gmc + (size_t)t0 * 2048 + 1024 + c); ct[bj] = *(const u32x4*)(tmp + (size_t)t0 * 1024 + c); }
            EPI_R8 { const int ai = r8 >> 2, m = r8 & 3; const int t = u.pm * 256 + EPI_RL(ai, m);
                if (r8 < 7) { const int tn = u.pm * 256 + EPI_RL((r8 + 1) >> 2, (r8 + 1) & 3);
#pragma unroll
                    for (int bj = 0; bj < 2; ++bj) { const int c = u.pn * 256 + EPI_CL(bj); ng[bj] = *(const u32x4*)(gmc + (size_t)tn * 2048 + 1024 + c); nt2[bj] = *(const u32x4*)(tmp + (size_t)tn * 1024 + c); } }
#pragma unroll
                for (int bj = 0; bj < 2; ++bj) { const int c = u.pn * 256 + EPI_CL(bj); f32x4 b0, b1, t0, t1; unpack8(cg[bj], b0, b1); unpack8(ct[bj], t0, t1);
                    *(u32x4*)(merged + (size_t)t * 1024 + c) = pack8((acc[ai][bj][m][0] + t0) * b0, (acc[ai][bj][m][1] + t1) * b1); }
                cg[0] = ng[0]; cg[1] = ng[1]; ct[0] = nt2[0]; ct[1] = nt2[1]; }
        }
    } };

struct SchedN4 { const char* a; const char* bt; size_t astep, bstep; int G, c;
    __device__ __forceinline__ bool next(int i, Unit& u) const {
        const int L = i * G + c; if (L >= 256) return false;
        map_n4(L, u.pm, u.pn); u.kind = 0; u.cont = 0; u.a = a + (size_t)u.pm * astep; u.b = bt + (size_t)u.pn * bstep; return true; } };
struct SchedPE { const char* a; const char* bt; int G, c;
    __device__ __forceinline__ bool next(int i, Unit& u) const {
        const int L = i * G + c; if (L >= 256 || c < 0) return false;
        u.pm = L >> 2; u.pn = L & 3; u.kind = 0; u.cont = 0; u.a = a + (size_t)u.pm * 256 * 256 * 2; u.b = bt + (size_t)u.pn * 256 * 256 * 2; return true; } };
template <bool SRC_BF16> struct EpiRes { static constexpr bool AFTER_DRAIN = false; const void* src; bf16_t* dstb; float* ssq;
    __device__ __forceinline__ void mid(Acc&, const Unit&, int, int, int, int) const {}
    __device__ __forceinline__ void pre(const Unit& u, int wr, int wc, int fr, int fq) const {
        if (!SRC_BF16) {
            EPI_ROWS(ai, m) { const int t = u.pm * 256 + EPI_RL(ai, m);
#pragma unroll
                for (int bj = 0; bj < 2; ++bj) { const float v = *((const float*)src + (size_t)t * 1024 + u.pn * 256 + EPI_CL(bj)); asm volatile("" :: "v"(v)); } }
        }
    }
    __device__ __forceinline__ void operator()(Acc& acc, const Unit& u, int wr, int wc, int fr, int fq) const {
        f32x4 rb[3][2][2];
#define ERES_LOAD(dst, t_) do { _Pragma("unroll") for (int bj = 0; bj < 2; ++bj) { const size_t o_ = (size_t)(t_) * 1024 + u.pn * 256 + EPI_CL(bj); \
            if (SRC_BF16) dst[bj][0] = __builtin_bit_cast(f32x4, *(const u32x4*)((const bf16_t*)src + o_)); \
            else { dst[bj][0] = *(const f32x4*)((const float*)src + o_); dst[bj][1] = *(const f32x4*)((const float*)src + o_ + 4); } } } while (0)
        ERES_LOAD(rb[0], u.pm * 256 + EPI_RL(0, 0)); ERES_LOAD(rb[1], u.pm * 256 + EPI_RL(0, 1));
        EPI_R8 { const int ai = r8 >> 2, m = r8 & 3; const int t = u.pm * 256 + EPI_RL(ai, m); float ss = 0.f;
            if (r8 < 6) ERES_LOAD(rb[(r8 + 2) % 3], u.pm * 256 + EPI_RL((r8 + 2) >> 2, (r8 + 2) & 3));
#pragma unroll
            for (int bj = 0; bj < 2; ++bj) { const size_t o = (size_t)t * 1024 + u.pn * 256 + EPI_CL(bj); f32x4 v0, v1;
                if (SRC_BF16) unpack8(__builtin_bit_cast(u32x4, rb[r8 % 3][bj][0]), v0, v1); else { v0 = rb[r8 % 3][bj][0]; v1 = rb[r8 % 3][bj][1]; }
                v0 += acc[ai][bj][m][0]; v1 += acc[ai][bj][m][1];
#pragma unroll
                for (int j = 0; j < 4; ++j) ss += v0[j] * v0[j] + v1[j] * v1[j];
                *(u32x4*)(dstb + o) = pack8(v0, v1); }
            ss += __shfl_xor(ss, 16); ss += __shfl_xor(ss, 32);
            if (fq == 0) unsafeAtomicAdd(ssq + t, ss); }
#undef ERES_LOAD
    } };

struct SchedP10 { const char* x1b; const char* wgut; int G, c;
    __device__ __forceinline__ bool next(int i, Unit& u) const {
        const int L = i * G + c; if (L >= 1408) return false;
        int pm, pn; tile_order(L, 64, 22, pm, pn); u.pm = pm; u.pn = pn; u.kind = 0; u.cont = 0;
        u.a = x1b + (size_t)pm * 256 * 1024 * 2; u.b = wgut + (size_t)pn * 256 * 1024 * 2; return true; } };
struct EpiP10 { static constexpr bool AFTER_DRAIN = false; const float* ssq; bf16_t* hid;
    __device__ __forceinline__ void mid(Acc&, const Unit&, int, int, int, int) const {}
    __device__ __forceinline__ void pre(const Unit&, int, int, int, int) const {}
    __device__ __forceinline__ void operator()(Acc& acc, const Unit& u, int wr, int wc, int fr, int fq) const {
        float rsv[2][4];
#pragma unroll
        for (int ai = 0; ai < 2; ++ai)
#pragma unroll
            for (int m = 0; m < 4; ++m) rsv[ai][m] = ssq[u.pm * 256 + EPI_RL(ai, m)];
        EPI_ROWS(ai, m) { const int t = u.pm * 256 + EPI_RL(ai, m); const float rs = rsqrtf(rsv[ai][m] * (1.0f / 1024.0f) + EPS_); f32x4 o0, o1;
#pragma unroll
            for (int j = 0; j < 4; ++j) { o0[j] = silu(acc[ai][0][m][0][j] * rs) * (acc[ai][1][m][0][j] * rs); o1[j] = silu(acc[ai][0][m][1][j] * rs) * (acc[ai][1][m][1][j] * rs); }
            *(u32x4*)(hid + (size_t)t * DFF_ + u.pn * 128 + wc * 32 + 8 * fq) = pack8(o0, o1); }
    } };

struct EpiBf { static constexpr bool AFTER_DRAIN = false; bf16_t* o;
    __device__ __forceinline__ void mid(Acc&, const Unit&, int, int, int, int) const {}
    __device__ __forceinline__ void pre(const Unit&, int, int, int, int) const {}
    __device__ __forceinline__ void operator()(Acc& acc, const Unit& u, int wr, int wc, int fr, int fq) const {
        EPI_ROWS(ai, m) { bf16_t* rowp = o + (size_t)(u.pm * 256 + EPI_RL(ai, m)) * 1024 + u.pn * 256 + EPI_CL(0);
#pragma unroll
            for (int bj = 0; bj < 2; ++bj) *(u32x4*)(rowp + bj * 128) = pack8(acc[ai][bj][m][0], acc[ai][bj][m][1]); }
    } };

struct EpiP12 { static constexpr bool AFTER_DRAIN = true; const float* ssq2; const bf16_t* pe; const bf16_t* xin; float* out; float* ssq3; unsigned* done; const float* fg;
    __device__ __forceinline__ void mid(Acc&, const Unit&, int, int, int, int) const {}
    __device__ __forceinline__ void pre(const Unit&, int, int, int, int) const {}
    __device__ __forceinline__ void operator()(Acc& acc, const Unit& u, int wr, int wc, int fr, int fq) const {
        float rsv[2][4];
#pragma unroll
        for (int ai = 0; ai < 2; ++ai)
#pragma unroll
            for (int m = 0; m < 4; ++m) rsv[ai][m] = ssq2[u.pm * 256 + EPI_RL(ai, m)];
        { u32x4 cx[2], cp[2], nx[2], np[2];
#pragma unroll
            for (int bj = 0; bj < 2; ++bj) { const size_t o = (size_t)(u.pm * 256 + EPI_RL(0, 0)) * 1024 + u.pn * 256 + EPI_CL(bj); cx[bj] = *(const u32x4*)(xin + o); cp[bj] = *(const u32x4*)(pe + o); }
            EPI_R8 { const int ai = r8 >> 2, m = r8 & 3; const int t = u.pm * 256 + EPI_RL(ai, m); const float rs = rsqrtf(rsv[ai][m] * (1.0f / 1024.0f) + EPS_); float ss = 0.f;
                if (r8 < 7) {
#pragma unroll
                    for (int bj = 0; bj < 2; ++bj) { const size_t o = (size_t)(u.pm * 256 + EPI_RL((r8 + 1) >> 2, (r8 + 1) & 3)) * 1024 + u.pn * 256 + EPI_CL(bj); nx[bj] = *(const u32x4*)(xin + o); np[bj] = *(const u32x4*)(pe + o); } }
#pragma unroll
                for (int bj = 0; bj < 2; ++bj) { f32x4 p0, p1, v0, v1; unpack8(cp[bj], p0, p1); unpack8(cx[bj], v0, v1);
#pragma unroll
                    for (int j = 0; j < 4; ++j) { v0[j] += sigm(acc[ai][bj][m][0][j] * rs) * p0[j]; v1[j] += sigm(acc[ai][bj][m][1][j] * rs) * p1[j]; ss += v0[j] * v0[j] + v1[j] * v1[j]; }
                    acc[ai][bj][m][0] = v0; acc[ai][bj][m][1] = v1; }
                ss += __shfl_xor(ss, 16); ss += __shfl_xor(ss, 32);
                if (fq == 0) unsafeAtomicAdd(ssq3 + t, ss);
                cx[0] = nx[0]; cx[1] = nx[1]; cp[0] = np[0]; cp[1] = np[1]; } }
        asm volatile("s_waitcnt vmcnt(0)" ::: "memory");
        unsigned* cnt = done + 64 * u.pm;
        if ((threadIdx.x & 63) == 0) __hip_atomic_fetch_add(cnt, 1u, __ATOMIC_RELAXED, __HIP_MEMORY_SCOPE_AGENT);
        { unsigned sp = 0; while (__hip_atomic_load(cnt, __ATOMIC_RELAXED, __HIP_MEMORY_SCOPE_AGENT) < 32u) { __builtin_amdgcn_s_sleep(1); if (++sp > (1u << 22)) break; } }
#pragma unroll
        for (int ai = 0; ai < 2; ++ai)
#pragma unroll
            for (int m = 0; m < 4; ++m) rsv[ai][m] = __hip_atomic_load(ssq3 + u.pm * 256 + EPI_RL(ai, m), __ATOMIC_RELAXED, __HIP_MEMORY_SCOPE_AGENT);
        f32x4 gv[2][2];
#pragma unroll
        for (int bj = 0; bj < 2; ++bj) { const int cc = u.pn * 256 + EPI_CL(bj); gv[bj][0] = *(const f32x4*)(fg + cc); gv[bj][1] = *(const f32x4*)(fg + cc + 4); }
        EPI_ROWS(ai, m) { const int t = u.pm * 256 + EPI_RL(ai, m);
            const float rs = rsqrtf(rsv[ai][m] * (1.0f / 1024.0f) + EPS_);
#pragma unroll
            for (int bj = 0; bj < 2; ++bj) { const size_t o = (size_t)t * 1024 + u.pn * 256 + EPI_CL(bj);
                *(f32x4*)(out + o) = acc[ai][bj][m][0] * rs * gv[bj][0]; *(f32x4*)(out + o + 4) = acc[ai][bj][m][1] * rs * gv[bj][1]; } }
    } };

struct CvtTile { const float* src; int ld; const float* scale; bf16_t* dst; int dstld; };
__device__ __forceinline__ CvtTile cvt_tile_params(const Params& p, int tl) {
    const int NT0 = 2048, NT4 = NT0 + 1024, NT5 = NT4 + 1408, NT6 = NT5 + 704;
    unsigned char* ws = p.ws; CvtTile t; t.scale = nullptr;
    if (tl < NT0) { const int nb = tl >> 4, kb = tl & 15; const int n0 = nb * 64; int col;
        if (n0 < 4096) col = n0; else if (n0 < 6144) { const int j = (n0 - 4096) >> 8, r = (n0 - 4096) & 255; col = (r < 128) ? (4104 + 128 * j + r) : (5128 + 128 * j + r - 128); }
        else { const int j = (n0 - 6144) >> 8, r = (n0 - 6144) & 255; col = 6152 + ((r < 128) ? (128 * j + r) : (1024 + 128 * j + r - 128)); }
        t.src = p.in[3] + (size_t)kb * 64 * NIN_ + col; t.ld = NIN_; t.scale = p.in[2] + kb * 64; t.dst = (bf16_t*)(ws + O_WINT) + (size_t)n0 * 1024 + kb * 64; t.dstld = 1024; }
    else if (tl < NT4) { const int w = (tl - NT0) >> 8, l = (tl - NT0) & 255; const int nb = l >> 4, kb = l & 15;
        const float* base = w == 0 ? p.in[12] : (w == 1 ? p.in[13] : (w == 2 ? p.in[14] : p.in[20])); const size_t od = w == 0 ? O_WMT : (w == 1 ? O_WCT : (w == 2 ? O_WOT : O_WPGT));
        t.src = base + (size_t)kb * 64 * 1024 + nb * 64; t.ld = 1024; if (w == 3) t.scale = p.in[19] + kb * 64; if (w == 0) t.scale = p.in[7] + kb * 64; t.dst = (bf16_t*)(ws + od) + (size_t)nb * 64 * 1024 + kb * 64; t.dstld = 1024; }
    else if (tl < NT5) { const int l = tl - NT4; const int nb = l >> 4, kb = l & 15; const int n0 = nb * 64; const int j = n0 >> 8, r = n0 & 255;
        const float* base = (r < 128) ? p.in[16] : p.in[17]; const int col = 128 * j + (r & 127);
        t.src = base + (size_t)kb * 64 * DFF_ + col; t.ld = DFF_; t.scale = p.in[15] + kb * 64; t.dst = (bf16_t*)(ws + O_WGUT) + (size_t)n0 * 1024 + kb * 64; t.dstld = 1024; }
    else if (tl < NT6) { const int l = tl - NT5; const int nb = l / 44, kb = l % 44;
        t.src = p.in[18] + (size_t)kb * 64 * 1024 + nb * 64; t.ld = 1024; t.dst = (bf16_t*)(ws + O_WDT) + (size_t)nb * 64 * DFF_ + kb * 64; t.dstld = DFF_; }
    else { const int l = tl - NT6; const int nb = l >> 2, kb = l & 3;
        t.src = p.in[21] + (size_t)kb * 64 * 1024 + nb * 64; t.ld = 1024; t.dst = (bf16_t*)(ws + O_WPPT) + (size_t)nb * 64 * 256 + kb * 64; t.dstld = 256; }
    return t;
}
__device__ __forceinline__ void cvt_tile_load(const CvtTile& t, f32x4 (&v)[2]) {
    const int tid = threadIdx.x, kk = tid >> 4, c4 = (tid & 15) * 4;
#pragma unroll
    for (int pss = 0; pss < 2; ++pss) { const int k = kk + pss * 32; v[pss] = *(const f32x4*)(t.src + (size_t)k * t.ld + c4); if (t.scale) v[pss] = v[pss] * t.scale[k]; }
}

__device__ __forceinline__ void phase0(const Params& p, unsigned char* sm) {
    unsigned char* ws = p.ws;
    const int tid = threadIdx.x, lane = tid & 63, wid = tid >> 6;
    const size_t gtid = (size_t)blockIdx.x * 512 + tid, gthreads = (size_t)gridDim.x * 512;
    for (size_t i = gtid; i < ZERO_BYTES / 16; i += gthreads) ((u32x4*)(ws + O_ZERO))[i] = (u32x4){0u, 0u, 0u, 0u};
    { const float* pp = p.in[1]; bf16_t* pb = (bf16_t*)(ws + O_PB);
        for (size_t i = gtid; i < (size_t)T_ * 256 / 8; i += gthreads) { const f32x4 a = *(const f32x4*)(pp + i * 8), b = *(const f32x4*)(pp + i * 8 + 4); *(u32x4*)(pb + i * 8) = pack8(a, b); } }
    { const float* x = p.in[0]; const float* g = p.in[2]; const float* win = p.in[3]; const float* bif = p.in[4];
        float* wgT = (float*)sm;
        for (int idx = tid; idx < 8192; idx += 512) { const int k = idx >> 3, j = idx & 7; wgT[j * 1024 + k] = win[(size_t)k * NIN_ + 4096 + j] * g[k]; }
        __syncthreads();
        bf16_t* hb = (bf16_t*)(ws + O_HB); float* ig = (float*)(ws + O_IG); float* lf = (float*)(ws + O_LF);
        const int rstep = gridDim.x * 8; int row = blockIdx.x * 8 + wid;
        f32x4 xn[4];
#pragma unroll
        for (int i = 0; i < 4; ++i) xn[i] = (row < T_) ? *(const f32x4*)(x + (size_t)row * 1024 + i * 256 + lane * 4) : (f32x4){0.f, 0.f, 0.f, 0.f};
        for (; row < T_; row += rstep) {
            f32x4 xv[4]; float ss = 0.f;
#pragma unroll
            for (int i = 0; i < 4; ++i) { xv[i] = xn[i]; ss += xv[i][0] * xv[i][0] + xv[i][1] * xv[i][1] + xv[i][2] * xv[i][2] + xv[i][3] * xv[i][3]; }
            { const int nrow = row + rstep;
                if (nrow < T_) {
#pragma unroll
                    for (int i = 0; i < 4; ++i) xn[i] = *(const f32x4*)(x + (size_t)nrow * 1024 + i * 256 + lane * 4); } }
            ss = wave_sum(ss); const float rs = rsqrtf(ss * (1.0f / 1024.0f) + EPS_);
            float d[8];
#pragma unroll
            for (int j = 0; j < 8; ++j) d[j] = 0.f;
            if (lane == 0) ((float*)(ws + O_RS))[row] = rs;
#pragma unroll
            for (int i = 0; i < 4; ++i) { const f32x4 hn = xv[i] * rs;
                u32x2 w; w.x = cvt_pk_bf16(xv[i][0], xv[i][1]); w.y = cvt_pk_bf16(xv[i][2], xv[i][3]); *(u32x2*)(hb + (size_t)row * 1024 + i * 256 + lane * 4) = w;
#pragma unroll
                for (int j = 0; j < 8; ++j) { const f32x4 wv = *(const f32x4*)(wgT + j * 1024 + i * 256 + lane * 4); d[j] += hn[0] * wv[0] + hn[1] * wv[1] + hn[2] * wv[2] + hn[3] * wv[3]; } }
#pragma unroll
            for (int j = 0; j < 8; ++j) d[j] = wave_sum(d[j]);
            if (lane < 8) { float v = d[0];
#pragma unroll
                for (int j = 1; j < 8; ++j) v = (lane == j) ? d[j] : v;
                v += bif[lane];
                if (lane < 4) ig[(size_t)row * 4 + lane] = v;
                else { const float z = v; lf[(size_t)row * 4 + lane - 4] = fminf(z, 0.f) - log1pf(__expf(-fabsf(z))); } }
        }
        __syncthreads();
    }
    { const int NTILES = 2048 + 1024 + 1408 + 704 + 64; const int gs = gridDim.x;
        float* tl = (float*)sm;
        int t = blockIdx.x; CvtTile c0{}, c1{}; f32x4 v0[2], v1[2];
        if (t < NTILES) { c0 = cvt_tile_params(p, t); cvt_tile_load(c0, v0); }
        if (t + gs < NTILES) { c1 = cvt_tile_params(p, t + gs); cvt_tile_load(c1, v1); }
        for (; t < NTILES; t += gs) {
            { const int kk = tid >> 4, c4 = (tid & 15) * 4;
#pragma unroll
                for (int pss = 0; pss < 2; ++pss) { const int k = kk + pss * 32;
#pragma unroll
                    for (int j = 0; j < 4; ++j) tl[k * 65 + c4 + j] = v0[pss][j]; } }
            __syncthreads();
            const CvtTile done = c0; c0 = c1; v0[0] = v1[0]; v0[1] = v1[1];
            { const int tn = t + 2 * gs; if (tn < NTILES) { c1 = cvt_tile_params(p, tn); cvt_tile_load(c1, v1); } }
            { const int n = tid >> 3, k8 = (tid & 7) * 8; float e[8];
#pragma unroll
                for (int q = 0; q < 8; ++q) e[q] = tl[(k8 + q) * 65 + n];
                u32x4 w; w.x = cvt_pk_bf16(e[0], e[1]); w.y = cvt_pk_bf16(e[2], e[3]); w.z = cvt_pk_bf16(e[4], e[5]); w.w = cvt_pk_bf16(e[6], e[7]);
                *(u32x4*)(done.dst + (size_t)n * done.dstld + k8) = w; }
            __syncthreads();
        }
    }
}

__device__ __forceinline__ void phase2(const Params& p, unsigned char* sm) {
    unsigned char* ws = p.ws;
    const int tid = threadIdx.x, lane = tid & 63, wid = tid >> 6;
    float* rowfac = (float*)sm; float* colfac = rowfac + 256; float* wsum = colfac + 256;
    const float* ig = (const float*)(ws + O_IG); const float* lf = (const float*)(ws + O_LF);
    const bf16_t* qkpre = (const bf16_t*)p.out;
    const float* cw = p.in[5]; const float* cb = p.in[6];
    for (int item = blockIdx.x; item < 256; item += gridDim.x) {
        const int b = item >> 5, h = (item >> 3) & 3, sc = item & 7; const int tokb = b * SEQ_ + sc * 256;
        float v = 0.f, igv = 0.f;
        if (tid < 256) { v = lf[(size_t)(tokb + tid) * 4 + h]; igv = ig[(size_t)(tokb + tid) * 4 + h]; }
#pragma unroll
        for (int o = 1; o < 64; o <<= 1) { const float n = __shfl_up(v, o); if (lane >= o) v += n; }
        if (tid < 256 && lane == 63) wsum[wid] = v;
        __syncthreads();
        if (tid < 256) { float add = 0.f; for (int j = 0; j < wid; ++j) add += wsum[j]; v += add; rowfac[tid] = __expf(v); colfac[tid] = __expf(igv - v);
            if (tid == 255) ((float*)(ws + O_EBL))[item] = __expf(v); }
        __syncthreads();
#pragma unroll 1
        for (int qt = 0; qt < 4; ++qt) {
        const int cp = tid & 127, tg = tid >> 7; const int ch = 2 * cp; const int tl0 = qt * 64 + tg * 16; const int s0 = sc * 256 + tl0;
        { const int col = h * 256 + ch; float x0[19], x1[19];
#pragma unroll
            for (int i = 0; i < 19; ++i) { const int s = s0 - 3 + i; unsigned w = 0u; if (s >= 0) w = *(const unsigned*)(qkpre + (size_t)(b * SEQ_ + s) * 2048 + col); x0[i] = bf_lo(w); x1[i] = bf_hi(w); }
            float w0[4], w1[4];
#pragma unroll
            for (int k = 0; k < 4; ++k) { const f32x2 wv = *(const f32x2*)(cw + (size_t)k * 2048 + col); w0[k] = wv[0]; w1[k] = wv[1]; }
            const f32x2 bv = *(const f32x2*)(cb + col);
            bf16_t* wq = (bf16_t*)(ws + O_WQ) + (size_t)item * 65536;
#pragma unroll
            for (int i = 0; i < 16; ++i) { float y0 = bv[0], y1 = bv[1];
#pragma unroll
                for (int k = 0; k < 4; ++k) { y0 += x0[i + k] * w0[k]; y1 += x1[i + k] * w1[k]; }
                const float f = rowfac[tl0 + i] * 0.0625f;
                *(unsigned*)(wq + (size_t)(tl0 + i) * 256 + ch) = cvt_pk_bf16(silu(y0) * f, silu(y1) * f); } }
        { const int col = 1024 + h * 256 + ch; float x0[19], x1[19];
#pragma unroll
            for (int i = 0; i < 19; ++i) { const int s = s0 - 3 + i; unsigned w = 0u; if (s >= 0) w = *(const unsigned*)(qkpre + (size_t)(b * SEQ_ + s) * 2048 + col); x0[i] = bf_lo(w); x1[i] = bf_hi(w); }
            float w0[4], w1[4];
#pragma unroll
            for (int k = 0; k < 4; ++k) { const f32x2 wv = *(const f32x2*)(cw + (size_t)k * 2048 + col); w0[k] = wv[0]; w1[k] = wv[1]; }
            const f32x2 bv = *(const f32x2*)(cb + col);
            bf16_t* kw = (bf16_t*)(ws + O_KW) + (size_t)item * 65536; bf16_t* kwt = (bf16_t*)(ws + O_KWT) + (size_t)item * 65536;
            float k0[16], k1[16]; float n0 = 0.f, n1 = 0.f;
#pragma unroll
            for (int i = 0; i < 16; ++i) { float y0 = bv[0], y1 = bv[1];
#pragma unroll
                for (int k = 0; k < 4; ++k) { y0 += x0[i + k] * w0[k]; y1 += x1[i + k] * w1[k]; }
                const float f = colfac[tl0 + i]; k0[i] = silu(y0) * f; k1[i] = silu(y1) * f; n0 += k0[i]; n1 += k1[i];
                *(unsigned*)(kw + (size_t)(tl0 + i) * 256 + ch) = cvt_pk_bf16(k0[i], k1[i]); }
            u32x4 a, c;
            a.x = cvt_pk_bf16(k0[0], k0[1]); a.y = cvt_pk_bf16(k0[2], k0[3]); a.z = cvt_pk_bf16(k0[4], k0[5]); a.w = cvt_pk_bf16(k0[6], k0[7]);
            c.x = cvt_pk_bf16(k0[8], k0[9]); c.y = cvt_pk_bf16(k0[10], k0[11]); c.z = cvt_pk_bf16(k0[12], k0[13]); c.w = cvt_pk_bf16(k0[14], k0[15]);
            *(u32x4*)(kwt + (size_t)ch * 256 + tl0) = a; *(u32x4*)(kwt + (size_t)ch * 256 + tl0 + 8) = c;
            a.x = cvt_pk_bf16(k1[0], k1[1]); a.y = cvt_pk_bf16(k1[2], k1[3]); a.z = cvt_pk_bf16(k1[4], k1[5]); a.w = cvt_pk_bf16(k1[6], k1[7]);
            c.x = cvt_pk_bf16(k1[8], k1[9]); c.y = cvt_pk_bf16(k1[10], k1[11]); c.z = cvt_pk_bf16(k1[12], k1[13]); c.w = cvt_pk_bf16(k1[14], k1[15]);
            *(u32x4*)(kwt + (size_t)(ch + 1) * 256 + tl0) = a; *(u32x4*)(kwt + (size_t)(ch + 1) * 256 + tl0 + 8) = c;
            float* nsum = (float*)(ws + O_NSUM) + (size_t)item * 256;
            unsafeAtomicAdd(nsum + ch, n0); unsafeAtomicAdd(nsum + ch + 1, n1); }
        }
        __syncthreads();
    }
}

__device__ __forceinline__ void phase4(const Params& p, unsigned char* sm) {
    unsigned char* ws = p.ws;
    const int tid = threadIdx.x;
    const float* ebl = (const float*)(ws + O_EBL);
    const bf16_t* lt = (const bf16_t*)(p.ws + O_KWT);
    bf16_t* cint = (bf16_t*)(ws + O_CINT);
    const size_t gtid = (size_t)blockIdx.x * 512 + tid, gthreads = (size_t)gridDim.x * 512;
#pragma unroll 2
    for (size_t g = gtid; g < (size_t)32 * 16384; g += gthreads) {
        const int bh = (int)(g >> 14), e4 = (int)(g & 16383);
        f32x4 c = {0.f, 0.f, 0.f, 0.f};
        u32x2 lw[7]; float eb[7];
#pragma unroll
        for (int sc = 0; sc < 7; ++sc) { lw[sc] = *(const u32x2*)(lt + (size_t)(bh * 8 + sc) * 65536 + e4 * 4); eb[sc] = ebl[bh * 8 + sc]; }
#pragma unroll
        for (int sc = 0; sc < 8; ++sc) { const int item = bh * 8 + sc;
            u32x2 w; w.x = cvt_pk_bf16(c[0], c[1]); w.y = cvt_pk_bf16(c[2], c[3]); *(u32x2*)(cint + (size_t)item * 65536 + e4 * 4) = w;
            if (sc < 7) { const f32x4 l = {bf_lo(lw[sc].x), bf_hi(lw[sc].x), bf_lo(lw[sc].y), bf_hi(lw[sc].y)}; c = (c + l) * eb[sc]; } }
    }
    float* nin = (float*)sm;
    const float* nsum = (const float*)(ws + O_NSUM);
    float* denx = (float*)(ws + O_DENX);
    for (int item = blockIdx.x; item < 256; item += gridDim.x) {
        const int b = item >> 5, h = (item >> 3) & 3, sc = item & 7; const int tokb = b * SEQ_ + sc * 256; const int bh = item >> 3;
        if (tid < 256) { float eb[7], ns[7];
#pragma unroll
            for (int j = 0; j < 7; ++j) { eb[j] = ebl[bh * 8 + j]; ns[j] = nsum[(size_t)(bh * 8 + j) * 256 + tid]; }
            float nv = 0.f;
#pragma unroll
            for (int j = 0; j < 7; ++j) if (j < sc) nv = eb[j] * (nv + ns[j]);
            nin[tid] = nv; }
        __syncthreads();
        const int tl = tid >> 1, half = tid & 1;
        const bf16_t* wq = (const bf16_t*)(ws + O_WQ) + (size_t)item * 65536 + (size_t)tl * 256 + half * 128;
        float d = 0.f;
#pragma unroll
        for (int i = 0; i < 16; ++i) { f32x4 a0, a1; unpack8(*(const u32x4*)(wq + i * 8), a0, a1); const float* nn = nin + half * 128 + i * 8;
            d += a0[0] * nn[0] + a0[1] * nn[1] + a0[2] * nn[2] + a0[3] * nn[3] + a1[0] * nn[4] + a1[1] * nn[5] + a1[2] * nn[6] + a1[3] * nn[7]; }
        d += __shfl_xor(d, 1);
        if (half == 0) denx[(size_t)(tokb + tl) * 4 + h] = d;
        __syncthreads();
    }
}

__device__ __forceinline__ void phase7(const Params& p, unsigned char* sm) {
    unsigned char* ws = p.ws;
    const int tid = threadIdx.x, lane = tid & 63, wid = tid >> 6;
    const bf16_t* uu = (const bf16_t*)p.out; bf16_t* uc = (bf16_t*)(ws + O_UC);
    const float* cw = p.in[8]; const float* cb = p.in[9]; const float* lg = p.in[10]; const float* lb = p.in[11];
    u32x4 pf[12];
#define P7_LOAD(tile_) do { const int t0_ = (tile_) * 16; const int b_ = t0_ / SEQ_, s0_ = t0_ % SEQ_; \
        _Pragma("unroll") for (int q = 0; q < 12; ++q) { const int idx = tid + q * 512; const int r = idx >> 7, c16 = idx & 127; const int s_ = s0_ - 30 + r; \
            pf[q] = (u32x4){0u, 0u, 0u, 0u}; if (idx < 46 * 128 && s_ >= 0) pf[q] = *(const u32x4*)(uu + (size_t)(b_ * SEQ_ + s_) * 1024 + c16 * 8); } } while (0)
    int tile = blockIdx.x;
    if (tile < 1024) P7_LOAD(tile);
    f32x2 wv[31];
#pragma unroll
    for (int k = 0; k < 31; ++k) wv[k] = *(const f32x2*)(cw + (size_t)k * 1024 + 2 * tid);
    const f32x2 bv = *(const f32x2*)(cb + 2 * tid);
    f32x4 lgv[4], lbv[4];
#pragma unroll
    for (int i = 0; i < 4; ++i) { lgv[i] = *(const f32x4*)(lg + i * 256 + lane * 4); lbv[i] = *(const f32x4*)(lb + i * 256 + lane * 4); }
    for (; tile < 1024; tile += gridDim.x) {
        const int t0 = tile * 16;
#pragma unroll
        for (int q = 0; q < 12; ++q) { const int idx = tid + q * 512; const int r = idx >> 7, c16 = idx & 127; if (idx < 46 * 128) *(u32x4*)(sm + r * 2048 + c16 * 16) = pf[q]; }
        __syncthreads();
        f32x2 yy[16];
        {
#pragma unroll
            for (int t = 0; t < 16; ++t) yy[t] = bv;
#pragma unroll
            for (int r = 0; r < 46; ++r) { const unsigned w = *(const unsigned*)(sm + r * 2048 + tid * 4); const f32x2 xx = {bf_lo(w), bf_hi(w)};
#pragma unroll
                for (int t = 0; t < 16; ++t) { const int k = r - t; if (k >= 0 && k <= 30) yy[t] = __builtin_elementwise_fma(wv[k], xx, yy[t]); }
                if ((r & 3) == 3) asm volatile("" ::: "memory"); }
        }
        __syncthreads();
#pragma unroll
        for (int t = 0; t < 16; ++t) *(f32x2*)(sm + t * 4096 + tid * 8) = yy[t];
        { const int tn = tile + gridDim.x; if (tn < 1024) P7_LOAD(tn); }
        __syncthreads();
#pragma unroll
        for (int tt = 0; tt < 2; ++tt) { const int t = wid * 2 + tt; f32x4 v[4]; float s1 = 0.f;
#pragma unroll
            for (int i = 0; i < 4; ++i) { v[i] = *(const f32x4*)(sm + t * 4096 + (i * 256 + lane * 4) * 4); s1 += v[i][0] + v[i][1] + v[i][2] + v[i][3]; }
            s1 = wave_sum(s1); const float mu = s1 * (1.0f / 1024.0f); float s2 = 0.f;
#pragma unroll
            for (int i = 0; i < 4; ++i) { v[i] = v[i] - mu; s2 += v[i][0] * v[i][0] + v[i][1] * v[i][1] + v[i][2] * v[i][2] + v[i][3] * v[i][3]; }
            s2 = wave_sum(s2); const float rstd = rsqrtf(s2 * (1.0f / 1024.0f) + EPS_);
#pragma unroll
            for (int i = 0; i < 4; ++i) { const int c = i * 256 + lane * 4; f32x4 z = v[i] * rstd * lgv[i] + lbv[i];
                u32x2 w; w.x = cvt_pk_bf16(silu(z[0]), silu(z[1])); w.y = cvt_pk_bf16(silu(z[2]), silu(z[3])); *(u32x2*)(uc + (size_t)(t0 + t) * 1024 + c) = w; } }
        __syncthreads();
    }
#undef P7_LOAD
}

__device__ __forceinline__ void phase13(const Params& p) {
    const float* ssq3 = (const float*)(p.ws + O_SSQ3); const float* fg = p.in[22];
    const size_t gtid = (size_t)blockIdx.x * 512 + threadIdx.x, gthreads = (size_t)gridDim.x * 512;
    for (size_t i = gtid; i < (size_t)T_ * 256; i += gthreads) { const int row = (int)(i >> 8), c = (int)(i & 255) * 4;
        const float rs = rsqrtf(ssq3[row] * (1.0f / 1024.0f) + EPS_); const f32x4 g = *(const f32x4*)(fg + c);
        f32x4 v = *(const f32x4*)(p.out + i * 4); v = v * rs * g; *(f32x4*)(p.out + i * 4) = v; }
}

#define XB_TMO      128
#define XB_XCNT(j)  (256  + 64 * (j))
#define XB_XSUB(j)  (1280 + 64 * (j))
#define XB_XGEN(j)  (2304 + 64 * (j))
#define XB_TOP      3328
#define XB_TOPGEN   3392
#define XCD_BAR_WORDS 3456
#define XB_SPIN_CAP (1u << 18)
__device__ __forceinline__ unsigned xb_ld(unsigned* p)              { return __hip_atomic_load(p, __ATOMIC_RELAXED, __HIP_MEMORY_SCOPE_AGENT); }
__device__ __forceinline__ unsigned xb_add(unsigned* p, unsigned v) { return __hip_atomic_fetch_add(p, v, __ATOMIC_RELAXED, __HIP_MEMORY_SCOPE_AGENT); }
__device__ __forceinline__ unsigned xb_xcc_id() { return (unsigned)__builtin_amdgcn_s_getreg((3 << 11) | 20) & 0xFu; }
#define XB_SPIN(cond, bar) do { unsigned _sp = 0; while (cond) { __builtin_amdgcn_s_sleep(1); \
    if ((++_sp & 255u) == 0u) { if (xb_ld(&(bar)[XB_TMO])) break; if (_sp > XB_SPIN_CAP) { atomicAdd(&(bar)[XB_TMO], 1u); break; } } } } while (0)
struct XcdBarrier { unsigned* bar; unsigned x; volatile LAS unsigned* st; };
__device__ __forceinline__ XcdBarrier xcd_barrier_post(unsigned* bar, volatile LAS unsigned* st) {
    XcdBarrier b; b.bar = bar; b.x = xb_xcc_id(); b.st = st;
    if (threadIdx.x == 0) (void)xb_add(&bar[XB_XCNT(b.x)], 1u);
    return b;
}
__device__ __forceinline__ void xcd_barrier_complete(unsigned* bar, unsigned x, unsigned& nloc, unsigned& nx) {
    const unsigned G = gridDim.x * gridDim.y * gridDim.z;
    unsigned sum, cnt, mine, sp = 0u;
    for (;;) {
        sum = 0u; cnt = 0u; mine = 0u;
#pragma unroll
        for (unsigned j = 0; j < 16; ++j) { const unsigned c = xb_ld(&bar[XB_XCNT(j)]); sum += c; cnt += (c > 0u) ? 1u : 0u; mine = (j == x) ? c : mine; }
        if (sum == G) break;
        __builtin_amdgcn_s_sleep(1);
        if ((++sp & 255u) == 0u) { if (xb_ld(&bar[XB_TMO])) break; if (sp > XB_SPIN_CAP) { atomicAdd(&bar[XB_TMO], 1u); break; } }
    }
    nloc = mine > 0u ? mine : 1u; nx = cnt > 0u ? cnt : 1u;
}
__device__ __forceinline__ void xcd_barrier(const XcdBarrier& b) {
    asm volatile("s_waitcnt vmcnt(0)" ::: "memory");
    __syncthreads();
    if (threadIdx.x == 0) {
        unsigned* bar = b.bar;
        __builtin_amdgcn_s_waitcnt(0);
        unsigned nloc = b.st[0], nx = b.st[1];
        if (nloc == 0u) { xcd_barrier_complete(bar, b.x, nloc, nx); b.st[0] = nloc; b.st[1] = nx; }
        const unsigned old = xb_add(&bar[XB_XSUB(b.x)], 1u);
        const unsigned gen = old / nloc;
        if (old + 1u == (gen + 1u) * nloc) {
            __builtin_amdgcn_fence(__ATOMIC_RELEASE, "agent");
            asm volatile("s_waitcnt vmcnt(0)" ::: "memory");
            const unsigned og = xb_add(&bar[XB_TOP], 1u);
            const unsigned tg = og / nx;
            if (og + 1u == (tg + 1u) * nx) xb_add(&bar[XB_TOPGEN], 1u);
            else XB_SPIN(xb_ld(&bar[XB_TOPGEN]) == tg, bar);
            __builtin_amdgcn_fence(__ATOMIC_ACQUIRE, "agent");
            xb_add(&bar[XB_XGEN(b.x)], 1u);
            asm volatile("s_waitcnt vmcnt(0)" ::: "memory");
        } else {
            XB_SPIN(xb_ld(&bar[XB_XGEN(b.x)]) == gen, bar);
            __builtin_amdgcn_fence(__ATOMIC_ACQUIRE, "agent");
            asm volatile("s_waitcnt vmcnt(0)" ::: "memory");
        }
    }
    __syncthreads();
}

template <bool COOP>
__global__ void __launch_bounds__(512, 2) mk_fwd(Params p) {
    extern __shared__ __attribute__((aligned(16))) unsigned char shm[];
    LAS unsigned char* lds = (LAS unsigned char*)shm;
    unsigned char* ws = p.ws;
    const int G = gridDim.x, c = blockIdx.x;
#ifndef PHMASK
#define PHMASK 0x3fff
#endif
#define PH(k) if (((PHMASK >> (k)) & 1) && p.ph_lo <= (k) && (k) < p.ph_hi)
    XcdBarrier xb{};
    if (COOP) { volatile LAS unsigned* st = (volatile LAS unsigned*)(lds + 131072);
        if (threadIdx.x == 0) { st[0] = 0u; st[1] = 0u; }
        __syncthreads();
        xb = xcd_barrier_post((unsigned*)(ws + O_BAR), st); }
#define SYNC(k) if (COOP) { if (p.ph_lo <= (k) && (k) + 1 < p.ph_hi) { xcd_barrier(xb); } }
    PH(0) phase0(p, shm);
    SYNC(0)
    PH(1) { SchedP1 S{(const char*)(ws + O_HB), (const char*)(ws + O_WINT), G, c}; EpiP1 E{(bf16_t*)p.out, (bf16_t*)(ws + O_VT), (const float*)(ws + O_RS)}; gemm_phase(lds, 1024, 1024, 1024, S, E); }
    SYNC(1)
    PH(3) { phase2(p, shm);
        asm volatile("s_waitcnt vmcnt(0)" ::: "memory"); __syncthreads();
        SchedP3 S{(const char*)(ws + O_WQ), (const char*)(ws + O_KW), (const char*)(ws + O_VT), (const char*)(ws + O_KWT), G, c};
        EpiP3 E{(bf16_t*)(ws + O_SS), (bf16_t*)(ws + O_KWT), (float*)(ws + O_DENI)}; gemm_phase(lds, 256, 256, 256, S, E); }
    SYNC(3)
    PH(4) phase4(p, shm);
    SYNC(4)
    PH(6) { { SchedP5 S{(const char*)(ws + O_SS), (const char*)(ws + O_VT), (const char*)(ws + O_WQ), (const char*)(ws + O_CINT), G, c};
            EpiP5 E{(bf16_t*)(ws + O_HM), (const float*)(ws + O_DENI), (const float*)(ws + O_DENX), (float*)(ws + O_HSS)}; gemm_phase(lds, 256, 256, 256, S, E); }
        { SchedP6 S{(const char*)(ws + O_HB), (const char*)(ws + O_WINT), G, c};
            EpiP6 E{(bf16_t*)(ws + O_HM), (float*)(ws + O_HSS), (const float*)(ws + O_RS), (bf16_t*)p.out}; gemm_phase(lds, 1024, 1024, 1024, S, E); } }
    SYNC(6)
    PH(7) phase7(p, shm);
    SYNC(7)
    PH(8) { SchedP8 S{(const char*)(ws + O_HB), (const char*)(ws + O_WINT), (const char*)(ws + O_HM), (const char*)(ws + O_UC), (const char*)(ws + O_WMT), (const char*)(ws + O_WCT), G, c};
        EpiP8 E{(bf16_t*)(ws + O_GMC), (bf16_t*)p.out + (size_t)T_ * 1024, (bf16_t*)(ws + O_MERGED), (const float*)(ws + O_RS)}; gemm_phase(lds, 1024, 1024, 1024, S, E); }
    SYNC(8)
    PH(9) { SchedN4 S{(const char*)(ws + O_MERGED), (const char*)(ws + O_WOT), (size_t)256 * 1024 * 2, (size_t)256 * 1024 * 2, G, c};
        EpiRes<true> E{(const void*)(ws + O_HB), (bf16_t*)(ws + O_X1B), (float*)(ws + O_SSQ1)}; gemm_phase(lds, 1024, 1024, 1024, S, E); }
    SYNC(9)
    PH(10) { { SchedP10 S{(const char*)(ws + O_X1B), (const char*)(ws + O_WGUT), G, c}; EpiP10 E{(const float*)(ws + O_SSQ1), (bf16_t*)(ws + O_HID)}; gemm_phase(lds, 1024, 1024, 1024, S, E); }
        { const int h = G >> 1; SchedPE S{(const char*)(ws + O_PB), (const char*)(ws + O_WPPT), h, c - h};
            EpiBf E{(bf16_t*)(ws + O_PE)}; if (c >= h) gemm_phase(lds, 256, 256, 256, S, E); } }
    SYNC(10)
    PH(11) { SchedN4 S{(const char*)(ws + O_HID), (const char*)(ws + O_WDT), (size_t)256 * DFF_ * 2, (size_t)256 * DFF_ * 2, G, c};
            EpiRes<true> E{(const void*)(ws + O_X1B), (bf16_t*)(ws + O_X2B), (float*)(ws + O_SSQ2)}; gemm_phase(lds, DFF_, DFF_, DFF_, S, E); }
    SYNC(11)
    PH(12) { SchedN4 S{(const char*)(ws + O_X2B), (const char*)(ws + O_WPGT), (size_t)256 * 1024 * 2, (size_t)256 * 1024 * 2, G, c};
        EpiP12 E{(const float*)(ws + O_SSQ2), (const bf16_t*)(ws + O_PE), (const bf16_t*)(ws + O_X2B), p.out, (float*)(ws + O_SSQ3), (unsigned*)(ws + O_BAR) + XCD_BAR_WORDS, p.in[22]}; gemm_phase(lds, 1024, 1024, 1024, S, E); }
#undef PH
#undef SYNC
}

extern "C" void kernel_launch(void* const* d_in, const int* in_sizes, int n_in, void* d_out, int out_size, void* d_ws, size_t ws_size, hipStream_t stream) {
    static int grid = 0;
    if (grid == 0) {
        if (n_in != 23 || out_size != T_ * D_ || ws_size < WS_NEED) { fprintf(stderr, "kernel_launch: unexpected shapes (n_in %d, out %d, ws %zu)\n", n_in, out_size, ws_size); grid = -1; return; }
        int dev = 0, cus = 0, per_cu = 0;
        hipGetDevice(&dev); hipDeviceGetAttribute(&cus, hipDeviceAttributeMultiprocessorCount, dev);
        hipFuncSetAttribute((const void*)mk_fwd<true>, hipFuncAttributeMaxDynamicSharedMemorySize, LDS_BYTES);
        hipFuncSetAttribute((const void*)mk_fwd<false>, hipFuncAttributeMaxDynamicSharedMemorySize, LDS_BYTES);
        hipOccupancyMaxActiveBlocksPerMultiprocessor(&per_cu, (const void*)mk_fwd<true>, 512, LDS_BYTES);
        if (per_cu < 1) { fprintf(stderr, "kernel_launch: occupancy query reports %d blocks per CU\n", per_cu); per_cu = 1; }
        (void)hipGetLastError();
        grid = cus;
        if (grid != 256) { fprintf(stderr, "kernel_launch: built for a 256-CU device (got %d CUs)\n", cus); grid = -1; return; }
    }
    if (grid < 0) return;
    Params p{};
    for (int i = 0; i < 23; ++i) p.in[i] = (const float*)d_in[i];
    p.out = (float*)d_out; p.ws = (unsigned char*)d_ws;
#if MK_MULTI
#ifndef PROBE_DUP
#define PROBE_DUP -1
#endif
    for (int k = 0; k < NPHASE; ++k) { p.ph_lo = k; p.ph_hi = k + 1; hipLaunchKernelGGL(mk_fwd<false>, dim3(grid), dim3(512), LDS_BYTES, stream, p);
        if (k == PROBE_DUP) hipLaunchKernelGGL(mk_fwd<false>, dim3(grid), dim3(512), LDS_BYTES, stream, p); }
#else
    p.ph_lo = 0; p.ph_hi = NPHASE;
    if (hipMemsetAsync((unsigned char*)d_ws + O_BAR, 0, (XCD_BAR_WORDS + 64 * 64) * 4, stream) != hipSuccess) { fprintf(stderr, "kernel_launch: memset of barrier words failed\n"); return; }
    void* args[] = {&p};
    hipError_t e = hipLaunchCooperativeKernel((const void*)mk_fwd<true>, dim3(grid), dim3(512), args, LDS_BYTES, stream);
    if (e != hipSuccess) fprintf(stderr, "cooperative launch failed: %s (grid %d)\n", hipGetErrorString(e), grid);
#endif
}
```

```cpp
#include <hip/hip_runtime.h>
#include <hip/hip_cooperative_groups.h>
#include <cstdio>
namespace cg = cooperative_groups;

#ifndef MK_MULTI
#define MK_MULTI 0
#endif

#define LAS __attribute__((address_space(3)))
typedef unsigned short bf16_t;
typedef short bf16x8 __attribute__((ext_vector_type(8)));
typedef float f32x4 __attribute__((ext_vector_type(4)));
typedef float f32x2 __attribute__((ext_vector_type(2)));
typedef unsigned u32x4 __attribute__((ext_vector_type(4)));
typedef unsigned u32x2 __attribute__((ext_vector_type(2)));

constexpr int T_ = 16384, D_ = 1024, NIN_ = 8200, DFF_ = 2816, SEQ_ = 2048;
constexpr float EPS_ = 1e-6f;
constexpr int BM = 256, BK = 64, HALF = 128, HTB = HALF * BK * 2, STAGE_BYTES = 8 * HTB;
constexpr int LDS_BYTES = 136 * 1024;
constexpr int NPHASE = 13;

constexpr size_t KiB = 1024, MiB = 1024 * 1024;
constexpr size_t O_WINT = 0, O_WMT = 16 * MiB, O_WCT = 18 * MiB, O_WOT = 20 * MiB, O_WPGT = 22 * MiB, O_WGUT = 24 * MiB, O_WDT = 35 * MiB, O_WPPT = 40 * MiB + 512 * KiB;
constexpr size_t O_IG = 41 * MiB, O_LF = O_IG + 256 * KiB, O_ZERO = O_LF + 256 * KiB;
constexpr size_t O_DENI = O_ZERO, O_HSS = O_DENI + 256 * KiB, O_SSQ1 = O_HSS + 256 * KiB, O_SSQ2 = O_SSQ1 + 64 * KiB, O_SSQ3 = O_SSQ2 + 64 * KiB, O_NSUM = O_SSQ3 + 64 * KiB;
constexpr size_t ZERO_BYTES = 960 * KiB;
constexpr size_t O_DENX = O_ZERO + ZERO_BYTES, O_EBL = O_DENX + 256 * KiB;
constexpr size_t O_RS = O_EBL + 4 * KiB;
constexpr size_t O_BAR = 43 * MiB;
constexpr size_t O_PB = 44 * MiB, O_HB = 52 * MiB, O_S1 = 84 * MiB, O_S2 = 116 * MiB, O_S3 = 148 * MiB, O_S4 = 180 * MiB, O_S5 = 212 * MiB, WS_NEED = 244 * MiB;
constexpr size_t O_PE = O_HB, O_VT = O_S1, O_U = O_S1, O_MERGED = O_S1, O_HID = O_S1, O_WQ = O_S2, O_GMC = O_S2, O_KW = O_S3, O_CINT = O_S3,
                 O_KWT = O_S4, O_HM = O_S4, O_X1B = O_S4, O_SS = O_S5, O_UC = O_S5, O_X2B = O_S5;

struct Params {
    const float* in[23];
    float* out;
    unsigned char* ws;
    int ph_lo, ph_hi;
};

__device__ __forceinline__ unsigned cvt_pk_bf16(float lo, float hi) { unsigned r; asm volatile("v_cvt_pk_bf16_f32 %0, %1, %2" : "=v"(r) : "v"(lo), "v"(hi)); return r; }
__device__ __forceinline__ float bf_lo(unsigned w) { return __uint_as_float(w << 16); }
__device__ __forceinline__ float bf_hi(unsigned w) { return __uint_as_float(w & 0xffff0000u); }
__device__ __forceinline__ float sigm(float x) { return __builtin_amdgcn_rcpf(1.0f + __builtin_amdgcn_exp2f(x * -1.4426950408889634f)); }
__device__ __forceinline__ float silu(float x) { return x * __builtin_amdgcn_rcpf(1.0f + __builtin_amdgcn_exp2f(x * -1.4426950408889634f)); }
__device__ __forceinline__ float wave_sum(float v) {
#pragma unroll
    for (int o = 32; o > 0; o >>= 1) v += __shfl_xor(v, o);
    return v;
}
__device__ __forceinline__ u32x4 pack8(const f32x4 a, const f32x4 b) { u32x4 w; w.x = cvt_pk_bf16(a[0], a[1]); w.y = cvt_pk_bf16(a[2], a[3]); w.z = cvt_pk_bf16(b[0], b[1]); w.w = cvt_pk_bf16(b[2], b[3]); return w; }
__device__ __forceinline__ void unpack8(const u32x4 w, f32x4& a, f32x4& b) { a[0] = bf_lo(w.x); a[1] = bf_hi(w.x); a[2] = bf_lo(w.y); a[3] = bf_hi(w.y); b[0] = bf_lo(w.z); b[1] = bf_hi(w.z); b[2] = bf_lo(w.w); b[3] = bf_hi(w.w); }

__host__ __device__ __forceinline__ int lds_byte(int r, int c) { const int st = (r >> 4) * 2 + (c >> 5), rr = r & 15, cc = c & 31, ob = rr * 64 + cc * 2; return st * 1024 + (ob ^ (((ob >> 9) & 1) << 5)); }
__host__ __device__ __forceinline__ void stage_rc(int b, int& R, int& C) { const int st = b / 1024, sb = b % 1024, swz = sb ^ (((sb >> 9) & 1) << 5); R = (st >> 1) * 16 + swz / 64; C = (st & 1) * 32 + (swz % 64) / 2; }
__host__ __device__ __forceinline__ int perm32(int rho) { const int n = rho >> 4, i = rho & 15; return 8 * (i >> 2) + 4 * n + (i & 3); }

struct Unit { const char* a; const char* b; int pm, pn, kind, cont; };
__device__ __forceinline__ void map_n4(int L, int& pm, int& pn) { const int x = L & 7, k = L >> 3; pm = x * 8 + (k & 7); pn = k >> 3; }

__device__ __forceinline__ void tile_order(int L, int nM, int nN, int& pm, int& pn) {
    const int nwg = nM * nN; int wgid = L;
    { const int q = nwg / 8, r = nwg % 8, xcd = wgid % 8, off = wgid / 8; wgid = (xcd < r ? xcd * (q + 1) : r * (q + 1) + (xcd - r) * q) + off; }
    const int nig = 8 * nN, gid = wgid / nig, fm = gid * 8, gsz = (nM - fm) < 8 ? (nM - fm) : 8;
    pm = fm + ((wgid % nig) % gsz); pn = (wgid % nig) / gsz;
}

template <class Epi, class Sched>
__device__ __forceinline__ void gemm_phase(LAS unsigned char* lds, const int K, const int lda, const int ldb, const Sched& S, const Epi& E) {
    const int tid = threadIdx.x, wid = __builtin_amdgcn_readfirstlane(tid >> 6), lane = tid & 63, wr = wid >> 2, wc = wid & 3, fr = lane & 15, fq = lane >> 4;
    const int nt = K / BK;
    unsigned voffA[2], voffB[2];
#pragma unroll
    for (int i = 0; i < 2; ++i) { int R, C; stage_rc(tid * 16 + i * 8192, R, C); const int Rb = (R & ~31) + perm32(R & 31);
        voffA[i] = (unsigned)(R * lda + C) * 2u; voffB[i] = (unsigned)(Rb * ldb + C) * 2u; }
    const size_t kstep = (size_t)(BK * 2);
    const size_t hstepA = (size_t)HALF * lda * 2, hstepB = (size_t)HALF * ldb * 2;
    const unsigned ldsw = (unsigned)wid * 1024u;
    const int aoff = lds_byte(wr * 64 + fr, fq * 8), boff = lds_byte(wc * 32 + fr, fq * 8);
#define PG8_SA(b, h) (((b) * 2 + (h)) * HTB)
#define PG8_SB(b, h) ((4 + (b) * 2 + (h)) * HTB)
#define PG8_STAGE(bufoff, gbase, voff) do { _Pragma("unroll") for (int _i = 0; _i < 2; ++_i) \
        __builtin_amdgcn_global_load_lds((const unsigned*)((const char*)(gbase) + (voff)[_i]), (LAS unsigned*)(lds + (bufoff) + ldsw + _i * 8192), 16, 0, 0); } while (0)
#define PG8_LDA(dst, b, h) do { _Pragma("unroll") for (int m = 0; m < 4; ++m) _Pragma("unroll") for (int k = 0; k < 2; ++k) dst[m][k] = *(const LAS bf16x8*)(lds + PG8_SA(b, h) + aoff + m * 2048 + k * 1024); } while (0)
#define PG8_LDB(dst, b, h) do { _Pragma("unroll") for (int n = 0; n < 2; ++n) _Pragma("unroll") for (int k = 0; k < 2; ++k) dst[n][k] = *(const LAS bf16x8*)(lds + PG8_SB(b, h) + boff + n * 2048 + k * 1024); } while (0)
#define PG8_MMA(ai, bj, At, Bt) do { __builtin_amdgcn_s_setprio(1); _Pragma("unroll") for (int m = 0; m < 4; ++m) _Pragma("unroll") for (int n = 0; n < 2; ++n) _Pragma("unroll") for (int k = 0; k < 2; ++k) \
        acc[ai][bj][m][n] = __builtin_amdgcn_mfma_f32_16x16x32_bf16(Bt[n][k], At[m][k], acc[ai][bj][m][n], 0, 0, 0); __builtin_amdgcn_s_setprio(0); } while (0)
#define PG8_WAIT_V(n) asm volatile("s_waitcnt vmcnt(" #n ")" ::: "memory")
#define PG8_WAIT_L(n) asm volatile("s_waitcnt lgkmcnt(" #n ")" ::: "memory")
#define PG8_BAR __builtin_amdgcn_s_barrier()
#define PG8_SCHED __builtin_amdgcn_sched_barrier(0)
#define PG8_ZERO() do { _Pragma("unroll") for (int a = 0; a < 2; ++a) _Pragma("unroll") for (int b = 0; b < 2; ++b) _Pragma("unroll") for (int m = 0; m < 4; ++m) _Pragma("unroll") for (int n = 0; n < 2; ++n) acc[a][b][m][n] = (f32x4){0.f, 0.f, 0.f, 0.f}; } while (0)
    Unit cur, nxt; int ui = 0;
    if (!S.next(0, cur)) return;
    E.pre(cur, wr, wc, fr, fq);
    f32x4 acc[2][2][4][2];
    PG8_ZERO();
    bf16x8 At[4][2], B0[2][2], B1[2][2];
    const char* cA = cur.a; const char* cB = cur.b;
    PG8_STAGE(PG8_SB(0, 0), cB, voffB); PG8_STAGE(PG8_SA(0, 0), cA, voffA); PG8_STAGE(PG8_SB(0, 1), cB + hstepB, voffB); PG8_STAGE(PG8_SA(0, 1), cA + hstepA, voffA);
    if (wr == 1) PG8_BAR;
    PG8_WAIT_V(4); PG8_BAR;
    PG8_STAGE(PG8_SB(1, 0), cB + kstep, voffB); PG8_STAGE(PG8_SA(1, 0), cA + kstep, voffA); PG8_STAGE(PG8_SB(1, 1), cB + hstepB + kstep, voffB);
    PG8_WAIT_V(6); PG8_BAR;
    for (;;) {
        const bool has_next = S.next(ui + 1, nxt);
        const char* nA = has_next ? nxt.a : cA; const char* nB = has_next ? nxt.b : cB;
#pragma unroll 1
        for (int t = 0; t < nt; t += 2) {
            const bool last = (t == nt - 2);
            const char* a1 = cA + (size_t)(t + 1) * kstep;
            const char* a2 = last ? nA : cA + (size_t)(t + 2) * kstep; const char* b2 = last ? nB : cB + (size_t)(t + 2) * kstep;
            const char* a3 = a2 + kstep; const char* b3 = b2 + kstep;
            PG8_LDB(B0, 0, 0); PG8_SCHED; PG8_LDA(At, 0, 0); PG8_STAGE(PG8_SA(1, 1), a1 + hstepA, voffA);
            PG8_WAIT_L(8); PG8_BAR; PG8_WAIT_L(0); PG8_MMA(0, 0, At, B0); PG8_BAR; PG8_SCHED;
            PG8_LDB(B1, 0, 1); PG8_STAGE(PG8_SB(0, 0), b2, voffB);
            PG8_BAR; PG8_WAIT_L(0); PG8_MMA(0, 1, At, B1); PG8_BAR;
            PG8_LDA(At, 0, 1); PG8_STAGE(PG8_SA(0, 0), a2, voffA);
            PG8_BAR; PG8_WAIT_L(0); PG8_MMA(1, 0, At, B0); PG8_BAR; PG8_SCHED;
            PG8_STAGE(PG8_SB(0, 1), b2 + hstepB, voffB);
            PG8_WAIT_V(6); PG8_BAR; PG8_MMA(1, 1, At, B1); PG8_BAR;
            PG8_LDB(B0, 1, 0); PG8_SCHED; PG8_LDA(At, 1, 0); PG8_STAGE(PG8_SA(0, 1), a2 + hstepA, voffA);
            PG8_WAIT_L(8); PG8_BAR; PG8_WAIT_L(0); PG8_MMA(0, 0, At, B0); PG8_BAR; PG8_SCHED;
            PG8_LDB(B1, 1, 1); PG8_STAGE(PG8_SB(1, 0), b3, voffB);
            PG8_BAR; PG8_WAIT_L(0); PG8_MMA(0, 1, At, B1); PG8_BAR;
            PG8_LDA(At, 1, 1); PG8_STAGE(PG8_SA(1, 0), a3, voffA);
            PG8_BAR; PG8_WAIT_L(0); PG8_MMA(1, 0, At, B0); PG8_BAR; PG8_SCHED;
            PG8_STAGE(PG8_SB(1, 1), b3 + hstepB, voffB);
            PG8_WAIT_V(6); PG8_BAR; PG8_MMA(1, 1, At, B1); PG8_BAR;
        }
        if (cur.cont) { E.mid(acc, cur, wr, wc, fr, fq); }
        else { if constexpr (!Epi::AFTER_DRAIN) E(acc, cur, wr, wc, fr, fq); if (!has_next) break; PG8_ZERO(); }
        cur = nxt; cA = nA; cB = nB; ++ui;
    }
    PG8_WAIT_V(0);
    if (wr == 0) PG8_BAR;
    PG8_BAR;
    if constexpr (Epi::AFTER_DRAIN) E(acc, cur, wr, wc, fr, fq);
#undef PG8_SA
#undef PG8_SB
#undef PG8_STAGE
#undef PG8_LDA
#undef PG8_LDB
#undef PG8_MMA
#undef PG8_WAIT_V
#undef PG8_WAIT_L
#undef PG8_BAR
#undef PG8_SCHED
#undef PG8_ZERO
}

typedef f32x4 Acc[2][2][4][2];
#define EPI_ROWS(ai, m) _Pragma("unroll") for (int ai = 0; ai < 2; ++ai) _Pragma("unroll") for (int m = 0; m < 4; ++m) if (epi_fence())
__device__ __forceinline__ bool epi_fence() { asm volatile("" ::: "memory"); return true; }
#define EPI_R8 _Pragma("unroll") for (int r8 = 0; r8 < 8; ++r8)
#define EPI_RL(ai, m) ((ai) * 128 + wr * 64 + (m) * 16 + fr)
#define EPI_CL(bj) ((bj) * 128 + wc * 32 + 8 * fq)

struct SchedP1 { const char* hb; const char* wint; int G, c;
    __device__ __forceinline__ bool next(int i, Unit& u) const {
        const int item = (i / 3) * G + c, r = i % 3; if (item >= 256) return false;
        const int b = item >> 5, h = (item >> 3) & 3, sc = item & 7; const int pt = b * 8 + sc;
        u.cont = 0;
        if (r < 2) { u.pm = pt; u.pn = r * 4 + h; u.kind = 0; u.a = hb + (size_t)pt * 256 * 1024 * 2; u.b = wint + (size_t)u.pn * 256 * 1024 * 2; }
        else { u.pm = h; u.pn = pt; u.kind = 1; u.a = wint + (size_t)(2048 + h * 256) * 1024 * 2; u.b = hb + (size_t)pt * 256 * 1024 * 2; }
        return true; } };
struct EpiP1 { static constexpr bool AFTER_DRAIN = false; bf16_t* qkpre; bf16_t* vt; const float* rsb;
    __device__ __forceinline__ void mid(Acc&, const Unit&, int, int, int, int) const {}
    __device__ __forceinline__ void pre(const Unit&, int, int, int, int) const {}
    __device__ __forceinline__ void operator()(Acc& acc, const Unit& u, int wr, int wc, int fr, int fq) const {
        if (u.kind == 0) {
            bf16_t* base = qkpre + (size_t)u.pm * 256 * 2048 + u.pn * 256; float rv[2][4];
#pragma unroll
            for (int ai = 0; ai < 2; ++ai)
#pragma unroll
                for (int m = 0; m < 4; ++m) rv[ai][m] = rsb[u.pm * 256 + EPI_RL(ai, m)];
            EPI_ROWS(ai, m) { bf16_t* rowp = base + (size_t)EPI_RL(ai, m) * 2048 + EPI_CL(0);
#pragma unroll
                for (int bj = 0; bj < 2; ++bj) *(u32x4*)(rowp + bj * 128) = pack8(acc[ai][bj][m][0] * rv[ai][m], acc[ai][bj][m][1] * rv[ai][m]); }
        } else {
            const int item = ((u.pn >> 3) * 4 + u.pm) * 8 + (u.pn & 7); bf16_t* base = vt + (size_t)item * 65536; f32x4 cv[2][2];
#pragma unroll
            for (int bj = 0; bj < 2; ++bj) { cv[bj][0] = *(const f32x4*)(rsb + u.pn * 256 + EPI_CL(bj)); cv[bj][1] = *(const f32x4*)(rsb + u.pn * 256 + EPI_CL(bj) + 4); }
            EPI_ROWS(ai, m) { bf16_t* rowp = base + (size_t)EPI_RL(ai, m) * 256 + EPI_CL(0);
#pragma unroll
                for (int bj = 0; bj < 2; ++bj) *(u32x4*)(rowp + bj * 128) = pack8(acc[ai][bj][m][0] * cv[bj][0], acc[ai][bj][m][1] * cv[bj][1]); }
        }
    } };

struct SchedP3 { const char* wq; const char* kw; const char* vt; const char* kwt; int G, c;
    __device__ __forceinline__ bool next(int i, Unit& u) const {
        const int L = i * G + c; if (L >= 512) return false;
        u.cont = 0; u.pn = 0;
        if (L < 256) { u.pm = L; u.kind = 0; u.a = wq + (size_t)L * 131072; u.b = kw + (size_t)L * 131072; }
        else { const int it = L - 256; u.pm = it; u.kind = 1; u.a = vt + (size_t)it * 131072; u.b = kwt + (size_t)it * 131072; }
        return true; } };
struct EpiP3 { static constexpr bool AFTER_DRAIN = false; bf16_t* s; bf16_t* lt; float* deni;
    __device__ __forceinline__ void mid(Acc&, const Unit&, int, int, int, int) const {}
    __device__ __forceinline__ void pre(const Unit&, int, int, int, int) const {}
    __device__ __forceinline__ void operator()(Acc& acc, const Unit& u, int wr, int wc, int fr, int fq) const {
        const int item = u.pm;
        if (u.kind == 0) {
            const int b = item >> 5, h = (item >> 3) & 3, sc = item & 7; const int tokb = b * SEQ_ + sc * 256;
            EPI_ROWS(ai, m) { int r = EPI_RL(ai, m); asm volatile("" : "+v"(r)); float rs = 0.f;
#pragma unroll
                for (int bj = 0; bj < 2; ++bj) { const int c0 = EPI_CL(bj); f32x4 v0 = acc[ai][bj][m][0], v1 = acc[ai][bj][m][1];
#pragma unroll
                    for (int j = 0; j < 4; ++j) { v0[j] = (c0 + j <= r) ? v0[j] : 0.f; v1[j] = (c0 + 4 + j <= r) ? v1[j] : 0.f; rs += v0[j] + v1[j]; }
                    *(u32x4*)(s + (size_t)item * 65536 + r * 256 + c0) = pack8(v0, v1); }
                rs += __shfl_xor(rs, 16); rs += __shfl_xor(rs, 32);
                if (fq == 0) unsafeAtomicAdd(deni + (size_t)(tokb + r) * 4 + h, rs); }
        } else {
            EPI_ROWS(ai, m) { bf16_t* rowp = lt + (size_t)item * 65536 + EPI_RL(ai, m) * 256 + EPI_CL(0);
#pragma unroll
                for (int bj = 0; bj < 2; ++bj) *(u32x4*)(rowp + bj * 128) = pack8(acc[ai][bj][m][0], acc[ai][bj][m][1]); }
        }
    } };

struct SchedP5 { const char* s; const char* vt; const char* wq; const char* cint; int G, c;
    __device__ __forceinline__ bool next(int i, Unit& u) const {
        const int item = (i >> 1) * G + c; if (item >= 256) return false;
        u.pm = item; u.pn = 0; u.kind = 0;
        if ((i & 1) == 0) { u.cont = 1; u.a = s + (size_t)item * 131072; u.b = vt + (size_t)item * 131072; }
        else { u.cont = 0; u.a = wq + (size_t)item * 131072; u.b = cint + (size_t)item * 131072; }
        return true; } };
struct EpiP5 { static constexpr bool AFTER_DRAIN = false; bf16_t* hm; const float* deni; const float* denx; float* hss;
    __device__ __forceinline__ void mid(Acc&, const Unit&, int, int, int, int) const {}
    __device__ __forceinline__ void pre(const Unit&, int, int, int, int) const {}
    __device__ __forceinline__ void operator()(Acc& acc, const Unit& u, int wr, int wc, int fr, int fq) const {
        const int item = u.pm; const int b = item >> 5, h = (item >> 3) & 3, sc = item & 7; const int tokb = b * SEQ_ + sc * 256;
        float dnv[2][4];
#pragma unroll
        for (int ai = 0; ai < 2; ++ai)
#pragma unroll
            for (int m = 0; m < 4; ++m) { const int t = tokb + EPI_RL(ai, m); dnv[ai][m] = deni[(size_t)t * 4 + h] + denx[(size_t)t * 4 + h]; }
        EPI_ROWS(ai, m) { const int t = tokb + EPI_RL(ai, m);
            const float den = dnv[ai][m]; const float inv = __builtin_amdgcn_rcpf(fmaxf(fabsf(den), 1.0f)); float ss = 0.f;
#pragma unroll
            for (int bj = 0; bj < 2; ++bj) { f32x4 v0 = acc[ai][bj][m][0] * inv, v1 = acc[ai][bj][m][1] * inv;
#pragma unroll
                for (int j = 0; j < 4; ++j) ss += v0[j] * v0[j] + v1[j] * v1[j];
                *(u32x4*)(hm + (size_t)t * 1024 + h * 256 + EPI_CL(bj)) = pack8(v0, v1); }
            ss += __shfl_xor(ss, 16); ss += __shfl_xor(ss, 32);
            if (fq == 0) unsafeAtomicAdd(hss + (size_t)t * 4 + h, ss); }
    } };

struct SchedP6 { const char* hb; const char* wint; int G, c;
    __device__ __forceinline__ bool next(int i, Unit& u) const {
        u.cont = 0;
        if (i == 0) { const int item = c; if (item >= 256) return false; const int b = item >> 5, h = (item >> 3) & 3, sc = item & 7;
            u.pm = b * 8 + sc; u.pn = h; u.kind = 0; u.a = hb + (size_t)u.pm * 256 * 1024 * 2; u.b = wint + (size_t)(3072 + h * 256) * 1024 * 2; return true; }
        const int L = (i - 1) * G + c; if (L >= 512) return false;
        int pm, pn; tile_order(L, 64, 8, pm, pn); u.pm = pm; u.pn = pn; u.kind = 1;
        u.a = hb + (size_t)pm * 256 * 1024 * 2; u.b = wint + (size_t)(4096 + pn * 256) * 1024 * 2; return true; } };
struct EpiP6 { static constexpr bool AFTER_DRAIN = false; bf16_t* hm; float* hss; const float* rsb; bf16_t* uu;
    __device__ __forceinline__ void mid(Acc&, const Unit&, int, int, int, int) const {}
    __device__ __forceinline__ void pre(const Unit&, int, int, int, int) const {}
    __device__ __forceinline__ void operator()(Acc& acc, const Unit& u, int wr, int wc, int fr, int fq) const {
        if (u.kind == 0) {
            float hsv[2][4], rxv[2][4];
#pragma unroll
            for (int ai = 0; ai < 2; ++ai)
#pragma unroll
                for (int m = 0; m < 4; ++m) rxv[ai][m] = rsb[u.pm * 256 + EPI_RL(ai, m)];
#pragma unroll
            for (int ai = 0; ai < 2; ++ai)
#pragma unroll
                for (int m = 0; m < 4; ++m) hsv[ai][m] = __hip_atomic_load(hss + (size_t)(u.pm * 256 + EPI_RL(ai, m)) * 4 + u.pn, __ATOMIC_RELAXED, __HIP_MEMORY_SCOPE_AGENT);
            u32x4 cur[2], nxt[2];
#pragma unroll
            for (int bj = 0; bj < 2; ++bj) cur[bj] = *(const u32x4*)(hm + (size_t)(u.pm * 256 + EPI_RL(0, 0)) * 1024 + u.pn * 256 + EPI_CL(bj));
            EPI_R8 { const int ai = r8 >> 2, m = r8 & 3; const int t = u.pm * 256 + EPI_RL(ai, m);
                if (r8 < 7) { const int tn = u.pm * 256 + EPI_RL((r8 + 1) >> 2, (r8 + 1) & 3);
#pragma unroll
                    for (int bj = 0; bj < 2; ++bj) nxt[bj] = *(const u32x4*)(hm + (size_t)tn * 1024 + u.pn * 256 + EPI_CL(bj)); }
                const float rsn = rsqrtf(hsv[ai][m] * (1.0f / 256.0f) + EPS_); const float rx = rxv[ai][m];
#pragma unroll
                for (int bj = 0; bj < 2; ++bj) { f32x4 h0, h1; unpack8(cur[bj], h0, h1); f32x4 o0, o1;
#pragma unroll
                    for (int j = 0; j < 4; ++j) { o0[j] = h0[j] * rsn * sigm(acc[ai][bj][m][0][j] * rx); o1[j] = h1[j] * rsn * sigm(acc[ai][bj][m][1][j] * rx); }
                    *(u32x4*)(hm + (size_t)t * 1024 + u.pn * 256 + EPI_CL(bj)) = pack8(o0, o1); }
                cur[0] = nxt[0]; cur[1] = nxt[1]; }
        } else {
            float rxv[2][4];
#pragma unroll
            for (int ai = 0; ai < 2; ++ai)
#pragma unroll
                for (int m = 0; m < 4; ++m) rxv[ai][m] = rsb[u.pm * 256 + EPI_RL(ai, m)];
            EPI_ROWS(ai, m) { const int t = u.pm * 256 + EPI_RL(ai, m); const float rx = rxv[ai][m]; f32x4 o0, o1;
#pragma unroll
                for (int j = 0; j < 4; ++j) { o0[j] = acc[ai][0][m][0][j] * rx * sigm(acc[ai][1][m][0][j] * rx); o1[j] = acc[ai][0][m][1][j] * rx * sigm(acc[ai][1][m][1][j] * rx); }
                *(u32x4*)(uu + (size_t)t * 1024 + u.pn * 128 + wc * 32 + 8 * fq) = pack8(o0, o1); }
        }
    } };

struct SchedP8 { const char* hb; const char* wint; const char* hmg; const char* uc; const char* wmt; const char* wct; int G, c;
    __device__ __forceinline__ bool next(int i, Unit& u) const {
        const int L = (i >> 2) * G + c, r = i & 3; if (L >= 256) return false;
        int pn; map_n4(L, u.pm, pn); u.cont = 0;
        if (r < 2) { u.kind = 2; u.pn = 2 * pn + r; u.a = hb + (size_t)u.pm * 256 * 1024 * 2; u.b = wint + (size_t)(6144 + u.pn * 256) * 1024 * 2; }
        else if (r == 2) { u.kind = 0; u.pn = pn; u.a = hmg + (size_t)u.pm * 256 * 1024 * 2; u.b = wmt + (size_t)pn * 256 * 1024 * 2; }
        else { u.kind = 1; u.pn = pn; u.a = uc + (size_t)u.pm * 256 * 1024 * 2; u.b = wct + (size_t)pn * 256 * 1024 * 2; }
        return true; } };
struct EpiP8 { static constexpr bool AFTER_DRAIN = false; bf16_t* gmc; bf16_t* tmp; bf16_t* merged; const float* rsb;
    __device__ __forceinline__ void mid(Acc&, const Unit&, int, int, int, int) const {}
    __device__ __forceinline__ void pre(const Unit&, int, int, int, int) const {}
    __device__ __forceinline__ void operator()(Acc& acc, const Unit& u, int wr, int wc, int fr, int fq) const {
        if (u.kind == 2) {
            float rxv[2][4];
#pragma unroll
            for (int ai = 0; ai < 2; ++ai)
#pragma unroll
                for (int m = 0; m < 4; ++m) rxv[ai][m] = rsb[u.pm * 256 + EPI_RL(ai, m)];
            EPI_ROWS(ai, m) { const int t = u.pm * 256 + EPI_RL(ai, m); const float rx = rxv[ai][m], rxe = rx * -1.4426950408889634f; f32x4 r0, r1, c0, c1;
#pragma unroll
                for (int j = 0; j < 4; ++j) { const float e0 = __builtin_amdgcn_exp2f(acc[ai][1][m][0][j] * rxe), e1 = __builtin_amdgcn_exp2f(acc[ai][1][m][1][j] * rxe);
                    r0[j] = sigm(acc[ai][0][m][0][j] * rx) * (1.0f + e0); r1[j] = sigm(acc[ai][0][m][1][j] * rx) * (1.0f + e1);
                    c0[j] = __builtin_amdgcn_rcpf(1.0f + e0); c1[j] = __builtin_amdgcn_rcpf(1.0f + e1); }
                bf16_t* ptr = gmc + (size_t)t * 2048 + u.pn * 128 + wc * 32 + 8 * fq;
                *(u32x4*)ptr = pack8(r0, r1); *(u32x4*)(ptr + 1024) = pack8(c0, c1); }
        } else if (u.kind == 0) {
            u32x4 cur[2], nxt[2];
#pragma unroll
            for (int bj = 0; bj < 2; ++bj) cur[bj] = *(const u32x4*)(gmc + (size_t)(u.pm * 256 + EPI_RL(0, 0)) * 2048 + u.pn * 256 + EPI_CL(bj));
            EPI_R8 { const int ai = r8 >> 2, m = r8 & 3; const int t = u.pm * 256 + EPI_RL(ai, m);
                if (r8 < 7) { const int tn = u.pm * 256 + EPI_RL((r8 + 1) >> 2, (r8 + 1) & 3);
#pragma unroll
                    for (int bj = 0; bj < 2; ++bj) nxt[bj] = *(const u32x4*)(gmc + (size_t)tn * 2048 + u.pn * 256 + EPI_CL(bj)); }
#pragma unroll
                for (int bj = 0; bj < 2; ++bj) { const int c = u.pn * 256 + EPI_CL(bj); f32x4 a0, a1; unpack8(cur[bj], a0, a1);
                    *(u32x4*)(tmp + (size_t)t * 1024 + c) = pack8(acc[ai][bj][m][0] * a0, acc[ai][bj][m][1] * a1); }
                cur[0] = nxt[0]; cur[1] = nxt[1]; }
        } else {
            u32x4 cg[2], ct[2], ng[2], nt2[2];
#pragma unroll
            for (int bj = 0; bj < 2; ++bj) { const int t0 = u.pm * 256 + EPI_RL(0, 0); const int c = u.pn * 256 + EPI_CL(bj);
                cg[bj] = *(const u32x4*)(gmc + (size_t)t0 * 2048 + 1024 + c); ct[bj] = *(const u32x4*)(tmp + (size_t)t0 * 1024 + c); }
            EPI_R8 { const int ai = r8 >> 2, m = r8 & 3; const int t = u.pm * 256 + EPI_RL(ai, m);
                if (r8 < 7) { const int tn = u.pm * 256 + EPI_RL((r8 + 1) >> 2, (r8 + 1) & 3);
#pragma unroll
                    for (int bj = 0; bj < 2; ++bj) { const int c = u.pn * 256 + EPI_CL(bj); ng[bj] = *(const u32x4*)(gmc + (size_t)tn * 2048 + 1024 + c); nt2[bj] = *(const u32x4*)(tmp + (size_t)tn * 1024 + c); } }
#pragma unroll
                for (int bj = 0; bj < 2; ++bj) { const int c = u.pn * 256 + EPI_CL(bj); f32x4 b0, b1, t0, t1; unpack8(cg[bj], b0, b1); unpack8(ct[bj], t0, t1);
                    *(u32x4*)(merged + (size_t)t * 1024 + c) = pack8((acc[ai][bj][m][0] + t0) * b0, (acc[ai][bj][m][1] + t1) * b1); }
                cg[0] = ng[0]; cg[1] = ng[1]; ct[0] = nt2[0]; ct[1] = nt2[1]; }
        }
    } };

struct SchedN4 { const char* a; const char* bt; size_t astep, bstep; int G, c;
    __device__ __forceinline__ bool next(int i, Unit& u) const {
        const int L = i * G + c; if (L >= 256) return false;
        map_n4(L, u.pm, u.pn); u.kind = 0; u.cont = 0; u.a = a + (size_t)u.pm * astep; u.b = bt + (size_t)u.pn * bstep; return true; } };
struct SchedPE { const char* a; const char* bt; int G, c;
    __device__ __forceinline__ bool next(int i, Unit& u) const {
        const int L = i * G + c; if (L >= 256 || c < 0) return false;
        u.pm = L >> 2; u.pn = L & 3; u.kind = 0; u.cont = 0; u.a = a + (size_t)u.pm * 256 * 256 * 2; u.b = bt + (size_t)u.pn * 256 * 256 * 2; return true; } };
template <bool SRC_BF16> struct EpiRes { static constexpr bool AFTER_DRAIN = false; const void* src; bf16_t* dstb; float* ssq;
    __device__ __forceinline__ void mid(Acc&, const Unit&, int, int, int, int) const {}
    __device__ __forceinline__ void pre(const Unit& u, int wr, int wc, int fr, int fq) const {
        if (!SRC_BF16) {
            EPI_ROWS(ai, m) { const int t = u.pm * 256 + EPI_RL(ai, m);
#pragma unroll
                for (int bj = 0; bj < 2; ++bj) { const float v = *((const float*)src + (size_t)t * 1024 + u.pn * 256 + EPI_CL(bj)); asm volatile("" :: "v"(v)); } }
        }
    }
    __device__ __forceinline__ void operator()(Acc& acc, const Unit& u, int wr, int wc, int fr, int fq) const {
        f32x4 rb[3][2][2];
#define ERES_LOAD(dst, t_) do { _Pragma("unroll") for (int bj = 0; bj < 2; ++bj) { const size_t o_ = (size_t)(t_) * 1024 + u.pn * 256 + EPI_CL(bj); \
            if (SRC_BF16) dst[bj][0] = __builtin_bit_cast(f32x4, *(const u32x4*)((const bf16_t*)src + o_)); \
            else { dst[bj][0] = *(const f32x4*)((const float*)src + o_); dst[bj][1] = *(const f32x4*)((const float*)src + o_ + 4); } } } while (0)
        ERES_LOAD(rb[0], u.pm * 256 + EPI_RL(0, 0)); ERES_LOAD(rb[1], u.pm * 256 + EPI_RL(0, 1));
        EPI_R8 { const int ai = r8 >> 2, m = r8 & 3; const int t = u.pm * 256 + EPI_RL(ai, m); float ss = 0.f;
            if (r8 < 6) ERES_LOAD(rb[(r8 + 2) % 3], u.pm * 256 + EPI_RL((r8 + 2) >> 2, (r8 + 2) & 3));
#pragma unroll
            for (int bj = 0; bj < 2; ++bj) { const size_t o = (size_t)t * 1024 + u.pn * 256 + EPI_CL(bj); f32x4 v0, v1;
                if (SRC_BF16) unpack8(__builtin_bit_cast(u32x4, rb[r8 % 3][bj][0]), v0, v1); else { v0 = rb[r8 % 3][bj][0]; v1 = rb[r8 % 3][bj][1]; }
                v0 += acc[ai][bj][m][0]; v1 += acc[ai][bj][m][1];
#pragma unroll
                for (int j = 0; j < 4; ++j) ss += v0[j] * v0[j] + v1[j] * v1[j];
                *(u32x4*)(dstb + o) = pack8(v0, v1); }
            ss += __shfl_xor(ss, 16); ss += __shfl_xor(ss, 32);
            if (fq == 0) unsafeAtomicAdd(ssq + t, ss); }
#undef ERES_LOAD
    } };

struct SchedP10 { const char* x1b; const char* wgut; int G, c;
    __device__ __forceinline__ bool next(int i, Unit& u) const {
        const int L = i * G + c; if (L >= 1408) return false;
        int pm, pn; tile_order(L, 64, 22, pm, pn); u.pm = pm; u.pn = pn; u.kind = 0; u.cont = 0;
        u.a = x1b + (size_t)pm * 256 * 1024 * 2; u.b = wgut + (size_t)pn * 256 * 1024 * 2; return true; } };
struct EpiP10 { static constexpr bool AFTER_DRAIN = false; const float* ssq; bf16_t* hid;
    __device__ __forceinline__ void mid(Acc&, const Unit&, int, int, int, int) const {}
    __device__ __forceinline__ void pre(const Unit&, int, int, int, int) const {}
    __device__ __forceinline__ void operator()(Acc& acc, const Unit& u, int wr, int wc, int fr, int fq) const {
        float rsv[2][4];
#pragma unroll
        for (int ai = 0; ai < 2; ++ai)
#pragma unroll
            for (int m = 0; m < 4; ++m) rsv[ai][m] = ssq[u.pm * 256 + EPI_RL(ai, m)];
        EPI_ROWS(ai, m) { const int t = u.pm * 256 + EPI_RL(ai, m); const float rs = rsqrtf(rsv[ai][m] * (1.0f / 1024.0f) + EPS_); f32x4 o0, o1;
#pragma unroll
            for (int j = 0; j < 4; ++j) { o0[j] = silu(acc[ai][0][m][0][j] * rs) * (acc[ai][1][m][0][j] * rs); o1[j] = silu(acc[ai][0][m][1][j] * rs) * (acc[ai][1][m][1][j] * rs); }
            *(u32x4*)(hid + (size_t)t * DFF_ + u.pn * 128 + wc * 32 + 8 * fq) = pack8(o0, o1); }
    } };

struct EpiBf { static constexpr bool AFTER_DRAIN = false; bf16_t* o;
    __device__ __forceinline__ void mid(Acc&, const Unit&, int, int, int, int) const {}
    __device__ __forceinline__ void pre(const Unit&, int, int, int, int) const {}
    __device__ __forceinline__ void operator()(Acc& acc, const Unit& u, int wr, int wc, int fr, int fq) const {
        EPI_ROWS(ai, m) { bf16_t* rowp = o + (size_t)(u.pm * 256 + EPI_RL(ai, m)) * 1024 + u.pn * 256 + EPI_CL(0);
#pragma unroll
            for (int bj = 0; bj < 2; ++bj) *(u32x4*)(rowp + bj * 128) = pack8(acc[ai][bj][m][0], acc[ai][bj][m][1]); }
    } };

struct EpiP12 { static constexpr bool AFTER_DRAIN = true; const float* ssq2; const bf16_t* pe; const bf16_t* xin; float* out; float* ssq3; unsigned* done; const float* fg;
    __device__ __forceinline__ void mid(Acc&, const Unit&, int, int, int, int) const {}
    __device__ __forceinline__ void pre(const Unit&, int, int, int, int) const {}
    __device__ __forceinline__ void operator()(Acc& acc, const Unit& u, int wr, int wc, int fr, int fq) const {
        float rsv[2][4];
#pragma unroll
        for (int ai = 0; ai < 2; ++ai)
#pragma unroll
            for (int m = 0; m < 4; ++m) rsv[ai][m] = ssq2[u.pm * 256 + EPI_RL(ai, m)];
        { u32x4 cx[2], cp[2], nx[2], np[2];
#pragma unroll
            for (int bj = 0; bj < 2; ++bj) { const size_t o = (size_t)(u.pm * 256 + EPI_RL(0, 0)) * 1024 + u.pn * 256 + EPI_CL(bj); cx[bj] = *(const u32x4*)(xin + o); cp[bj] = *(const u32x4*)(pe + o); }
            EPI_R8 { const int ai = r8 >> 2, m = r8 & 3; const int t = u.pm * 256 + EPI_RL(ai, m); const float rs = rsqrtf(rsv[ai][m] * (1.0f / 1024.0f) + EPS_); float ss = 0.f;
                if (r8 < 7) {
#pragma unroll
                    for (int bj = 0; bj < 2; ++bj) { const size_t o = (size_t)(u.pm * 256 + EPI_RL((r8 + 1) >> 2, (r8 + 1) & 3)) * 1024 + u.pn * 256 + EPI_CL(bj); nx[bj] = *(const u32x4*)(xin + o); np[bj] = *(const u32x4*)(pe + o); } }
#pragma unroll
                for (int bj = 0; bj < 2; ++bj) { f32x4 p0, p1, v0, v1; unpack8(cp[bj], p0, p1); unpack8(cx[bj], v0, v1);
#pragma unroll
                    for (int j = 0; j < 4; ++j) { v0[j] += sigm(acc[ai][bj][m][0][j] * rs) * p0[j]; v1[j] += sigm(acc[ai][bj][m][1][j] * rs) * p1[j]; ss += v0[j] * v0[j] + v1[j] * v1[j]; }
                    acc[ai][bj][m][0] = v0; acc[ai][bj][m][1] = v1; }
                ss += __shfl_xor(ss, 16); ss += __shfl_xor(ss, 32);
                if (fq == 0) unsafeAtomicAdd(ssq3 + t, ss);
                cx[0] = nx[0]; cx[1] = nx[1]; cp[0] = np[0]; cp[1] = np[1]; } }
        asm volatile("s_waitcnt vmcnt(0)" ::: "memory");
        unsigned* cnt = done + 64 * u.pm;
        if ((threadIdx.x & 63) == 0) __hip_atomic_fetch_add(cnt, 1u, __ATOMIC_RELAXED, __HIP_MEMORY_SCOPE_AGENT);
        { unsigned sp = 0; while (__hip_atomic_load(cnt, __ATOMIC_RELAXED, __HIP_MEMORY_SCOPE_AGENT) < 32u) { __builtin_amdgcn_s_sleep(1); if (++sp > (1u << 22)) break; } }
#pragma unroll
        for (int ai = 0; ai < 2; ++ai)
#pragma unroll
            for (int m = 0; m < 4; ++m) rsv[ai][m] = __hip_atomic_load(ssq3 + u.pm * 256 + EPI_RL(ai, m), __ATOMIC_RELAXED, __HIP_MEMORY_SCOPE_AGENT);
        f32x4 gv[2][2];
#pragma unroll
        for (int bj = 0; bj < 2; ++bj) { const int cc = u.pn * 256 + EPI_CL(bj); gv[bj][0] = *(const f32x4*)(fg + cc); gv[bj][1] = *(const f32x4*)(fg + cc + 4); }
        EPI_ROWS(ai, m) { const int t = u.pm * 256 + EPI_RL(ai, m);
            const float rs = rsqrtf(rsv[ai][m] * (1.0f / 1024.0f) + EPS_);
#pragma unroll
            for (int bj = 0; bj < 2; ++bj) { const size_t o = (size_t)t * 1024 + u.pn * 256 + EPI_CL(bj);
                *(f32x4*)(out + o) = acc[ai][bj][m][0] * rs * gv[bj][0]; *(f32x4*)(out + o + 4) = acc[ai][bj][m][1] * rs * gv[bj][1]; } }
    } };

struct CvtTile { const float* src; int ld; const float* scale; bf16_t* dst; int dstld; };
__device__ __forceinline__ CvtTile cvt_tile_params(const Params& p, int tl) {
    const int NT0 = 2048, NT4 = NT0 + 1024, NT5 = NT4 + 1408, NT6 = NT5 + 704;
    unsigned char* ws = p.ws; CvtTile t; t.scale = nullptr;
    if (tl < NT0) { const int nb = tl >> 4, kb = tl & 15; const int n0 = nb * 64; int col;
        if (n0 < 4096) col = n0; else if (n0 < 6144) { const int j = (n0 - 4096) >> 8, r = (n0 - 4096) & 255; col = (r < 128) ? (4104 + 128 * j + r) : (5128 + 128 * j + r - 128); }
        else { const int j = (n0 - 6144) >> 8, r = (n0 - 6144) & 255; col = 6152 + ((r < 128) ? (128 * j + r) : (1024 + 128 * j + r - 128)); }
        t.src = p.in[3] + (size_t)kb * 64 * NIN_ + col; t.ld = NIN_; t.scale = p.in[2] + kb * 64; t.dst = (bf16_t*)(ws + O_WINT) + (size_t)n0 * 1024 + kb * 64; t.dstld = 1024; }
    else if (tl < NT4) { const int w = (tl - NT0) >> 8, l = (tl - NT0) & 255; const int nb = l >> 4, kb = l & 15;
        const float* base = w == 0 ? p.in[12] : (w == 1 ? p.in[13] : (w == 2 ? p.in[14] : p.in[20])); const size_t od = w == 0 ? O_WMT : (w == 1 ? O_WCT : (w == 2 ? O_WOT : O_WPGT));
        t.src = base + (size_t)kb * 64 * 1024 + nb * 64; t.ld = 1024; if (w == 3) t.scale = p.in[19] + kb * 64; if (w == 0) t.scale = p.in[7] + kb * 64; t.dst = (bf16_t*)(ws + od) + (size_t)nb * 64 * 1024 + kb * 64; t.dstld = 1024; }
    else if (tl < NT5) { const int l = tl - NT4; const int nb = l >> 4, kb = l & 15; const int n0 = nb * 64; const int j = n0 >> 8, r = n0 & 255;
        const float* base = (r < 128) ? p.in[16] : p.in[17]; const int col = 128 * j + (r & 127);
        t.src = base + (size_t)kb * 64 * DFF_ + col; t.ld = DFF_; t.scale = p.in[15] + kb * 64; t.dst = (bf16_t*)(ws + O_WGUT) + (size_t)n0 * 1024 + kb * 64; t.dstld = 1024; }
    else if (tl < NT6) { const int l = tl - NT5; const int nb = l / 44, kb = l % 44;
        t.src = p.in[18] + (size_t)kb * 64 * 1024 + nb * 64; t.ld = 1024; t.dst = (bf16_t*)(ws + O_WDT) + (size_t)nb * 64 * DFF_ + kb * 64; t.dstld = DFF_; }
    else { const int l = tl - NT6; const int nb = l >> 2, kb = l & 3;
        t.src = p.in[21] + (size_t)kb * 64 * 1024 + nb * 64; t.ld = 1024; t.dst = (bf16_t*)(ws + O_WPPT) + (size_t)nb * 64 * 256 + kb * 64; t.dstld = 256; }
    return t;
}
__device__ __forceinline__ void cvt_tile_load(const CvtTile& t, f32x4 (&v)[2]) {
    const int tid = threadIdx.x, kk = tid >> 4, c4 = (tid & 15) * 4;
#pragma unroll
    for (int pss = 0; pss < 2; ++pss) { const int k = kk + pss * 32; v[pss] = *(const f32x4*)(t.src + (size_t)k * t.ld + c4); if (t.scale) v[pss] = v[pss] * t.scale[k]; }
}

__device__ __forceinline__ void phase0(const Params& p, unsigned char* sm) {
    unsigned char* ws = p.ws;
    const int tid = threadIdx.x, lane = tid & 63, wid = tid >> 6;
    const size_t gtid = (size_t)blockIdx.x * 512 + tid, gthreads = (size_t)gridDim.x * 512;
    for (size_t i = gtid; i < ZERO_BYTES / 16; i += gthreads) ((u32x4*)(ws + O_ZERO))[i] = (u32x4){0u, 0u, 0u, 0u};
    { const float* pp = p.in[1]; bf16_t* pb = (bf16_t*)(ws + O_PB);
        for (size_t i = gtid; i < (size_t)T_ * 256 / 8; i += gthreads) { const f32x4 a = *(const f32x4*)(pp + i * 8), b = *(const f32x4*)(pp + i * 8 + 4); *(u32x4*)(pb + i * 8) = pack8(a, b); } }
    { const float* x = p.in[0]; const float* g = p.in[2]; const float* win = p.in[3]; const float* bif = p.in[4];
        float* wgT = (float*)sm;
        for (int idx = tid; idx < 8192; idx += 512) { const int k = idx >> 3, j = idx & 7; wgT[j * 1024 + k] = win[(size_t)k * NIN_ + 4096 + j] * g[k]; }
        __syncthreads();
        bf16_t* hb = (bf16_t*)(ws + O_HB); float* ig = (float*)(ws + O_IG); float* lf = (float*)(ws + O_LF);
        const int rstep = gridDim.x * 8; int row = blockIdx.x * 8 + wid;
        f32x4 xn[4];
#pragma unroll
        for (int i = 0; i < 4; ++i) xn[i] = (row < T_) ? *(const f32x4*)(x + (size_t)row * 1024 + i * 256 + lane * 4) : (f32x4){0.f, 0.f, 0.f, 0.f};
        for (; row < T_; row += rstep) {
            f32x4 xv[4]; float ss = 0.f;
#pragma unroll
            for (int i = 0; i < 4; ++i) { xv[i] = xn[i]; ss += xv[i][0] * xv[i][0] + xv[i][1] * xv[i][1] + xv[i][2] * xv[i][2] + xv[i][3] * xv[i][3]; }
            { const int nrow = row + rstep;
                if (nrow < T_) {
#pragma unroll
                    for (int i = 0; i < 4; ++i) xn[i] = *(const f32x4*)(x + (size_t)nrow * 1024 + i * 256 + lane * 4); } }
            ss = wave_sum(ss); const float rs = rsqrtf(ss * (1.0f / 1024.0f) + EPS_);
            float d[8];
#pragma unroll
            for (int j = 0; j < 8; ++j) d[j] = 0.f;
            if (lane == 0) ((float*)(ws + O_RS))[row] = rs;
#pragma unroll
            for (int i = 0; i < 4; ++i) { const f32x4 hn = xv[i] * rs;
                u32x2 w; w.x = cvt_pk_bf16(xv[i][0], xv[i][1]); w.y = cvt_pk_bf16(xv[i][2], xv[i][3]); *(u32x2*)(hb + (size_t)row * 1024 + i * 256 + lane * 4) = w;
#pragma unroll
                for (int j = 0; j < 8; ++j) { const f32x4 wv = *(const f32x4*)(wgT + j * 1024 + i * 256 + lane * 4); d[j] += hn[0] * wv[0] + hn[1] * wv[1] + hn[2] * wv[2] + hn[3] * wv[3]; } }
#pragma unroll
            for (int j = 0; j < 8; ++j) d[j] = wave_sum(d[j]);
            if (lane < 8) { float v = d[0];
#pragma unroll
                for (int j = 1; j < 8; ++j) v = (lane == j) ? d[j] : v;
                v += bif[lane];
                if (lane < 4) ig[(size_t)row * 4 + lane] = v;
                else { const float z = v; lf[(size_t)row * 4 + lane - 4] = fminf(z, 0.f) - log1pf(__expf(-fabsf(z))); } }
        }
        __syncthreads();
    }
    { const int NTILES = 2048 + 1024 + 1408 + 704 + 64; const int gs = gridDim.x;
        float* tl = (float*)sm;
        int t = blockIdx.x; CvtTile c0{}, c1{}; f32x4 v0[2], v1[2];
        if (t < NTILES) { c0 = cvt_tile_params(p, t); cvt_tile_load(c0, v0); }
        if (t + gs < NTILES) { c1 = cvt_tile_params(p, t + gs); cvt_tile_load(c1, v1); }
        for (; t < NTILES; t += gs) {
            { const int kk = tid >> 4, c4 = (tid & 15) * 4;
#pragma unroll
                for (int pss = 0; pss < 2; ++pss) { const int k = kk + pss * 32;
#pragma unroll
                    for (int j = 0; j < 4; ++j) tl[k * 65 + c4 + j] = v0[pss][j]; } }
            __syncthreads();
            const CvtTile done = c0; c0 = c1; v0[0] = v1[0]; v0[1] = v1[1];
            { const int tn = t + 2 * gs; if (tn < NTILES) { c1 = cvt_tile_params(p, tn); cvt_tile_load(c1, v1); } }
            { const int n = tid >> 3, k8 = (tid & 7) * 8; float e[8];
#pragma unroll
                for (int q = 0; q < 8; ++q) e[q] = tl[(k8 + q) * 65 + n];
                u32x4 w; w.x = cvt_pk_bf16(e[0], e[1]); w.y = cvt_pk_bf16(e[2], e[3]); w.z = cvt_pk_bf16(e[4], e[5]); w.w = cvt_pk_bf16(e[6], e[7]);
                *(u32x4*)(done.dst + (size_t)n * done.dstld + k8) = w; }
            __syncthreads();
        }
    }
}

__device__ __forceinline__ void phase2(const Params& p, unsigned char* sm) {
    unsigned char* ws = p.ws;
    const int tid = threadIdx.x, lane = tid & 63, wid = tid >> 6;
    float* rowfac = (float*)sm; float* colfac = rowfac + 256; float* wsum = colfac + 256;
    const float* ig = (const float*)(ws + O_IG); const float* lf = (const float*)(ws + O_LF);
    const bf16_t* qkpre = (const bf16_t*)p.out;
    const float* cw = p.in[5]; const float* cb = p.in[6];
    for (int item = blockIdx.x; item < 256; item += gridDim.x) {
        const int b = item >> 5, h = (item >> 3) & 3, sc = item & 7; const int tokb = b * SEQ_ + sc * 256;
        float v = 0.f, igv = 0.f;
        if (tid < 256) { v = lf[(size_t)(tokb + tid) * 4 + h]; igv = ig[(size_t)(tokb + tid) * 4 + h]; }
#pragma unroll
        for (int o = 1; o < 64; o <<= 1) { const float n = __shfl_up(v, o); if (lane >= o) v += n; }
        if (tid < 256 && lane == 63) wsum[wid] = v;
        __syncthreads();
        if (tid < 256) { float add = 0.f; for (int j = 0; j < wid; ++j) add += wsum[j]; v += add; rowfac[tid] = __expf(v); colfac[tid] = __expf(igv - v);
            if (tid == 255) ((float*)(ws + O_EBL))[item] = __expf(v); }
        __syncthreads();
#pragma unroll 1
        for (int qt = 0; qt < 4; ++qt) {
        const int cp = tid & 127, tg = tid >> 7; const int ch = 2 * cp; const int tl0 = qt * 64 + tg * 16; const int s0 = sc * 256 + tl0;
        { const int col = h * 256 + ch; float x0[19], x1[19];
#pragma unroll
            for (int i = 0; i < 19; ++i) { const int s = s0 - 3 + i; unsigned w = 0u; if (s >= 0) w = *(const unsigned*)(qkpre + (size_t)(b * SEQ_ + s) * 2048 + col); x0[i] = bf_lo(w); x1[i] = bf_hi(w); }
            float w0[4], w1[4];
#pragma unroll
            for (int k = 0; k < 4; ++k) { const f32x2 wv = *(const f32x2*)(cw + (size_t)k * 2048 + col); w0[k] = wv[0]; w1[k] = wv[1]; }
            const f32x2 bv = *(const f32x2*)(cb + col);
            bf16_t* wq = (bf16_t*)(ws + O_WQ) + (size_t)item * 65536;
#pragma unroll
            for (int i = 0; i < 16; ++i) { float y0 = bv[0], y1 = bv[1];
#pragma unroll
                for (int k = 0; k < 4; ++k) { y0 += x0[i + k] * w0[k]; y1 += x1[i + k] * w1[k]; }
                const float f = rowfac[tl0 + i] * 0.0625f;
                *(unsigned*)(wq + (size_t)(tl0 + i) * 256 + ch) = cvt_pk_bf16(silu(y0) * f, silu(y1) * f); } }
        { const int col = 1024 + h * 256 + ch; float x0[19], x1[19];
#pragma unroll
            for (int i = 0; i < 19; ++i) { const int s = s0 - 3 + i; unsigned w = 0u; if (s >= 0) w = *(const unsigned*)(qkpre + (size_t)(b * SEQ_ + s) * 2048 + col); x0[i] = bf_lo(w); x1[i] = bf_hi(w); }
            float w0[4], w1[4];
#pragma unroll
            for (int k = 0; k < 4; ++k) { const f32x2 wv = *(const f32x2*)(cw + (size_t)k * 2048 + col); w0[k] = wv[0]; w1[k] = wv[1]; }
            const f32x2 bv = *(const f32x2*)(cb + col);
            bf16_t* kw = (bf16_t*)(ws + O_KW) + (size_t)item * 65536; bf16_t* kwt = (bf16_t*)(ws + O_KWT) + (size_t)item * 65536;
            float k0[16], k1[16]; float n0 = 0.f, n1 = 0.f;
#pragma unroll
            for (int i = 0; i < 16; ++i) { float y0 = bv[0], y1 = bv[1];
#pragma unroll
                for (int k = 0; k < 4; ++k) { y0 += x0[i + k] * w0[k]; y1 += x1[i + k] * w1[k]; }
                const float f = colfac[tl0 + i]; k0[i] = silu(y0) * f; k1[i] = silu(y1) * f; n0 += k0[i]; n1 += k1[i];
                *(unsigned*)(kw + (size_t)(tl0 + i) * 256 + ch) = cvt_pk_bf16(k0[i], k1[i]); }
            u32x4 a, c;
            a.x = cvt_pk_bf16(k0[0], k0[1]); a.y = cvt_pk_bf16(k0[2], k0[3]); a.z = cvt_pk_bf16(k0[4], k0[5]); a.w = cvt_pk_bf16(k0[6], k0[7]);
            c.x = cvt_pk_bf16(k0[8], k0[9]); c.y = cvt_pk_bf16(k0[10], k0[11]); c.z = cvt_pk_bf16(k0[12], k0[13]); c.w = cvt_pk_bf16(k0[14], k0[15]);
            *(u32x4*)(kwt + (size_t)ch * 256 + tl0) = a; *(u32x4*)(kwt + (size_t)ch * 256 + tl0 + 8) = c;
            a.x = cvt_pk_bf16(k1[0], k1[1]); a.y = cvt_pk_bf16(k1[2], k1[3]); a.z = cvt_pk_bf16(k1[4], k1[5]); a.w = cvt_pk_bf16(k1[6], k1[7]);
            c.x = cvt_pk_bf16(k1[8], k1[9]); c.y = cvt_pk_bf16(k1[10], k1[11]); c.z = cvt_pk_bf16(k1[12], k1[13]); c.w = cvt_pk_bf16(k1[14], k1[15]);
            *(u32x4*)(kwt + (size_t)(ch + 1) * 256 + tl0) = a; *(u32x4*)(kwt + (size_t)(ch + 1) * 256 + tl0 + 8) = c;
            float* nsum = (float*)(ws + O_NSUM) + (size_t)item * 256;
            unsafeAtomicAdd(nsum + ch, n0); unsafeAtomicAdd(nsum + ch + 1, n1); }
        }
        __syncthreads();
    }
}

__device__ __forceinline__ void phase4(const Params& p, unsigned char* sm) {
    unsigned char* ws = p.ws;
    const int tid = threadIdx.x;
    const float* ebl = (const float*)(ws + O_EBL);
    const bf16_t* lt = (const bf16_t*)(p.ws + O_KWT);
    bf16_t* cint = (bf16_t*)(ws + O_CINT);
    const size_t gtid = (size_t)blockIdx.x * 512 + tid, gthreads = (size_t)gridDim.x * 512;
#pragma unroll 2
    for (size_t g = gtid; g < (size_t)32 * 16384; g += gthreads) {
        const int bh = (int)(g >> 14), e4 = (int)(g & 16383);
        f32x4 c = {0.f, 0.f, 0.f, 0.f};
        u32x2 lw[7]; float eb[7];
#pragma unroll
        for (int sc = 0; sc < 7; ++sc) { lw[sc] = *(const u32x2*)(lt + (size_t)(bh * 8 + sc) * 65536 + e4 * 4); eb[sc] = ebl[bh * 8 + sc]; }
#pragma unroll
        for (int sc = 0; sc < 8; ++sc) { const int item = bh * 8 + sc;
            u32x2 w; w.x = cvt_pk_bf16(c[0], c[1]); w.y = cvt_pk_bf16(c[2], c[3]); *(u32x2*)(cint + (size_t)item * 65536 + e4 * 4) = w;
            if (sc < 7) { const f32x4 l = {bf_lo(lw[sc].x), bf_hi(lw[sc].x), bf_lo(lw[sc].y), bf_hi(lw[sc].y)}; c = (c + l) * eb[sc]; } }
    }
    float* nin = (float*)sm;
    const float* nsum = (const float*)(ws + O_NSUM);
    float* denx = (float*)(ws + O_DENX);
    for (int item = blockIdx.x; item < 256; item += gridDim.x) {
        const int b = item >> 5, h = (item >> 3) & 3, sc = item & 7; const int tokb = b * SEQ_ + sc * 256; const int bh = item >> 3;
        if (tid < 256) { float eb[7], ns[7];
#pragma unroll
            for (int j = 0; j < 7; ++j) { eb[j] = ebl[bh * 8 + j]; ns[j] = nsum[(size_t)(bh * 8 + j) * 256 + tid]; }
            float nv = 0.f;
#pragma unroll
            for (int j = 0; j < 7; ++j) if (j < sc) nv = eb[j] * (nv + ns[j]);
            nin[tid] = nv; }
        __syncthreads();
        const int tl = tid >> 1, half = tid & 1;
        const bf16_t* wq = (const bf16_t*)(ws + O_WQ) + (size_t)item * 65536 + (size_t)tl * 256 + half * 128;
        float d = 0.f;
#pragma unroll
        for (int i = 0; i < 16; ++i) { f32x4 a0, a1; unpack8(*(const u32x4*)(wq + i * 8), a0, a1); const float* nn = nin + half * 128 + i * 8;
            d += a0[0] * nn[0] + a0[1] * nn[1] + a0[2] * nn[2] + a0[3] * nn[3] + a1[0] * nn[4] + a1[1] * nn[5] + a1[2] * nn[6] + a1[3] * nn[7]; }
        d += __shfl_xor(d, 1);
        if (half == 0) denx[(size_t)(tokb + tl) * 4 + h] = d;
        __syncthreads();
    }
}

__device__ __forceinline__ void phase7(const Params& p, unsigned char* sm) {
    unsigned char* ws = p.ws;
    const int tid = threadIdx.x, lane = tid & 63, wid = tid >> 6;
    const bf16_t* uu = (const bf16_t*)p.out; bf16_t* uc = (bf16_t*)(ws + O_UC);
    const float* cw = p.in[8]; const float* cb = p.in[9]; const float* lg = p.in[10]; const float* lb = p.in[11];
    u32x4 pf[12];
#define P7_LOAD(tile_) do { const int t0_ = (tile_) * 16; const int b_ = t0_ / SEQ_, s0_ = t0_ % SEQ_; \
        _Pragma("unroll") for (int q = 0; q < 12; ++q) { const int idx = tid + q * 512; const int r = idx >> 7, c16 = idx & 127; const int s_ = s0_ - 30 + r; \
            pf[q] = (u32x4){0u, 0u, 0u, 0u}; if (idx < 46 * 128 && s_ >= 0) pf[q] = *(const u32x4*)(uu + (size_t)(b_ * SEQ_ + s_) * 1024 + c16 * 8); } } while (0)
    int tile = blockIdx.x;
    if (tile < 1024) P7_LOAD(tile);
    f32x2 wv[31];
#pragma unroll
    for (int k = 0; k < 31; ++k) wv[k] = *(const f32x2*)(cw + (size_t)k * 1024 + 2 * tid);
    const f32x2 bv = *(const f32x2*)(cb + 2 * tid);
    f32x4 lgv[4], lbv[4];
#pragma unroll
    for (int i = 0; i < 4; ++i) { lgv[i] = *(const f32x4*)(lg + i * 256 + lane * 4); lbv[i] = *(const f32x4*)(lb + i * 256 + lane * 4); }
    for (; tile < 1024; tile += gridDim.x) {
        const int t0 = tile * 16;
#pragma unroll
        for (int q = 0; q < 12; ++q) { const int idx = tid + q * 512; const int r = idx >> 7, c16 = idx & 127; if (idx < 46 * 128) *(u32x4*)(sm + r * 2048 + c16 * 16) = pf[q]; }
        __syncthreads();
        f32x2 yy[16];
        {
#pragma unroll
            for (int t = 0; t < 16; ++t) yy[t] = bv;
#pragma unroll
            for (int r = 0; r < 46; ++r) { const unsigned w = *(const unsigned*)(sm + r * 2048 + tid * 4); const f32x2 xx = {bf_lo(w), bf_hi(w)};
#pragma unroll
                for (int t = 0; t < 16; ++t) { const int k = r - t; if (k >= 0 && k <= 30) yy[t] = __builtin_elementwise_fma(wv[k], xx, yy[t]); }
                if ((r & 3) == 3) asm volatile("" ::: "memory"); }
        }
        __syncthreads();
#pragma unroll
        for (int t = 0; t < 16; ++t) *(f32x2*)(sm + t * 4096 + tid * 8) = yy[t];
        { const int tn = tile + gridDim.x; if (tn < 1024) P7_LOAD(tn); }
        __syncthreads();
#pragma unroll
        for (int tt = 0; tt < 2; ++tt) { const int t = wid * 2 + tt; f32x4 v[4]; float s1 = 0.f;
#pragma unroll
            for (int i = 0; i < 4; ++i) { v[i] = *(const f32x4*)(sm + t * 4096 + (i * 256 + lane * 4) * 4); s1 += v[i][0] + v[i][1] + v[i][2] + v[i][3]; }
            s1 = wave_sum(s1); const float mu = s1 * (1.0f / 1024.0f); float s2 = 0.f;
#pragma unroll
            for (int i = 0; i < 4; ++i) { v[i] = v[i] - mu; s2 += v[i][0] * v[i][0] + v[i][1] * v[i][1] + v[i][2] * v[i][2] + v[i][3] * v[i][3]; }
            s2 = wave_sum(s2); const float rstd = rsqrtf(s2 * (1.0f / 1024.0f) + EPS_);
#pragma unroll
            for (int i = 0; i < 4; ++i) { const int c = i * 256 + lane * 4; f32x4 z = v[i] * rstd * lgv[i] + lbv[i];
                u32x2 w; w.x = cvt_pk_bf16(silu(z[0]), silu(z[1])); w.y = cvt_pk_bf16(silu(z[2]), silu(z[3])); *(u32x2*)(uc + (size_t)(t0 + t) * 1024 + c) = w; } }
        __syncthreads();
    }
#undef P7_LOAD
}

__device__ __forceinline__ void phase13(const Params& p) {
    const float* ssq3 = (const float*)(p.ws + O_SSQ3); const float* fg = p.in[22];
    const size_t gtid = (size_t)blockIdx.x * 512 + threadIdx.x, gthreads = (size_t)gridDim.x * 512;
    for (size_t i = gtid; i < (size_t)T_ * 256; i += gthreads) { const int row = (int)(i >> 8), c = (int)(i & 255) * 4;
        const float rs = rsqrtf(ssq3[row] * (1.0f / 1024.0f) + EPS_); const f32x4 g = *(const f32x4*)(fg + c);
        f32x4 v = *(const f32x4*)(p.out + i * 4); v = v * rs * g; *(f32x4*)(p.out + i * 4) = v; }
}

#define XB_TMO      128
#define XB_XCNT(j)  (256  + 64 * (j))
#define XB_XSUB(j)  (1280 + 64 * (j))
#define XB_XGEN(j)  (2304 + 64 * (j))
#define XB_TOP      3328
#define XB_TOPGEN   3392
#define XCD_BAR_WORDS 3456
#define XB_SPIN_CAP (1u << 18)
__device__ __forceinline__ unsigned xb_ld(unsigned* p)              { return __hip_atomic_load(p, __ATOMIC_RELAXED, __HIP_MEMORY_SCOPE_AGENT); }
__device__ __forceinline__ unsigned xb_add(unsigned* p, unsigned v) { return __hip_atomic_fetch_add(p, v, __ATOMIC_RELAXED, __HIP_MEMORY_SCOPE_AGENT); }
__device__ __forceinline__ unsigned xb_xcc_id() { return (unsigned)__builtin_amdgcn_s_getreg((3 << 11) | 20) & 0xFu; }
#define XB_SPIN(cond, bar) do { unsigned _sp = 0; while (cond) { __builtin_amdgcn_s_sleep(1); \
    if ((++_sp & 255u) == 0u) { if (xb_ld(&(bar)[XB_TMO])) break; if (_sp > XB_SPIN_CAP) { atomicAdd(&(bar)[XB_TMO], 1u); break; } } } } while (0)
struct XcdBarrier { unsigned* bar; unsigned x; volatile LAS unsigned* st; };
__device__ __forceinline__ XcdBarrier xcd_barrier_post(unsigned* bar, volatile LAS unsigned* st) {
    XcdBarrier b; b.bar = bar; b.x = xb_xcc_id(); b.st = st;
    if (threadIdx.x == 0) (void)xb_add(&bar[XB_XCNT(b.x)], 1u);
    return b;
}
__device__ __forceinline__ void xcd_barrier_complete(unsigned* bar, unsigned x, unsigned& nloc, unsigned& nx) {
    const unsigned G = gridDim.x * gridDim.y * gridDim.z;
    unsigned sum, cnt, mine, sp = 0u;
    for (;;) {
        sum = 0u; cnt = 0u; mine = 0u;
#pragma unroll
        for (unsigned j = 0; j < 16; ++j) { const unsigned c = xb_ld(&bar[XB_XCNT(j)]); sum += c; cnt += (c > 0u) ? 1u : 0u; mine = (j == x) ? c : mine; }
        if (sum == G) break;
        __builtin_amdgcn_s_sleep(1);
        if ((++sp & 255u) == 0u) { if (xb_ld(&bar[XB_TMO])) break; if (sp > XB_SPIN_CAP) { atomicAdd(&bar[XB_TMO], 1u); break; } }
    }
    nloc = mine > 0u ? mine : 1u; nx = cnt > 0u ? cnt : 1u;
}
__device__ __forceinline__ void xcd_barrier(const XcdBarrier& b) {
    asm volatile("s_waitcnt vmcnt(0)" ::: "memory");
    __syncthreads();
    if (threadIdx.x == 0) {
        unsigned* bar = b.bar;
        __builtin_amdgcn_s_waitcnt(0);
        unsigned nloc = b.st[0], nx = b.st[1];
        if (nloc == 0u) { xcd_barrier_complete(bar, b.x, nloc, nx); b.st[0] = nloc; b.st[1] = nx; }
        const unsigned old = xb_add(&bar[XB_XSUB(b.x)], 1u);
        const unsigned gen = old / nloc;
        if (old + 1u == (gen + 1u) * nloc) {
            __builtin_amdgcn_fence(__ATOMIC_RELEASE, "agent");
            asm volatile("s_waitcnt vmcnt(0)" ::: "memory");
            const unsigned og = xb_add(&bar[XB_TOP], 1u);
            const unsigned tg = og / nx;
            if (og + 1u == (tg + 1u) * nx) xb_add(&bar[XB_TOPGEN], 1u);
            else XB_SPIN(xb_ld(&bar[XB_TOPGEN]) == tg, bar);
            __builtin_amdgcn_fence(__ATOMIC_ACQUIRE, "agent");
            xb_add(&bar[XB_XGEN(b.x)], 1u);
            asm volatile("s_waitcnt vmcnt(0)" ::: "memory");
        } else {
            XB_SPIN(xb_ld(&bar[XB_XGEN(b.x)]) == gen, bar);
            __builtin_amdgcn_fence(__ATOMIC_ACQUIRE, "agent");
            asm volatile("s_waitcnt vmcnt(0)" ::: "memory");
        }
    }
    __syncthreads();
}

template <bool COOP>
__global__ void __launch_bounds__(512, 2) mk_fwd(Params p) {
    extern __shared__ __attribute__((aligned(16))) unsigned char shm[];
    LAS unsigned char* lds = (LAS unsigned char*)shm;
    unsigned char* ws = p.ws;
    const int G = gridDim.x, c = blockIdx.x;
#ifndef PHMASK
#define PHMASK 0x3fff
#endif
#define PH(k) if (((PHMASK >> (k)) & 1) && p.ph_lo <= (k) && (k) < p.ph_hi)
    XcdBarrier xb{};
    if (COOP) { volatile LAS unsigned* st = (volatile LAS unsigned*)(lds + 131072);
        if (threadIdx.x == 0) { st[0] = 0u; st[1] = 0u; }
        __syncthreads();
        xb = xcd_barrier_post((unsigned*)(ws + O_BAR), st); }
#define SYNC(k) if (COOP) { if (p.ph_lo <= (k) && (k) + 1 < p.ph_hi) { xcd_barrier(xb); } }
    PH(0) phase0(p, shm);
    SYNC(0)
    PH(1) { SchedP1 S{(const char*)(ws + O_HB), (const char*)(ws + O_WINT), G, c}; EpiP1 E{(bf16_t*)p.out, (bf16_t*)(ws + O_VT), (const float*)(ws + O_RS)}; gemm_phase(lds, 1024, 1024, 1024, S, E); }
    SYNC(1)
    PH(3) { phase2(p, shm);
        asm volatile("s_waitcnt vmcnt(0)" ::: "memory"); __syncthreads();
        SchedP3 S{(const char*)(ws + O_WQ), (const char*)(ws + O_KW), (const char*)(ws + O_VT), (const char*)(ws + O_KWT), G, c};
        EpiP3 E{(bf16_t*)(ws + O_SS), (bf16_t*)(ws + O_KWT), (float*)(ws + O_DENI)}; gemm_phase(lds, 256, 256, 256, S, E); }
    SYNC(3)
    PH(4) phase4(p, shm);
    SYNC(4)
    PH(6) { { SchedP5 S{(const char*)(ws + O_SS), (const char*)(ws + O_VT), (const char*)(ws + O_WQ), (const char*)(ws + O_CINT), G, c};
            EpiP5 E{(bf16_t*)(ws + O_HM), (const float*)(ws + O_DENI), (const float*)(ws + O_DENX), (float*)(ws + O_HSS)}; gemm_phase(lds, 256, 256, 256, S, E); }
        { SchedP6 S{(const char*)(ws + O_HB), (const char*)(ws + O_WINT), G, c};
            EpiP6 E{(bf16_t*)(ws + O_HM), (float*)(ws + O_HSS), (const float*)(ws + O_RS), (bf16_t*)p.out}; gemm_phase(lds, 1024, 1024, 1024, S, E); } }
    SYNC(6)
    PH(7) phase7(p, shm);
    SYNC(7)
    PH(8) { SchedP8 S{(const char*)(ws + O_HB), (const char*)(ws + O_WINT), (const char*)(ws + O_HM), (const char*)(ws + O_UC), (const char*)(ws + O_WMT), (const char*)(ws + O_WCT), G, c};
        EpiP8 E{(bf16_t*)(ws + O_GMC), (bf16_t*)p.out + (size_t)T_ * 1024, (bf16_t*)(ws + O_MERGED), (const float*)(ws + O_RS)}; gemm_phase(lds, 1024, 1024, 1024, S, E); }
    SYNC(8)
    PH(9) { SchedN4 S{(const char*)(ws + O_MERGED), (const char*)(ws + O_WOT), (size_t)256 * 1024 * 2, (size_t)256 * 1024 * 2, G, c};
        EpiRes<true> E{(const void*)(ws + O_HB), (bf16_t*)(ws + O_X1B), (float*)(ws + O_SSQ1)}; gemm_phase(lds, 1024, 1024, 1024, S, E); }
    SYNC(9)
    PH(10) { { SchedP10 S{(const char*)(ws + O_X1B), (const char*)(ws + O_WGUT), G, c}; EpiP10 E{(const float*)(ws + O_SSQ1), (bf16_t*)(ws + O_HID)}; gemm_phase(lds, 1024, 1024, 1024, S, E); }
        { const int h = G >> 1; SchedPE S{(const char*)(ws + O_PB), (const char*)(ws + O_WPPT), h, c - h};
            EpiBf E{(bf16_t*)(ws + O_PE)}; if (c >= h) gemm_phase(lds, 256, 256, 256, S, E); } }
    SYNC(10)
    PH(11) { SchedN4 S{(const char*)(ws + O_HID), (const char*)(ws + O_WDT), (size_t)256 * DFF_ * 2, (size_t)256 * DFF_ * 2, G, c};
            EpiRes<true> E{(const void*)(ws + O_X1B), (bf16_t*)(ws + O_X2B), (float*)(ws + O_SSQ2)}; gemm_phase(lds, DFF_, DFF_, DFF_, S, E); }
    SYNC(11)
    PH(12) { SchedN4 S{(const char*)(ws + O_X2B), (const char*)(ws + O_WPGT), (size_t)256 * 1024 * 2, (size_t)256 * 1024 * 2, G, c};
        EpiP12 E{(const float*)(ws + O_SSQ2), (const bf16_t*)(ws + O_PE), (const bf16_t*)(ws + O_X2B), p.out, (float*)(ws + O_SSQ3), (unsigned*)(ws + O_BAR) + XCD_BAR_WORDS, p.in[22]}; gemm_phase(lds, 1024, 1024, 1024, S, E); }
#undef PH
#undef SYNC
}

extern "C" void kernel_launch(void* const* d_in, const int* in_sizes, int n_in, void* d_out, int out_size, void* d_ws, size_t ws_size, hipStream_t stream) {
    static int grid = 0;
    if (grid == 0) {
        if (n_in != 23 || out_size != T_ * D_ || ws_size < WS_NEED) { fprintf(stderr, "kernel_launch: unexpected shapes (n_in %d, out %d, ws %zu)\n", n_in, out_size, ws_size); grid = -1; return; }
        int dev = 0, cus = 0, per_cu = 0;
        hipGetDevice(&dev); hipDeviceGetAttribute(&cus, hipDeviceAttributeMultiprocessorCount, dev);
        hipFuncSetAttribute((const void*)mk_fwd<true>, hipFuncAttributeMaxDynamicSharedMemorySize, LDS_BYTES);
        hipFuncSetAttribute((const void*)mk_fwd<false>, hipFuncAttributeMaxDynamicSharedMemorySize, LDS_BYTES);
        hipOccupancyMaxActiveBlocksPerMultiprocessor(&per_cu, (const void*)mk_fwd<true>, 512, LDS_BYTES);
        if (per_cu < 1) { fprintf(stderr, "kernel_launch: occupancy query reports %d blocks per CU\n", per_cu); per_cu = 1; }
        (void)hipGetLastError();
        grid = cus;
        if (grid != 256) { fprintf(stderr, "kernel_launch: built for a 256-CU device (got %d CUs)\n", cus); grid = -1; return; }
    }
    if (grid < 0) return;
    Params p{};
    for (int i = 0; i < 23; ++i) p.in[i] = (const float*)d_in[i];
    p.out = (float*)d_out; p.ws = (unsigned char*)d_ws;
#if MK_MULTI
#ifndef PROBE_DUP
#define PROBE_DUP -1
#endif
    for (int k = 0; k < NPHASE; ++k) { p.ph_lo = k; p.ph_hi = k + 1; hipLaunchKernelGGL(mk_fwd<false>, dim3(grid), dim3(512), LDS_BYTES, stream, p);
        if (k == PROBE_DUP) hipLaunchKernelGGL(mk_fwd<false>, dim3(grid), dim3(512), LDS_BYTES, stream, p); }
#else
    p.ph_lo = 0; p.ph_hi = NPHASE;
    if (hipMemsetAsync((unsigned char*)d_ws + O_BAR, 0, (XCD_BAR_WORDS + 64 * 64) * 4, stream) != hipSuccess) { fprintf(stderr, "kernel_launch: memset of barrier words failed\n"); return; }
    void* args[] = {&p};
    hipError_t e = hipLaunchCooperativeKernel((const void*)mk_fwd<true>, dim3(grid), dim3(512), args, LDS_BYTES, stream);
    if (e != hipSuccess) fprintf(stderr, "cooperative launch failed: %s (grid %d)\n", hipGetErrorString(e), grid);
#endif
}
```

```cpp
#include <hip/hip_runtime.h>
#include <hip/hip_cooperative_groups.h>
#include <cstdio>
namespace cg = cooperative_groups;

#ifndef MK_MULTI
#define MK_MULTI 0
#endif

#define LAS __attribute__((address_space(3)))
typedef unsigned short bf16_t;
typedef short bf16x8 __attribute__((ext_vector_type(8)));
typedef float f32x4 __attribute__((ext_vector_type(4)));
typedef float f32x2 __attribute__((ext_vector_type(2)));
typedef unsigned u32x4 __attribute__((ext_vector_type(4)));
typedef unsigned u32x2 __attribute__((ext_vector_type(2)));

constexpr int T_ = 16384, D_ = 1024, NIN_ = 8200, DFF_ = 2816, SEQ_ = 2048;
constexpr float EPS_ = 1e-6f;
constexpr int BM = 256, BK = 64, HALF = 128, HTB = HALF * BK * 2, STAGE_BYTES = 8 * HTB;
constexpr int LDS_BYTES = 136 * 1024;
constexpr int NPHASE = 13;

constexpr size_t KiB = 1024, MiB = 1024 * 1024;
constexpr size_t O_WINT = 0, O_WMT = 16 * MiB, O_WCT = 18 * MiB, O_WOT = 20 * MiB, O_WPGT = 22 * MiB, O_WGUT = 24 * MiB, O_WDT = 35 * MiB, O_WPPT = 40 * MiB + 512 * KiB;
constexpr size_t O_IG = 41 * MiB, O_LF = O_IG + 256 * KiB, O_ZERO = O_LF + 256 * KiB;
constexpr size_t O_DENI = O_ZERO, O_HSS = O_DENI + 256 * KiB, O_SSQ1 = O_HSS + 256 * KiB, O_SSQ2 = O_SSQ1 + 64 * KiB, O_SSQ3 = O_SSQ2 + 64 * KiB, O_NSUM = O_SSQ3 + 64 * KiB;
constexpr size_t ZERO_BYTES = 960 * KiB;
constexpr size_t O_DENX = O_ZERO + ZERO_BYTES, O_EBL = O_DENX + 256 * KiB;
constexpr size_t O_RS = O_EBL + 4 * KiB;
constexpr size_t O_BAR = 43 * MiB;
constexpr size_t O_PB = 44 * MiB, O_HB = 52 * MiB, O_S1 = 84 * MiB, O_S2 = 116 * MiB, O_S3 = 148 * MiB, O_S4 = 180 * MiB, O_S5 = 212 * MiB, WS_NEED = 244 * MiB;
constexpr size_t O_PE = O_HB, O_VT = O_S1, O_U = O_S1, O_MERGED = O_S1, O_HID = O_S1, O_WQ = O_S2, O_GMC = O_S2, O_KW = O_S3, O_CINT = O_S3,
                 O_KWT = O_S4, O_HM = O_S4, O_X1B = O_S4, O_SS = O_S5, O_UC = O_S5, O_X2B = O_S5;

struct Params {
    const float* in[23];
    float* out;
    unsigned char* ws;
    int ph_lo, ph_hi;
};

__device__ __forceinline__ unsigned cvt_pk_bf16(float lo, float hi) { unsigned r; asm volatile("v_cvt_pk_bf16_f32 %0, %1, %2" : "=v"(r) : "v"(lo), "v"(hi)); return r; }
__device__ __forceinline__ float bf_lo(unsigned w) { return __uint_as_float(w << 16); }
__device__ __forceinline__ float bf_hi(unsigned w) { return __uint_as_float(w & 0xffff0000u); }
__device__ __forceinline__ float sigm(float x) { return __builtin_amdgcn_rcpf(1.0f + __builtin_amdgcn_exp2f(x * -1.4426950408889634f)); }
__device__ __forceinline__ float silu(float x) { return x * __builtin_amdgcn_rcpf(1.0f + __builtin_amdgcn_exp2f(x * -1.4426950408889634f)); }
__device__ __forceinline__ f32x4 exp2v(f32x4 t) { f32x4 e; e[0] = __builtin_amdgcn_exp2f(t[0]); e[1] = __builtin_amdgcn_exp2f(t[1]); e[2] = __builtin_amdgcn_exp2f(t[2]); e[3] = __builtin_amdgcn_exp2f(t[3]); return e; }
__device__ __forceinline__ f32x4 rcpv(f32x4 d) { f32x4 r; r[0] = __builtin_amdgcn_rcpf(d[0]); r[1] = __builtin_amdgcn_rcpf(d[1]); r[2] = __builtin_amdgcn_rcpf(d[2]); r[3] = __builtin_amdgcn_rcpf(d[3]); return r; }
__device__ __forceinline__ f32x4 sigm4(f32x4 x) { return rcpv(exp2v(x * -1.4426950408889634f) + 1.0f); }
__device__ __forceinline__ f32x4 silu4(f32x4 x) { return x * sigm4(x); }
__device__ __forceinline__ float wave_sum(float v) {
#pragma unroll
    for (int o = 32; o > 0; o >>= 1) v += __shfl_xor(v, o);
    return v;
}
__device__ __forceinline__ u32x4 pack8(const f32x4 a, const f32x4 b) { u32x4 w; w.x = cvt_pk_bf16(a[0], a[1]); w.y = cvt_pk_bf16(a[2], a[3]); w.z = cvt_pk_bf16(b[0], b[1]); w.w = cvt_pk_bf16(b[2], b[3]); return w; }
__device__ __forceinline__ void unpack8(const u32x4 w, f32x4& a, f32x4& b) { a[0] = bf_lo(w.x); a[1] = bf_hi(w.x); a[2] = bf_lo(w.y); a[3] = bf_hi(w.y); b[0] = bf_lo(w.z); b[1] = bf_hi(w.z); b[2] = bf_lo(w.w); b[3] = bf_hi(w.w); }

__host__ __device__ __forceinline__ int lds_byte(int r, int c) { const int st = (r >> 4) * 2 + (c >> 5), rr = r & 15, cc = c & 31, ob = rr * 64 + cc * 2; return st * 1024 + (ob ^ (((ob >> 9) & 1) << 5)); }
__host__ __device__ __forceinline__ void stage_rc(int b, int& R, int& C) { const int st = b / 1024, sb = b % 1024, swz = sb ^ (((sb >> 9) & 1) << 5); R = (st >> 1) * 16 + swz / 64; C = (st & 1) * 32 + (swz % 64) / 2; }
__host__ __device__ __forceinline__ int perm32(int rho) { const int n = rho >> 4, i = rho & 15; return 8 * (i >> 2) + 4 * n + (i & 3); }

struct Unit { const char* a; const char* b; int pm, pn, kind, cont; };
__device__ __forceinline__ void map_n4(int L, int& pm, int& pn) { const int x = L & 7, k = L >> 3; pm = x * 8 + (k & 7); pn = k >> 3; }

__device__ __forceinline__ void tile_order(int L, int nM, int nN, int& pm, int& pn) {
    const int nwg = nM * nN; int wgid = L;
    { const int q = nwg / 8, r = nwg % 8, xcd = wgid % 8, off = wgid / 8; wgid = (xcd < r ? xcd * (q + 1) : r * (q + 1) + (xcd - r) * q) + off; }
    const int nig = 8 * nN, gid = wgid / nig, fm = gid * 8, gsz = (nM - fm) < 8 ? (nM - fm) : 8;
    pm = fm + ((wgid % nig) % gsz); pn = (wgid % nig) / gsz;
}

template <class Epi, class Sched>
__device__ __forceinline__ void gemm_phase(LAS unsigned char* lds, const int K, const int lda, const int ldb, const Sched& S, const Epi& E) {
    const int tid = threadIdx.x, wid = __builtin_amdgcn_readfirstlane(tid >> 6), lane = tid & 63, wr = wid >> 2, wc = wid & 3, fr = lane & 15, fq = lane >> 4;
    const int nt = K / BK;
    unsigned voffA[2], voffB[2];
#pragma unroll
    for (int i = 0; i < 2; ++i) { int R, C; stage_rc(tid * 16 + i * 8192, R, C); const int Rb = (R & ~31) + perm32(R & 31);
        voffA[i] = (unsigned)(R * lda + C) * 2u; voffB[i] = (unsigned)(Rb * ldb + C) * 2u; }
    const size_t kstep = (size_t)(BK * 2);
    const size_t hstepA = (size_t)HALF * lda * 2, hstepB = (size_t)HALF * ldb * 2;
    const unsigned ldsw = (unsigned)wid * 1024u;
    const int aoff = lds_byte(wr * 64 + fr, fq * 8), boff = lds_byte(wc * 32 + fr, fq * 8);
#define PG8_SA(b, h) (((b) * 2 + (h)) * HTB)
#define PG8_SB(b, h) ((4 + (b) * 2 + (h)) * HTB)
#define PG8_STAGE(bufoff, gbase, voff) do { _Pragma("unroll") for (int _i = 0; _i < 2; ++_i) \
        __builtin_amdgcn_global_load_lds((const unsigned*)((const char*)(gbase) + (voff)[_i]), (LAS unsigned*)(lds + (bufoff) + ldsw + _i * 8192), 16, 0, 0); } while (0)
#define PG8_LDA(dst, b, h) do { _Pragma("unroll") for (int m = 0; m < 4; ++m) _Pragma("unroll") for (int k = 0; k < 2; ++k) dst[m][k] = *(const LAS bf16x8*)(lds + PG8_SA(b, h) + aoff + m * 2048 + k * 1024); } while (0)
#define PG8_LDB(dst, b, h) do { _Pragma("unroll") for (int n = 0; n < 2; ++n) _Pragma("unroll") for (int k = 0; k < 2; ++k) dst[n][k] = *(const LAS bf16x8*)(lds + PG8_SB(b, h) + boff + n * 2048 + k * 1024); } while (0)
#define PG8_MMA(ai, bj, At, Bt) do { __builtin_amdgcn_s_setprio(1); _Pragma("unroll") for (int m = 0; m < 4; ++m) _Pragma("unroll") for (int n = 0; n < 2; ++n) _Pragma("unroll") for (int k = 0; k < 2; ++k) \
        acc[ai][bj][m][n] = __builtin_amdgcn_mfma_f32_16x16x32_bf16(Bt[n][k], At[m][k], acc[ai][bj][m][n], 0, 0, 0); __builtin_amdgcn_s_setprio(0); } while (0)
#define PG8_WAIT_V(n) asm volatile("s_waitcnt vmcnt(" #n ")" ::: "memory")
#define PG8_WAIT_L(n) asm volatile("s_waitcnt lgkmcnt(" #n ")" ::: "memory")
#define PG8_BAR __builtin_amdgcn_s_barrier()
#define PG8_SCHED __builtin_amdgcn_sched_barrier(0)
#define PG8_ZERO() do { _Pragma("unroll") for (int a = 0; a < 2; ++a) _Pragma("unroll") for (int b = 0; b < 2; ++b) _Pragma("unroll") for (int m = 0; m < 4; ++m) _Pragma("unroll") for (int n = 0; n < 2; ++n) acc[a][b][m][n] = (f32x4){0.f, 0.f, 0.f, 0.f}; } while (0)
    Unit cur, nxt; int ui = 0;
    if (!S.next(0, cur)) return;
    E.pre(cur, wr, wc, fr, fq);
    f32x4 acc[2][2][4][2];
    PG8_ZERO();
    bf16x8 At[4][2], B0[2][2], B1[2][2];
    const char* cA = cur.a; const char* cB = cur.b;
    PG8_STAGE(PG8_SB(0, 0), cB, voffB); PG8_STAGE(PG8_SA(0, 0), cA, voffA); PG8_STAGE(PG8_SB(0, 1), cB + hstepB, voffB); PG8_STAGE(PG8_SA(0, 1), cA + hstepA, voffA);
    if (wr == 1) PG8_BAR;
    PG8_WAIT_V(4); PG8_BAR;
    PG8_STAGE(PG8_SB(1, 0), cB + kstep, voffB); PG8_STAGE(PG8_SA(1, 0), cA + kstep, voffA); PG8_STAGE(PG8_SB(1, 1), cB + hstepB + kstep, voffB);
    PG8_WAIT_V(6); PG8_BAR;
    for (;;) {
        const bool has_next = S.next(ui + 1, nxt);
        const char* nA = has_next ? nxt.a : cA; const char* nB = has_next ? nxt.b : cB;
#pragma unroll 1
        for (int t = 0; t < nt; t += 2) {
            const bool last = (t == nt - 2);
            const char* a1 = cA + (size_t)(t + 1) * kstep;
            const char* a2 = last ? nA : cA + (size_t)(t + 2) * kstep; const char* b2 = last ? nB : cB + (size_t)(t + 2) * kstep;
            const char* a3 = a2 + kstep; const char* b3 = b2 + kstep;
            PG8_LDB(B0, 0, 0); PG8_SCHED; PG8_LDA(At, 0, 0); PG8_STAGE(PG8_SA(1, 1), a1 + hstepA, voffA);
            PG8_WAIT_L(8); PG8_BAR; PG8_WAIT_L(0); PG8_MMA(0, 0, At, B0); PG8_BAR; PG8_SCHED;
            PG8_LDB(B1, 0, 1); PG8_STAGE(PG8_SB(0, 0), b2, voffB);
            PG8_BAR; PG8_WAIT_L(0); PG8_MMA(0, 1, At, B1); PG8_BAR;
            PG8_LDA(At, 0, 1); PG8_STAGE(PG8_SA(0, 0), a2, voffA);
            PG8_BAR; PG8_WAIT_L(0); PG8_MMA(1, 0, At, B0); PG8_BAR; PG8_SCHED;
            PG8_STAGE(PG8_SB(0, 1), b2 + hstepB, voffB);
            PG8_WAIT_V(6); PG8_BAR; PG8_MMA(1, 1, At, B1); PG8_BAR;
            PG8_LDB(B0, 1, 0); PG8_SCHED; PG8_LDA(At, 1, 0); PG8_STAGE(PG8_SA(0, 1), a2 + hstepA, voffA);
            PG8_WAIT_L(8); PG8_BAR; PG8_WAIT_L(0); PG8_MMA(0, 0, At, B0); PG8_BAR; PG8_SCHED;
            PG8_LDB(B1, 1, 1); PG8_STAGE(PG8_SB(1, 0), b3, voffB);
            PG8_BAR; PG8_WAIT_L(0); PG8_MMA(0, 1, At, B1); PG8_BAR;
            PG8_LDA(At, 1, 1); PG8_STAGE(PG8_SA(1, 0), a3, voffA);
            PG8_BAR; PG8_WAIT_L(0); PG8_MMA(1, 0, At, B0); PG8_BAR; PG8_SCHED;
            PG8_STAGE(PG8_SB(1, 1), b3 + hstepB, voffB);
            PG8_WAIT_V(6); PG8_BAR; PG8_MMA(1, 1, At, B1); PG8_BAR;
        }
        if (cur.cont) { E.mid(acc, cur, wr, wc, fr, fq); }
        else { if constexpr (!Epi::AFTER_DRAIN) E(acc, cur, wr, wc, fr, fq); if (!has_next) break; PG8_ZERO(); }
        cur = nxt; cA = nA; cB = nB; ++ui;
    }
    PG8_WAIT_V(0);
    if (wr == 0) PG8_BAR;
    PG8_BAR;
    if constexpr (Epi::AFTER_DRAIN) E(acc, cur, wr, wc, fr, fq);
#undef PG8_SA
#undef PG8_SB
#undef PG8_STAGE
#undef PG8_LDA
#undef PG8_LDB
#undef PG8_MMA
#undef PG8_WAIT_V
#undef PG8_WAIT_L
#undef PG8_BAR
#undef PG8_SCHED
#undef PG8_ZERO
}

typedef f32x4 Acc[2][2][4][2];
#define EPI_ROWS(ai, m) _Pragma("unroll") for (int ai = 0; ai < 2; ++ai) _Pragma("unroll") for (int m = 0; m < 4; ++m) if (epi_fence())
__device__ __forceinline__ bool epi_fence() { asm volatile("" ::: "memory"); return true; }
#define EPI_R8 _Pragma("unroll") for (int r8 = 0; r8 < 8; ++r8)
#define EPI_RL(ai, m) ((ai) * 128 + wr * 64 + (m) * 16 + fr)
#define EPI_CL(bj) ((bj) * 128 + wc * 32 + 8 * fq)

struct SchedP1 { const char* hb; const char* wint; int G, c;
    __device__ __forceinline__ bool next(int i, Unit& u) const {
        const int item = (i / 3) * G + c, r = i % 3; if (item >= 256) return false;
        const int b = item >> 5, h = (item >> 3) & 3, sc = item & 7; const int pt = b * 8 + sc;
        u.cont = 0;
        if (r < 2) { u.pm = pt; u.pn = r * 4 + h; u.kind = 0; u.a = hb + (size_t)pt * 256 * 1024 * 2; u.b = wint + (size_t)u.pn * 256 * 1024 * 2; }
        else { u.pm = h; u.pn = pt; u.kind = 1; u.a = wint + (size_t)(2048 + h * 256) * 1024 * 2; u.b = hb + (size_t)pt * 256 * 1024 * 2; }
        return true; } };
struct EpiP1 { static constexpr bool AFTER_DRAIN = false; bf16_t* qkpre; bf16_t* vt; const float* rsb;
    __device__ __forceinline__ void mid(Acc&, const Unit&, int, int, int, int) const {}
    __device__ __forceinline__ void pre(const Unit&, int, int, int, int) const {}
    __device__ __forceinline__ void operator()(Acc& acc, const Unit& u, int wr, int wc, int fr, int fq) const {
        if (u.kind == 0) {
            bf16_t* base = qkpre + (size_t)u.pm * 256 * 2048 + u.pn * 256; float rv[2][4];
#pragma unroll
            for (int ai = 0; ai < 2; ++ai)
#pragma unroll
                for (int m = 0; m < 4; ++m) rv[ai][m] = rsb[u.pm * 256 + EPI_RL(ai, m)];
            EPI_ROWS(ai, m) { bf16_t* rowp = base + (size_t)EPI_RL(ai, m) * 2048 + EPI_CL(0);
#pragma unroll
                for (int bj = 0; bj < 2; ++bj) *(u32x4*)(rowp + bj * 128) = pack8(acc[ai][bj][m][0] * rv[ai][m], acc[ai][bj][m][1] * rv[ai][m]); }
        } else {
            const int item = ((u.pn >> 3) * 4 + u.pm) * 8 + (u.pn & 7); bf16_t* base = vt + (size_t)item * 65536; f32x4 cv[2][2];
#pragma unroll
            for (int bj = 0; bj < 2; ++bj) { cv[bj][0] = *(const f32x4*)(rsb + u.pn * 256 + EPI_CL(bj)); cv[bj][1] = *(const f32x4*)(rsb + u.pn * 256 + EPI_CL(bj) + 4); }
            EPI_ROWS(ai, m) { bf16_t* rowp = base + (size_t)EPI_RL(ai, m) * 256 + EPI_CL(0);
#pragma unroll
                for (int bj = 0; bj < 2; ++bj) *(u32x4*)(rowp + bj * 128) = pack8(acc[ai][bj][m][0] * cv[bj][0], acc[ai][bj][m][1] * cv[bj][1]); }
        }
    } };

struct SchedP3 { const char* wq; const char* kw; const char* vt; const char* kwt; int G, c;
    __device__ __forceinline__ bool next(int i, Unit& u) const {
        const int L = i * G + c; if (L >= 512) return false;
        u.cont = 0; u.pn = 0;
        if (L < 256) { u.pm = L; u.kind = 0; u.a = wq + (size_t)L * 131072; u.b = kw + (size_t)L * 131072; }
        else { const int it = L - 256; u.pm = it; u.kind = 1; u.a = vt + (size_t)it * 131072; u.b = kwt + (size_t)it * 131072; }
        return true; } };
struct EpiP3 { static constexpr bool AFTER_DRAIN = false; bf16_t* s; bf16_t* lt; float* deni;
    __device__ __forceinline__ void mid(Acc&, const Unit&, int, int, int, int) const {}
    __device__ __forceinline__ void pre(const Unit&, int, int, int, int) const {}
    __device__ __forceinline__ void operator()(Acc& acc, const Unit& u, int wr, int wc, int fr, int fq) const {
        const int item = u.pm;
        if (u.kind == 0) {
            const int b = item >> 5, h = (item >> 3) & 3, sc = item & 7; const int tokb = b * SEQ_ + sc * 256;
            EPI_ROWS(ai, m) { int r = EPI_RL(ai, m); asm volatile("" : "+v"(r)); float rs = 0.f;
#pragma unroll
                for (int bj = 0; bj < 2; ++bj) { const int c0 = EPI_CL(bj); f32x4 v0 = acc[ai][bj][m][0], v1 = acc[ai][bj][m][1];
#pragma unroll
                    for (int j = 0; j < 4; ++j) { v0[j] = (c0 + j <= r) ? v0[j] : 0.f; v1[j] = (c0 + 4 + j <= r) ? v1[j] : 0.f; rs += v0[j] + v1[j]; }
                    *(u32x4*)(s + (size_t)item * 65536 + r * 256 + c0) = pack8(v0, v1); }
                rs += __shfl_xor(rs, 16); rs += __shfl_xor(rs, 32);
                if (fq == 0) unsafeAtomicAdd(deni + (size_t)(tokb + r) * 4 + h, rs); }
        } else {
            EPI_ROWS(ai, m) { bf16_t* rowp = lt + (size_t)item * 65536 + EPI_RL(ai, m) * 256 + EPI_CL(0);
#pragma unroll
                for (int bj = 0; bj < 2; ++bj) *(u32x4*)(rowp + bj * 128) = pack8(acc[ai][bj][m][0], acc[ai][bj][m][1]); }
        }
    } };

struct SchedP5 { const char* s; const char* vt; const char* wq; const char* cint; int G, c;
    __device__ __forceinline__ bool next(int i, Unit& u) const {
        const int item = (i >> 1) * G + c; if (item >= 256) return false;
        u.pm = item; u.pn = 0; u.kind = 0;
        if ((i & 1) == 0) { u.cont = 1; u.a = s + (size_t)item * 131072; u.b = vt + (size_t)item * 131072; }
        else { u.cont = 0; u.a = wq + (size_t)item * 131072; u.b = cint + (size_t)item * 131072; }
        return true; } };
struct EpiP5 { static constexpr bool AFTER_DRAIN = false; bf16_t* hm; const float* deni; const float* denx; float* hss;
    __device__ __forceinline__ void mid(Acc&, const Unit&, int, int, int, int) const {}
    __device__ __forceinline__ void pre(const Unit&, int, int, int, int) const {}
    __device__ __forceinline__ void operator()(Acc& acc, const Unit& u, int wr, int wc, int fr, int fq) const {
        const int item = u.pm; const int b = item >> 5, h = (item >> 3) & 3, sc = item & 7; const int tokb = b * SEQ_ + sc * 256;
        float dnv[2][4];
#pragma unroll
        for (int ai = 0; ai < 2; ++ai)
#pragma unroll
            for (int m = 0; m < 4; ++m) { const int t = tokb + EPI_RL(ai, m); dnv[ai][m] = deni[(size_t)t * 4 + h] + denx[(size_t)t * 4 + h]; }
        EPI_ROWS(ai, m) { const int t = tokb + EPI_RL(ai, m);
            const float den = dnv[ai][m]; const float inv = __builtin_amdgcn_rcpf(fmaxf(fabsf(den), 1.0f)); float ss = 0.f;
#pragma unroll
            for (int bj = 0; bj < 2; ++bj) { f32x4 v0 = acc[ai][bj][m][0] * inv, v1 = acc[ai][bj][m][1] * inv;
#pragma unroll
                for (int j = 0; j < 4; ++j) ss += v0[j] * v0[j] + v1[j] * v1[j];
                *(u32x4*)(hm + (size_t)t * 1024 + h * 256 + EPI_CL(bj)) = pack8(v0, v1); }
            ss += __shfl_xor(ss, 16); ss += __shfl_xor(ss, 32);
            if (fq == 0) unsafeAtomicAdd(hss + (size_t)t * 4 + h, ss); }
    } };

struct SchedP6 { const char* hb; const char* wint; int G, c;
    __device__ __forceinline__ bool next(int i, Unit& u) const {
        u.cont = 0;
        if (i == 0) { const int item = c; if (item >= 256) return false; const int b = item >> 5, h = (item >> 3) & 3, sc = item & 7;
            u.pm = b * 8 + sc; u.pn = h; u.kind = 0; u.a = hb + (size_t)u.pm * 256 * 1024 * 2; u.b = wint + (size_t)(3072 + h * 256) * 1024 * 2; return true; }
        const int L = (i - 1) * G + c; if (L >= 512) return false;
        int pm, pn; tile_order(L, 64, 8, pm, pn); u.pm = pm; u.pn = pn; u.kind = 1;
        u.a = hb + (size_t)pm * 256 * 1024 * 2; u.b = wint + (size_t)(4096 + pn * 256) * 1024 * 2; return true; } };
struct EpiP6 { static constexpr bool AFTER_DRAIN = false; bf16_t* hm; float* hss; const float* rsb; bf16_t* uu;
    __device__ __forceinline__ void mid(Acc&, const Unit&, int, int, int, int) const {}
    __device__ __forceinline__ void pre(const Unit&, int, int, int, int) const {}
    __device__ __forceinline__ void operator()(Acc& acc, const Unit& u, int wr, int wc, int fr, int fq) const {
        if (u.kind == 0) {
            float hsv[2][4], rxv[2][4];
#pragma unroll
            for (int ai = 0; ai < 2; ++ai)
#pragma unroll
                for (int m = 0; m < 4; ++m) rxv[ai][m] = rsb[u.pm * 256 + EPI_RL(ai, m)];
#pragma unroll
            for (int ai = 0; ai < 2; ++ai)
#pragma unroll
                for (int m = 0; m < 4; ++m) hsv[ai][m] = __hip_atomic_load(hss + (size_t)(u.pm * 256 + EPI_RL(ai, m)) * 4 + u.pn, __ATOMIC_RELAXED, __HIP_MEMORY_SCOPE_AGENT);
            u32x4 cur[2], nxt[2];
#pragma unroll
            for (int bj = 0; bj < 2; ++bj) cur[bj] = *(const u32x4*)(hm + (size_t)(u.pm * 256 + EPI_RL(0, 0)) * 1024 + u.pn * 256 + EPI_CL(bj));
            EPI_R8 { const int ai = r8 >> 2, m = r8 & 3; const int t = u.pm * 256 + EPI_RL(ai, m);
                if (r8 < 7) { const int tn = u.pm * 256 + EPI_RL((r8 + 1) >> 2, (r8 + 1) & 3);
#pragma unroll
                    for (int bj = 0; bj < 2; ++bj) nxt[bj] = *(const u32x4*)(hm + (size_t)tn * 1024 + u.pn * 256 + EPI_CL(bj)); }
                const float rsn = rsqrtf(hsv[ai][m] * (1.0f / 256.0f) + EPS_); const float rx = rxv[ai][m];
#pragma unroll
                for (int bj = 0; bj < 2; ++bj) { f32x4 h0, h1; unpack8(cur[bj], h0, h1);
                    const f32x4 o0 = h0 * rsn * sigm4(acc[ai][bj][m][0] * rx), o1 = h1 * rsn * sigm4(acc[ai][bj][m][1] * rx);
                    *(u32x4*)(hm + (size_t)t * 1024 + u.pn * 256 + EPI_CL(bj)) = pack8(o0, o1); }
                cur[0] = nxt[0]; cur[1] = nxt[1]; }
        } else {
            float rxv[2][4];
#pragma unroll
            for (int ai = 0; ai < 2; ++ai)
#pragma unroll
                for (int m = 0; m < 4; ++m) rxv[ai][m] = rsb[u.pm * 256 + EPI_RL(ai, m)];
            EPI_ROWS(ai, m) { const int t = u.pm * 256 + EPI_RL(ai, m); const float rx = rxv[ai][m];
                const f32x4 o0 = acc[ai][0][m][0] * rx * sigm4(acc[ai][1][m][0] * rx), o1 = acc[ai][0][m][1] * rx * sigm4(acc[ai][1][m][1] * rx);
                *(u32x4*)(uu + (size_t)t * 1024 + u.pn * 128 + wc * 32 + 8 * fq) = pack8(o0, o1); }
        }
    } };

struct SchedP8 { const char* hb; const char* wint; const char* hmg; const char* uc; const char* wmt; const char* wct; int G, c;
    __device__ __forceinline__ bool next(int i, Unit& u) const {
        const int L = (i >> 2) * G + c, r = i & 3; if (L >= 256) return false;
        int pn; map_n4(L, u.pm, pn); u.cont = 0;
        if (r < 2) { u.kind = 2; u.pn = 2 * pn + r; u.a = hb + (size_t)u.pm * 256 * 1024 * 2; u.b = wint + (size_t)(6144 + u.pn * 256) * 1024 * 2; }
        else if (r == 2) { u.kind = 0; u.pn = pn; u.a = hmg + (size_t)u.pm * 256 * 1024 * 2; u.b = wmt + (size_t)pn * 256 * 1024 * 2; }
        else { u.kind = 1; u.pn = pn; u.a = uc + (size_t)u.pm * 256 * 1024 * 2; u.b = wct + (size_t)pn * 256 * 1024 * 2; }
        return true; } };
struct EpiP8 { static constexpr bool AFTER_DRAIN = false; bf16_t* gmc; bf16_t* tmp; bf16_t* merged; const float* rsb;
    __device__ __forceinline__ void mid(Acc&, const Unit&, int, int, int, int) const {}
    __device__ __forceinline__ void pre(const Unit&, int, int, int, int) const {}
    __device__ __forceinline__ void operator()(Acc& acc, const Unit& u, int wr, int wc, int fr, int fq) const {
        if (u.kind == 2) {
            float rxv[2][4];
#pragma unroll
            for (int ai = 0; ai < 2; ++ai)
#pragma unroll
                for (int m = 0; m < 4; ++m) rxv[ai][m] = rsb[u.pm * 256 + EPI_RL(ai, m)];
            EPI_ROWS(ai, m) { const int t = u.pm * 256 + EPI_RL(ai, m); const float rx = rxv[ai][m], rxe = rx * -1.4426950408889634f;
                const f32x4 d0 = exp2v(acc[ai][1][m][0] * rxe) + 1.0f, d1 = exp2v(acc[ai][1][m][1] * rxe) + 1.0f;
                const f32x4 r0 = sigm4(acc[ai][0][m][0] * rx) * d0, r1 = sigm4(acc[ai][0][m][1] * rx) * d1, c0 = rcpv(d0), c1 = rcpv(d1);
                bf16_t* ptr = gmc + (size_t)t * 2048 + u.pn * 128 + wc * 32 + 8 * fq;
                *(u32x4*)ptr = pack8(r0, r1); *(u32x4*)(ptr + 1024) = pack8(c0, c1); }
        } else if (u.kind == 0) {
            u32x4 cur[2], nxt[2];
#pragma unroll
            for (int bj = 0; bj < 2; ++bj) cur[bj] = *(const u32x4*)(gmc + (size_t)(u.pm * 256 + EPI_RL(0, 0)) * 2048 + u.pn * 256 + EPI_CL(bj));
            EPI_R8 { const int ai = r8 >> 2, m = r8 & 3; const int t = u.pm * 256 + EPI_RL(ai, m);
                if (r8 < 7) { const int tn = u.pm * 256 + EPI_RL((r8 + 1) >> 2, (r8 + 1) & 3);
#pragma unroll
                    for (int bj = 0; bj < 2; ++bj) nxt[bj] = *(const u32x4*)(gmc + (size_t)tn * 2048 + u.pn * 256 + EPI_CL(bj)); }
#pragma unroll
                for (int bj = 0; bj < 2; ++bj) { const int c = u.pn * 256 + EPI_CL(bj); f32x4 a0, a1; unpack8(cur[bj], a0, a1);
                    *(u32x4*)(tmp + (size_t)t * 1024 + c) = pack8(acc[ai][bj][m][0] * a0, acc[ai][bj][m][1] * a1); }
                cur[0] = nxt[0]; cur[1] = nxt[1]; }
        } else {
            u32x4 cg[2], ct[2], ng[2], nt2[2];
#pragma unroll
            for (int bj = 0; bj < 2; ++bj) { const int t0 = u.pm * 256 + EPI_RL(0, 0); const int c = u.pn * 256 + EPI_CL(bj);
                cg[bj] = *(const u32x4*)(gmc + (size_t)t0 * 2048 + 1024 + c); ct[bj] = *(const u32x4*)(tmp + (size_t)t0 * 1024 + c); }
            EPI_R8 { const int ai = r8 >> 2, m = r8 & 3; const int t = u.pm * 256 + EPI_RL(ai, m);
                if (r8 < 7) { const int tn = u.pm * 256 + EPI_RL((r8 + 1) >> 2, (r8 + 1) & 3);
#pragma unroll
                    for (int bj = 0; bj < 2; ++bj) { const int c = u.pn * 256 + EPI_CL(bj); ng[bj] = *(const u32x4*)(gmc + (size_t)tn * 2048 + 1024 + c); nt2[bj] = *(const u32x4*)(tmp + (size_t)tn * 1024 + c); } }
#pragma unroll
                for (int bj = 0; bj < 2; ++bj) { const int c = u.pn * 256 + EPI_CL(bj); f32x4 b0, b1, t0, t1; unpack8(cg[bj], b0, b1); unpack8(ct[bj], t0, t1);
                    *(u32x4*)(merged + (size_t)t * 1024 + c) = pack8((acc[ai][bj][m][0] + t0) * b0, (acc[ai][bj][m][1] + t1) * b1); }
                cg[0] = ng[0]; cg[1] = ng[1]; ct[0] = nt2[0]; ct[1] = nt2[1]; }
        }
    } };

struct SchedN4 { const char* a; const char* bt; size_t astep, bstep; int G, c;
    __device__ __forceinline__ bool next(int i, Unit& u) const {
        const int L = i * G + c; if (L >= 256) return false;
        map_n4(L, u.pm, u.pn); u.kind = 0; u.cont = 0; u.a = a + (size_t)u.pm * astep; u.b = bt + (size_t)u.pn * bstep; return true; } };
struct SchedPE { const char* a; const char* bt; int G, c;
    __device__ __forceinline__ bool next(int i, Unit& u) const {
        const int L = i * G + c; if (L >= 256 || c < 0) return false;
        u.pm = L >> 2; u.pn = L & 3; u.kind = 0; u.cont = 0; u.a = a + (size_t)u.pm * 256 * 256 * 2; u.b = bt + (size_t)u.pn * 256 * 256 * 2; return true; } };
template <bool SRC_BF16> struct EpiRes { static constexpr bool AFTER_DRAIN = false; const void* src; bf16_t* dstb; float* ssq;
    __device__ __forceinline__ void mid(Acc&, const Unit&, int, int, int, int) const {}
    __device__ __forceinline__ void pre(const Unit& u, int wr, int wc, int fr, int fq) const {
        if (!SRC_BF16) {
            EPI_ROWS(ai, m) { const int t = u.pm * 256 + EPI_RL(ai, m);
#pragma unroll
                for (int bj = 0; bj < 2; ++bj) { const float v = *((const float*)src + (size_t)t * 1024 + u.pn * 256 + EPI_CL(bj)); asm volatile("" :: "v"(v)); } }
        }
    }
    __device__ __forceinline__ void operator()(Acc& acc, const Unit& u, int wr, int wc, int fr, int fq) const {
        f32x4 rb[3][2][2];
#define ERES_LOAD(dst, t_) do { _Pragma("unroll") for (int bj = 0; bj < 2; ++bj) { const size_t o_ = (size_t)(t_) * 1024 + u.pn * 256 + EPI_CL(bj); \
            if (SRC_BF16) dst[bj][0] = __builtin_bit_cast(f32x4, *(const u32x4*)((const bf16_t*)src + o_)); \
            else { dst[bj][0] = *(const f32x4*)((const float*)src + o_); dst[bj][1] = *(const f32x4*)((const float*)src + o_ + 4); } } } while (0)
        ERES_LOAD(rb[0], u.pm * 256 + EPI_RL(0, 0)); ERES_LOAD(rb[1], u.pm * 256 + EPI_RL(0, 1));
        EPI_R8 { const int ai = r8 >> 2, m = r8 & 3; const int t = u.pm * 256 + EPI_RL(ai, m); float ss = 0.f;
            if (r8 < 6) ERES_LOAD(rb[(r8 + 2) % 3], u.pm * 256 + EPI_RL((r8 + 2) >> 2, (r8 + 2) & 3));
#pragma unroll
            for (int bj = 0; bj < 2; ++bj) { const size_t o = (size_t)t * 1024 + u.pn * 256 + EPI_CL(bj); f32x4 v0, v1;
                if (SRC_BF16) unpack8(__builtin_bit_cast(u32x4, rb[r8 % 3][bj][0]), v0, v1); else { v0 = rb[r8 % 3][bj][0]; v1 = rb[r8 % 3][bj][1]; }
                v0 += acc[ai][bj][m][0]; v1 += acc[ai][bj][m][1];
#pragma unroll
                for (int j = 0; j < 4; ++j) ss += v0[j] * v0[j] + v1[j] * v1[j];
                *(u32x4*)(dstb + o) = pack8(v0, v1); }
            ss += __shfl_xor(ss, 16); ss += __shfl_xor(ss, 32);
            if (fq == 0) unsafeAtomicAdd(ssq + t, ss); }
#undef ERES_LOAD
    } };

struct SchedP10 { const char* x1b; const char* wgut; int G, c;
    __device__ __forceinline__ bool next(int i, Unit& u) const {
        const int L = i * G + c; if (L >= 1408) return false;
        int pm, pn; tile_order(L, 64, 22, pm, pn); u.pm = pm; u.pn = pn; u.kind = 0; u.cont = 0;
        u.a = x1b + (size_t)pm * 256 * 1024 * 2; u.b = wgut + (size_t)pn * 256 * 1024 * 2; return true; } };
struct EpiP10 { static constexpr bool AFTER_DRAIN = false; const float* ssq; bf16_t* hid;
    __device__ __forceinline__ void mid(Acc&, const Unit&, int, int, int, int) const {}
    __device__ __forceinline__ void pre(const Unit&, int, int, int, int) const {}
    __device__ __forceinline__ void operator()(Acc& acc, const Unit& u, int wr, int wc, int fr, int fq) const {
        float rsv[2][4];
#pragma unroll
        for (int ai = 0; ai < 2; ++ai)
#pragma unroll
            for (int m = 0; m < 4; ++m) rsv[ai][m] = ssq[u.pm * 256 + EPI_RL(ai, m)];
        EPI_ROWS(ai, m) { const int t = u.pm * 256 + EPI_RL(ai, m); const float rs = rsqrtf(rsv[ai][m] * (1.0f / 1024.0f) + EPS_);
            const f32x4 o0 = silu4(acc[ai][0][m][0] * rs) * (acc[ai][1][m][0] * rs), o1 = silu4(acc[ai][0][m][1] * rs) * (acc[ai][1][m][1] * rs);
            *(u32x4*)(hid + (size_t)t * DFF_ + u.pn * 128 + wc * 32 + 8 * fq) = pack8(o0, o1); }
    } };

struct EpiBf { static constexpr bool AFTER_DRAIN = false; bf16_t* o;
    __device__ __forceinline__ void mid(Acc&, const Unit&, int, int, int, int) const {}
    __device__ __forceinline__ void pre(const Unit&, int, int, int, int) const {}
    __device__ __forceinline__ void operator()(Acc& acc, const Unit& u, int wr, int wc, int fr, int fq) const {
        EPI_ROWS(ai, m) { bf16_t* rowp = o + (size_t)(u.pm * 256 + EPI_RL(ai, m)) * 1024 + u.pn * 256 + EPI_CL(0);
#pragma unroll
            for (int bj = 0; bj < 2; ++bj) *(u32x4*)(rowp + bj * 128) = pack8(acc[ai][bj][m][0], acc[ai][bj][m][1]); }
    } };

struct EpiP12 { static constexpr bool AFTER_DRAIN = true; const float* ssq2; const bf16_t* pe; const bf16_t* xin; float* out; float* ssq3; unsigned* done; const float* fg;
    __device__ __forceinline__ void mid(Acc&, const Unit&, int, int, int, int) const {}
    __device__ __forceinline__ void pre(const Unit&, int, int, int, int) const {}
    __device__ __forceinline__ void operator()(Acc& acc, const Unit& u, int wr, int wc, int fr, int fq) const {
        float rsv[2][4];
#pragma unroll
        for (int ai = 0; ai < 2; ++ai)
#pragma unroll
            for (int m = 0; m < 4; ++m) rsv[ai][m] = ssq2[u.pm * 256 + EPI_RL(ai, m)];
        { u32x4 cx[2], cp[2], nx[2], np[2];
#pragma unroll
            for (int bj = 0; bj < 2; ++bj) { const size_t o = (size_t)(u.pm * 256 + EPI_RL(0, 0)) * 1024 + u.pn * 256 + EPI_CL(bj); cx[bj] = *(const u32x4*)(xin + o); cp[bj] = *(const u32x4*)(pe + o); }
            EPI_R8 { const int ai = r8 >> 2, m = r8 & 3; const int t = u.pm * 256 + EPI_RL(ai, m); const float rs = rsqrtf(rsv[ai][m] * (1.0f / 1024.0f) + EPS_); float ss = 0.f;
                if (r8 < 7) {
#pragma unroll
                    for (int bj = 0; bj < 2; ++bj) { const size_t o = (size_t)(u.pm * 256 + EPI_RL((r8 + 1) >> 2, (r8 + 1) & 3)) * 1024 + u.pn * 256 + EPI_CL(bj); nx[bj] = *(const u32x4*)(xin + o); np[bj] = *(const u32x4*)(pe + o); } }
#pragma unroll
                for (int bj = 0; bj < 2; ++bj) { f32x4 p0, p1, v0, v1; unpack8(cp[bj], p0, p1); unpack8(cx[bj], v0, v1);
                    v0 += sigm4(acc[ai][bj][m][0] * rs) * p0; v1 += sigm4(acc[ai][bj][m][1] * rs) * p1;
                    { const f32x4 q = v0 * v0 + v1 * v1; ss += (q[0] + q[1]) + (q[2] + q[3]); }
                    acc[ai][bj][m][0] = v0; acc[ai][bj][m][1] = v1; }
                ss += __shfl_xor(ss, 16); ss += __shfl_xor(ss, 32);
                if (fq == 0) unsafeAtomicAdd(ssq3 + t, ss);
                cx[0] = nx[0]; cx[1] = nx[1]; cp[0] = np[0]; cp[1] = np[1]; } }
        asm volatile("s_waitcnt vmcnt(0)" ::: "memory");
        unsigned* cnt = done + 64 * u.pm;
        if ((threadIdx.x & 63) == 0) __hip_atomic_fetch_add(cnt, 1u, __ATOMIC_RELAXED, __HIP_MEMORY_SCOPE_AGENT);
        { unsigned sp = 0; while (__hip_atomic_load(cnt, __ATOMIC_RELAXED, __HIP_MEMORY_SCOPE_AGENT) < 32u) { __builtin_amdgcn_s_sleep(1); if (++sp > (1u << 22)) break; } }
#pragma unroll
        for (int ai = 0; ai < 2; ++ai)
#pragma unroll
            for (int m = 0; m < 4; ++m) rsv[ai][m] = __hip_atomic_load(ssq3 + u.pm * 256 + EPI_RL(ai, m), __ATOMIC_RELAXED, __HIP_MEMORY_SCOPE_AGENT);
        f32x4 gv[2][2];
#pragma unroll
        for (int bj = 0; bj < 2; ++bj) { const int cc = u.pn * 256 + EPI_CL(bj); gv[bj][0] = *(const f32x4*)(fg + cc); gv[bj][1] = *(const f32x4*)(fg + cc + 4); }
        EPI_ROWS(ai, m) { const int t = u.pm * 256 + EPI_RL(ai, m);
            const float rs = rsqrtf(rsv[ai][m] * (1.0f / 1024.0f) + EPS_);
#pragma unroll
            for (int bj = 0; bj < 2; ++bj) { const size_t o = (size_t)t * 1024 + u.pn * 256 + EPI_CL(bj);
                *(f32x4*)(out + o) = acc[ai][bj][m][0] * rs * gv[bj][0]; *(f32x4*)(out + o + 4) = acc[ai][bj][m][1] * rs * gv[bj][1]; } }
    } };

struct CvtTile { const float* src; int ld; const float* scale; bf16_t* dst; int dstld; };
__device__ __forceinline__ CvtTile cvt_tile_params(const Params& p, int tl) {
    const int NT0 = 2048, NT4 = NT0 + 1024, NT5 = NT4 + 1408, NT6 = NT5 + 704;
    unsigned char* ws = p.ws; CvtTile t; t.scale = nullptr;
    if (tl < NT0) { const int nb = tl >> 4, kb = tl & 15; const int n0 = nb * 64; int col;
        if (n0 < 4096) col = n0; else if (n0 < 6144) { const int j = (n0 - 4096) >> 8, r = (n0 - 4096) & 255; col = (r < 128) ? (4104 + 128 * j + r) : (5128 + 128 * j + r - 128); }
        else { const int j = (n0 - 6144) >> 8, r = (n0 - 6144) & 255; col = 6152 + ((r < 128) ? (128 * j + r) : (1024 + 128 * j + r - 128)); }
        t.src = p.in[3] + (size_t)kb * 64 * NIN_ + col; t.ld = NIN_; t.scale = p.in[2] + kb * 64; t.dst = (bf16_t*)(ws + O_WINT) + (size_t)n0 * 1024 + kb * 64; t.dstld = 1024; }
    else if (tl < NT4) { const int w = (tl - NT0) >> 8, l = (tl - NT0) & 255; const int nb = l >> 4, kb = l & 15;
        const float* base = w == 0 ? p.in[12] : (w == 1 ? p.in[13] : (w == 2 ? p.in[14] : p.in[20])); const size_t od = w == 0 ? O_WMT : (w == 1 ? O_WCT : (w == 2 ? O_WOT : O_WPGT));
        t.src = base + (size_t)kb * 64 * 1024 + nb * 64; t.ld = 1024; if (w == 3) t.scale = p.in[19] + kb * 64; if (w == 0) t.scale = p.in[7] + kb * 64; t.dst = (bf16_t*)(ws + od) + (size_t)nb * 64 * 1024 + kb * 64; t.dstld = 1024; }
    else if (tl < NT5) { const int l = tl - NT4; const int nb = l >> 4, kb = l & 15; const int n0 = nb * 64; const int j = n0 >> 8, r = n0 & 255;
        const float* base = (r < 128) ? p.in[16] : p.in[17]; const int col = 128 * j + (r & 127);
        t.src = base + (size_t)kb * 64 * DFF_ + col; t.ld = DFF_; t.scale = p.in[15] + kb * 64; t.dst = (bf16_t*)(ws + O_WGUT) + (size_t)n0 * 1024 + kb * 64; t.dstld = 1024; }
    else if (tl < NT6) { const int l = tl - NT5; const int nb = l / 44, kb = l % 44;
        t.src = p.in[18] + (size_t)kb * 64 * 1024 + nb * 64; t.ld = 1024; t.dst = (bf16_t*)(ws + O_WDT) + (size_t)nb * 64 * DFF_ + kb * 64; t.dstld = DFF_; }
    else { const int l = tl - NT6; const int nb = l >> 2, kb = l & 3;
        t.src = p.in[21] + (size_t)kb * 64 * 1024 + nb * 64; t.ld = 1024; t.dst = (bf16_t*)(ws + O_WPPT) + (size_t)nb * 64 * 256 + kb * 64; t.dstld = 256; }
    return t;
}
__device__ __forceinline__ void cvt_tile_load(const CvtTile& t, f32x4 (&v)[2]) {
    const int tid = threadIdx.x, kk = tid >> 4, c4 = (tid & 15) * 4;
#pragma unroll
    for (int pss = 0; pss < 2; ++pss) { const int k = kk + pss * 32; v[pss] = *(const f32x4*)(t.src + (size_t)k * t.ld + c4); if (t.scale) v[pss] = v[pss] * t.scale[k]; }
}

__device__ __forceinline__ void phase0(const Params& p, unsigned char* sm) {
    unsigned char* ws = p.ws;
    const int tid = threadIdx.x, lane = tid & 63, wid = tid >> 6;
    const size_t gtid = (size_t)blockIdx.x * 512 + tid, gthreads = (size_t)gridDim.x * 512;
    for (size_t i = gtid; i < ZERO_BYTES / 16; i += gthreads) ((u32x4*)(ws + O_ZERO))[i] = (u32x4){0u, 0u, 0u, 0u};
    { const float* pp = p.in[1]; bf16_t* pb = (bf16_t*)(ws + O_PB);
        for (size_t i = gtid; i < (size_t)T_ * 256 / 8; i += gthreads) { const f32x4 a = *(const f32x4*)(pp + i * 8), b = *(const f32x4*)(pp + i * 8 + 4); *(u32x4*)(pb + i * 8) = pack8(a, b); } }
    { const float* x = p.in[0]; const float* g = p.in[2]; const float* win = p.in[3]; const float* bif = p.in[4];
        float* wgT = (float*)sm;
        for (int idx = tid; idx < 8192; idx += 512) { const int k = idx >> 3, j = idx & 7; wgT[j * 1024 + k] = win[(size_t)k * NIN_ + 4096 + j] * g[k]; }
        __syncthreads();
        bf16_t* hb = (bf16_t*)(ws + O_HB); float* ig = (float*)(ws + O_IG); float* lf = (float*)(ws + O_LF);
        const int rstep = gridDim.x * 8; int row = blockIdx.x * 8 + wid;
        f32x4 xn[4];
#pragma unroll
        for (int i = 0; i < 4; ++i) xn[i] = (row < T_) ? *(const f32x4*)(x + (size_t)row * 1024 + i * 256 + lane * 4) : (f32x4){0.f, 0.f, 0.f, 0.f};
        for (; row < T_; row += rstep) {
            f32x4 xv[4]; float ss = 0.f;
#pragma unroll
            for (int i = 0; i < 4; ++i) { xv[i] = xn[i]; ss += xv[i][0] * xv[i][0] + xv[i][1] * xv[i][1] + xv[i][2] * xv[i][2] + xv[i][3] * xv[i][3]; }
            { const int nrow = row + rstep;
                if (nrow < T_) {
#pragma unroll
                    for (int i = 0; i < 4; ++i) xn[i] = *(const f32x4*)(x + (size_t)nrow * 1024 + i * 256 + lane * 4); } }
            ss = wave_sum(ss); const float rs = rsqrtf(ss * (1.0f / 1024.0f) + EPS_);
            float d[8];
#pragma unroll
            for (int j = 0; j < 8; ++j) d[j] = 0.f;
            if (lane == 0) ((float*)(ws + O_RS))[row] = rs;
#pragma unroll
            for (int i = 0; i < 4; ++i) { const f32x4 hn = xv[i] * rs;
                u32x2 w; w.x = cvt_pk_bf16(xv[i][0], xv[i][1]); w.y = cvt_pk_bf16(xv[i][2], xv[i][3]); *(u32x2*)(hb + (size_t)row * 1024 + i * 256 + lane * 4) = w;
#pragma unroll
                for (int j = 0; j < 8; ++j) { const f32x4 wv = *(const f32x4*)(wgT + j * 1024 + i * 256 + lane * 4); d[j] += hn[0] * wv[0] + hn[1] * wv[1] + hn[2] * wv[2] + hn[3] * wv[3]; } }
#pragma unroll
            for (int j = 0; j < 8; ++j) d[j] = wave_sum(d[j]);
            if (lane < 8) { float v = d[0];
#pragma unroll
                for (int j = 1; j < 8; ++j) v = (lane == j) ? d[j] : v;
                v += bif[lane];
                if (lane < 4) ig[(size_t)row * 4 + lane] = v;
                else { const float z = v; lf[(size_t)row * 4 + lane - 4] = fminf(z, 0.f) - log1pf(__expf(-fabsf(z))); } }
        }
        __syncthreads();
    }
    { const int NTILES = 2048 + 1024 + 1408 + 704 + 64; const int gs = gridDim.x;
        float* tl = (float*)sm;
        int t = blockIdx.x; CvtTile c0{}, c1{}; f32x4 v0[2], v1[2];
        if (t < NTILES) { c0 = cvt_tile_params(p, t); cvt_tile_load(c0, v0); }
        if (t + gs < NTILES) { c1 = cvt_tile_params(p, t + gs); cvt_tile_load(c1, v1); }
        for (; t < NTILES; t += gs) {
            { const int kk = tid >> 4, c4 = (tid & 15) * 4;
#pragma unroll
                for (int pss = 0; pss < 2; ++pss) { const int k = kk + pss * 32;
#pragma unroll
                    for (int j = 0; j < 4; ++j) tl[k * 65 + c4 + j] = v0[pss][j]; } }
            __syncthreads();
            const CvtTile done = c0; c0 = c1; v0[0] = v1[0]; v0[1] = v1[1];
            { const int tn = t + 2 * gs; if (tn < NTILES) { c1 = cvt_tile_params(p, tn); cvt_tile_load(c1, v1); } }
            { const int n = tid >> 3, k8 = (tid & 7) * 8; float e[8];
#pragma unroll
                for (int q = 0; q < 8; ++q) e[q] = tl[(k8 + q) * 65 + n];
                u32x4 w; w.x = cvt_pk_bf16(e[0], e[1]); w.y = cvt_pk_bf16(e[2], e[3]); w.z = cvt_pk_bf16(e[4], e[5]); w.w = cvt_pk_bf16(e[6], e[7]);
                *(u32x4*)(done.dst + (size_t)n * done.dstld + k8) = w; }
            __syncthreads();
        }
    }
}

__device__ __forceinline__ void phase2(const Params& p, unsigned char* sm) {
    unsigned char* ws = p.ws;
    const int tid = threadIdx.x, lane = tid & 63, wid = tid >> 6;
    float* rowfac = (float*)sm; float* colfac = rowfac + 256; float* wsum = colfac + 256;
    const float* ig = (const float*)(ws + O_IG); const float* lf = (const float*)(ws + O_LF);
    const bf16_t* qkpre = (const bf16_t*)p.out;
    const float* cw = p.in[5]; const float* cb = p.in[6];
    for (int item = blockIdx.x; item < 256; item += gridDim.x) {
        const int b = item >> 5, h = (item >> 3) & 3, sc = item & 7; const int tokb = b * SEQ_ + sc * 256;
        float v = 0.f, igv = 0.f;
        if (tid < 256) { v = lf[(size_t)(tokb + tid) * 4 + h]; igv = ig[(size_t)(tokb + tid) * 4 + h]; }
#pragma unroll
        for (int o = 1; o < 64; o <<= 1) { const float n = __shfl_up(v, o); if (lane >= o) v += n; }
        if (tid < 256 && lane == 63) wsum[wid] = v;
        __syncthreads();
        if (tid < 256) { float add = 0.f; for (int j = 0; j < wid; ++j) add += wsum[j]; v += add; rowfac[tid] = __expf(v); colfac[tid] = __expf(igv - v);
            if (tid == 255) ((float*)(ws + O_EBL))[item] = __expf(v); }
        __syncthreads();
#pragma unroll 1
        for (int qt = 0; qt < 4; ++qt) {
        const int cp = tid & 127, tg = tid >> 7; const int ch = 2 * cp; const int tl0 = qt * 64 + tg * 16; const int s0 = sc * 256 + tl0;
        { const int col = h * 256 + ch; float x0[19], x1[19];
#pragma unroll
            for (int i = 0; i < 19; ++i) { const int s = s0 - 3 + i; unsigned w = 0u; if (s >= 0) w = *(const unsigned*)(qkpre + (size_t)(b * SEQ_ + s) * 2048 + col); x0[i] = bf_lo(w); x1[i] = bf_hi(w); }
            float w0[4], w1[4];
#pragma unroll
            for (int k = 0; k < 4; ++k) { const f32x2 wv = *(const f32x2*)(cw + (size_t)k * 2048 + col); w0[k] = wv[0]; w1[k] = wv[1]; }
            const f32x2 bv = *(const f32x2*)(cb + col);
            bf16_t* wq = (bf16_t*)(ws + O_WQ) + (size_t)item * 65536;
#pragma unroll
            for (int i = 0; i < 16; ++i) { float y0 = bv[0], y1 = bv[1];
#pragma unroll
                for (int k = 0; k < 4; ++k) { y0 += x0[i + k] * w0[k]; y1 += x1[i + k] * w1[k]; }
                const float f = rowfac[tl0 + i] * 0.0625f;
                *(unsigned*)(wq + (size_t)(tl0 + i) * 256 + ch) = cvt_pk_bf16(silu(y0) * f, silu(y1) * f); } }
        { const int col = 1024 + h * 256 + ch; float x0[19], x1[19];
#pragma unroll
            for (int i = 0; i < 19; ++i) { const int s = s0 - 3 + i; unsigned w = 0u; if (s >= 0) w = *(const unsigned*)(qkpre + (size_t)(b * SEQ_ + s) * 2048 + col); x0[i] = bf_lo(w); x1[i] = bf_hi(w); }
            float w0[4], w1[4];
#pragma unroll
            for (int k = 0; k < 4; ++k) { const f32x2 wv = *(const f32x2*)(cw + (size_t)k * 2048 + col); w0[k] = wv[0]; w1[k] = wv[1]; }
            const f32x2 bv = *(const f32x2*)(cb + col);
            bf16_t* kw = (bf16_t*)(ws + O_KW) + (size_t)item * 65536; bf16_t* kwt = (bf16_t*)(ws + O_KWT) + (size_t)item * 65536;
            float k0[16], k1[16]; float n0 = 0.f, n1 = 0.f;
#pragma unroll
            for (int i = 0; i < 16; ++i) { float y0 = bv[0], y1 = bv[1];
#pragma unroll
                for (int k = 0; k < 4; ++k) { y0 += x0[i + k] * w0[k]; y1 += x1[i + k] * w1[k]; }
                const float f = colfac[tl0 + i]; k0[i] = silu(y0) * f; k1[i] = silu(y1) * f; n0 += k0[i]; n1 += k1[i];
                *(unsigned*)(kw + (size_t)(tl0 + i) * 256 + ch) = cvt_pk_bf16(k0[i], k1[i]); }
            u32x4 a, c;
            a.x = cvt_pk_bf16(k0[0], k0[1]); a.y = cvt_pk_bf16(k0[2], k0[3]); a.z = cvt_pk_bf16(k0[4], k0[5]); a.w = cvt_pk_bf16(k0[6], k0[7]);
            c.x = cvt_pk_bf16(k0[8], k0[9]); c.y = cvt_pk_bf16(k0[10], k0[11]); c.z = cvt_pk_bf16(k0[12], k0[13]); c.w = cvt_pk_bf16(k0[14], k0[15]);
            *(u32x4*)(kwt + (size_t)ch * 256 + tl0) = a; *(u32x4*)(kwt + (size_t)ch * 256 + tl0 + 8) = c;
            a.x = cvt_pk_bf16(k1[0], k1[1]); a.y = cvt_pk_bf16(k1[2], k1[3]); a.z = cvt_pk_bf16(k1[4], k1[5]); a.w = cvt_pk_bf16(k1[6], k1[7]);
            c.x = cvt_pk_bf16(k1[8], k1[9]); c.y = cvt_pk_bf16(k1[10], k1[11]); c.z = cvt_pk_bf16(k1[12], k1[13]); c.w = cvt_pk_bf16(k1[14], k1[15]);
            *(u32x4*)(kwt + (size_t)(ch + 1) * 256 + tl0) = a; *(u32x4*)(kwt + (size_t)(ch + 1) * 256 + tl0 + 8) = c;
            float* nsum = (float*)(ws + O_NSUM) + (size_t)item * 256;
            unsafeAtomicAdd(nsum + ch, n0); unsafeAtomicAdd(nsum + ch + 1, n1); }
        }
        __syncthreads();
    }
}

__device__ __forceinline__ void phase4(const Params& p, unsigned char* sm) {
    unsigned char* ws = p.ws;
    const int tid = threadIdx.x;
    const float* ebl = (const float*)(ws + O_EBL);
    const bf16_t* lt = (const bf16_t*)(p.ws + O_KWT);
    bf16_t* cint = (bf16_t*)(ws + O_CINT);
    const size_t gtid = (size_t)blockIdx.x * 512 + tid, gthreads = (size_t)gridDim.x * 512;
#pragma unroll 2
    for (size_t g = gtid; g < (size_t)32 * 16384; g += gthreads) {
        const int bh = (int)(g >> 14), e4 = (int)(g & 16383);
        f32x4 c = {0.f, 0.f, 0.f, 0.f};
        u32x2 lw[7]; float eb[7];
#pragma unroll
        for (int sc = 0; sc < 7; ++sc) { lw[sc] = *(const u32x2*)(lt + (size_t)(bh * 8 + sc) * 65536 + e4 * 4); eb[sc] = ebl[bh * 8 + sc]; }
#pragma unroll
        for (int sc = 0; sc < 8; ++sc) { const int item = bh * 8 + sc;
            u32x2 w; w.x = cvt_pk_bf16(c[0], c[1]); w.y = cvt_pk_bf16(c[2], c[3]); *(u32x2*)(cint + (size_t)item * 65536 + e4 * 4) = w;
            if (sc < 7) { const f32x4 l = {bf_lo(lw[sc].x), bf_hi(lw[sc].x), bf_lo(lw[sc].y), bf_hi(lw[sc].y)}; c = (c + l) * eb[sc]; } }
    }
    float* nin = (float*)sm;
    const float* nsum = (const float*)(ws + O_NSUM);
    float* denx = (float*)(ws + O_DENX);
    for (int item = blockIdx.x; item < 256; item += gridDim.x) {
        const int b = item >> 5, h = (item >> 3) & 3, sc = item & 7; const int tokb = b * SEQ_ + sc * 256; const int bh = item >> 3;
        if (tid < 256) { float eb[7], ns[7];
#pragma unroll
            for (int j = 0; j < 7; ++j) { eb[j] = ebl[bh * 8 + j]; ns[j] = nsum[(size_t)(bh * 8 + j) * 256 + tid]; }
            float nv = 0.f;
#pragma unroll
            for (int j = 0; j < 7; ++j) if (j < sc) nv = eb[j] * (nv + ns[j]);
            nin[tid] = nv; }
        __syncthreads();
        const int tl = tid >> 1, half = tid & 1;
        const bf16_t* wq = (const bf16_t*)(ws + O_WQ) + (size_t)item * 65536 + (size_t)tl * 256 + half * 128;
        float d = 0.f;
#pragma unroll
        for (int i = 0; i < 16; ++i) { f32x4 a0, a1; unpack8(*(const u32x4*)(wq + i * 8), a0, a1); const float* nn = nin + half * 128 + i * 8;
            d += a0[0] * nn[0] + a0[1] * nn[1] + a0[2] * nn[2] + a0[3] * nn[3] + a1[0] * nn[4] + a1[1] * nn[5] + a1[2] * nn[6] + a1[3] * nn[7]; }
        d += __shfl_xor(d, 1);
        if (half == 0) denx[(size_t)(tokb + tl) * 4 + h] = d;
        __syncthreads();
    }
}

__device__ __forceinline__ void phase7(const Params& p, unsigned char* sm) {
    unsigned char* ws = p.ws;
    const int tid = threadIdx.x, lane = tid & 63, wid = tid >> 6;
    const bf16_t* uu = (const bf16_t*)p.out; bf16_t* uc = (bf16_t*)(ws + O_UC);
    const float* cw = p.in[8]; const float* cb = p.in[9]; const float* lg = p.in[10]; const float* lb = p.in[11];
    u32x4 pf[12];
#define P7_LOAD(tile_) do { const int t0_ = (tile_) * 16; const int b_ = t0_ / SEQ_, s0_ = t0_ % SEQ_; \
        _Pragma("unroll") for (int q = 0; q < 12; ++q) { const int idx = tid + q * 512; const int r = idx >> 7, c16 = idx & 127; const int s_ = s0_ - 30 + r; \
            pf[q] = (u32x4){0u, 0u, 0u, 0u}; if (idx < 46 * 128 && s_ >= 0) pf[q] = *(const u32x4*)(uu + (size_t)(b_ * SEQ_ + s_) * 1024 + c16 * 8); } } while (0)
    int tile = blockIdx.x;
    if (tile < 1024) P7_LOAD(tile);
    f32x2 wv[31];
#pragma unroll
    for (int k = 0; k < 31; ++k) wv[k] = *(const f32x2*)(cw + (size_t)k * 1024 + 2 * tid);
    const f32x2 bv = *(const f32x2*)(cb + 2 * tid);
    f32x4 lgv[4], lbv[4];
#pragma unroll
    for (int i = 0; i < 4; ++i) { lgv[i] = *(const f32x4*)(lg + i * 256 + lane * 4); lbv[i] = *(const f32x4*)(lb + i * 256 + lane * 4); }
    for (; tile < 1024; tile += gridDim.x) {
        const int t0 = tile * 16;
#pragma unroll
        for (int q = 0; q < 12; ++q) { const int idx = tid + q * 512; const int r = idx >> 7, c16 = idx & 127; if (idx < 46 * 128) *(u32x4*)(sm + r * 2048 + c16 * 16) = pf[q]; }
        __syncthreads();
        f32x2 yy[16];
        {
#pragma unroll
            for (int t = 0; t < 16; ++t) yy[t] = bv;
#pragma unroll
            for (int r = 0; r < 46; ++r) { const unsigned w = *(const unsigned*)(sm + r * 2048 + tid * 4); const f32x2 xx = {bf_lo(w), bf_hi(w)};
#pragma unroll
                for (int t = 0; t < 16; ++t) { const int k = r - t; if (k >= 0 && k <= 30) yy[t] = __builtin_elementwise_fma(wv[k], xx, yy[t]); }
                if ((r & 3) == 3) asm volatile("" ::: "memory"); }
        }
        __syncthreads();
#pragma unroll
        for (int t = 0; t < 16; ++t) *(f32x2*)(sm + t * 4096 + tid * 8) = yy[t];
        { const int tn = tile + gridDim.x; if (tn < 1024) P7_LOAD(tn); }
        __syncthreads();
#pragma unroll
        for (int tt = 0; tt < 2; ++tt) { const int t = wid * 2 + tt; f32x4 v[4]; float s1 = 0.f;
#pragma unroll
            for (int i = 0; i < 4; ++i) { v[i] = *(const f32x4*)(sm + t * 4096 + (i * 256 + lane * 4) * 4); s1 += v[i][0] + v[i][1] + v[i][2] + v[i][3]; }
            s1 = wave_sum(s1); const float mu = s1 * (1.0f / 1024.0f); float s2 = 0.f;
#pragma unroll
            for (int i = 0; i < 4; ++i) { v[i] = v[i] - mu; s2 += v[i][0] * v[i][0] + v[i][1] * v[i][1] + v[i][2] * v[i][2] + v[i][3] * v[i][3]; }
            s2 = wave_sum(s2); const float rstd = rsqrtf(s2 * (1.0f / 1024.0f) + EPS_);
#pragma unroll
            for (int i = 0; i < 4; ++i) { const int c = i * 256 + lane * 4; f32x4 z = v[i] * rstd * lgv[i] + lbv[i];
                z = silu4(z); u32x2 w; w.x = cvt_pk_bf16(z[0], z[1]); w.y = cvt_pk_bf16(z[2], z[3]); *(u32x2*)(uc + (size_t)(t0 + t) * 1024 + c) = w; } }
        __syncthreads();
    }
#undef P7_LOAD
}

__device__ __forceinline__ void phase13(const Params& p) {
    const float* ssq3 = (const float*)(p.ws + O_SSQ3); const float* fg = p.in[22];
    const size_t gtid = (size_t)blockIdx.x * 512 + threadIdx.x, gthreads = (size_t)gridDim.x * 512;
    for (size_t i = gtid; i < (size_t)T_ * 256; i += gthreads) { const int row = (int)(i >> 8), c = (int)(i & 255) * 4;
        const float rs = rsqrtf(ssq3[row] * (1.0f / 1024.0f) + EPS_); const f32x4 g = *(const f32x4*)(fg + c);
        f32x4 v = *(const f32x4*)(p.out + i * 4); v = v * rs * g; *(f32x4*)(p.out + i * 4) = v; }
}

#define XB_TMO      128
#define XB_XCNT(j)  (256  + 64 * (j))
#define XB_XSUB(j)  (1280 + 64 * (j))
#define XB_XGEN(j)  (2304 + 64 * (j))
#define XB_TOP      3328
#define XB_TOPGEN   3392
#define XCD_BAR_WORDS 3456
#define XB_SPIN_CAP (1u << 18)
__device__ __forceinline__ unsigned xb_ld(unsigned* p)              { return __hip_atomic_load(p, __ATOMIC_RELAXED, __HIP_MEMORY_SCOPE_AGENT); }
__device__ __forceinline__ unsigned xb_add(unsigned* p, unsigned v) { return __hip_atomic_fetch_add(p, v, __ATOMIC_RELAXED, __HIP_MEMORY_SCOPE_AGENT); }
__device__ __forceinline__ unsigned xb_xcc_id() { return (unsigned)__builtin_amdgcn_s_getreg((3 << 11) | 20) & 0xFu; }
#define XB_SPIN(cond, bar) do { unsigned _sp = 0; while (cond) { __builtin_amdgcn_s_sleep(1); \
    if ((++_sp & 255u) == 0u) { if (xb_ld(&(bar)[XB_TMO])) break; if (_sp > XB_SPIN_CAP) { atomicAdd(&(bar)[XB_TMO], 1u); break; } } } } while (0)
struct XcdBarrier { unsigned* bar; unsigned x; volatile LAS unsigned* st; };
__device__ __forceinline__ XcdBarrier xcd_barrier_post(unsigned* bar, volatile LAS unsigned* st) {
    XcdBarrier b; b.bar = bar; b.x = xb_xcc_id(); b.st = st;
    if (threadIdx.x == 0) (void)xb_add(&bar[XB_XCNT(b.x)], 1u);
    return b;
}
__device__ __forceinline__ void xcd_barrier_complete(unsigned* bar, unsigned x, unsigned& nloc, unsigned& nx) {
    const unsigned G = gridDim.x * gridDim.y * gridDim.z;
    unsigned sum, cnt, mine, sp = 0u;
    for (;;) {
        sum = 0u; cnt = 0u; mine = 0u;
#pragma unroll
        for (unsigned j = 0; j < 16; ++j) { const unsigned c = xb_ld(&bar[XB_XCNT(j)]); sum += c; cnt += (c > 0u) ? 1u : 0u; mine = (j == x) ? c : mine; }
        if (sum == G) break;
        __builtin_amdgcn_s_sleep(1);
        if ((++sp & 255u) == 0u) { if (xb_ld(&bar[XB_TMO])) break; if (sp > XB_SPIN_CAP) { atomicAdd(&bar[XB_TMO], 1u); break; } }
    }
    nloc = mine > 0u ? mine : 1u; nx = cnt > 0u ? cnt : 1u;
}
__device__ __forceinline__ void xcd_barrier(const XcdBarrier& b) {
    asm volatile("s_waitcnt vmcnt(0)" ::: "memory");
    __syncthreads();
    if (threadIdx.x == 0) {
        unsigned* bar = b.bar;
        __builtin_amdgcn_s_waitcnt(0);
        unsigned nloc = b.st[0], nx = b.st[1];
        if (nloc == 0u) { xcd_barrier_complete(bar, b.x, nloc, nx); b.st[0] = nloc; b.st[1] = nx; }
        const unsigned old = xb_add(&bar[XB_XSUB(b.x)], 1u);
        const unsigned gen = old / nloc;
        if (old + 1u == (gen + 1u) * nloc) {
            __builtin_amdgcn_fence(__ATOMIC_RELEASE, "agent");
            asm volatile("s_waitcnt vmcnt(0)" ::: "memory");
            const unsigned og = xb_add(&bar[XB_TOP], 1u);
            const unsigned tg = og / nx;
            if (og + 1u == (tg + 1u) * nx) xb_add(&bar[XB_TOPGEN], 1u);
            else XB_SPIN(xb_ld(&bar[XB_TOPGEN]) == tg, bar);
            __builtin_amdgcn_fence(__ATOMIC_ACQUIRE, "agent");
            xb_add(&bar[XB_XGEN(b.x)], 1u);
            asm volatile("s_waitcnt vmcnt(0)" ::: "memory");
        } else {
            XB_SPIN(xb_ld(&bar[XB_XGEN(b.x)]) == gen, bar);
            __builtin_amdgcn_fence(__ATOMIC_ACQUIRE, "agent");
            asm volatile("s_waitcnt vmcnt(0)" ::: "memory");
        }
    }
    __syncthreads();
}

template <bool COOP>
__global__ void __launch_bounds__(512, 2) mk_fwd(Params p) {
    extern __shared__ __attribute__((aligned(16))) unsigned char shm[];
    LAS unsigned char* lds = (LAS unsigned char*)shm;
    unsigned char* ws = p.ws;
    const int G = gridDim.x, c = blockIdx.x;
#ifndef PHMASK
#define PHMASK 0x3fff
#endif
#define PH(k) if (((PHMASK >> (k)) & 1) && p.ph_lo <= (k) && (k) < p.ph_hi)
    XcdBarrier xb{};
    if (COOP) { volatile LAS unsigned* st = (volatile LAS unsigned*)(lds + 131072);
        if (threadIdx.x == 0) { st[0] = 0u; st[1] = 0u; }
        __syncthreads();
        xb = xcd_barrier_post((unsigned*)(ws + O_BAR), st); }
#define SYNC(k) if (COOP) { if (p.ph_lo <= (k) && (k) + 1 < p.ph_hi) { xcd_barrier(xb); } }
    PH(0) phase0(p, shm);
    SYNC(0)
    PH(1) { SchedP1 S{(const char*)(ws + O_HB), (const char*)(ws + O_WINT), G, c}; EpiP1 E{(bf16_t*)p.out, (bf16_t*)(ws + O_VT), (const float*)(ws + O_RS)}; gemm_phase(lds, 1024, 1024, 1024, S, E); }
    SYNC(1)
    PH(3) { phase2(p, shm);
        asm volatile("s_waitcnt vmcnt(0)" ::: "memory"); __syncthreads();
        SchedP3 S{(const char*)(ws + O_WQ), (const char*)(ws + O_KW), (const char*)(ws + O_VT), (const char*)(ws + O_KWT), G, c};
        EpiP3 E{(bf16_t*)(ws + O_SS), (bf16_t*)(ws + O_KWT), (float*)(ws + O_DENI)}; gemm_phase(lds, 256, 256, 256, S, E); }
    SYNC(3)
    PH(4) phase4(p, shm);
    SYNC(4)
    PH(6) { { SchedP5 S{(const char*)(ws + O_SS), (const char*)(ws + O_VT), (const char*)(ws + O_WQ), (const char*)(ws + O_CINT), G, c};
            EpiP5 E{(bf16_t*)(ws + O_HM), (const float*)(ws + O_DENI), (const float*)(ws + O_DENX), (float*)(ws + O_HSS)}; gemm_phase(lds, 256, 256, 256, S, E); }
        { SchedP6 S{(const char*)(ws + O_HB), (const char*)(ws + O_WINT), G, c};
            EpiP6 E{(bf16_t*)(ws + O_HM), (float*)(ws + O_HSS), (const float*)(ws + O_RS), (bf16_t*)p.out}; gemm_phase(lds, 1024, 1024, 1024, S, E); } }
    SYNC(6)
    PH(7) phase7(p, shm);
    SYNC(7)
    PH(8) { SchedP8 S{(const char*)(ws + O_HB), (const char*)(ws + O_WINT), (const char*)(ws + O_HM), (const char*)(ws + O_UC), (const char*)(ws + O_WMT), (const char*)(ws + O_WCT), G, c};
        EpiP8 E{(bf16_t*)(ws + O_GMC), (bf16_t*)p.out + (size_t)T_ * 1024, (bf16_t*)(ws + O_MERGED), (const float*)(ws + O_RS)}; gemm_phase(lds, 1024, 1024, 1024, S, E); }
    SYNC(8)
    PH(9) { SchedN4 S{(const char*)(ws + O_MERGED), (const char*)(ws + O_WOT), (size_t)256 * 1024 * 2, (size_t)256 * 1024 * 2, G, c};
        EpiRes<true> E{(const void*)(ws + O_HB), (bf16_t*)(ws + O_X1B), (float*)(ws + O_SSQ1)}; gemm_phase(lds, 1024, 1024, 1024, S, E); }
    SYNC(9)
    PH(10) { { SchedP10 S{(const char*)(ws + O_X1B), (const char*)(ws + O_WGUT), G, c}; EpiP10 E{(const float*)(ws + O_SSQ1), (bf16_t*)(ws + O_HID)}; gemm_phase(lds, 1024, 1024, 1024, S, E); }
        { const int h = G >> 1; SchedPE S{(const char*)(ws + O_PB), (const char*)(ws + O_WPPT), h, c - h};
            EpiBf E{(bf16_t*)(ws + O_PE)}; if (c >= h) gemm_phase(lds, 256, 256, 256, S, E); } }
    SYNC(10)
    PH(11) { SchedN4 S{(const char*)(ws + O_HID), (const char*)(ws + O_WDT), (size_t)256 * DFF_ * 2, (size_t)256 * DFF_ * 2, G, c};
            EpiRes<true> E{(const void*)(ws + O_X1B), (bf16_t*)(ws + O_X2B), (float*)(ws + O_SSQ2)}; gemm_phase(lds, DFF_, DFF_, DFF_, S, E); }
    SYNC(11)
    PH(12) { SchedN4 S{(const char*)(ws + O_X2B), (const char*)(ws + O_WPGT), (size_t)256 * 1024 * 2, (size_t)256 * 1024 * 2, G, c};
        EpiP12 E{(const float*)(ws + O_SSQ2), (const bf16_t*)(ws + O_PE), (const bf16_t*)(ws + O_X2B), p.out, (float*)(ws + O_SSQ3), (unsigned*)(ws + O_BAR) + XCD_BAR_WORDS, p.in[22]}; gemm_phase(lds, 1024, 1024, 1024, S, E); }
#undef PH
#undef SYNC
}

extern "C" void kernel_launch(void* const* d_in, const int* in_sizes, int n_in, void* d_out, int out_size, void* d_ws, size_t ws_size, hipStream_t stream) {
    static int grid = 0;
    if (grid == 0) {
        if (n_in != 23 || out_size != T_ * D_ || ws_size < WS_NEED) { fprintf(stderr, "kernel_launch: unexpected shapes (n_in %d, out %d, ws %zu)\n", n_in, out_size, ws_size); grid = -1; return; }
        int dev = 0, cus = 0, per_cu = 0;
        hipGetDevice(&dev); hipDeviceGetAttribute(&cus, hipDeviceAttributeMultiprocessorCount, dev);
        hipFuncSetAttribute((const void*)mk_fwd<true>, hipFuncAttributeMaxDynamicSharedMemorySize, LDS_BYTES);
        hipFuncSetAttribute((const void*)mk_fwd<false>, hipFuncAttributeMaxDynamicSharedMemorySize, LDS_BYTES);
        hipOccupancyMaxActiveBlocksPerMultiprocessor(&per_cu, (const void*)mk_fwd<true>, 512, LDS_BYTES);
        if (per_cu < 1) { fprintf(stderr, "kernel_launch: occupancy query reports %d blocks per CU\n", per_cu); per_cu = 1; }
        (void)hipGetLastError();
        grid = cus;
        if (grid != 256) { fprintf(stderr, "kernel_launch: built for a 256-CU device (got %d CUs)\n", cus); grid = -1; return; }
    }
    if (grid < 0) return;
    Params p{};
    for (int i = 0; i < 23; ++i) p.in[i] = (const float*)d_in[i];
    p.out = (float*)d_out; p.ws = (unsigned char*)d_ws;
#if MK_MULTI
#ifndef PROBE_DUP
#define PROBE_DUP -1
#endif
    for (int k = 0; k < NPHASE; ++k) { p.ph_lo = k; p.ph_hi = k + 1; hipLaunchKernelGGL(mk_fwd<false>, dim3(grid), dim3(512), LDS_BYTES, stream, p);
        if (k == PROBE_DUP) hipLaunchKernelGGL(mk_fwd<false>, dim3(grid), dim3(512), LDS_BYTES, stream, p); }
#else
    p.ph_lo = 0; p.ph_hi = NPHASE;
    if (hipMemsetAsync((unsigned char*)d_ws + O_BAR, 0, (XCD_BAR_WORDS + 64 * 64) * 4, stream) != hipSuccess) { fprintf(stderr, "kernel_launch: memset of barrier words failed\n"); return; }
    void* args[] = {&p};
    hipError_t e = hipLaunchCooperativeKernel((const void*)mk_fwd<true>, dim3(grid), dim3(512), args, LDS_BYTES, stream);
    if (e != hipSuccess) fprintf(stderr, "cooperative launch failed: %s (grid %d)\n", hipGetErrorString(e), grid);
#endif
}
```

```cpp
#include <hip/hip_runtime.h>
#include <hip/hip_cooperative_groups.h>
#include <cstdio>
namespace cg = cooperative_groups;

#ifndef MK_MULTI
#define MK_MULTI 0
#endif

#define LAS __attribute__((address_space(3)))
typedef unsigned short bf16_t;
typedef short bf16x8 __attribute__((ext_vector_type(8)));
typedef float f32x4 __attribute__((ext_vector_type(4)));
typedef float f32x2 __attribute__((ext_vector_type(2)));
typedef unsigned u32x4 __attribute__((ext_vector_type(4)));
typedef unsigned u32x2 __attribute__((ext_vector_type(2)));

constexpr int T_ = 16384, D_ = 1024, NIN_ = 8200, DFF_ = 2816, SEQ_ = 2048;
constexpr float EPS_ = 1e-6f;
constexpr int BM = 256, BK = 64, HALF = 128, HTB = HALF * BK * 2, STAGE_BYTES = 8 * HTB;
constexpr int LDS_BYTES = 136 * 1024;
constexpr int NPHASE = 13;

constexpr size_t KiB = 1024, MiB = 1024 * 1024;
constexpr size_t O_WINT = 0, O_WMT = 16 * MiB, O_WCT = 18 * MiB, O_WOT = 20 * MiB, O_WPGT = 22 * MiB, O_WGUT = 24 * MiB, O_WDT = 35 * MiB, O_WPPT = 40 * MiB + 512 * KiB;
constexpr size_t O_IG = 41 * MiB, O_LF = O_IG + 256 * KiB, O_ZERO = O_LF + 256 * KiB;
constexpr size_t O_DENI = O_ZERO, O_HSS = O_DENI + 256 * KiB, O_SSQ1 = O_HSS + 256 * KiB, O_SSQ2 = O_SSQ1 + 64 * KiB, O_SSQ3 = O_SSQ2 + 64 * KiB, O_NSUM = O_SSQ3 + 64 * KiB;
constexpr size_t ZERO_BYTES = 960 * KiB;
constexpr size_t O_DENX = O_ZERO + ZERO_BYTES, O_EBL = O_DENX + 256 * KiB;
constexpr size_t O_RS = O_EBL + 4 * KiB;
constexpr size_t O_BAR = 43 * MiB;
constexpr size_t O_PB = 44 * MiB, O_HB = 52 * MiB, O_S1 = 84 * MiB, O_S2 = 116 * MiB, O_S3 = 148 * MiB, O_S4 = 180 * MiB, O_S5 = 212 * MiB, WS_NEED = 244 * MiB;
constexpr size_t O_PE = O_HB, O_VT = O_S1, O_U = O_S1, O_MERGED = O_S1, O_HID = O_S1, O_WQ = O_S2, O_GMC = O_S2, O_KW = O_S3, O_CINT = O_S3,
                 O_KWT = O_S4, O_HM = O_S4, O_X1B = O_S4, O_SS = O_S5, O_UC = O_S5, O_X2B = O_S5;

struct Params {
    const float* in[23];
    float* out;
    unsigned char* ws;
    int ph_lo, ph_hi;
};

__device__ __forceinline__ unsigned cvt_pk_bf16(float lo, float hi) { unsigned r; asm volatile("v_cvt_pk_bf16_f32 %0, %1, %2" : "=v"(r) : "v"(lo), "v"(hi)); return r; }
__device__ __forceinline__ float bf_lo(unsigned w) { return __uint_as_float(w << 16); }
__device__ __forceinline__ float bf_hi(unsigned w) { return __uint_as_float(w & 0xffff0000u); }
__device__ __forceinline__ float sigm(float x) { return __builtin_amdgcn_rcpf(1.0f + __builtin_amdgcn_exp2f(x * -1.4426950408889634f)); }
__device__ __forceinline__ float silu(float x) { return x * __builtin_amdgcn_rcpf(1.0f + __builtin_amdgcn_exp2f(x * -1.4426950408889634f)); }
__device__ __forceinline__ f32x4 exp2v(f32x4 t) { f32x4 e; e[0] = __builtin_amdgcn_exp2f(t[0]); e[1] = __builtin_amdgcn_exp2f(t[1]); e[2] = __builtin_amdgcn_exp2f(t[2]); e[3] = __builtin_amdgcn_exp2f(t[3]); return e; }
__device__ __forceinline__ f32x4 rcpv(f32x4 d) { f32x4 r; r[0] = __builtin_amdgcn_rcpf(d[0]); r[1] = __builtin_amdgcn_rcpf(d[1]); r[2] = __builtin_amdgcn_rcpf(d[2]); r[3] = __builtin_amdgcn_rcpf(d[3]); return r; }
__device__ __forceinline__ f32x4 sigm4(f32x4 x) { return rcpv(exp2v(x * -1.4426950408889634f) + 1.0f); }
__device__ __forceinline__ f32x4 silu4(f32x4 x) { return x * sigm4(x); }
__device__ __forceinline__ float wave_sum(float v) {
#pragma unroll
    for (int o = 32; o > 0; o >>= 1) v += __shfl_xor(v, o);
    return v;
}
__device__ __forceinline__ u32x4 pack8(const f32x4 a, const f32x4 b) { u32x4 w; w.x = cvt_pk_bf16(a[0], a[1]); w.y = cvt_pk_bf16(a[2], a[3]); w.z = cvt_pk_bf16(b[0], b[1]); w.w = cvt_pk_bf16(b[2], b[3]); return w; }
__device__ __forceinline__ void unpack8(const u32x4 w, f32x4& a, f32x4& b) { a[0] = bf_lo(w.x); a[1] = bf_hi(w.x); a[2] = bf_lo(w.y); a[3] = bf_hi(w.y); b[0] = bf_lo(w.z); b[1] = bf_hi(w.z); b[2] = bf_lo(w.w); b[3] = bf_hi(w.w); }

__host__ __device__ __forceinline__ int lds_byte(int r, int c) { const int st = (r >> 4) * 2 + (c >> 5), rr = r & 15, cc = c & 31, ob = rr * 64 + cc * 2; return st * 1024 + (ob ^ (((ob >> 9) & 1) << 5)); }
__host__ __device__ __forceinline__ void stage_rc(int b, int& R, int& C) { const int st = b / 1024, sb = b % 1024, swz = sb ^ (((sb >> 9) & 1) << 5); R = (st >> 1) * 16 + swz / 64; C = (st & 1) * 32 + (swz % 64) / 2; }
__host__ __device__ __forceinline__ int perm32(int rho) { const int n = rho >> 4, i = rho & 15; return 8 * (i >> 2) + 4 * n + (i & 3); }

struct Unit { const char* a; const char* b; int pm, pn, kind, cont; };
__device__ __forceinline__ void map_n4(int L, int& pm, int& pn) { const int x = L & 7, k = L >> 3; pm = x * 8 + (k & 7); pn = k >> 3; }

__device__ __forceinline__ void tile_order(int L, int nM, int nN, int& pm, int& pn) {
    const int nwg = nM * nN; int wgid = L;
    { const int q = nwg / 8, r = nwg % 8, xcd = wgid % 8, off = wgid / 8; wgid = (xcd < r ? xcd * (q + 1) : r * (q + 1) + (xcd - r) * q) + off; }
    const int nig = 8 * nN, gid = wgid / nig, fm = gid * 8, gsz = (nM - fm) < 8 ? (nM - fm) : 8;
    pm = fm + ((wgid % nig) % gsz); pn = (wgid % nig) / gsz;
}

template <class Epi, class Sched>
__device__ __forceinline__ void gemm_phase(LAS unsigned char* lds, const int K, const int lda, const int ldb, const Sched& S, const Epi& E) {
    const int tid = threadIdx.x, wid = __builtin_amdgcn_readfirstlane(tid >> 6), lane = tid & 63, wr = wid >> 2, wc = wid & 3, fr = lane & 15, fq = lane >> 4;
    const int nt = K / BK;
    unsigned voffA[2], voffB[2];
#pragma unroll
    for (int i = 0; i < 2; ++i) { int R, C; stage_rc(tid * 16 + i * 8192, R, C); const int Rb = (R & ~31) + perm32(R & 31);
        voffA[i] = (unsigned)(R * lda + C) * 2u; voffB[i] = (unsigned)(Rb * ldb + C) * 2u; }
    const size_t kstep = (size_t)(BK * 2);
    const size_t hstepA = (size_t)HALF * lda * 2, hstepB = (size_t)HALF * ldb * 2;
    const unsigned ldsw = (unsigned)wid * 1024u;
    const int aoff = lds_byte(wr * 64 + fr, fq * 8), boff = lds_byte(wc * 32 + fr, fq * 8);
#define PG8_SA(b, h) (((b) * 2 + (h)) * HTB)
#define PG8_SB(b, h) ((4 + (b) * 2 + (h)) * HTB)
#define PG8_STAGE(bufoff, gbase, voff) do { _Pragma("unroll") for (int _i = 0; _i < 2; ++_i) \
        __builtin_amdgcn_global_load_lds((const unsigned*)((const char*)(gbase) + (voff)[_i]), (LAS unsigned*)(lds + (bufoff) + ldsw + _i * 8192), 16, 0, 0); } while (0)
#define PG8_LDA(dst, b, h) do { _Pragma("unroll") for (int m = 0; m < 4; ++m) _Pragma("unroll") for (int k = 0; k < 2; ++k) dst[m][k] = *(const LAS bf16x8*)(lds + PG8_SA(b, h) + aoff + m * 2048 + k * 1024); } while (0)
#define PG8_LDB(dst, b, h) do { _Pragma("unroll") for (int n = 0; n < 2; ++n) _Pragma("unroll") for (int k = 0; k < 2; ++k) dst[n][k] = *(const LAS bf16x8*)(lds + PG8_SB(b, h) + boff + n * 2048 + k * 1024); } while (0)
#define PG8_MMA(ai, bj, At, Bt) do { __builtin_amdgcn_s_setprio(1); _Pragma("unroll") for (int m = 0; m < 4; ++m) _Pragma("unroll") for (int n = 0; n < 2; ++n) _Pragma("unroll") for (int k = 0; k < 2; ++k) \
        acc[ai][bj][m][n] = __builtin_amdgcn_mfma_f32_16x16x32_bf16(Bt[n][k], At[m][k], acc[ai][bj][m][n], 0, 0, 0); __builtin_amdgcn_s_setprio(0); } while (0)
#define PG8_WAIT_V(n) asm volatile("s_waitcnt vmcnt(" #n ")" ::: "memory")
#define PG8_WAIT_L(n) asm volatile("s_waitcnt lgkmcnt(" #n ")" ::: "memory")
#define PG8_BAR __builtin_amdgcn_s_barrier()
#define PG8_SCHED __builtin_amdgcn_sched_barrier(0)
#define PG8_ZERO() do { _Pragma("unroll") for (int a = 0; a < 2; ++a) _Pragma("unroll") for (int b = 0; b < 2; ++b) _Pragma("unroll") for (int m = 0; m < 4; ++m) _Pragma("unroll") for (int n = 0; n < 2; ++n) acc[a][b][m][n] = (f32x4){0.f, 0.f, 0.f, 0.f}; } while (0)
    Unit cur, nxt; int ui = 0;
    if (!S.next(0, cur)) return;
    E.pre(cur, wr, wc, fr, fq);
    f32x4 acc[2][2][4][2];
    PG8_ZERO();
    bf16x8 At[4][2], B0[2][2], B1[2][2];
    const char* cA = cur.a; const char* cB = cur.b;
    PG8_STAGE(PG8_SB(0, 0), cB, voffB); PG8_STAGE(PG8_SA(0, 0), cA, voffA); PG8_STAGE(PG8_SB(0, 1), cB + hstepB, voffB); PG8_STAGE(PG8_SA(0, 1), cA + hstepA, voffA);
    if (wr == 1) PG8_BAR;
    PG8_WAIT_V(4); PG8_BAR;
    PG8_STAGE(PG8_SB(1, 0), cB + kstep, voffB); PG8_STAGE(PG8_SA(1, 0), cA + kstep, voffA); PG8_STAGE(PG8_SB(1, 1), cB + hstepB + kstep, voffB);
    PG8_WAIT_V(6); PG8_BAR;
    for (;;) {
        const bool has_next = S.next(ui + 1, nxt);
        const char* nA = has_next ? nxt.a : cA; const char* nB = has_next ? nxt.b : cB;
#pragma unroll 1
        for (int t = 0; t < nt; t += 2) {
            const bool last = (t == nt - 2);
            const char* a1 = cA + (size_t)(t + 1) * kstep;
            const char* a2 = last ? nA : cA + (size_t)(t + 2) * kstep; const char* b2 = last ? nB : cB + (size_t)(t + 2) * kstep;
            const char* a3 = a2 + kstep; const char* b3 = b2 + kstep;
            PG8_LDB(B0, 0, 0); PG8_SCHED; PG8_LDA(At, 0, 0); PG8_STAGE(PG8_SA(1, 1), a1 + hstepA, voffA);
            PG8_WAIT_L(8); PG8_BAR; PG8_WAIT_L(0); PG8_MMA(0, 0, At, B0); PG8_BAR; PG8_SCHED;
            PG8_LDB(B1, 0, 1); PG8_STAGE(PG8_SB(0, 0), b2, voffB);
            PG8_BAR; PG8_WAIT_L(0); PG8_MMA(0, 1, At, B1); PG8_BAR;
            PG8_LDA(At, 0, 1); PG8_STAGE(PG8_SA(0, 0), a2, voffA);
            PG8_BAR; PG8_WAIT_L(0); PG8_MMA(1, 0, At, B0); PG8_BAR; PG8_SCHED;
            PG8_STAGE(PG8_SB(0, 1), b2 + hstepB, voffB);
            PG8_WAIT_V(6); PG8_BAR; PG8_MMA(1, 1, At, B1); PG8_BAR;
            PG8_LDB(B0, 1, 0); PG8_SCHED; PG8_LDA(At, 1, 0); PG8_STAGE(PG8_SA(0, 1), a2 + hstepA, voffA);
            PG8_WAIT_L(8); PG8_BAR; PG8_WAIT_L(0); PG8_MMA(0, 0, At, B0); PG8_BAR; PG8_SCHED;
            PG8_LDB(B1, 1, 1); PG8_STAGE(PG8_SB(1, 0), b3, voffB);
            PG8_BAR; PG8_WAIT_L(0); PG8_MMA(0, 1, At, B1); PG8_BAR;
            PG8_LDA(At, 1, 1); PG8_STAGE(PG8_SA(1, 0), a3, voffA);
            PG8_BAR; PG8_WAIT_L(0); PG8_MMA(1, 0, At, B0); PG8_BAR; PG8_SCHED;
            PG8_STAGE(PG8_SB(1, 1), b3 + hstepB, voffB);
            PG8_WAIT_V(6); PG8_BAR; PG8_MMA(1, 1, At, B1); PG8_BAR;
        }
        if (cur.cont) { E.mid(acc, cur, wr, wc, fr, fq); }
        else { if constexpr (!Epi::AFTER_DRAIN) E(acc, cur, wr, wc, fr, fq); if (!has_next) break; PG8_ZERO(); }
        cur = nxt; cA = nA; cB = nB; ++ui;
    }
    PG8_WAIT_V(0);
    if (wr == 0) PG8_BAR;
    PG8_BAR;
    if constexpr (Epi::AFTER_DRAIN) E(acc, cur, wr, wc, fr, fq);
#undef PG8_SA
#undef PG8_SB
#undef PG8_STAGE
#undef PG8_LDA
#undef PG8_LDB
#undef PG8_MMA
#undef PG8_WAIT_V
#undef PG8_WAIT_L
#undef PG8_BAR
#undef PG8_SCHED
#undef PG8_ZERO
}

typedef f32x4 Acc[2][2][4][2];
#define EPI_ROWS(ai, m) _Pragma("unroll") for (int ai = 0; ai < 2; ++ai) _Pragma("unroll") for (int m = 0; m < 4; ++m) if (epi_fence())
__device__ __forceinline__ bool epi_fence() { asm volatile("" ::: "memory"); return true; }
#define EPI_R8 _Pragma("unroll") for (int r8 = 0; r8 < 8; ++r8)
#define EPI_RL(ai, m) ((ai) * 128 + wr * 64 + (m) * 16 + fr)
#define EPI_CL(bj) ((bj) * 128 + wc * 32 + 8 * fq)

struct SchedP1 { const char* hb; const char* wint; int G, c;
    __device__ __forceinline__ bool next(int i, Unit& u) const {
        const int item = (i / 3) * G + c, r = i % 3; if (item >= 256) return false;
        const int b = item >> 5, h = (item >> 3) & 3, sc = item & 7; const int pt = b * 8 + sc;
        u.cont = 0;
        if (r < 2) { u.pm = pt; u.pn = r * 4 + h; u.kind = 0; u.a = hb + (size_t)pt * 256 * 1024 * 2; u.b = wint + (size_t)u.pn * 256 * 1024 * 2; }
        else { u.pm = h; u.pn = pt; u.kind = 1; u.a = wint + (size_t)(2048 + h * 256) * 1024 * 2; u.b = hb + (size_t)pt * 256 * 1024 * 2; }
        return true; } };
struct EpiP1 { static constexpr bool AFTER_DRAIN = false; bf16_t* qkpre; bf16_t* vt; const float* rsb;
    __device__ __forceinline__ void mid(Acc&, const Unit&, int, int, int, int) const {}
    __device__ __forceinline__ void pre(const Unit&, int, int, int, int) const {}
    __device__ __forceinline__ void operator()(Acc& acc, const Unit& u, int wr, int wc, int fr, int fq) const {
        if (u.kind == 0) {
            bf16_t* base = qkpre + (size_t)u.pm * 256 * 2048 + u.pn * 256; float rv[2][4];
#pragma unroll
            for (int ai = 0; ai < 2; ++ai)
#pragma unroll
                for (int m = 0; m < 4; ++m) rv[ai][m] = rsb[u.pm * 256 + EPI_RL(ai, m)];
            EPI_ROWS(ai, m) { bf16_t* rowp = base + (size_t)EPI_RL(ai, m) * 2048 + EPI_CL(0);
#pragma unroll
                for (int bj = 0; bj < 2; ++bj) *(u32x4*)(rowp + bj * 128) = pack8(acc[ai][bj][m][0] * rv[ai][m], acc[ai][bj][m][1] * rv[ai][m]); }
        } else {
            const int item = ((u.pn >> 3) * 4 + u.pm) * 8 + (u.pn & 7); bf16_t* base = vt + (size_t)item * 65536; f32x4 cv[2][2];
#pragma unroll
            for (int bj = 0; bj < 2; ++bj) { cv[bj][0] = *(const f32x4*)(rsb + u.pn * 256 + EPI_CL(bj)); cv[bj][1] = *(const f32x4*)(rsb + u.pn * 256 + EPI_CL(bj) + 4); }
            EPI_ROWS(ai, m) { bf16_t* rowp = base + (size_t)EPI_RL(ai, m) * 256 + EPI_CL(0);
#pragma unroll
                for (int bj = 0; bj < 2; ++bj) *(u32x4*)(rowp + bj * 128) = pack8(acc[ai][bj][m][0] * cv[bj][0], acc[ai][bj][m][1] * cv[bj][1]); }
        }
    } };

struct SchedP3 { const char* wq; const char* kw; const char* vt; const char* kwt; int G, c;
    __device__ __forceinline__ bool next(int i, Unit& u) const {
        const int L = i * G + c; if (L >= 512) return false;
        u.cont = 0; u.pn = 0;
        if (L < 256) { u.pm = L; u.kind = 0; u.a = wq + (size_t)L * 131072; u.b = kw + (size_t)L * 131072; }
        else { const int it = L - 256; u.pm = it; u.kind = 1; u.a = vt + (size_t)it * 131072; u.b = kwt + (size_t)it * 131072; }
        return true; } };
struct EpiP3 { static constexpr bool AFTER_DRAIN = false; bf16_t* s; bf16_t* lt; float* deni;
    __device__ __forceinline__ void mid(Acc&, const Unit&, int, int, int, int) const {}
    __device__ __forceinline__ void pre(const Unit&, int, int, int, int) const {}
    __device__ __forceinline__ void operator()(Acc& acc, const Unit& u, int wr, int wc, int fr, int fq) const {
        const int item = u.pm;
        if (u.kind == 0) {
            const int b = item >> 5, h = (item >> 3) & 3, sc = item & 7; const int tokb = b * SEQ_ + sc * 256;
            EPI_ROWS(ai, m) { int r = EPI_RL(ai, m); asm volatile("" : "+v"(r)); float rs = 0.f;
#pragma unroll
                for (int bj = 0; bj < 2; ++bj) { const int c0 = EPI_CL(bj); f32x4 v0 = acc[ai][bj][m][0], v1 = acc[ai][bj][m][1];
#pragma unroll
                    for (int j = 0; j < 4; ++j) { v0[j] = (c0 + j <= r) ? v0[j] : 0.f; v1[j] = (c0 + 4 + j <= r) ? v1[j] : 0.f; rs += v0[j] + v1[j]; }
                    *(u32x4*)(s + (size_t)item * 65536 + r * 256 + c0) = pack8(v0, v1); }
                rs += __shfl_xor(rs, 16); rs += __shfl_xor(rs, 32);
                if (fq == 0) unsafeAtomicAdd(deni + (size_t)(tokb + r) * 4 + h, rs); }
        } else {
            EPI_ROWS(ai, m) { bf16_t* rowp = lt + (size_t)item * 65536 + EPI_RL(ai, m) * 256 + EPI_CL(0);
#pragma unroll
                for (int bj = 0; bj < 2; ++bj) *(u32x4*)(rowp + bj * 128) = pack8(acc[ai][bj][m][0], acc[ai][bj][m][1]); }
        }
    } };

struct SchedP5 { const char* s; const char* vt; const char* wq; const char* cint; int G, c;
    __device__ __forceinline__ bool next(int i, Unit& u) const {
        const int item = (i >> 1) * G + c; if (item >= 256) return false;
        u.pm = item; u.pn = 0; u.kind = 0;
        if ((i & 1) == 0) { u.cont = 1; u.a = s + (size_t)item * 131072; u.b = vt + (size_t)item * 131072; }
        else { u.cont = 0; u.a = wq + (size_t)item * 131072; u.b = cint + (size_t)item * 131072; }
        return true; } };
struct EpiP5 { static constexpr bool AFTER_DRAIN = false; bf16_t* hm; const float* deni; const float* denx; float* hss;
    __device__ __forceinline__ void mid(Acc&, const Unit&, int, int, int, int) const {}
    __device__ __forceinline__ void pre(const Unit&, int, int, int, int) const {}
    __device__ __forceinline__ void operator()(Acc& acc, const Unit& u, int wr, int wc, int fr, int fq) const {
        const int item = u.pm; const int b = item >> 5, h = (item >> 3) & 3, sc = item & 7; const int tokb = b * SEQ_ + sc * 256;
        float dnv[2][4];
#pragma unroll
        for (int ai = 0; ai < 2; ++ai)
#pragma unroll
            for (int m = 0; m < 4; ++m) { const int t = tokb + EPI_RL(ai, m); dnv[ai][m] = deni[(size_t)t * 4 + h] + denx[(size_t)t * 4 + h]; }
        EPI_ROWS(ai, m) { const int t = tokb + EPI_RL(ai, m);
            const float den = dnv[ai][m]; const float inv = __builtin_amdgcn_rcpf(fmaxf(fabsf(den), 1.0f)); float ss = 0.f;
#pragma unroll
            for (int bj = 0; bj < 2; ++bj) { f32x4 v0 = acc[ai][bj][m][0] * inv, v1 = acc[ai][bj][m][1] * inv;
                { const f32x4 q = v0 * v0 + v1 * v1; ss += (q[0] + q[1]) + (q[2] + q[3]); }
                *(u32x4*)(hm + (size_t)t * 1024 + h * 256 + EPI_CL(bj)) = pack8(v0, v1); }
            ss += __shfl_xor(ss, 16); ss += __shfl_xor(ss, 32);
            if (fq == 0) unsafeAtomicAdd(hss + (size_t)t * 4 + h, ss); }
    } };

struct SchedP6 { const char* hb; const char* wint; int G, c;
    __device__ __forceinline__ bool next(int i, Unit& u) const {
        u.cont = 0;
        if (i == 0) { const int item = c; if (item >= 256) return false; const int b = item >> 5, h = (item >> 3) & 3, sc = item & 7;
            u.pm = b * 8 + sc; u.pn = h; u.kind = 0; u.a = hb + (size_t)u.pm * 256 * 1024 * 2; u.b = wint + (size_t)(3072 + h * 256) * 1024 * 2; return true; }
        const int L = (i - 1) * G + c; if (L >= 512) return false;
        int pm, pn; tile_order(L, 64, 8, pm, pn); u.pm = pm; u.pn = pn; u.kind = 1;
        u.a = hb + (size_t)pm * 256 * 1024 * 2; u.b = wint + (size_t)(4096 + pn * 256) * 1024 * 2; return true; } };
struct EpiP6 { static constexpr bool AFTER_DRAIN = false; bf16_t* hm; float* hss; const float* rsb; bf16_t* uu;
    __device__ __forceinline__ void mid(Acc&, const Unit&, int, int, int, int) const {}
    __device__ __forceinline__ void pre(const Unit&, int, int, int, int) const {}
    __device__ __forceinline__ void operator()(Acc& acc, const Unit& u, int wr, int wc, int fr, int fq) const {
        if (u.kind == 0) {
            float hsv[2][4], rxv[2][4];
#pragma unroll
            for (int ai = 0; ai < 2; ++ai)
#pragma unroll
                for (int m = 0; m < 4; ++m) rxv[ai][m] = rsb[u.pm * 256 + EPI_RL(ai, m)];
#pragma unroll
            for (int ai = 0; ai < 2; ++ai)
#pragma unroll
                for (int m = 0; m < 4; ++m) hsv[ai][m] = __hip_atomic_load(hss + (size_t)(u.pm * 256 + EPI_RL(ai, m)) * 4 + u.pn, __ATOMIC_RELAXED, __HIP_MEMORY_SCOPE_AGENT);
            u32x4 cur[2], nxt[2];
#pragma unroll
            for (int bj = 0; bj < 2; ++bj) cur[bj] = *(const u32x4*)(hm + (size_t)(u.pm * 256 + EPI_RL(0, 0)) * 1024 + u.pn * 256 + EPI_CL(bj));
            EPI_R8 { const int ai = r8 >> 2, m = r8 & 3; const int t = u.pm * 256 + EPI_RL(ai, m);
                if (r8 < 7) { const int tn = u.pm * 256 + EPI_RL((r8 + 1) >> 2, (r8 + 1) & 3);
#pragma unroll
                    for (int bj = 0; bj < 2; ++bj) nxt[bj] = *(const u32x4*)(hm + (size_t)tn * 1024 + u.pn * 256 + EPI_CL(bj)); }
                const float rsn = rsqrtf(hsv[ai][m] * (1.0f / 256.0f) + EPS_); const float rx = rxv[ai][m];
#pragma unroll
                for (int bj = 0; bj < 2; ++bj) { f32x4 h0, h1; unpack8(cur[bj], h0, h1);
                    const f32x4 o0 = h0 * rsn * sigm4(acc[ai][bj][m][0] * rx), o1 = h1 * rsn * sigm4(acc[ai][bj][m][1] * rx);
                    *(u32x4*)(hm + (size_t)t * 1024 + u.pn * 256 + EPI_CL(bj)) = pack8(o0, o1); }
                cur[0] = nxt[0]; cur[1] = nxt[1]; }
        } else {
            float rxv[2][4];
#pragma unroll
            for (int ai = 0; ai < 2; ++ai)
#pragma unroll
                for (int m = 0; m < 4; ++m) rxv[ai][m] = rsb[u.pm * 256 + EPI_RL(ai, m)];
            EPI_ROWS(ai, m) { const int t = u.pm * 256 + EPI_RL(ai, m); const float rx = rxv[ai][m];
                const f32x4 o0 = acc[ai][0][m][0] * rx * sigm4(acc[ai][1][m][0] * rx), o1 = acc[ai][0][m][1] * rx * sigm4(acc[ai][1][m][1] * rx);
                *(u32x4*)(uu + (size_t)t * 1024 + u.pn * 128 + wc * 32 + 8 * fq) = pack8(o0, o1); }
        }
    } };

struct SchedP8 { const char* hb; const char* wint; const char* hmg; const char* uc; const char* wmt; const char* wct; int G, c;
    __device__ __forceinline__ bool next(int i, Unit& u) const {
        const int L = (i >> 2) * G + c, r = i & 3; if (L >= 256) return false;
        int pn; map_n4(L, u.pm, pn); u.cont = 0;
        if (r < 2) { u.kind = 2; u.pn = 2 * pn + r; u.a = hb + (size_t)u.pm * 256 * 1024 * 2; u.b = wint + (size_t)(6144 + u.pn * 256) * 1024 * 2; }
        else if (r == 2) { u.kind = 0; u.pn = pn; u.a = hmg + (size_t)u.pm * 256 * 1024 * 2; u.b = wmt + (size_t)pn * 256 * 1024 * 2; }
        else { u.kind = 1; u.pn = pn; u.a = uc + (size_t)u.pm * 256 * 1024 * 2; u.b = wct + (size_t)pn * 256 * 1024 * 2; }
        return true; } };
struct EpiP8 { static constexpr bool AFTER_DRAIN = false; bf16_t* gmc; bf16_t* tmp; bf16_t* merged; const float* rsb;
    __device__ __forceinline__ void mid(Acc&, const Unit&, int, int, int, int) const {}
    __device__ __forceinline__ void pre(const Unit&, int, int, int, int) const {}
    __device__ __forceinline__ void operator()(Acc& acc, const Unit& u, int wr, int wc, int fr, int fq) const {
        if (u.kind == 2) {
            float rxv[2][4];
#pragma unroll
            for (int ai = 0; ai < 2; ++ai)
#pragma unroll
                for (int m = 0; m < 4; ++m) rxv[ai][m] = rsb[u.pm * 256 + EPI_RL(ai, m)];
            EPI_ROWS(ai, m) { const int t = u.pm * 256 + EPI_RL(ai, m); const float rx = rxv[ai][m], rxe = rx * -1.4426950408889634f;
                const f32x4 d0 = exp2v(acc[ai][1][m][0] * rxe) + 1.0f, d1 = exp2v(acc[ai][1][m][1] * rxe) + 1.0f;
                const f32x4 m0 = exp2v(acc[ai][0][m][0] * rxe) + 1.0f, m1 = exp2v(acc[ai][0][m][1] * rxe) + 1.0f;
                const f32x4 p0 = rcpv(m0 * d0), p1 = rcpv(m1 * d1);
                const f32x4 r0 = d0 * d0 * p0, r1 = d1 * d1 * p1, c0 = m0 * p0, c1 = m1 * p1;
                bf16_t* ptr = gmc + (size_t)t * 2048 + u.pn * 128 + wc * 32 + 8 * fq;
                *(u32x4*)ptr = pack8(r0, r1); *(u32x4*)(ptr + 1024) = pack8(c0, c1); }
        } else if (u.kind == 0) {
            u32x4 cur[2], nxt[2];
#pragma unroll
            for (int bj = 0; bj < 2; ++bj) cur[bj] = *(const u32x4*)(gmc + (size_t)(u.pm * 256 + EPI_RL(0, 0)) * 2048 + u.pn * 256 + EPI_CL(bj));
            EPI_R8 { const int ai = r8 >> 2, m = r8 & 3; const int t = u.pm * 256 + EPI_RL(ai, m);
                if (r8 < 7) { const int tn = u.pm * 256 + EPI_RL((r8 + 1) >> 2, (r8 + 1) & 3);
#pragma unroll
                    for (int bj = 0; bj < 2; ++bj) nxt[bj] = *(const u32x4*)(gmc + (size_t)tn * 2048 + u.pn * 256 + EPI_CL(bj)); }
#pragma unroll
                for (int bj = 0; bj < 2; ++bj) { const int c = u.pn * 256 + EPI_CL(bj); f32x4 a0, a1; unpack8(cur[bj], a0, a1);
                    *(u32x4*)(tmp + (size_t)t * 1024 + c) = pack8(acc[ai][bj][m][0] * a0, acc[ai][bj][m][1] * a1); }
                cur[0] = nxt[0]; cur[1] = nxt[1]; }
        } else {
            u32x4 cg[2], ct[2], ng[2], nt2[2];
#pragma unroll
            for (int bj = 0; bj < 2; ++bj) { const int t0 = u.pm * 256 + EPI_RL(0, 0); const int c = u.pn * 256 + EPI_CL(bj);
                cg[bj] = *(const u32x4*)(gmc + (size_t)t0 * 2048 + 1024 + c); ct[bj] = *(const u32x4*)(tmp + (size_t)t0 * 1024 + c); }
            EPI_R8 { const int ai = r8 >> 2, m = r8 & 3; const int t = u.pm * 256 + EPI_RL(ai, m);
                if (r8 < 7) { const int tn = u.pm * 256 + EPI_RL((r8 + 1) >> 2, (r8 + 1) & 3);
#pragma unroll
                    for (int bj = 0; bj < 2; ++bj) { const int c = u.pn * 256 + EPI_CL(bj); ng[bj] = *(const u32x4*)(gmc + (size_t)tn * 2048 + 1024 + c); nt2[bj] = *(const u32x4*)(tmp + (size_t)tn * 1024 + c); } }
#pragma unroll
                for (int bj = 0; bj < 2; ++bj) { const int c = u.pn * 256 + EPI_CL(bj); f32x4 b0, b1, t0, t1; unpack8(cg[bj], b0, b1); unpack8(ct[bj], t0, t1);
                    *(u32x4*)(merged + (size_t)t * 1024 + c) = pack8((acc[ai][bj][m][0] + t0) * b0, (acc[ai][bj][m][1] + t1) * b1); }
                cg[0] = ng[0]; cg[1] = ng[1]; ct[0] = nt2[0]; ct[1] = nt2[1]; }
        }
    } };

struct SchedN4 { const char* a; const char* bt; size_t astep, bstep; int G, c;
    __device__ __forceinline__ bool next(int i, Unit& u) const {
        const int L = i * G + c; if (L >= 256) return false;
        map_n4(L, u.pm, u.pn); u.kind = 0; u.cont = 0; u.a = a + (size_t)u.pm * astep; u.b = bt + (size_t)u.pn * bstep; return true; } };
struct SchedPE { const char* a; const char* bt; int G, c;
    __device__ __forceinline__ bool next(int i, Unit& u) const {
        const int L = i * G + c; if (L >= 256 || c < 0) return false;
        u.pm = L >> 2; u.pn = L & 3; u.kind = 0; u.cont = 0; u.a = a + (size_t)u.pm * 256 * 256 * 2; u.b = bt + (size_t)u.pn * 256 * 256 * 2; return true; } };
template <bool SRC_BF16> struct EpiRes { static constexpr bool AFTER_DRAIN = false; const void* src; bf16_t* dstb; float* ssq;
    __device__ __forceinline__ void mid(Acc&, const Unit&, int, int, int, int) const {}
    __device__ __forceinline__ void pre(const Unit& u, int wr, int wc, int fr, int fq) const {
        if (!SRC_BF16) {
            EPI_ROWS(ai, m) { const int t = u.pm * 256 + EPI_RL(ai, m);
#pragma unroll
                for (int bj = 0; bj < 2; ++bj) { const float v = *((const float*)src + (size_t)t * 1024 + u.pn * 256 + EPI_CL(bj)); asm volatile("" :: "v"(v)); } }
        }
    }
    __device__ __forceinline__ void operator()(Acc& acc, const Unit& u, int wr, int wc, int fr, int fq) const {
        f32x4 rb[3][2][2];
#define ERES_LOAD(dst, t_) do { _Pragma("unroll") for (int bj = 0; bj < 2; ++bj) { const size_t o_ = (size_t)(t_) * 1024 + u.pn * 256 + EPI_CL(bj); \
            if (SRC_BF16) dst[bj][0] = __builtin_bit_cast(f32x4, *(const u32x4*)((const bf16_t*)src + o_)); \
            else { dst[bj][0] = *(const f32x4*)((const float*)src + o_); dst[bj][1] = *(const f32x4*)((const float*)src + o_ + 4); } } } while (0)
        ERES_LOAD(rb[0], u.pm * 256 + EPI_RL(0, 0)); ERES_LOAD(rb[1], u.pm * 256 + EPI_RL(0, 1));
        EPI_R8 { const int ai = r8 >> 2, m = r8 & 3; const int t = u.pm * 256 + EPI_RL(ai, m); float ss = 0.f;
            if (r8 < 6) ERES_LOAD(rb[(r8 + 2) % 3], u.pm * 256 + EPI_RL((r8 + 2) >> 2, (r8 + 2) & 3));
#pragma unroll
            for (int bj = 0; bj < 2; ++bj) { const size_t o = (size_t)t * 1024 + u.pn * 256 + EPI_CL(bj); f32x4 v0, v1;
                if (SRC_BF16) unpack8(__builtin_bit_cast(u32x4, rb[r8 % 3][bj][0]), v0, v1); else { v0 = rb[r8 % 3][bj][0]; v1 = rb[r8 % 3][bj][1]; }
                v0 += acc[ai][bj][m][0]; v1 += acc[ai][bj][m][1];
                { const f32x4 q = v0 * v0 + v1 * v1; ss += (q[0] + q[1]) + (q[2] + q[3]); }
                *(u32x4*)(dstb + o) = pack8(v0, v1); }
            ss += __shfl_xor(ss, 16); ss += __shfl_xor(ss, 32);
            if (fq == 0) unsafeAtomicAdd(ssq + t, ss); }
#undef ERES_LOAD
    } };

struct SchedP10 { const char* x1b; const char* wgut; int G, c;
    __device__ __forceinline__ bool next(int i, Unit& u) const {
        const int L = i * G + c; if (L >= 1408) return false;
        int pm, pn; tile_order(L, 64, 22, pm, pn); u.pm = pm; u.pn = pn; u.kind = 0; u.cont = 0;
        u.a = x1b + (size_t)pm * 256 * 1024 * 2; u.b = wgut + (size_t)pn * 256 * 1024 * 2; return true; } };
struct EpiP10 { static constexpr bool AFTER_DRAIN = false; const float* ssq; bf16_t* hid;
    __device__ __forceinline__ void mid(Acc&, const Unit&, int, int, int, int) const {}
    __device__ __forceinline__ void pre(const Unit&, int, int, int, int) const {}
    __device__ __forceinline__ void operator()(Acc& acc, const Unit& u, int wr, int wc, int fr, int fq) const {
        float rsv[2][4];
#pragma unroll
        for (int ai = 0; ai < 2; ++ai)
#pragma unroll
            for (int m = 0; m < 4; ++m) rsv[ai][m] = ssq[u.pm * 256 + EPI_RL(ai, m)];
        EPI_ROWS(ai, m) { const int t = u.pm * 256 + EPI_RL(ai, m); const float rs = rsqrtf(rsv[ai][m] * (1.0f / 1024.0f) + EPS_);
            const f32x4 o0 = silu4(acc[ai][0][m][0] * rs) * (acc[ai][1][m][0] * rs), o1 = silu4(acc[ai][0][m][1] * rs) * (acc[ai][1][m][1] * rs);
            *(u32x4*)(hid + (size_t)t * DFF_ + u.pn * 128 + wc * 32 + 8 * fq) = pack8(o0, o1); }
    } };

struct EpiBf { static constexpr bool AFTER_DRAIN = false; bf16_t* o;
    __device__ __forceinline__ void mid(Acc&, const Unit&, int, int, int, int) const {}
    __device__ __forceinline__ void pre(const Unit&, int, int, int, int) const {}
    __device__ __forceinline__ void operator()(Acc& acc, const Unit& u, int wr, int wc, int fr, int fq) const {
        EPI_ROWS(ai, m) { bf16_t* rowp = o + (size_t)(u.pm * 256 + EPI_RL(ai, m)) * 1024 + u.pn * 256 + EPI_CL(0);
#pragma unroll
            for (int bj = 0; bj < 2; ++bj) *(u32x4*)(rowp + bj * 128) = pack8(acc[ai][bj][m][0], acc[ai][bj][m][1]); }
    } };

struct EpiP12 { static constexpr bool AFTER_DRAIN = true; const float* ssq2; const bf16_t* pe; const bf16_t* xin; float* out; float* ssq3; unsigned* done; const float* fg;
    __device__ __forceinline__ void mid(Acc&, const Unit&, int, int, int, int) const {}
    __device__ __forceinline__ void pre(const Unit&, int, int, int, int) const {}
    __device__ __forceinline__ void operator()(Acc& acc, const Unit& u, int wr, int wc, int fr, int fq) const {
        float rsv[2][4];
#pragma unroll
        for (int ai = 0; ai < 2; ++ai)
#pragma unroll
            for (int m = 0; m < 4; ++m) rsv[ai][m] = ssq2[u.pm * 256 + EPI_RL(ai, m)];
        { u32x4 cx[2], cp[2], nx[2], np[2];
#pragma unroll
            for (int bj = 0; bj < 2; ++bj) { const size_t o = (size_t)(u.pm * 256 + EPI_RL(0, 0)) * 1024 + u.pn * 256 + EPI_CL(bj); cx[bj] = *(const u32x4*)(xin + o); cp[bj] = *(const u32x4*)(pe + o); }
            EPI_R8 { const int ai = r8 >> 2, m = r8 & 3; const int t = u.pm * 256 + EPI_RL(ai, m); const float rs = rsqrtf(rsv[ai][m] * (1.0f / 1024.0f) + EPS_); float ss = 0.f;
                if (r8 < 7) {
#pragma unroll
                    for (int bj = 0; bj < 2; ++bj) { const size_t o = (size_t)(u.pm * 256 + EPI_RL((r8 + 1) >> 2, (r8 + 1) & 3)) * 1024 + u.pn * 256 + EPI_CL(bj); nx[bj] = *(const u32x4*)(xin + o); np[bj] = *(const u32x4*)(pe + o); } }
#pragma unroll
                for (int bj = 0; bj < 2; ++bj) { f32x4 p0, p1, v0, v1; unpack8(cp[bj], p0, p1); unpack8(cx[bj], v0, v1);
                    v0 += sigm4(acc[ai][bj][m][0] * rs) * p0; v1 += sigm4(acc[ai][bj][m][1] * rs) * p1;
                    { const f32x4 q = v0 * v0 + v1 * v1; ss += (q[0] + q[1]) + (q[2] + q[3]); }
                    acc[ai][bj][m][0] = v0; acc[ai][bj][m][1] = v1; }
                ss += __shfl_xor(ss, 16); ss += __shfl_xor(ss, 32);
                if (fq == 0) unsafeAtomicAdd(ssq3 + t, ss);
                cx[0] = nx[0]; cx[1] = nx[1]; cp[0] = np[0]; cp[1] = np[1]; } }
        asm volatile("s_waitcnt vmcnt(0)" ::: "memory");
        unsigned* cnt = done + 64 * u.pm;
        if ((threadIdx.x & 63) == 0) __hip_atomic_fetch_add(cnt, 1u, __ATOMIC_RELAXED, __HIP_MEMORY_SCOPE_AGENT);
        { unsigned sp = 0; while (__hip_atomic_load(cnt, __ATOMIC_RELAXED, __HIP_MEMORY_SCOPE_AGENT) < 32u) { __builtin_amdgcn_s_sleep(1); if (++sp > (1u << 22)) break; } }
#pragma unroll
        for (int ai = 0; ai < 2; ++ai)
#pragma unroll
            for (int m = 0; m < 4; ++m) rsv[ai][m] = __hip_atomic_load(ssq3 + u.pm * 256 + EPI_RL(ai, m), __ATOMIC_RELAXED, __HIP_MEMORY_SCOPE_AGENT);
        f32x4 gv[2][2];
#pragma unroll
        for (int bj = 0; bj < 2; ++bj) { const int cc = u.pn * 256 + EPI_CL(bj); gv[bj][0] = *(const f32x4*)(fg + cc); gv[bj][1] = *(const f32x4*)(fg + cc + 4); }
        EPI_ROWS(ai, m) { const int t = u.pm * 256 + EPI_RL(ai, m);
            const float rs = rsqrtf(rsv[ai][m] * (1.0f / 1024.0f) + EPS_);
#pragma unroll
            for (int bj = 0; bj < 2; ++bj) { const size_t o = (size_t)t * 1024 + u.pn * 256 + EPI_CL(bj);
                *(f32x4*)(out + o) = acc[ai][bj][m][0] * rs * gv[bj][0]; *(f32x4*)(out + o + 4) = acc[ai][bj][m][1] * rs * gv[bj][1]; } }
    } };

struct CvtTile { const float* src; int ld; const float* scale; bf16_t* dst; int dstld; };
__device__ __forceinline__ CvtTile cvt_tile_params(const Params& p, int tl) {
    const int NT0 = 2048, NT4 = NT0 + 1024, NT5 = NT4 + 1408, NT6 = NT5 + 704;
    unsigned char* ws = p.ws; CvtTile t; t.scale = nullptr;
    if (tl < NT0) { const int nb = tl >> 4, kb = tl & 15; const int n0 = nb * 64; int col;
        if (n0 < 4096) col = n0; else if (n0 < 6144) { const int j = (n0 - 4096) >> 8, r = (n0 - 4096) & 255; col = (r < 128) ? (4104 + 128 * j + r) : (5128 + 128 * j + r - 128); }
        else { const int j = (n0 - 6144) >> 8, r = (n0 - 6144) & 255; col = 6152 + ((r < 128) ? (128 * j + r) : (1024 + 128 * j + r - 128)); }
        t.src = p.in[3] + (size_t)kb * 64 * NIN_ + col; t.ld = NIN_; t.scale = p.in[2] + kb * 64; t.dst = (bf16_t*)(ws + O_WINT) + (size_t)n0 * 1024 + kb * 64; t.dstld = 1024; }
    else if (tl < NT4) { const int w = (tl - NT0) >> 8, l = (tl - NT0) & 255; const int nb = l >> 4, kb = l & 15;
        const float* base = w == 0 ? p.in[12] : (w == 1 ? p.in[13] : (w == 2 ? p.in[14] : p.in[20])); const size_t od = w == 0 ? O_WMT : (w == 1 ? O_WCT : (w == 2 ? O_WOT : O_WPGT));
        t.src = base + (size_t)kb * 64 * 1024 + nb * 64; t.ld = 1024; if (w == 3) t.scale = p.in[19] + kb * 64; if (w == 0) t.scale = p.in[7] + kb * 64; t.dst = (bf16_t*)(ws + od) + (size_t)nb * 64 * 1024 + kb * 64; t.dstld = 1024; }
    else if (tl < NT5) { const int l = tl - NT4; const int nb = l >> 4, kb = l & 15; const int n0 = nb * 64; const int j = n0 >> 8, r = n0 & 255;
        const float* base = (r < 128) ? p.in[16] : p.in[17]; const int col = 128 * j + (r & 127);
        t.src = base + (size_t)kb * 64 * DFF_ + col; t.ld = DFF_; t.scale = p.in[15] + kb * 64; t.dst = (bf16_t*)(ws + O_WGUT) + (size_t)n0 * 1024 + kb * 64; t.dstld = 1024; }
    else if (tl < NT6) { const int l = tl - NT5; const int nb = l / 44, kb = l % 44;
        t.src = p.in[18] + (size_t)kb * 64 * 1024 + nb * 64; t.ld = 1024; t.dst = (bf16_t*)(ws + O_WDT) + (size_t)nb * 64 * DFF_ + kb * 64; t.dstld = DFF_; }
    else { const int l = tl - NT6; const int nb = l >> 2, kb = l & 3;
        t.src = p.in[21] + (size_t)kb * 64 * 1024 + nb * 64; t.ld = 1024; t.dst = (bf16_t*)(ws + O_WPPT) + (size_t)nb * 64 * 256 + kb * 64; t.dstld = 256; }
    return t;
}
__device__ __forceinline__ void cvt_tile_load(const CvtTile& t, f32x4 (&v)[2]) {
    const int tid = threadIdx.x, kk = tid >> 4, c4 = (tid & 15) * 4;
#pragma unroll
    for (int pss = 0; pss < 2; ++pss) { const int k = kk + pss * 32; v[pss] = *(const f32x4*)(t.src + (size_t)k * t.ld + c4); if (t.scale) v[pss] = v[pss] * t.scale[k]; }
}

__device__ __forceinline__ void phase0(const Params& p, unsigned char* sm) {
    unsigned char* ws = p.ws;
    const int tid = threadIdx.x, lane = tid & 63, wid = tid >> 6;
    const size_t gtid = (size_t)blockIdx.x * 512 + tid, gthreads = (size_t)gridDim.x * 512;
    for (size_t i = gtid; i < ZERO_BYTES / 16; i += gthreads) ((u32x4*)(ws + O_ZERO))[i] = (u32x4){0u, 0u, 0u, 0u};
    { const float* pp = p.in[1]; bf16_t* pb = (bf16_t*)(ws + O_PB);
        for (size_t i = gtid; i < (size_t)T_ * 256 / 8; i += gthreads) { const f32x4 a = *(const f32x4*)(pp + i * 8), b = *(const f32x4*)(pp + i * 8 + 4); *(u32x4*)(pb + i * 8) = pack8(a, b); } }
    { const float* x = p.in[0]; const float* g = p.in[2]; const float* win = p.in[3]; const float* bif = p.in[4];
        float* wgT = (float*)sm;
        for (int idx = tid; idx < 8192; idx += 512) { const int k = idx >> 3, j = idx & 7; wgT[j * 1024 + k] = win[(size_t)k * NIN_ + 4096 + j] * g[k]; }
        __syncthreads();
        bf16_t* hb = (bf16_t*)(ws + O_HB); float* ig = (float*)(ws + O_IG); float* lf = (float*)(ws + O_LF);
        const int rstep = gridDim.x * 8; int row = blockIdx.x * 8 + wid;
        f32x4 xn[4];
#pragma unroll
        for (int i = 0; i < 4; ++i) xn[i] = (row < T_) ? *(const f32x4*)(x + (size_t)row * 1024 + i * 256 + lane * 4) : (f32x4){0.f, 0.f, 0.f, 0.f};
        for (; row < T_; row += rstep) {
            f32x4 xv[4]; float ss = 0.f;
#pragma unroll
            for (int i = 0; i < 4; ++i) { xv[i] = xn[i]; ss += xv[i][0] * xv[i][0] + xv[i][1] * xv[i][1] + xv[i][2] * xv[i][2] + xv[i][3] * xv[i][3]; }
            { const int nrow = row + rstep;
                if (nrow < T_) {
#pragma unroll
                    for (int i = 0; i < 4; ++i) xn[i] = *(const f32x4*)(x + (size_t)nrow * 1024 + i * 256 + lane * 4); } }
            ss = wave_sum(ss); const float rs = rsqrtf(ss * (1.0f / 1024.0f) + EPS_);
            float d[8];
#pragma unroll
            for (int j = 0; j < 8; ++j) d[j] = 0.f;
            if (lane == 0) ((float*)(ws + O_RS))[row] = rs;
#pragma unroll
            for (int i = 0; i < 4; ++i) { const f32x4 hn = xv[i] * rs;
                u32x2 w; w.x = cvt_pk_bf16(xv[i][0], xv[i][1]); w.y = cvt_pk_bf16(xv[i][2], xv[i][3]); *(u32x2*)(hb + (size_t)row * 1024 + i * 256 + lane * 4) = w;
#pragma unroll
                for (int j = 0; j < 8; ++j) { const f32x4 wv = *(const f32x4*)(wgT + j * 1024 + i * 256 + lane * 4); d[j] += hn[0] * wv[0] + hn[1] * wv[1] + hn[2] * wv[2] + hn[3] * wv[3]; } }
#pragma unroll
            for (int j = 0; j < 8; ++j) d[j] = wave_sum(d[j]);
            if (lane < 8) { float v = d[0];
#pragma unroll
                for (int j = 1; j < 8; ++j) v = (lane == j) ? d[j] : v;
                v += bif[lane];
                if (lane < 4) ig[(size_t)row * 4 + lane] = v;
                else { const float z = v; lf[(size_t)row * 4 + lane - 4] = fminf(z, 0.f) - log1pf(__expf(-fabsf(z))); } }
        }
        __syncthreads();
    }
    { const int NTILES = 2048 + 1024 + 1408 + 704 + 64; const int gs = gridDim.x;
        float* tl = (float*)sm;
        int t = blockIdx.x; CvtTile c0{}, c1{}; f32x4 v0[2], v1[2];
        if (t < NTILES) { c0 = cvt_tile_params(p, t); cvt_tile_load(c0, v0); }
        if (t + gs < NTILES) { c1 = cvt_tile_params(p, t + gs); cvt_tile_load(c1, v1); }
        for (; t < NTILES; t += gs) {
            { const int kk = tid >> 4, c4 = (tid & 15) * 4;
#pragma unroll
                for (int pss = 0; pss < 2; ++pss) { const int k = kk + pss * 32;
#pragma unroll
                    for (int j = 0; j < 4; ++j) tl[k * 65 + c4 + j] = v0[pss][j]; } }
            __syncthreads();
            const CvtTile done = c0; c0 = c1; v0[0] = v1[0]; v0[1] = v1[1];
            { const int tn = t + 2 * gs; if (tn < NTILES) { c1 = cvt_tile_params(p, tn); cvt_tile_load(c1, v1); } }
            { const int n = tid >> 3, k8 = (tid & 7) * 8; float e[8];
#pragma unroll
                for (int q = 0; q < 8; ++q) e[q] = tl[(k8 + q) * 65 + n];
                u32x4 w; w.x = cvt_pk_bf16(e[0], e[1]); w.y = cvt_pk_bf16(e[2], e[3]); w.z = cvt_pk_bf16(e[4], e[5]); w.w = cvt_pk_bf16(e[6], e[7]);
                *(u32x4*)(done.dst + (size_t)n * done.dstld + k8) = w; }
            __syncthreads();
        }
    }
}

__device__ __forceinline__ void phase2(const Params& p, unsigned char* sm) {
    unsigned char* ws = p.ws;
    const int tid = threadIdx.x, lane = tid & 63, wid = tid >> 6;
    float* rowfac = (float*)sm; float* colfac = rowfac + 256; float* wsum = colfac + 256;
    const float* ig = (const float*)(ws + O_IG); const float* lf = (const float*)(ws + O_LF);
    const bf16_t* qkpre = (const bf16_t*)p.out;
    const float* cw = p.in[5]; const float* cb = p.in[6];
    for (int item = blockIdx.x; item < 256; item += gridDim.x) {
        const int b = item >> 5, h = (item >> 3) & 3, sc = item & 7; const int tokb = b * SEQ_ + sc * 256;
        float v = 0.f, igv = 0.f;
        if (tid < 256) { v = lf[(size_t)(tokb + tid) * 4 + h]; igv = ig[(size_t)(tokb + tid) * 4 + h]; }
#pragma unroll
        for (int o = 1; o < 64; o <<= 1) { const float n = __shfl_up(v, o); if (lane >= o) v += n; }
        if (tid < 256 && lane == 63) wsum[wid] = v;
        __syncthreads();
        if (tid < 256) { float add = 0.f; for (int j = 0; j < wid; ++j) add += wsum[j]; v += add; rowfac[tid] = __expf(v); colfac[tid] = __expf(igv - v);
            if (tid == 255) ((float*)(ws + O_EBL))[item] = __expf(v); }
        __syncthreads();
#pragma unroll 1
        for (int qt = 0; qt < 4; ++qt) {
        const int cp = tid & 127, tg = tid >> 7; const int ch = 2 * cp; const int tl0 = qt * 64 + tg * 16; const int s0 = sc * 256 + tl0;
        { const int col = h * 256 + ch; float x0[19], x1[19];
#pragma unroll
            for (int i = 0; i < 19; ++i) { const int s = s0 - 3 + i; unsigned w = 0u; if (s >= 0) w = *(const unsigned*)(qkpre + (size_t)(b * SEQ_ + s) * 2048 + col); x0[i] = bf_lo(w); x1[i] = bf_hi(w); }
            float w0[4], w1[4];
#pragma unroll
            for (int k = 0; k < 4; ++k) { const f32x2 wv = *(const f32x2*)(cw + (size_t)k * 2048 + col); w0[k] = wv[0]; w1[k] = wv[1]; }
            const f32x2 bv = *(const f32x2*)(cb + col);
            bf16_t* wq = (bf16_t*)(ws + O_WQ) + (size_t)item * 65536;
#pragma unroll
            for (int i = 0; i < 16; ++i) { float y0 = bv[0], y1 = bv[1];
#pragma unroll
                for (int k = 0; k < 4; ++k) { y0 += x0[i + k] * w0[k]; y1 += x1[i + k] * w1[k]; }
                const float f = rowfac[tl0 + i] * 0.0625f;
                *(unsigned*)(wq + (size_t)(tl0 + i) * 256 + ch) = cvt_pk_bf16(silu(y0) * f, silu(y1) * f); } }
        { const int col = 1024 + h * 256 + ch; float x0[19], x1[19];
#pragma unroll
            for (int i = 0; i < 19; ++i) { const int s = s0 - 3 + i; unsigned w = 0u; if (s >= 0) w = *(const unsigned*)(qkpre + (size_t)(b * SEQ_ + s) * 2048 + col); x0[i] = bf_lo(w); x1[i] = bf_hi(w); }
            float w0[4], w1[4];
#pragma unroll
            for (int k = 0; k < 4; ++k) { const f32x2 wv = *(const f32x2*)(cw + (size_t)k * 2048 + col); w0[k] = wv[0]; w1[k] = wv[1]; }
            const f32x2 bv = *(const f32x2*)(cb + col);
            bf16_t* kw = (bf16_t*)(ws + O_KW) + (size_t)item * 65536; bf16_t* kwt = (bf16_t*)(ws + O_KWT) + (size_t)item * 65536;
            float k0[16], k1[16]; float n0 = 0.f, n1 = 0.f;
#pragma unroll
            for (int i = 0; i < 16; ++i) { float y0 = bv[0], y1 = bv[1];
#pragma unroll
                for (int k = 0; k < 4; ++k) { y0 += x0[i + k] * w0[k]; y1 += x1[i + k] * w1[k]; }
                const float f = colfac[tl0 + i]; k0[i] = silu(y0) * f; k1[i] = silu(y1) * f; n0 += k0[i]; n1 += k1[i];
                *(unsigned*)(kw + (size_t)(tl0 + i) * 256 + ch) = cvt_pk_bf16(k0[i], k1[i]); }
            u32x4 a, c;
            a.x = cvt_pk_bf16(k0[0], k0[1]); a.y = cvt_pk_bf16(k0[2], k0[3]); a.z = cvt_pk_bf16(k0[4], k0[5]); a.w = cvt_pk_bf16(k0[6], k0[7]);
            c.x = cvt_pk_bf16(k0[8], k0[9]); c.y = cvt_pk_bf16(k0[10], k0[11]); c.z = cvt_pk_bf16(k0[12], k0[13]); c.w = cvt_pk_bf16(k0[14], k0[15]);
            *(u32x4*)(kwt + (size_t)ch * 256 + tl0) = a; *(u32x4*)(kwt + (size_t)ch * 256 + tl0 + 8) = c;
            a.x = cvt_pk_bf16(k1[0], k1[1]); a.y = cvt_pk_bf16(k1[2], k1[3]); a.z = cvt_pk_bf16(k1[4], k1[5]); a.w = cvt_pk_bf16(k1[6], k1[7]);
            c.x = cvt_pk_bf16(k1[8], k1[9]); c.y = cvt_pk_bf16(k1[10], k1[11]); c.z = cvt_pk_bf16(k1[12], k1[13]); c.w = cvt_pk_bf16(k1[14], k1[15]);
            *(u32x4*)(kwt + (size_t)(ch + 1) * 256 + tl0) = a; *(u32x4*)(kwt + (size_t)(ch + 1) * 256 + tl0 + 8) = c;
            float* nsum = (float*)(ws + O_NSUM) + (size_t)item * 256;
            unsafeAtomicAdd(nsum + ch, n0); unsafeAtomicAdd(nsum + ch + 1, n1); }
        }
        __syncthreads();
    }
}

__device__ __forceinline__ void phase4(const Params& p, unsigned char* sm) {
    unsigned char* ws = p.ws;
    const int tid = threadIdx.x;
    const float* ebl = (const float*)(ws + O_EBL);
    const bf16_t* lt = (const bf16_t*)(p.ws + O_KWT);
    bf16_t* cint = (bf16_t*)(ws + O_CINT);
    const size_t gtid = (size_t)blockIdx.x * 512 + tid, gthreads = (size_t)gridDim.x * 512;
#pragma unroll 2
    for (size_t g = gtid; g < (size_t)32 * 16384; g += gthreads) {
        const int bh = (int)(g >> 14), e4 = (int)(g & 16383);
        f32x4 c = {0.f, 0.f, 0.f, 0.f};
        u32x2 lw[7]; float eb[7];
#pragma unroll
        for (int sc = 0; sc < 7; ++sc) { lw[sc] = *(const u32x2*)(lt + (size_t)(bh * 8 + sc) * 65536 + e4 * 4); eb[sc] = ebl[bh * 8 + sc]; }
#pragma unroll
        for (int sc = 0; sc < 8; ++sc) { const int item = bh * 8 + sc;
            u32x2 w; w.x = cvt_pk_bf16(c[0], c[1]); w.y = cvt_pk_bf16(c[2], c[3]); *(u32x2*)(cint + (size_t)item * 65536 + e4 * 4) = w;
            if (sc < 7) { const f32x4 l = {bf_lo(lw[sc].x), bf_hi(lw[sc].x), bf_lo(lw[sc].y), bf_hi(lw[sc].y)}; c = (c + l) * eb[sc]; } }
    }
    float* nin = (float*)sm;
    const float* nsum = (const float*)(ws + O_NSUM);
    float* denx = (float*)(ws + O_DENX);
    for (int item = blockIdx.x; item < 256; item += gridDim.x) {
        const int b = item >> 5, h = (item >> 3) & 3, sc = item & 7; const int tokb = b * SEQ_ + sc * 256; const int bh = item >> 3;
        if (tid < 256) { float eb[7], ns[7];
#pragma unroll
            for (int j = 0; j < 7; ++j) { eb[j] = ebl[bh * 8 + j]; ns[j] = nsum[(size_t)(bh * 8 + j) * 256 + tid]; }
            float nv = 0.f;
#pragma unroll
            for (int j = 0; j < 7; ++j) if (j < sc) nv = eb[j] * (nv + ns[j]);
            nin[tid] = nv; }
        __syncthreads();
        const int tl = tid >> 1, half = tid & 1;
        const bf16_t* wq = (const bf16_t*)(ws + O_WQ) + (size_t)item * 65536 + (size_t)tl * 256 + half * 128;
        float d = 0.f;
#pragma unroll
        for (int i = 0; i < 16; ++i) { f32x4 a0, a1; unpack8(*(const u32x4*)(wq + i * 8), a0, a1); const float* nn = nin + half * 128 + i * 8;
            d += a0[0] * nn[0] + a0[1] * nn[1] + a0[2] * nn[2] + a0[3] * nn[3] + a1[0] * nn[4] + a1[1] * nn[5] + a1[2] * nn[6] + a1[3] * nn[7]; }
        d += __shfl_xor(d, 1);
        if (half == 0) denx[(size_t)(tokb + tl) * 4 + h] = d;
        __syncthreads();
    }
}

__device__ __forceinline__ void phase7(const Params& p, unsigned char* sm) {
    unsigned char* ws = p.ws;
    const int tid = threadIdx.x, lane = tid & 63, wid = tid >> 6;
    const bf16_t* uu = (const bf16_t*)p.out; bf16_t* uc = (bf16_t*)(ws + O_UC);
    const float* cw = p.in[8]; const float* cb = p.in[9]; const float* lg = p.in[10]; const float* lb = p.in[11];
    u32x4 pf[12];
#define P7_LOAD(tile_) do { const int t0_ = (tile_) * 16; const int b_ = t0_ / SEQ_, s0_ = t0_ % SEQ_; \
        _Pragma("unroll") for (int q = 0; q < 12; ++q) { const int idx = tid + q * 512; const int r = idx >> 7, c16 = idx & 127; const int s_ = s0_ - 30 + r; \
            pf[q] = (u32x4){0u, 0u, 0u, 0u}; if (idx < 46 * 128 && s_ >= 0) pf[q] = *(const u32x4*)(uu + (size_t)(b_ * SEQ_ + s_) * 1024 + c16 * 8); } } while (0)
    int tile = blockIdx.x;
    if (tile < 1024) P7_LOAD(tile);
    f32x2 wv[31];
#pragma unroll
    for (int k = 0; k < 31; ++k) wv[k] = *(const f32x2*)(cw + (size_t)k * 1024 + 2 * tid);
    const f32x2 bv = *(const f32x2*)(cb + 2 * tid);
    f32x4 lgv[4], lbv[4];
#pragma unroll
    for (int i = 0; i < 4; ++i) { lgv[i] = *(const f32x4*)(lg + i * 256 + lane * 4); lbv[i] = *(const f32x4*)(lb + i * 256 + lane * 4); }
    for (; tile < 1024; tile += gridDim.x) {
        const int t0 = tile * 16;
#pragma unroll
        for (int q = 0; q < 12; ++q) { const int idx = tid + q * 512; const int r = idx >> 7, c16 = idx & 127; if (idx < 46 * 128) *(u32x4*)(sm + r * 2048 + c16 * 16) = pf[q]; }
        __syncthreads();
        f32x2 yy[16];
        {
#pragma unroll
            for (int t = 0; t < 16; ++t) yy[t] = bv;
#pragma unroll
            for (int r = 0; r < 46; ++r) { const unsigned w = *(const unsigned*)(sm + r * 2048 + tid * 4); const f32x2 xx = {bf_lo(w), bf_hi(w)};
#pragma unroll
                for (int t = 0; t < 16; ++t) { const int k = r - t; if (k >= 0 && k <= 30) yy[t] = __builtin_elementwise_fma(wv[k], xx, yy[t]); }
                if ((r & 3) == 3) asm volatile("" ::: "memory"); }
        }
        __syncthreads();
#pragma unroll
        for (int t = 0; t < 16; ++t) *(f32x2*)(sm + t * 4096 + tid * 8) = yy[t];
        { const int tn = tile + gridDim.x; if (tn < 1024) P7_LOAD(tn); }
        __syncthreads();
#pragma unroll
        for (int tt = 0; tt < 2; ++tt) { const int t = wid * 2 + tt; f32x4 v[4]; float s1 = 0.f;
#pragma unroll
            for (int i = 0; i < 4; ++i) { v[i] = *(const f32x4*)(sm + t * 4096 + (i * 256 + lane * 4) * 4); s1 += v[i][0] + v[i][1] + v[i][2] + v[i][3]; }
            s1 = wave_sum(s1); const float mu = s1 * (1.0f / 1024.0f); float s2 = 0.f;
#pragma unroll
            for (int i = 0; i < 4; ++i) { v[i] = v[i] - mu; s2 += v[i][0] * v[i][0] + v[i][1] * v[i][1] + v[i][2] * v[i][2] + v[i][3] * v[i][3]; }
            s2 = wave_sum(s2); const float rstd = rsqrtf(s2 * (1.0f / 1024.0f) + EPS_);
#pragma unroll
            for (int i = 0; i < 4; ++i) { const int c = i * 256 + lane * 4; f32x4 z = v[i] * rstd * lgv[i] + lbv[i];
                z = silu4(z); u32x2 w; w.x = cvt_pk_bf16(z[0], z[1]); w.y = cvt_pk_bf16(z[2], z[3]); *(u32x2*)(uc + (size_t)(t0 + t) * 1024 + c) = w; } }
        __syncthreads();
    }
#undef P7_LOAD
}

__device__ __forceinline__ void phase13(const Params& p) {
    const float* ssq3 = (const float*)(p.ws + O_SSQ3); const float* fg = p.in[22];
    const size_t gtid = (size_t)blockIdx.x * 512 + threadIdx.x, gthreads = (size_t)gridDim.x * 512;
    for (size_t i = gtid; i < (size_t)T_ * 256; i += gthreads) { const int row = (int)(i >> 8), c = (int)(i & 255) * 4;
        const float rs = rsqrtf(ssq3[row] * (1.0f / 1024.0f) + EPS_); const f32x4 g = *(const f32x4*)(fg + c);
        f32x4 v = *(const f32x4*)(p.out + i * 4); v = v * rs * g; *(f32x4*)(p.out + i * 4) = v; }
}

#define XB_TMO      128
#define XB_XCNT(j)  (256  + 64 * (j))
#define XB_XSUB(j)  (1280 + 64 * (j))
#define XB_XGEN(j)  (2304 + 64 * (j))
#define XB_TOP      3328
#define XB_TOPGEN   3392
#define XCD_BAR_WORDS 3456
#define XB_SPIN_CAP (1u << 18)
__device__ __forceinline__ unsigned xb_ld(unsigned* p)              { return __hip_atomic_load(p, __ATOMIC_RELAXED, __HIP_MEMORY_SCOPE_AGENT); }
__device__ __forceinline__ unsigned xb_add(unsigned* p, unsigned v) { return __hip_atomic_fetch_add(p, v, __ATOMIC_RELAXED, __HIP_MEMORY_SCOPE_AGENT); }
__device__ __forceinline__ unsigned xb_xcc_id() { return (unsigned)__builtin_amdgcn_s_getreg((3 << 11) | 20) & 0xFu; }
#define XB_SPIN(cond, bar) do { unsigned _sp = 0; while (cond) { __builtin_amdgcn_s_sleep(1); \
    if ((++_sp & 255u) == 0u) { if (xb_ld(&(bar)[XB_TMO])) break; if (_sp > XB_SPIN_CAP) { atomicAdd(&(bar)[XB_TMO], 1u); break; } } } } while (0)
struct XcdBarrier { unsigned* bar; unsigned x; volatile LAS unsigned* st; };
__device__ __forceinline__ XcdBarrier xcd_barrier_post(unsigned* bar, volatile LAS unsigned* st) {
    XcdBarrier b; b.bar = bar; b.x = xb_xcc_id(); b.st = st;
    if (threadIdx.x == 0) (void)xb_add(&bar[XB_XCNT(b.x)], 1u);
    return b;
}
__device__ __forceinline__ void xcd_barrier_complete(unsigned* bar, unsigned x, unsigned& nloc, unsigned& nx) {
    const unsigned G = gridDim.x * gridDim.y * gridDim.z;
    unsigned sum, cnt, mine, sp = 0u;
    for (;;) {
        sum = 0u; cnt = 0u; mine = 0u;
#pragma unroll
        for (unsigned j = 0; j < 16; ++j) { const unsigned c = xb_ld(&bar[XB_XCNT(j)]); sum += c; cnt += (c > 0u) ? 1u : 0u; mine = (j == x) ? c : mine; }
        if (sum == G) break;
        __builtin_amdgcn_s_sleep(1);
        if ((++sp & 255u) == 0u) { if (xb_ld(&bar[XB_TMO])) break; if (sp > XB_SPIN_CAP) { atomicAdd(&bar[XB_TMO], 1u); break; } }
    }
    nloc = mine > 0u ? mine : 1u; nx = cnt > 0u ? cnt : 1u;
}
__device__ __forceinline__ void xcd_barrier(const XcdBarrier& b) {
    asm volatile("s_waitcnt vmcnt(0)" ::: "memory");
    __syncthreads();
    if (threadIdx.x == 0) {
        unsigned* bar = b.bar;
        __builtin_amdgcn_s_waitcnt(0);
        unsigned nloc = b.st[0], nx = b.st[1];
        if (nloc == 0u) { xcd_barrier_complete(bar, b.x, nloc, nx); b.st[0] = nloc; b.st[1] = nx; }
        const unsigned old = xb_add(&bar[XB_XSUB(b.x)], 1u);
        const unsigned gen = old / nloc;
        if (old + 1u == (gen + 1u) * nloc) {
            __builtin_amdgcn_fence(__ATOMIC_RELEASE, "agent");
            asm volatile("s_waitcnt vmcnt(0)" ::: "memory");
            const unsigned og = xb_add(&bar[XB_TOP], 1u);
            const unsigned tg = og / nx;
            if (og + 1u == (tg + 1u) * nx) xb_add(&bar[XB_TOPGEN], 1u);
            else XB_SPIN(xb_ld(&bar[XB_TOPGEN]) == tg, bar);
            __builtin_amdgcn_fence(__ATOMIC_ACQUIRE, "agent");
            xb_add(&bar[XB_XGEN(b.x)], 1u);
            asm volatile("s_waitcnt vmcnt(0)" ::: "memory");
        } else {
            XB_SPIN(xb_ld(&bar[XB_XGEN(b.x)]) == gen, bar);
            __builtin_amdgcn_fence(__ATOMIC_ACQUIRE, "agent");
            asm volatile("s_waitcnt vmcnt(0)" ::: "memory");
        }
    }
    __syncthreads();
}

template <bool COOP>
__global__ void __launch_bounds__(512, 2) mk_fwd(Params p) {
    extern __shared__ __attribute__((aligned(16))) unsigned char shm[];
    LAS unsigned char* lds = (LAS unsigned char*)shm;
    unsigned char* ws = p.ws;
    const int G = gridDim.x, c = blockIdx.x;
#ifndef PHMASK
#define PHMASK 0x3fff
#endif
#define PH(k) if (((PHMASK >> (k)) & 1) && p.ph_lo <= (k) && (k) < p.ph_hi)
    XcdBarrier xb{};
    if (COOP) { volatile LAS unsigned* st = (volatile LAS unsigned*)(lds + 131072);
        if (threadIdx.x == 0) { st[0] = 0u; st[1] = 0u; }
        __syncthreads();
        xb = xcd_barrier_post((unsigned*)(ws + O_BAR), st); }
#define SYNC(k) if (COOP) { if (p.ph_lo <= (k) && (k) + 1 < p.ph_hi) { xcd_barrier(xb); } }
    PH(0) phase0(p, shm);
    SYNC(0)
    PH(1) { SchedP1 S{(const char*)(ws + O_HB), (const char*)(ws + O_WINT), G, c}; EpiP1 E{(bf16_t*)p.out, (bf16_t*)(ws + O_VT), (const float*)(ws + O_RS)}; gemm_phase(lds, 1024, 1024, 1024, S, E); }
    SYNC(1)
    PH(3) { phase2(p, shm);
        asm volatile("s_waitcnt vmcnt(0)" ::: "memory"); __syncthreads();
        SchedP3 S{(const char*)(ws + O_WQ), (const char*)(ws + O_KW), (const char*)(ws + O_VT), (const char*)(ws + O_KWT), G, c};
        EpiP3 E{(bf16_t*)(ws + O_SS), (bf16_t*)(ws + O_KWT), (float*)(ws + O_DENI)}; gemm_phase(lds, 256, 256, 256, S, E); }
    SYNC(3)
    PH(4) phase4(p, shm);
    SYNC(4)
    PH(6) { { SchedP5 S{(const char*)(ws + O_SS), (const char*)(ws + O_VT), (const char*)(ws + O_WQ), (const char*)(ws + O_CINT), G, c};
            EpiP5 E{(bf16_t*)(ws + O_HM), (const float*)(ws + O_DENI), (const float*)(ws + O_DENX), (float*)(ws + O_HSS)}; gemm_phase(lds, 256, 256, 256, S, E); }
        { SchedP6 S{(const char*)(ws + O_HB), (const char*)(ws + O_WINT), G, c};
            EpiP6 E{(bf16_t*)(ws + O_HM), (float*)(ws + O_HSS), (const float*)(ws + O_RS), (bf16_t*)p.out}; gemm_phase(lds, 1024, 1024, 1024, S, E); } }
    SYNC(6)
    PH(7) phase7(p, shm);
    SYNC(7)
    PH(8) { SchedP8 S{(const char*)(ws + O_HB), (const char*)(ws + O_WINT), (const char*)(ws + O_HM), (const char*)(ws + O_UC), (const char*)(ws + O_WMT), (const char*)(ws + O_WCT), G, c};
        EpiP8 E{(bf16_t*)(ws + O_GMC), (bf16_t*)p.out + (size_t)T_ * 1024, (bf16_t*)(ws + O_MERGED), (const float*)(ws + O_RS)}; gemm_phase(lds, 1024, 1024, 1024, S, E); }
    SYNC(8)
    PH(9) { SchedN4 S{(const char*)(ws + O_MERGED), (const char*)(ws + O_WOT), (size_t)256 * 1024 * 2, (size_t)256 * 1024 * 2, G, c};
        EpiRes<true> E{(const void*)(ws + O_HB), (bf16_t*)(ws + O_X1B), (float*)(ws + O_SSQ1)}; gemm_phase(lds, 1024, 1024, 1024, S, E); }
    SYNC(9)
    PH(10) { { SchedP10 S{(const char*)(ws + O_X1B), (const char*)(ws + O_WGUT), G, c}; EpiP10 E{(const float*)(ws + O_SSQ1), (bf16_t*)(ws + O_HID)}; gemm_phase(lds, 1024, 1024, 1024, S, E); }
        { const int h = G >> 1; SchedPE S{(const char*)(ws + O_PB), (const char*)(ws + O_WPPT), h, c - h};
            EpiBf E{(bf16_t*)(ws + O_PE)}; if (c >= h) gemm_phase(lds, 256, 256, 256, S, E); } }
    SYNC(10)
    PH(11) { SchedN4 S{(const char*)(ws + O_HID), (const char*)(ws + O_WDT), (size_t)256 * DFF_ * 2, (size_t)256 * DFF_ * 2, G, c};
            EpiRes<true> E{(const void*)(ws + O_X1B), (bf16_t*)(ws + O_X2B), (float*)(ws + O_SSQ2)}; gemm_phase(lds, DFF_, DFF_, DFF_, S, E); }
    SYNC(11)
    PH(12) { SchedN4 S{(const char*)(ws + O_X2B), (const char*)(ws + O_WPGT), (size_t)256 * 1024 * 2, (size_t)256 * 1024 * 2, G, c};
        EpiP12 E{(const float*)(ws + O_SSQ2), (const bf16_t*)(ws + O_PE), (const bf16_t*)(ws + O_X2B), p.out, (float*)(ws + O_SSQ3), (unsigned*)(ws + O_BAR) + XCD_BAR_WORDS, p.in[22]}; gemm_phase(lds, 1024, 1024, 1024, S, E); }
#undef PH
#undef SYNC
}

extern "C" void kernel_launch(void* const* d_in, const int* in_sizes, int n_in, void* d_out, int out_size, void* d_ws, size_t ws_size, hipStream_t stream) {
    static int grid = 0;
    if (grid == 0) {
        if (n_in != 23 || out_size != T_ * D_ || ws_size < WS_NEED) { fprintf(stderr, "kernel_launch: unexpected shapes (n_in %d, out %d, ws %zu)\n", n_in, out_size, ws_size); grid = -1; return; }
        int dev = 0, cus = 0, per_cu = 0;
        hipGetDevice(&dev); hipDeviceGetAttribute(&cus, hipDeviceAttributeMultiprocessorCount, dev);
        hipFuncSetAttribute((const void*)mk_fwd<true>, hipFuncAttributeMaxDynamicSharedMemorySize, LDS_BYTES);
        hipFuncSetAttribute((const void*)mk_fwd<false>, hipFuncAttributeMaxDynamicSharedMemorySize, LDS_BYTES);
        hipOccupancyMaxActiveBlocksPerMultiprocessor(&per_cu, (const void*)mk_fwd<true>, 512, LDS_BYTES);
        if (per_cu < 1) { fprintf(stderr, "kernel_launch: occupancy query reports %d blocks per CU\n", per_cu); per_cu = 1; }
        (void)hipGetLastError();
        grid = cus;
        if (grid != 256) { fprintf(stderr, "kernel_launch: built for a 256-CU device (got %d CUs)\n", cus); grid = -1; return; }
    }
    if (grid < 0) return;
    Params p{};
    for (int i = 0; i < 23; ++i) p.in[i] = (const float*)d_in[i];
    p.out = (float*)d_out; p.ws = (unsigned char*)d_ws;
#if MK_MULTI
#ifndef PROBE_DUP
#define PROBE_DUP -1
#endif
    for (int k = 0; k < NPHASE; ++k) { p.ph_lo = k; p.ph_hi = k + 1; hipLaunchKernelGGL(mk_fwd<false>, dim3(grid), dim3(512), LDS_BYTES, stream, p);
        if (k == PROBE_DUP) hipLaunchKernelGGL(mk_fwd<false>, dim3(grid), dim3(512), LDS_BYTES, stream, p); }
#else
    p.ph_lo = 0; p.ph_hi = NPHASE;
    if (hipMemsetAsync((unsigned char*)d_ws + O_BAR, 0, (XCD_BAR_WORDS + 64 * 64) * 4, stream) != hipSuccess) { fprintf(stderr, "kernel_launch: memset of barrier words failed\n"); return; }
    void* args[] = {&p};
    hipError_t e = hipLaunchCooperativeKernel((const void*)mk_fwd<true>, dim3(grid), dim3(512), args, LDS_BYTES, stream);
    if (e != hipSuccess) fprintf(stderr, "cooperative launch failed: %s (grid %d)\n", hipGetErrorString(e), grid);
#endif
}
```

```cpp
#include <hip/hip_runtime.h>
#include <hip/hip_cooperative_groups.h>
#include <cstdio>
namespace cg = cooperative_groups;

#ifndef MK_MULTI
#define MK_MULTI 0
#endif

#define LAS __attribute__((address_space(3)))
typedef unsigned short bf16_t;
typedef short bf16x8 __attribute__((ext_vector_type(8)));
typedef float f32x4 __attribute__((ext_vector_type(4)));
typedef float f32x2 __attribute__((ext_vector_type(2)));
typedef unsigned u32x4 __attribute__((ext_vector_type(4)));
typedef unsigned u32x2 __attribute__((ext_vector_type(2)));

constexpr int T_ = 16384, D_ = 1024, NIN_ = 8200, DFF_ = 2816, SEQ_ = 2048;
constexpr float EPS_ = 1e-6f;
constexpr int BM = 256, BK = 64, HALF = 128, HTB = HALF * BK * 2, STAGE_BYTES = 8 * HTB;
constexpr int LDS_BYTES = 136 * 1024;
constexpr int NPHASE = 13;

constexpr size_t KiB = 1024, MiB = 1024 * 1024;
constexpr size_t O_WINT = 0, O_WMT = 16 * MiB, O_WCT = 18 * MiB, O_WOT = 20 * MiB, O_WPGT = 22 * MiB, O_WGUT = 24 * MiB, O_WDT = 35 * MiB, O_WPPT = 40 * MiB + 512 * KiB;
constexpr size_t O_IG = 41 * MiB, O_LF = O_IG + 256 * KiB, O_ZERO = O_LF + 256 * KiB;
constexpr size_t O_DENI = O_ZERO, O_HSS = O_DENI + 256 * KiB, O_SSQ1 = O_HSS + 256 * KiB, O_SSQ2 = O_SSQ1 + 64 * KiB, O_SSQ3 = O_SSQ2 + 64 * KiB, O_NSUM = O_SSQ3 + 64 * KiB;
constexpr size_t ZERO_BYTES = 960 * KiB;
constexpr size_t O_DENX = O_ZERO + ZERO_BYTES, O_EBL = O_DENX + 256 * KiB;
constexpr size_t O_RS = O_EBL + 4 * KiB;
constexpr size_t O_BAR = 43 * MiB;
constexpr size_t O_PB = 44 * MiB, O_HB = 52 * MiB, O_S1 = 84 * MiB, O_S2 = 116 * MiB, O_S3 = 148 * MiB, O_S4 = 180 * MiB, O_S5 = 212 * MiB, WS_NEED = 244 * MiB;
constexpr size_t O_PE = O_HB, O_VT = O_S1, O_U = O_S1, O_MERGED = O_S1, O_HID = O_S1, O_WQ = O_S2, O_GMC = O_S2, O_KW = O_S3, O_CINT = O_S3,
                 O_KWT = O_S4, O_HM = O_S4, O_X1B = O_S4, O_SS = O_S5, O_UC = O_S5, O_X2B = O_S5;

struct Params {
    const float* in[23];
    float* out;
    unsigned char* ws;
    int ph_lo, ph_hi;
};

__device__ __forceinline__ unsigned cvt_pk_bf16(float lo, float hi) { unsigned r; asm volatile("v_cvt_pk_bf16_f32 %0, %1, %2" : "=v"(r) : "v"(lo), "v"(hi)); return r; }
__device__ __forceinline__ float bf_lo(unsigned w) { return __uint_as_float(w << 16); }
__device__ __forceinline__ float bf_hi(unsigned w) { return __uint_as_float(w & 0xffff0000u); }
__device__ __forceinline__ float sigm(float x) { return __builtin_amdgcn_rcpf(1.0f + __builtin_amdgcn_exp2f(x * -1.4426950408889634f)); }
__device__ __forceinline__ float silu(float x) { return x * __builtin_amdgcn_rcpf(1.0f + __builtin_amdgcn_exp2f(x * -1.4426950408889634f)); }
__device__ __forceinline__ f32x4 exp2v(f32x4 t) { f32x4 e; e[0] = __builtin_amdgcn_exp2f(t[0]); e[1] = __builtin_amdgcn_exp2f(t[1]); e[2] = __builtin_amdgcn_exp2f(t[2]); e[3] = __builtin_amdgcn_exp2f(t[3]); return e; }
__device__ __forceinline__ f32x4 rcpv(f32x4 d) { f32x4 r; r[0] = __builtin_amdgcn_rcpf(d[0]); r[1] = __builtin_amdgcn_rcpf(d[1]); r[2] = __builtin_amdgcn_rcpf(d[2]); r[3] = __builtin_amdgcn_rcpf(d[3]); return r; }
__device__ __forceinline__ f32x4 sigm4(f32x4 x) { return rcpv(exp2v(x * -1.4426950408889634f) + 1.0f); }
__device__ __forceinline__ f32x4 silu4(f32x4 x) { return x * sigm4(x); }
__device__ __forceinline__ f32x2 silu2(f32x2 x) { const f32x2 t = x * -1.4426950408889634f; f32x2 d; d[0] = __builtin_amdgcn_exp2f(t[0]); d[1] = __builtin_amdgcn_exp2f(t[1]); d = d + 1.0f;
    f32x2 r; r[0] = __builtin_amdgcn_rcpf(d[0]); r[1] = __builtin_amdgcn_rcpf(d[1]); return x * r; }
__device__ __forceinline__ float wave_sum(float v) {
#pragma unroll
    for (int o = 32; o > 0; o >>= 1) v += __shfl_xor(v, o);
    return v;
}
__device__ __forceinline__ u32x4 pack8(const f32x4 a, const f32x4 b) { u32x4 w; w.x = cvt_pk_bf16(a[0], a[1]); w.y = cvt_pk_bf16(a[2], a[3]); w.z = cvt_pk_bf16(b[0], b[1]); w.w = cvt_pk_bf16(b[2], b[3]); return w; }
__device__ __forceinline__ void unpack8(const u32x4 w, f32x4& a, f32x4& b) { a[0] = bf_lo(w.x); a[1] = bf_hi(w.x); a[2] = bf_lo(w.y); a[3] = bf_hi(w.y); b[0] = bf_lo(w.z); b[1] = bf_hi(w.z); b[2] = bf_lo(w.w); b[3] = bf_hi(w.w); }

__host__ __device__ __forceinline__ int lds_byte(int r, int c) { const int st = (r >> 4) * 2 + (c >> 5), rr = r & 15, cc = c & 31, ob = rr * 64 + cc * 2; return st * 1024 + (ob ^ (((ob >> 9) & 1) << 5)); }
__host__ __device__ __forceinline__ void stage_rc(int b, int& R, int& C) { const int st = b / 1024, sb = b % 1024, swz = sb ^ (((sb >> 9) & 1) << 5); R = (st >> 1) * 16 + swz / 64; C = (st & 1) * 32 + (swz % 64) / 2; }
__host__ __device__ __forceinline__ int perm32(int rho) { const int n = rho >> 4, i = rho & 15; return 8 * (i >> 2) + 4 * n + (i & 3); }

struct Unit { const char* a; const char* b; int pm, pn, kind, cont; };
__device__ __forceinline__ void map_n4(int L, int& pm, int& pn) { const int x = L & 7, k = L >> 3; pm = x * 8 + (k & 7); pn = k >> 3; }

__device__ __forceinline__ void tile_order(int L, int nM, int nN, int& pm, int& pn) {
    const int nwg = nM * nN; int wgid = L;
    { const int q = nwg / 8, r = nwg % 8, xcd = wgid % 8, off = wgid / 8; wgid = (xcd < r ? xcd * (q + 1) : r * (q + 1) + (xcd - r) * q) + off; }
    const int nig = 8 * nN, gid = wgid / nig, fm = gid * 8, gsz = (nM - fm) < 8 ? (nM - fm) : 8;
    pm = fm + ((wgid % nig) % gsz); pn = (wgid % nig) / gsz;
}

template <class Epi, class Sched>
__device__ __forceinline__ void gemm_phase(LAS unsigned char* lds, const int K, const int lda, const int ldb, const Sched& S, const Epi& E) {
    const int tid = threadIdx.x, wid = __builtin_amdgcn_readfirstlane(tid >> 6), lane = tid & 63, wr = wid >> 2, wc = wid & 3, fr = lane & 15, fq = lane >> 4;
    const int nt = K / BK;
    unsigned voffA[2], voffB[2];
#pragma unroll
    for (int i = 0; i < 2; ++i) { int R, C; stage_rc(tid * 16 + i * 8192, R, C); const int Rb = (R & ~31) + perm32(R & 31);
        voffA[i] = (unsigned)(R * lda + C) * 2u; voffB[i] = (unsigned)(Rb * ldb + C) * 2u; }
    const size_t kstep = (size_t)(BK * 2);
    const size_t hstepA = (size_t)HALF * lda * 2, hstepB = (size_t)HALF * ldb * 2;
    const unsigned ldsw = (unsigned)wid * 1024u;
    const int aoff = lds_byte(wr * 64 + fr, fq * 8), boff = lds_byte(wc * 32 + fr, fq * 8);
#define PG8_SA(b, h) (((b) * 2 + (h)) * HTB)
#define PG8_SB(b, h) ((4 + (b) * 2 + (h)) * HTB)
#define PG8_STAGE(bufoff, gbase, voff) do { _Pragma("unroll") for (int _i = 0; _i < 2; ++_i) \
        __builtin_amdgcn_global_load_lds((const unsigned*)((const char*)(gbase) + (voff)[_i]), (LAS unsigned*)(lds + (bufoff) + ldsw + _i * 8192), 16, 0, 0); } while (0)
#define PG8_LDA(dst, b, h) do { _Pragma("unroll") for (int m = 0; m < 4; ++m) _Pragma("unroll") for (int k = 0; k < 2; ++k) dst[m][k] = *(const LAS bf16x8*)(lds + PG8_SA(b, h) + aoff + m * 2048 + k * 1024); } while (0)
#define PG8_LDB(dst, b, h) do { _Pragma("unroll") for (int n = 0; n < 2; ++n) _Pragma("unroll") for (int k = 0; k < 2; ++k) dst[n][k] = *(const LAS bf16x8*)(lds + PG8_SB(b, h) + boff + n * 2048 + k * 1024); } while (0)
#define PG8_MMA(ai, bj, At, Bt) do { __builtin_amdgcn_s_setprio(1); _Pragma("unroll") for (int m = 0; m < 4; ++m) _Pragma("unroll") for (int n = 0; n < 2; ++n) _Pragma("unroll") for (int k = 0; k < 2; ++k) \
        acc[ai][bj][m][n] = __builtin_amdgcn_mfma_f32_16x16x32_bf16(Bt[n][k], At[m][k], acc[ai][bj][m][n], 0, 0, 0); __builtin_amdgcn_s_setprio(0); } while (0)
#define PG8_WAIT_V(n) asm volatile("s_waitcnt vmcnt(" #n ")" ::: "memory")
#define PG8_WAIT_L(n) asm volatile("s_waitcnt lgkmcnt(" #n ")" ::: "memory")
#define PG8_BAR __builtin_amdgcn_s_barrier()
#define PG8_SCHED __builtin_amdgcn_sched_barrier(0)
#define PG8_ZERO() do { _Pragma("unroll") for (int a = 0; a < 2; ++a) _Pragma("unroll") for (int b = 0; b < 2; ++b) _Pragma("unroll") for (int m = 0; m < 4; ++m) _Pragma("unroll") for (int n = 0; n < 2; ++n) acc[a][b][m][n] = (f32x4){0.f, 0.f, 0.f, 0.f}; } while (0)
    Unit cur, nxt; int ui = 0;
    if (!S.next(0, cur)) return;
    E.pre(cur, wr, wc, fr, fq);
    f32x4 acc[2][2][4][2];
    PG8_ZERO();
    bf16x8 At[4][2], B0[2][2], B1[2][2];
    const char* cA = cur.a; const char* cB = cur.b;
    PG8_STAGE(PG8_SB(0, 0), cB, voffB); PG8_STAGE(PG8_SA(0, 0), cA, voffA); PG8_STAGE(PG8_SB(0, 1), cB + hstepB, voffB); PG8_STAGE(PG8_SA(0, 1), cA + hstepA, voffA);
    if (wr == 1) PG8_BAR;
    PG8_WAIT_V(4); PG8_BAR;
    PG8_STAGE(PG8_SB(1, 0), cB + kstep, voffB); PG8_STAGE(PG8_SA(1, 0), cA + kstep, voffA); PG8_STAGE(PG8_SB(1, 1), cB + hstepB + kstep, voffB);
    PG8_WAIT_V(6); PG8_BAR;
    for (;;) {
        const bool has_next = S.next(ui + 1, nxt);
        const char* nA = has_next ? nxt.a : cA; const char* nB = has_next ? nxt.b : cB;
#pragma unroll 1
        for (int t = 0; t < nt; t += 2) {
            const bool last = (t == nt - 2);
            const char* a1 = cA + (size_t)(t + 1) * kstep;
            const char* a2 = last ? nA : cA + (size_t)(t + 2) * kstep; const char* b2 = last ? nB : cB + (size_t)(t + 2) * kstep;
            const char* a3 = a2 + kstep; const char* b3 = b2 + kstep;
            PG8_LDB(B0, 0, 0); PG8_SCHED; PG8_LDA(At, 0, 0); PG8_STAGE(PG8_SA(1, 1), a1 + hstepA, voffA);
            PG8_WAIT_L(8); PG8_BAR; PG8_WAIT_L(0); PG8_MMA(0, 0, At, B0); PG8_BAR; PG8_SCHED;
            PG8_LDB(B1, 0, 1); PG8_STAGE(PG8_SB(0, 0), b2, voffB);
            PG8_BAR; PG8_WAIT_L(0); PG8_MMA(0, 1, At, B1); PG8_BAR;
            PG8_LDA(At, 0, 1); PG8_STAGE(PG8_SA(0, 0), a2, voffA);
            PG8_BAR; PG8_WAIT_L(0); PG8_MMA(1, 0, At, B0); PG8_BAR; PG8_SCHED;
            PG8_STAGE(PG8_SB(0, 1), b2 + hstepB, voffB);
            PG8_WAIT_V(6); PG8_BAR; PG8_MMA(1, 1, At, B1); PG8_BAR;
            PG8_LDB(B0, 1, 0); PG8_SCHED; PG8_LDA(At, 1, 0); PG8_STAGE(PG8_SA(0, 1), a2 + hstepA, voffA);
            PG8_WAIT_L(8); PG8_BAR; PG8_WAIT_L(0); PG8_MMA(0, 0, At, B0); PG8_BAR; PG8_SCHED;
            PG8_LDB(B1, 1, 1); PG8_STAGE(PG8_SB(1, 0), b3, voffB);
            PG8_BAR; PG8_WAIT_L(0); PG8_MMA(0, 1, At, B1); PG8_BAR;
            PG8_LDA(At, 1, 1); PG8_STAGE(PG8_SA(1, 0), a3, voffA);
            PG8_BAR; PG8_WAIT_L(0); PG8_MMA(1, 0, At, B0); PG8_BAR; PG8_SCHED;
            PG8_STAGE(PG8_SB(1, 1), b3 + hstepB, voffB);
            PG8_WAIT_V(6); PG8_BAR; PG8_MMA(1, 1, At, B1); PG8_BAR;
        }
        if (cur.cont) { E.mid(acc, cur, wr, wc, fr, fq); }
        else { if constexpr (!Epi::AFTER_DRAIN) E(acc, cur, wr, wc, fr, fq); if (!has_next) break; PG8_ZERO(); }
        cur = nxt; cA = nA; cB = nB; ++ui;
    }
    PG8_WAIT_V(0);
    if (wr == 0) PG8_BAR;
    PG8_BAR;
    if constexpr (Epi::AFTER_DRAIN) E(acc, cur, wr, wc, fr, fq);
#undef PG8_SA
#undef PG8_SB
#undef PG8_STAGE
#undef PG8_LDA
#undef PG8_LDB
#undef PG8_MMA
#undef PG8_WAIT_V
#undef PG8_WAIT_L
#undef PG8_BAR
#undef PG8_SCHED
#undef PG8_ZERO
}

typedef f32x4 Acc[2][2][4][2];
#define EPI_ROWS(ai, m) _Pragma("unroll") for (int ai = 0; ai < 2; ++ai) _Pragma("unroll") for (int m = 0; m < 4; ++m) if (epi_fence())
__device__ __forceinline__ bool epi_fence() { asm volatile("" ::: "memory"); return true; }
#define EPI_R8 _Pragma("unroll") for (int r8 = 0; r8 < 8; ++r8)
#define EPI_RL(ai, m) ((ai) * 128 + wr * 64 + (m) * 16 + fr)
#define EPI_CL(bj) ((bj) * 128 + wc * 32 + 8 * fq)

struct SchedP1 { const char* hb; const char* wint; int G, c;
    __device__ __forceinline__ bool next(int i, Unit& u) const {
        const int item = (i / 3) * G + c, r = i % 3; if (item >= 256) return false;
        const int b = item >> 5, h = (item >> 3) & 3, sc = item & 7; const int pt = b * 8 + sc;
        u.cont = 0;
        if (r < 2) { u.pm = pt; u.pn = r * 4 + h; u.kind = 0; u.a = hb + (size_t)pt * 256 * 1024 * 2; u.b = wint + (size_t)u.pn * 256 * 1024 * 2; }
        else { u.pm = h; u.pn = pt; u.kind = 1; u.a = wint + (size_t)(2048 + h * 256) * 1024 * 2; u.b = hb + (size_t)pt * 256 * 1024 * 2; }
        return true; } };
struct EpiP1 { static constexpr bool AFTER_DRAIN = false; bf16_t* qkpre; bf16_t* vt; const float* rsb;
    __device__ __forceinline__ void mid(Acc&, const Unit&, int, int, int, int) const {}
    __device__ __forceinline__ void pre(const Unit&, int, int, int, int) const {}
    __device__ __forceinline__ void operator()(Acc& acc, const Unit& u, int wr, int wc, int fr, int fq) const {
        if (u.kind == 0) {
            bf16_t* base = qkpre + (size_t)u.pm * 256 * 2048 + u.pn * 256; float rv[2][4];
#pragma unroll
            for (int ai = 0; ai < 2; ++ai)
#pragma unroll
                for (int m = 0; m < 4; ++m) rv[ai][m] = rsb[u.pm * 256 + EPI_RL(ai, m)];
            EPI_ROWS(ai, m) { bf16_t* rowp = base + (size_t)EPI_RL(ai, m) * 2048 + EPI_CL(0);
#pragma unroll
                for (int bj = 0; bj < 2; ++bj) *(u32x4*)(rowp + bj * 128) = pack8(acc[ai][bj][m][0] * rv[ai][m], acc[ai][bj][m][1] * rv[ai][m]); }
        } else {
            const int item = ((u.pn >> 3) * 4 + u.pm) * 8 + (u.pn & 7); bf16_t* base = vt + (size_t)item * 65536; f32x4 cv[2][2];
#pragma unroll
            for (int bj = 0; bj < 2; ++bj) { cv[bj][0] = *(const f32x4*)(rsb + u.pn * 256 + EPI_CL(bj)); cv[bj][1] = *(const f32x4*)(rsb + u.pn * 256 + EPI_CL(bj) + 4); }
            EPI_ROWS(ai, m) { bf16_t* rowp = base + (size_t)EPI_RL(ai, m) * 256 + EPI_CL(0);
#pragma unroll
                for (int bj = 0; bj < 2; ++bj) *(u32x4*)(rowp + bj * 128) = pack8(acc[ai][bj][m][0] * cv[bj][0], acc[ai][bj][m][1] * cv[bj][1]); }
        }
    } };

struct SchedP3 { const char* wq; const char* kw; const char* vt; const char* kwt; int G, c;
    __device__ __forceinline__ bool next(int i, Unit& u) const {
        const int L = i * G + c; if (L >= 512) return false;
        u.cont = 0; u.pn = 0;
        if (L < 256) { u.pm = L; u.kind = 0; u.a = wq + (size_t)L * 131072; u.b = kw + (size_t)L * 131072; }
        else { const int it = L - 256; u.pm = it; u.kind = 1; u.a = vt + (size_t)it * 131072; u.b = kwt + (size_t)it * 131072; }
        return true; } };
struct EpiP3 { static constexpr bool AFTER_DRAIN = false; bf16_t* s; bf16_t* lt; float* deni;
    __device__ __forceinline__ void mid(Acc&, const Unit&, int, int, int, int) const {}
    __device__ __forceinline__ void pre(const Unit&, int, int, int, int) const {}
    __device__ __forceinline__ void operator()(Acc& acc, const Unit& u, int wr, int wc, int fr, int fq) const {
        const int item = u.pm;
        if (u.kind == 0) {
            const int b = item >> 5, h = (item >> 3) & 3, sc = item & 7; const int tokb = b * SEQ_ + sc * 256;
            EPI_ROWS(ai, m) { int r = EPI_RL(ai, m); asm volatile("" : "+v"(r)); float rs = 0.f;
#pragma unroll
                for (int bj = 0; bj < 2; ++bj) { const int c0 = EPI_CL(bj); f32x4 v0 = acc[ai][bj][m][0], v1 = acc[ai][bj][m][1];
#pragma unroll
                    for (int j = 0; j < 4; ++j) { v0[j] = (c0 + j <= r) ? v0[j] : 0.f; v1[j] = (c0 + 4 + j <= r) ? v1[j] : 0.f; rs += v0[j] + v1[j]; }
                    *(u32x4*)(s + (size_t)item * 65536 + r * 256 + c0) = pack8(v0, v1); }
                rs += __shfl_xor(rs, 16); rs += __shfl_xor(rs, 32);
                if (fq == 0) unsafeAtomicAdd(deni + (size_t)(tokb + r) * 4 + h, rs); }
        } else {
            EPI_ROWS(ai, m) { bf16_t* rowp = lt + (size_t)item * 65536 + EPI_RL(ai, m) * 256 + EPI_CL(0);
#pragma unroll
                for (int bj = 0; bj < 2; ++bj) *(u32x4*)(rowp + bj * 128) = pack8(acc[ai][bj][m][0], acc[ai][bj][m][1]); }
        }
    } };

struct SchedP5 { const char* s; const char* vt; const char* wq; const char* cint; int G, c;
    __device__ __forceinline__ bool next(int i, Unit& u) const {
        const int item = (i >> 1) * G + c; if (item >= 256) return false;
        u.pm = item; u.pn = 0; u.kind = 0;
        if ((i & 1) == 0) { u.cont = 1; u.a = s + (size_t)item * 131072; u.b = vt + (size_t)item * 131072; }
        else { u.cont = 0; u.a = wq + (size_t)item * 131072; u.b = cint + (size_t)item * 131072; }
        return true; } };
struct EpiP5 { static constexpr bool AFTER_DRAIN = false; bf16_t* hm; const float* deni; const float* denx; float* hss;
    __device__ __forceinline__ void mid(Acc&, const Unit&, int, int, int, int) const {}
    __device__ __forceinline__ void pre(const Unit&, int, int, int, int) const {}
    __device__ __forceinline__ void operator()(Acc& acc, const Unit& u, int wr, int wc, int fr, int fq) const {
        const int item = u.pm; const int b = item >> 5, h = (item >> 3) & 3, sc = item & 7; const int tokb = b * SEQ_ + sc * 256;
        float dnv[2][4];
#pragma unroll
        for (int ai = 0; ai < 2; ++ai)
#pragma unroll
            for (int m = 0; m < 4; ++m) { const int t = tokb + EPI_RL(ai, m); dnv[ai][m] = deni[(size_t)t * 4 + h] + denx[(size_t)t * 4 + h]; }
        EPI_ROWS(ai, m) { const int t = tokb + EPI_RL(ai, m);
            const float den = dnv[ai][m]; const float inv = __builtin_amdgcn_rcpf(fmaxf(fabsf(den), 1.0f)); float ss = 0.f;
#pragma unroll
            for (int bj = 0; bj < 2; ++bj) { f32x4 v0 = acc[ai][bj][m][0] * inv, v1 = acc[ai][bj][m][1] * inv;
                { const f32x4 q = v0 * v0 + v1 * v1; ss += (q[0] + q[1]) + (q[2] + q[3]); }
                *(u32x4*)(hm + (size_t)t * 1024 + h * 256 + EPI_CL(bj)) = pack8(v0, v1); }
            ss += __shfl_xor(ss, 16); ss += __shfl_xor(ss, 32);
            if (fq == 0) unsafeAtomicAdd(hss + (size_t)t * 4 + h, ss); }
    } };

struct SchedP6 { const char* hb; const char* wint; int G, c;
    __device__ __forceinline__ bool next(int i, Unit& u) const {
        u.cont = 0;
        if (i == 0) { const int item = c; if (item >= 256) return false; const int b = item >> 5, h = (item >> 3) & 3, sc = item & 7;
            u.pm = b * 8 + sc; u.pn = h; u.kind = 0; u.a = hb + (size_t)u.pm * 256 * 1024 * 2; u.b = wint + (size_t)(3072 + h * 256) * 1024 * 2; return true; }
        const int L = (i - 1) * G + c; if (L >= 512) return false;
        int pm, pn; tile_order(L, 64, 8, pm, pn); u.pm = pm; u.pn = pn; u.kind = 1;
        u.a = hb + (size_t)pm * 256 * 1024 * 2; u.b = wint + (size_t)(4096 + pn * 256) * 1024 * 2; return true; } };
struct EpiP6 { static constexpr bool AFTER_DRAIN = false; bf16_t* hm; float* hss; const float* rsb; bf16_t* uu;
    __device__ __forceinline__ void mid(Acc&, const Unit&, int, int, int, int) const {}
    __device__ __forceinline__ void pre(const Unit&, int, int, int, int) const {}
    __device__ __forceinline__ void operator()(Acc& acc, const Unit& u, int wr, int wc, int fr, int fq) const {
        if (u.kind == 0) {
            float hsv[2][4], rxv[2][4];
#pragma unroll
            for (int ai = 0; ai < 2; ++ai)
#pragma unroll
                for (int m = 0; m < 4; ++m) rxv[ai][m] = rsb[u.pm * 256 + EPI_RL(ai, m)];
#pragma unroll
            for (int ai = 0; ai < 2; ++ai)
#pragma unroll
                for (int m = 0; m < 4; ++m) hsv[ai][m] = __hip_atomic_load(hss + (size_t)(u.pm * 256 + EPI_RL(ai, m)) * 4 + u.pn, __ATOMIC_RELAXED, __HIP_MEMORY_SCOPE_AGENT);
            u32x4 cur[2], nxt[2];
#pragma unroll
            for (int bj = 0; bj < 2; ++bj) cur[bj] = *(const u32x4*)(hm + (size_t)(u.pm * 256 + EPI_RL(0, 0)) * 1024 + u.pn * 256 + EPI_CL(bj));
            EPI_R8 { const int ai = r8 >> 2, m = r8 & 3; const int t = u.pm * 256 + EPI_RL(ai, m);
                if (r8 < 7) { const int tn = u.pm * 256 + EPI_RL((r8 + 1) >> 2, (r8 + 1) & 3);
#pragma unroll
                    for (int bj = 0; bj < 2; ++bj) nxt[bj] = *(const u32x4*)(hm + (size_t)tn * 1024 + u.pn * 256 + EPI_CL(bj)); }
                const float rsn = rsqrtf(hsv[ai][m] * (1.0f / 256.0f) + EPS_); const float rx = rxv[ai][m];
#pragma unroll
                for (int bj = 0; bj < 2; ++bj) { f32x4 h0, h1; unpack8(cur[bj], h0, h1);
                    const f32x4 o0 = h0 * rsn * sigm4(acc[ai][bj][m][0] * rx), o1 = h1 * rsn * sigm4(acc[ai][bj][m][1] * rx);
                    *(u32x4*)(hm + (size_t)t * 1024 + u.pn * 256 + EPI_CL(bj)) = pack8(o0, o1); }
                cur[0] = nxt[0]; cur[1] = nxt[1]; }
        } else {
            float rxv[2][4];
#pragma unroll
            for (int ai = 0; ai < 2; ++ai)
#pragma unroll
                for (int m = 0; m < 4; ++m) rxv[ai][m] = rsb[u.pm * 256 + EPI_RL(ai, m)];
            EPI_ROWS(ai, m) { const int t = u.pm * 256 + EPI_RL(ai, m); const float rx = rxv[ai][m];
                const f32x4 o0 = acc[ai][0][m][0] * rx * sigm4(acc[ai][1][m][0] * rx), o1 = acc[ai][0][m][1] * rx * sigm4(acc[ai][1][m][1] * rx);
                *(u32x4*)(uu + (size_t)t * 1024 + u.pn * 128 + wc * 32 + 8 * fq) = pack8(o0, o1); }
        }
    } };

struct SchedP8 { const char* hb; const char* wint; const char* hmg; const char* uc; const char* wmt; const char* wct; int G, c;
    __device__ __forceinline__ bool next(int i, Unit& u) const {
        const int L = (i >> 2) * G + c, r = i & 3; if (L >= 256) return false;
        int pn; map_n4(L, u.pm, pn); u.cont = 0;
        if (r < 2) { u.kind = 2; u.pn = 2 * pn + r; u.a = hb + (size_t)u.pm * 256 * 1024 * 2; u.b = wint + (size_t)(6144 + u.pn * 256) * 1024 * 2; }
        else if (r == 2) { u.kind = 0; u.pn = pn; u.a = hmg + (size_t)u.pm * 256 * 1024 * 2; u.b = wmt + (size_t)pn * 256 * 1024 * 2; }
        else { u.kind = 1; u.pn = pn; u.a = uc + (size_t)u.pm * 256 * 1024 * 2; u.b = wct + (size_t)pn * 256 * 1024 * 2; }
        return true; } };
struct EpiP8 { static constexpr bool AFTER_DRAIN = false; bf16_t* gmc; bf16_t* tmp; bf16_t* merged; const float* rsb;
    __device__ __forceinline__ void mid(Acc&, const Unit&, int, int, int, int) const {}
    __device__ __forceinline__ void pre(const Unit&, int, int, int, int) const {}
    __device__ __forceinline__ void operator()(Acc& acc, const Unit& u, int wr, int wc, int fr, int fq) const {
        if (u.kind == 2) {
            float rxv[2][4];
#pragma unroll
            for (int ai = 0; ai < 2; ++ai)
#pragma unroll
                for (int m = 0; m < 4; ++m) rxv[ai][m] = rsb[u.pm * 256 + EPI_RL(ai, m)];
            EPI_ROWS(ai, m) { const int t = u.pm * 256 + EPI_RL(ai, m); const float rx = rxv[ai][m], rxe = rx * -1.4426950408889634f;
                const f32x4 d0 = exp2v(acc[ai][1][m][0] * rxe) + 1.0f, d1 = exp2v(acc[ai][1][m][1] * rxe) + 1.0f;
                const f32x4 m0 = exp2v(acc[ai][0][m][0] * rxe) + 1.0f, m1 = exp2v(acc[ai][0][m][1] * rxe) + 1.0f;
                const f32x4 p0 = rcpv(m0 * d0), p1 = rcpv(m1 * d1);
                const f32x4 r0 = d0 * d0 * p0, r1 = d1 * d1 * p1, c0 = m0 * p0, c1 = m1 * p1;
                bf16_t* ptr = gmc + (size_t)t * 2048 + u.pn * 128 + wc * 32 + 8 * fq;
                *(u32x4*)ptr = pack8(r0, r1); *(u32x4*)(ptr + 1024) = pack8(c0, c1); }
        } else if (u.kind == 0) {
            u32x4 cur[2], nxt[2];
#pragma unroll
            for (int bj = 0; bj < 2; ++bj) cur[bj] = *(const u32x4*)(gmc + (size_t)(u.pm * 256 + EPI_RL(0, 0)) * 2048 + u.pn * 256 + EPI_CL(bj));
            EPI_R8 { const int ai = r8 >> 2, m = r8 & 3; const int t = u.pm * 256 + EPI_RL(ai, m);
                if (r8 < 7) { const int tn = u.pm * 256 + EPI_RL((r8 + 1) >> 2, (r8 + 1) & 3);
#pragma unroll
                    for (int bj = 0; bj < 2; ++bj) nxt[bj] = *(const u32x4*)(gmc + (size_t)tn * 2048 + u.pn * 256 + EPI_CL(bj)); }
#pragma unroll
                for (int bj = 0; bj < 2; ++bj) { const int c = u.pn * 256 + EPI_CL(bj); f32x4 a0, a1; unpack8(cur[bj], a0, a1);
                    *(u32x4*)(tmp + (size_t)t * 1024 + c) = pack8(acc[ai][bj][m][0] * a0, acc[ai][bj][m][1] * a1); }
                cur[0] = nxt[0]; cur[1] = nxt[1]; }
        } else {
            u32x4 cg[2], ct[2], ng[2], nt2[2];
#pragma unroll
            for (int bj = 0; bj < 2; ++bj) { const int t0 = u.pm * 256 + EPI_RL(0, 0); const int c = u.pn * 256 + EPI_CL(bj);
                cg[bj] = *(const u32x4*)(gmc + (size_t)t0 * 2048 + 1024 + c); ct[bj] = *(const u32x4*)(tmp + (size_t)t0 * 1024 + c); }
            EPI_R8 { const int ai = r8 >> 2, m = r8 & 3; const int t = u.pm * 256 + EPI_RL(ai, m);
                if (r8 < 7) { const int tn = u.pm * 256 + EPI_RL((r8 + 1) >> 2, (r8 + 1) & 3);
#pragma unroll
                    for (int bj = 0; bj < 2; ++bj) { const int c = u.pn * 256 + EPI_CL(bj); ng[bj] = *(const u32x4*)(gmc + (size_t)tn * 2048 + 1024 + c); nt2[bj] = *(const u32x4*)(tmp + (size_t)tn * 1024 + c); } }
#pragma unroll
                for (int bj = 0; bj < 2; ++bj) { const int c = u.pn * 256 + EPI_CL(bj); f32x4 b0, b1, t0, t1; unpack8(cg[bj], b0, b1); unpack8(ct[bj], t0, t1);
                    *(u32x4*)(merged + (size_t)t * 1024 + c) = pack8((acc[ai][bj][m][0] + t0) * b0, (acc[ai][bj][m][1] + t1) * b1); }
                cg[0] = ng[0]; cg[1] = ng[1]; ct[0] = nt2[0]; ct[1] = nt2[1]; }
        }
    } };

struct SchedN4 { const char* a; const char* bt; size_t astep, bstep; int G, c;
    __device__ __forceinline__ bool next(int i, Unit& u) const {
        const int L = i * G + c; if (L >= 256) return false;
        map_n4(L, u.pm, u.pn); u.kind = 0; u.cont = 0; u.a = a + (size_t)u.pm * astep; u.b = bt + (size_t)u.pn * bstep; return true; } };
struct SchedPE { const char* a; const char* bt; int G, c;
    __device__ __forceinline__ bool next(int i, Unit& u) const {
        const int L = i * G + c; if (L >= 256 || c < 0) return false;
        u.pm = L >> 2; u.pn = L & 3; u.kind = 0; u.cont = 0; u.a = a + (size_t)u.pm * 256 * 256 * 2; u.b = bt + (size_t)u.pn * 256 * 256 * 2; return true; } };
template <bool SRC_BF16> struct EpiRes { static constexpr bool AFTER_DRAIN = false; const void* src; bf16_t* dstb; float* ssq;
    __device__ __forceinline__ void mid(Acc&, const Unit&, int, int, int, int) const {}
    __device__ __forceinline__ void pre(const Unit& u, int wr, int wc, int fr, int fq) const {
        if (!SRC_BF16) {
            EPI_ROWS(ai, m) { const int t = u.pm * 256 + EPI_RL(ai, m);
#pragma unroll
                for (int bj = 0; bj < 2; ++bj) { const float v = *((const float*)src + (size_t)t * 1024 + u.pn * 256 + EPI_CL(bj)); asm volatile("" :: "v"(v)); } }
        }
    }
    __device__ __forceinline__ void operator()(Acc& acc, const Unit& u, int wr, int wc, int fr, int fq) const {
        f32x4 rb[3][2][2];
#define ERES_LOAD(dst, t_) do { _Pragma("unroll") for (int bj = 0; bj < 2; ++bj) { const size_t o_ = (size_t)(t_) * 1024 + u.pn * 256 + EPI_CL(bj); \
            if (SRC_BF16) dst[bj][0] = __builtin_bit_cast(f32x4, *(const u32x4*)((const bf16_t*)src + o_)); \
            else { dst[bj][0] = *(const f32x4*)((const float*)src + o_); dst[bj][1] = *(const f32x4*)((const float*)src + o_ + 4); } } } while (0)
        ERES_LOAD(rb[0], u.pm * 256 + EPI_RL(0, 0)); ERES_LOAD(rb[1], u.pm * 256 + EPI_RL(0, 1));
        EPI_R8 { const int ai = r8 >> 2, m = r8 & 3; const int t = u.pm * 256 + EPI_RL(ai, m); float ss = 0.f;
            if (r8 < 6) ERES_LOAD(rb[(r8 + 2) % 3], u.pm * 256 + EPI_RL((r8 + 2) >> 2, (r8 + 2) & 3));
#pragma unroll
            for (int bj = 0; bj < 2; ++bj) { const size_t o = (size_t)t * 1024 + u.pn * 256 + EPI_CL(bj); f32x4 v0, v1;
                if (SRC_BF16) unpack8(__builtin_bit_cast(u32x4, rb[r8 % 3][bj][0]), v0, v1); else { v0 = rb[r8 % 3][bj][0]; v1 = rb[r8 % 3][bj][1]; }
                v0 += acc[ai][bj][m][0]; v1 += acc[ai][bj][m][1];
                { const f32x4 q = v0 * v0 + v1 * v1; ss += (q[0] + q[1]) + (q[2] + q[3]); }
                *(u32x4*)(dstb + o) = pack8(v0, v1); }
            ss += __shfl_xor(ss, 16); ss += __shfl_xor(ss, 32);
            if (fq == 0) unsafeAtomicAdd(ssq + t, ss); }
#undef ERES_LOAD
    } };

struct SchedP10 { const char* x1b; const char* wgut; int G, c;
    __device__ __forceinline__ bool next(int i, Unit& u) const {
        const int L = i * G + c; if (L >= 1408) return false;
        int pm, pn; tile_order(L, 64, 22, pm, pn); u.pm = pm; u.pn = pn; u.kind = 0; u.cont = 0;
        u.a = x1b + (size_t)pm * 256 * 1024 * 2; u.b = wgut + (size_t)pn * 256 * 1024 * 2; return true; } };
struct EpiP10 { static constexpr bool AFTER_DRAIN = false; const float* ssq; bf16_t* hid;
    __device__ __forceinline__ void mid(Acc&, const Unit&, int, int, int, int) const {}
    __device__ __forceinline__ void pre(const Unit&, int, int, int, int) const {}
    __device__ __forceinline__ void operator()(Acc& acc, const Unit& u, int wr, int wc, int fr, int fq) const {
        float rsv[2][4];
#pragma unroll
        for (int ai = 0; ai < 2; ++ai)
#pragma unroll
            for (int m = 0; m < 4; ++m) rsv[ai][m] = ssq[u.pm * 256 + EPI_RL(ai, m)];
        EPI_ROWS(ai, m) { const int t = u.pm * 256 + EPI_RL(ai, m); const float rs = rsqrtf(rsv[ai][m] * (1.0f / 1024.0f) + EPS_);
            const f32x4 o0 = silu4(acc[ai][0][m][0] * rs) * (acc[ai][1][m][0] * rs), o1 = silu4(acc[ai][0][m][1] * rs) * (acc[ai][1][m][1] * rs);
            *(u32x4*)(hid + (size_t)t * DFF_ + u.pn * 128 + wc * 32 + 8 * fq) = pack8(o0, o1); }
    } };

struct EpiBf { static constexpr bool AFTER_DRAIN = false; bf16_t* o;
    __device__ __forceinline__ void mid(Acc&, const Unit&, int, int, int, int) const {}
    __device__ __forceinline__ void pre(const Unit&, int, int, int, int) const {}
    __device__ __forceinline__ void operator()(Acc& acc, const Unit& u, int wr, int wc, int fr, int fq) const {
        EPI_ROWS(ai, m) { bf16_t* rowp = o + (size_t)(u.pm * 256 + EPI_RL(ai, m)) * 1024 + u.pn * 256 + EPI_CL(0);
#pragma unroll
            for (int bj = 0; bj < 2; ++bj) *(u32x4*)(rowp + bj * 128) = pack8(acc[ai][bj][m][0], acc[ai][bj][m][1]); }
    } };

struct EpiP12 { static constexpr bool AFTER_DRAIN = true; const float* ssq2; const bf16_t* pe; const bf16_t* xin; float* out; float* ssq3; unsigned* done; const float* fg;
    __device__ __forceinline__ void mid(Acc&, const Unit&, int, int, int, int) const {}
    __device__ __forceinline__ void pre(const Unit&, int, int, int, int) const {}
    __device__ __forceinline__ void operator()(Acc& acc, const Unit& u, int wr, int wc, int fr, int fq) const {
        float rsv[2][4];
#pragma unroll
        for (int ai = 0; ai < 2; ++ai)
#pragma unroll
            for (int m = 0; m < 4; ++m) rsv[ai][m] = ssq2[u.pm * 256 + EPI_RL(ai, m)];
        { u32x4 cx[2], cp[2], nx[2], np[2];
#pragma unroll
            for (int bj = 0; bj < 2; ++bj) { const size_t o = (size_t)(u.pm * 256 + EPI_RL(0, 0)) * 1024 + u.pn * 256 + EPI_CL(bj); cx[bj] = *(const u32x4*)(xin + o); cp[bj] = *(const u32x4*)(pe + o); }
            EPI_R8 { const int ai = r8 >> 2, m = r8 & 3; const int t = u.pm * 256 + EPI_RL(ai, m); const float rs = rsqrtf(rsv[ai][m] * (1.0f / 1024.0f) + EPS_); float ss = 0.f;
                if (r8 < 7) {
#pragma unroll
                    for (int bj = 0; bj < 2; ++bj) { const size_t o = (size_t)(u.pm * 256 + EPI_RL((r8 + 1) >> 2, (r8 + 1) & 3)) * 1024 + u.pn * 256 + EPI_CL(bj); nx[bj] = *(const u32x4*)(xin + o); np[bj] = *(const u32x4*)(pe + o); } }
#pragma unroll
                for (int bj = 0; bj < 2; ++bj) { f32x4 p0, p1, v0, v1; unpack8(cp[bj], p0, p1); unpack8(cx[bj], v0, v1);
                    v0 += sigm4(acc[ai][bj][m][0] * rs) * p0; v1 += sigm4(acc[ai][bj][m][1] * rs) * p1;
                    { const f32x4 q = v0 * v0 + v1 * v1; ss += (q[0] + q[1]) + (q[2] + q[3]); }
                    acc[ai][bj][m][0] = v0; acc[ai][bj][m][1] = v1; }
                ss += __shfl_xor(ss, 16); ss += __shfl_xor(ss, 32);
                if (fq == 0) unsafeAtomicAdd(ssq3 + t, ss);
                cx[0] = nx[0]; cx[1] = nx[1]; cp[0] = np[0]; cp[1] = np[1]; } }
        asm volatile("s_waitcnt vmcnt(0)" ::: "memory");
        unsigned* cnt = done + 64 * u.pm;
        if ((threadIdx.x & 63) == 0) __hip_atomic_fetch_add(cnt, 1u, __ATOMIC_RELAXED, __HIP_MEMORY_SCOPE_AGENT);
        { unsigned sp = 0; while (__hip_atomic_load(cnt, __ATOMIC_RELAXED, __HIP_MEMORY_SCOPE_AGENT) < 32u) { __builtin_amdgcn_s_sleep(1); if (++sp > (1u << 22)) break; } }
#pragma unroll
        for (int ai = 0; ai < 2; ++ai)
#pragma unroll
            for (int m = 0; m < 4; ++m) rsv[ai][m] = __hip_atomic_load(ssq3 + u.pm * 256 + EPI_RL(ai, m), __ATOMIC_RELAXED, __HIP_MEMORY_SCOPE_AGENT);
        f32x4 gv[2][2];
#pragma unroll
        for (int bj = 0; bj < 2; ++bj) { const int cc = u.pn * 256 + EPI_CL(bj); gv[bj][0] = *(const f32x4*)(fg + cc); gv[bj][1] = *(const f32x4*)(fg + cc + 4); }
        EPI_ROWS(ai, m) { const int t = u.pm * 256 + EPI_RL(ai, m);
            const float rs = rsqrtf(rsv[ai][m] * (1.0f / 1024.0f) + EPS_);
#pragma unroll
            for (int bj = 0; bj < 2; ++bj) { const size_t o = (size_t)t * 1024 + u.pn * 256 + EPI_CL(bj);
                *(f32x4*)(out + o) = acc[ai][bj][m][0] * rs * gv[bj][0]; *(f32x4*)(out + o + 4) = acc[ai][bj][m][1] * rs * gv[bj][1]; } }
    } };

struct CvtTile { const float* src; int ld; const float* scale; bf16_t* dst; int dstld; };
__device__ __forceinline__ CvtTile cvt_tile_params(const Params& p, int tl) {
    const int NT0 = 2048, NT4 = NT0 + 1024, NT5 = NT4 + 1408, NT6 = NT5 + 704;
    unsigned char* ws = p.ws; CvtTile t; t.scale = nullptr;
    if (tl < NT0) { const int nb = tl >> 4, kb = tl & 15; const int n0 = nb * 64; int col;
        if (n0 < 4096) col = n0; else if (n0 < 6144) { const int j = (n0 - 4096) >> 8, r = (n0 - 4096) & 255; col = (r < 128) ? (4104 + 128 * j + r) : (5128 + 128 * j + r - 128); }
        else { const int j = (n0 - 6144) >> 8, r = (n0 - 6144) & 255; col = 6152 + ((r < 128) ? (128 * j + r) : (1024 + 128 * j + r - 128)); }
        t.src = p.in[3] + (size_t)kb * 64 * NIN_ + col; t.ld = NIN_; t.scale = p.in[2] + kb * 64; t.dst = (bf16_t*)(ws + O_WINT) + (size_t)n0 * 1024 + kb * 64; t.dstld = 1024; }
    else if (tl < NT4) { const int w = (tl - NT0) >> 8, l = (tl - NT0) & 255; const int nb = l >> 4, kb = l & 15;
        const float* base = w == 0 ? p.in[12] : (w == 1 ? p.in[13] : (w == 2 ? p.in[14] : p.in[20])); const size_t od = w == 0 ? O_WMT : (w == 1 ? O_WCT : (w == 2 ? O_WOT : O_WPGT));
        t.src = base + (size_t)kb * 64 * 1024 + nb * 64; t.ld = 1024; if (w == 3) t.scale = p.in[19] + kb * 64; if (w == 0) t.scale = p.in[7] + kb * 64; t.dst = (bf16_t*)(ws + od) + (size_t)nb * 64 * 1024 + kb * 64; t.dstld = 1024; }
    else if (tl < NT5) { const int l = tl - NT4; const int nb = l >> 4, kb = l & 15; const int n0 = nb * 64; const int j = n0 >> 8, r = n0 & 255;
        const float* base = (r < 128) ? p.in[16] : p.in[17]; const int col = 128 * j + (r & 127);
        t.src = base + (size_t)kb * 64 * DFF_ + col; t.ld = DFF_; t.scale = p.in[15] + kb * 64; t.dst = (bf16_t*)(ws + O_WGUT) + (size_t)n0 * 1024 + kb * 64; t.dstld = 1024; }
    else if (tl < NT6) { const int l = tl - NT5; const int nb = l / 44, kb = l % 44;
        t.src = p.in[18] + (size_t)kb * 64 * 1024 + nb * 64; t.ld = 1024; t.dst = (bf16_t*)(ws + O_WDT) + (size_t)nb * 64 * DFF_ + kb * 64; t.dstld = DFF_; }
    else { const int l = tl - NT6; const int nb = l >> 2, kb = l & 3;
        t.src = p.in[21] + (size_t)kb * 64 * 1024 + nb * 64; t.ld = 1024; t.dst = (bf16_t*)(ws + O_WPPT) + (size_t)nb * 64 * 256 + kb * 64; t.dstld = 256; }
    return t;
}
__device__ __forceinline__ void cvt_tile_load(const CvtTile& t, f32x4 (&v)[2]) {
    const int tid = threadIdx.x, kk = tid >> 4, c4 = (tid & 15) * 4;
#pragma unroll
    for (int pss = 0; pss < 2; ++pss) { const int k = kk + pss * 32; v[pss] = *(const f32x4*)(t.src + (size_t)k * t.ld + c4); if (t.scale) v[pss] = v[pss] * t.scale[k]; }
}

__device__ __forceinline__ void phase0(const Params& p, unsigned char* sm) {
    unsigned char* ws = p.ws;
    const int tid = threadIdx.x, lane = tid & 63, wid = tid >> 6;
    const size_t gtid = (size_t)blockIdx.x * 512 + tid, gthreads = (size_t)gridDim.x * 512;
    for (size_t i = gtid; i < ZERO_BYTES / 16; i += gthreads) ((u32x4*)(ws + O_ZERO))[i] = (u32x4){0u, 0u, 0u, 0u};
    { const float* pp = p.in[1]; bf16_t* pb = (bf16_t*)(ws + O_PB);
        for (size_t i = gtid; i < (size_t)T_ * 256 / 8; i += gthreads) { const f32x4 a = *(const f32x4*)(pp + i * 8), b = *(const f32x4*)(pp + i * 8 + 4); *(u32x4*)(pb + i * 8) = pack8(a, b); } }
    { const float* x = p.in[0]; const float* g = p.in[2]; const float* win = p.in[3]; const float* bif = p.in[4];
        float* wgT = (float*)sm;
        for (int idx = tid; idx < 8192; idx += 512) { const int k = idx >> 3, j = idx & 7; wgT[j * 1024 + k] = win[(size_t)k * NIN_ + 4096 + j] * g[k]; }
        __syncthreads();
        bf16_t* hb = (bf16_t*)(ws + O_HB); float* ig = (float*)(ws + O_IG); float* lf = (float*)(ws + O_LF);
        const int rstep = gridDim.x * 8; int row = blockIdx.x * 8 + wid;
        f32x4 xn[4];
#pragma unroll
        for (int i = 0; i < 4; ++i) xn[i] = (row < T_) ? *(const f32x4*)(x + (size_t)row * 1024 + i * 256 + lane * 4) : (f32x4){0.f, 0.f, 0.f, 0.f};
        for (; row < T_; row += rstep) {
            f32x4 xv[4]; float ss = 0.f;
#pragma unroll
            for (int i = 0; i < 4; ++i) { xv[i] = xn[i]; ss += xv[i][0] * xv[i][0] + xv[i][1] * xv[i][1] + xv[i][2] * xv[i][2] + xv[i][3] * xv[i][3]; }
            { const int nrow = row + rstep;
                if (nrow < T_) {
#pragma unroll
                    for (int i = 0; i < 4; ++i) xn[i] = *(const f32x4*)(x + (size_t)nrow * 1024 + i * 256 + lane * 4); } }
            ss = wave_sum(ss); const float rs = rsqrtf(ss * (1.0f / 1024.0f) + EPS_);
            float d[8];
#pragma unroll
            for (int j = 0; j < 8; ++j) d[j] = 0.f;
            if (lane == 0) ((float*)(ws + O_RS))[row] = rs;
#pragma unroll
            for (int i = 0; i < 4; ++i) { const f32x4 hn = xv[i] * rs;
                u32x2 w; w.x = cvt_pk_bf16(xv[i][0], xv[i][1]); w.y = cvt_pk_bf16(xv[i][2], xv[i][3]); *(u32x2*)(hb + (size_t)row * 1024 + i * 256 + lane * 4) = w;
#pragma unroll
                for (int j = 0; j < 8; ++j) { const f32x4 wv = *(const f32x4*)(wgT + j * 1024 + i * 256 + lane * 4); d[j] += hn[0] * wv[0] + hn[1] * wv[1] + hn[2] * wv[2] + hn[3] * wv[3]; } }
#pragma unroll
            for (int j = 0; j < 8; ++j) d[j] = wave_sum(d[j]);
            if (lane < 8) { float v = d[0];
#pragma unroll
                for (int j = 1; j < 8; ++j) v = (lane == j) ? d[j] : v;
                v += bif[lane];
                if (lane < 4) ig[(size_t)row * 4 + lane] = v;
                else { const float z = v; lf[(size_t)row * 4 + lane - 4] = fminf(z, 0.f) - log1pf(__expf(-fabsf(z))); } }
        }
        __syncthreads();
    }
    { const int NTILES = 2048 + 1024 + 1408 + 704 + 64; const int gs = gridDim.x;
        float* tl = (float*)sm;
        int t = blockIdx.x; CvtTile c0{}, c1{}; f32x4 v0[2], v1[2];
        if (t < NTILES) { c0 = cvt_tile_params(p, t); cvt_tile_load(c0, v0); }
        if (t + gs < NTILES) { c1 = cvt_tile_params(p, t + gs); cvt_tile_load(c1, v1); }
        for (; t < NTILES; t += gs) {
            { const int kk = tid >> 4, c4 = (tid & 15) * 4;
#pragma unroll
                for (int pss = 0; pss < 2; ++pss) { const int k = kk + pss * 32;
#pragma unroll
                    for (int j = 0; j < 4; ++j) tl[k * 65 + c4 + j] = v0[pss][j]; } }
            __syncthreads();
            const CvtTile done = c0; c0 = c1; v0[0] = v1[0]; v0[1] = v1[1];
            { const int tn = t + 2 * gs; if (tn < NTILES) { c1 = cvt_tile_params(p, tn); cvt_tile_load(c1, v1); } }
            { const int n = tid >> 3, k8 = (tid & 7) * 8; float e[8];
#pragma unroll
                for (int q = 0; q < 8; ++q) e[q] = tl[(k8 + q) * 65 + n];
                u32x4 w; w.x = cvt_pk_bf16(e[0], e[1]); w.y = cvt_pk_bf16(e[2], e[3]); w.z = cvt_pk_bf16(e[4], e[5]); w.w = cvt_pk_bf16(e[6], e[7]);
                *(u32x4*)(done.dst + (size_t)n * done.dstld + k8) = w; }
            __syncthreads();
        }
    }
}

__device__ __forceinline__ void phase2(const Params& p, unsigned char* sm) {
    unsigned char* ws = p.ws;
    const int tid = threadIdx.x, lane = tid & 63, wid = tid >> 6;
    float* rowfac = (float*)sm; float* colfac = rowfac + 256; float* wsum = colfac + 256;
    const float* ig = (const float*)(ws + O_IG); const float* lf = (const float*)(ws + O_LF);
    const bf16_t* qkpre = (const bf16_t*)p.out;
    const float* cw = p.in[5]; const float* cb = p.in[6];
    for (int item = blockIdx.x; item < 256; item += gridDim.x) {
        const int b = item >> 5, h = (item >> 3) & 3, sc = item & 7; const int tokb = b * SEQ_ + sc * 256;
        float v = 0.f, igv = 0.f;
        if (tid < 256) { v = lf[(size_t)(tokb + tid) * 4 + h]; igv = ig[(size_t)(tokb + tid) * 4 + h]; }
#pragma unroll
        for (int o = 1; o < 64; o <<= 1) { const float n = __shfl_up(v, o); if (lane >= o) v += n; }
        if (tid < 256 && lane == 63) wsum[wid] = v;
        __syncthreads();
        if (tid < 256) { float add = 0.f; for (int j = 0; j < wid; ++j) add += wsum[j]; v += add; rowfac[tid] = __expf(v); colfac[tid] = __expf(igv - v);
            if (tid == 255) ((float*)(ws + O_EBL))[item] = __expf(v); }
        __syncthreads();
#pragma unroll 1
        for (int qt = 0; qt < 4; ++qt) {
        const int cp = tid & 127, tg = tid >> 7; const int ch = 2 * cp; const int tl0 = qt * 64 + tg * 16; const int s0 = sc * 256 + tl0;
        { const int col = h * 256 + ch; f32x2 xx[19];
#pragma unroll
            for (int i = 0; i < 19; ++i) { const int s = s0 - 3 + i; unsigned w = 0u; if (s >= 0) w = *(const unsigned*)(qkpre + (size_t)(b * SEQ_ + s) * 2048 + col); xx[i] = (f32x2){bf_lo(w), bf_hi(w)}; }
            f32x2 wv[4];
#pragma unroll
            for (int k = 0; k < 4; ++k) wv[k] = *(const f32x2*)(cw + (size_t)k * 2048 + col);
            const f32x2 bv = *(const f32x2*)(cb + col);
            bf16_t* wq = (bf16_t*)(ws + O_WQ) + (size_t)item * 65536;
#pragma unroll
            for (int i = 0; i < 16; ++i) { f32x2 y = bv;
#pragma unroll
                for (int k = 0; k < 4; ++k) y = __builtin_elementwise_fma(xx[i + k], wv[k], y);
                const f32x2 o = silu2(y) * (rowfac[tl0 + i] * 0.0625f);
                *(unsigned*)(wq + (size_t)(tl0 + i) * 256 + ch) = cvt_pk_bf16(o[0], o[1]); } }
        { const int col = 1024 + h * 256 + ch; f32x2 xx[19];
#pragma unroll
            for (int i = 0; i < 19; ++i) { const int s = s0 - 3 + i; unsigned w = 0u; if (s >= 0) w = *(const unsigned*)(qkpre + (size_t)(b * SEQ_ + s) * 2048 + col); xx[i] = (f32x2){bf_lo(w), bf_hi(w)}; }
            f32x2 wv[4];
#pragma unroll
            for (int k = 0; k < 4; ++k) wv[k] = *(const f32x2*)(cw + (size_t)k * 2048 + col);
            const f32x2 bv = *(const f32x2*)(cb + col);
            bf16_t* kw = (bf16_t*)(ws + O_KW) + (size_t)item * 65536; bf16_t* kwt = (bf16_t*)(ws + O_KWT) + (size_t)item * 65536;
            float k0[16], k1[16]; f32x2 nn = {0.f, 0.f};
#pragma unroll
            for (int i = 0; i < 16; ++i) { f32x2 y = bv;
#pragma unroll
                for (int k = 0; k < 4; ++k) y = __builtin_elementwise_fma(xx[i + k], wv[k], y);
                const f32x2 o = silu2(y) * colfac[tl0 + i]; k0[i] = o[0]; k1[i] = o[1]; nn += o;
                *(unsigned*)(kw + (size_t)(tl0 + i) * 256 + ch) = cvt_pk_bf16(o[0], o[1]); }
            const float n0 = nn[0], n1 = nn[1];
            u32x4 a, c;
            a.x = cvt_pk_bf16(k0[0], k0[1]); a.y = cvt_pk_bf16(k0[2], k0[3]); a.z = cvt_pk_bf16(k0[4], k0[5]); a.w = cvt_pk_bf16(k0[6], k0[7]);
            c.x = cvt_pk_bf16(k0[8], k0[9]); c.y = cvt_pk_bf16(k0[10], k0[11]); c.z = cvt_pk_bf16(k0[12], k0[13]); c.w = cvt_pk_bf16(k0[14], k0[15]);
            *(u32x4*)(kwt + (size_t)ch * 256 + tl0) = a; *(u32x4*)(kwt + (size_t)ch * 256 + tl0 + 8) = c;
            a.x = cvt_pk_bf16(k1[0], k1[1]); a.y = cvt_pk_bf16(k1[2], k1[3]); a.z = cvt_pk_bf16(k1[4], k1[5]); a.w = cvt_pk_bf16(k1[6], k1[7]);
            c.x = cvt_pk_bf16(k1[8], k1[9]); c.y = cvt_pk_bf16(k1[10], k1[11]); c.z = cvt_pk_bf16(k1[12], k1[13]); c.w = cvt_pk_bf16(k1[14], k1[15]);
            *(u32x4*)(kwt + (size_t)(ch + 1) * 256 + tl0) = a; *(u32x4*)(kwt + (size_t)(ch + 1) * 256 + tl0 + 8) = c;
            float* nsum = (float*)(ws + O_NSUM) + (size_t)item * 256;
            unsafeAtomicAdd(nsum + ch, n0); unsafeAtomicAdd(nsum + ch + 1, n1); }
        }
        __syncthreads();
    }
}

__device__ __forceinline__ void phase4(const Params& p, unsigned char* sm) {
    unsigned char* ws = p.ws;
    const int tid = threadIdx.x;
    const float* ebl = (const float*)(ws + O_EBL);
    const bf16_t* lt = (const bf16_t*)(p.ws + O_KWT);
    bf16_t* cint = (bf16_t*)(ws + O_CINT);
    const size_t gtid = (size_t)blockIdx.x * 512 + tid, gthreads = (size_t)gridDim.x * 512;
#pragma unroll 2
    for (size_t g = gtid; g < (size_t)32 * 16384; g += gthreads) {
        const int bh = (int)(g >> 14), e4 = (int)(g & 16383);
        f32x4 c = {0.f, 0.f, 0.f, 0.f};
        u32x2 lw[7]; float eb[7];
#pragma unroll
        for (int sc = 0; sc < 7; ++sc) { lw[sc] = *(const u32x2*)(lt + (size_t)(bh * 8 + sc) * 65536 + e4 * 4); eb[sc] = ebl[bh * 8 + sc]; }
#pragma unroll
        for (int sc = 0; sc < 8; ++sc) { const int item = bh * 8 + sc;
            u32x2 w; w.x = cvt_pk_bf16(c[0], c[1]); w.y = cvt_pk_bf16(c[2], c[3]); *(u32x2*)(cint + (size_t)item * 65536 + e4 * 4) = w;
            if (sc < 7) { const f32x4 l = {bf_lo(lw[sc].x), bf_hi(lw[sc].x), bf_lo(lw[sc].y), bf_hi(lw[sc].y)}; c = (c + l) * eb[sc]; } }
    }
    float* nin = (float*)sm;
    const float* nsum = (const float*)(ws + O_NSUM);
    float* denx = (float*)(ws + O_DENX);
    for (int item = blockIdx.x; item < 256; item += gridDim.x) {
        const int b = item >> 5, h = (item >> 3) & 3, sc = item & 7; const int tokb = b * SEQ_ + sc * 256; const int bh = item >> 3;
        if (tid < 256) { float eb[7], ns[7];
#pragma unroll
            for (int j = 0; j < 7; ++j) { eb[j] = ebl[bh * 8 + j]; ns[j] = nsum[(size_t)(bh * 8 + j) * 256 + tid]; }
            float nv = 0.f;
#pragma unroll
            for (int j = 0; j < 7; ++j) if (j < sc) nv = eb[j] * (nv + ns[j]);
            nin[tid] = nv; }
        __syncthreads();
        const int tl = tid >> 1, half = tid & 1;
        const bf16_t* wq = (const bf16_t*)(ws + O_WQ) + (size_t)item * 65536 + (size_t)tl * 256 + half * 128;
        float d = 0.f;
#pragma unroll
        for (int i = 0; i < 16; ++i) { f32x4 a0, a1; unpack8(*(const u32x4*)(wq + i * 8), a0, a1); const float* nn = nin + half * 128 + i * 8;
            d += a0[0] * nn[0] + a0[1] * nn[1] + a0[2] * nn[2] + a0[3] * nn[3] + a1[0] * nn[4] + a1[1] * nn[5] + a1[2] * nn[6] + a1[3] * nn[7]; }
        d += __shfl_xor(d, 1);
        if (half == 0) denx[(size_t)(tokb + tl) * 4 + h] = d;
        __syncthreads();
    }
}

__device__ __forceinline__ void phase7(const Params& p, unsigned char* sm) {
    unsigned char* ws = p.ws;
    const int tid = threadIdx.x, lane = tid & 63, wid = tid >> 6;
    const bf16_t* uu = (const bf16_t*)p.out; bf16_t* uc = (bf16_t*)(ws + O_UC);
    const float* cw = p.in[8]; const float* cb = p.in[9]; const float* lg = p.in[10]; const float* lb = p.in[11];
    u32x4 pf[12];
#define P7_LOAD(tile_) do { const int t0_ = (tile_) * 16; const int b_ = t0_ / SEQ_, s0_ = t0_ % SEQ_; \
        _Pragma("unroll") for (int q = 0; q < 12; ++q) { const int idx = tid + q * 512; const int r = idx >> 7, c16 = idx & 127; const int s_ = s0_ - 30 + r; \
            pf[q] = (u32x4){0u, 0u, 0u, 0u}; if (idx < 46 * 128 && s_ >= 0) pf[q] = *(const u32x4*)(uu + (size_t)(b_ * SEQ_ + s_) * 1024 + c16 * 8); } } while (0)
    int tile = blockIdx.x;
    if (tile < 1024) P7_LOAD(tile);
    f32x2 wv[31];
#pragma unroll
    for (int k = 0; k < 31; ++k) wv[k] = *(const f32x2*)(cw + (size_t)k * 1024 + 2 * tid);
    const f32x2 bv = *(const f32x2*)(cb + 2 * tid);
    f32x4 lgv[4], lbv[4];
#pragma unroll
    for (int i = 0; i < 4; ++i) { lgv[i] = *(const f32x4*)(lg + i * 256 + lane * 4); lbv[i] = *(const f32x4*)(lb + i * 256 + lane * 4); }
    for (; tile < 1024; tile += gridDim.x) {
        const int t0 = tile * 16;
#pragma unroll
        for (int q = 0; q < 12; ++q) { const int idx = tid + q * 512; const int r = idx >> 7, c16 = idx & 127; if (idx < 46 * 128) *(u32x4*)(sm + r * 2048 + c16 * 16) = pf[q]; }
        __syncthreads();
        f32x2 yy[16];
        {
#pragma unroll
            for (int t = 0; t < 16; ++t) yy[t] = bv;
#pragma unroll
            for (int r = 0; r < 46; ++r) { const unsigned w = *(const unsigned*)(sm + r * 2048 + tid * 4); const f32x2 xx = {bf_lo(w), bf_hi(w)};
#pragma unroll
                for (int t = 0; t < 16; ++t) { const int k = r - t; if (k >= 0 && k <= 30) yy[t] = __builtin_elementwise_fma(wv[k], xx, yy[t]); }
                if ((r & 3) == 3) asm volatile("" ::: "memory"); }
        }
        __syncthreads();
#pragma unroll
        for (int t = 0; t < 16; ++t) *(f32x2*)(sm + t * 4096 + tid * 8) = yy[t];
        { const int tn = tile + gridDim.x; if (tn < 1024) P7_LOAD(tn); }
        __syncthreads();
#pragma unroll
        for (int tt = 0; tt < 2; ++tt) { const int t = wid * 2 + tt; f32x4 v[4]; float s1 = 0.f;
#pragma unroll
            for (int i = 0; i < 4; ++i) { v[i] = *(const f32x4*)(sm + t * 4096 + (i * 256 + lane * 4) * 4); s1 += v[i][0] + v[i][1] + v[i][2] + v[i][3]; }
            s1 = wave_sum(s1); const float mu = s1 * (1.0f / 1024.0f); float s2 = 0.f;
#pragma unroll
            for (int i = 0; i < 4; ++i) { v[i] = v[i] - mu; s2 += v[i][0] * v[i][0] + v[i][1] * v[i][1] + v[i][2] * v[i][2] + v[i][3] * v[i][3]; }
            s2 = wave_sum(s2); const float rstd = rsqrtf(s2 * (1.0f / 1024.0f) + EPS_);
#pragma unroll
            for (int i = 0; i < 4; ++i) { const int c = i * 256 + lane * 4; f32x4 z = v[i] * rstd * lgv[i] + lbv[i];
                z = silu4(z); u32x2 w; w.x = cvt_pk_bf16(z[0], z[1]); w.y = cvt_pk_bf16(z[2], z[3]); *(u32x2*)(uc + (size_t)(t0 + t) * 1024 + c) = w; } }
        __syncthreads();
    }
#undef P7_LOAD
}

__device__ __forceinline__ void phase13(const Params& p) {
    const float* ssq3 = (const float*)(p.ws + O_SSQ3); const float* fg = p.in[22];
    const size_t gtid = (size_t)blockIdx.x * 512 + threadIdx.x, gthreads = (size_t)gridDim.x * 512;
    for (size_t i = gtid; i < (size_t)T_ * 256; i += gthreads) { const int row = (int)(i >> 8), c = (int)(i & 255) * 4;
        const float rs = rsqrtf(ssq3[row] * (1.0f / 1024.0f) + EPS_); const f32x4 g = *(const f32x4*)(fg + c);
        f32x4 v = *(const f32x4*)(p.out + i * 4); v = v * rs * g; *(f32x4*)(p.out + i * 4) = v; }
}

#define XB_TMO      128
#define XB_XCNT(j)  (256  + 64 * (j))
#define XB_XSUB(j)  (1280 + 64 * (j))
#define XB_XGEN(j)  (2304 + 64 * (j))
#define XB_TOP      3328
#define XB_TOPGEN   3392
#define XCD_BAR_WORDS 3456
#define XB_SPIN_CAP (1u << 18)
__device__ __forceinline__ unsigned xb_ld(unsigned* p)              { return __hip_atomic_load(p, __ATOMIC_RELAXED, __HIP_MEMORY_SCOPE_AGENT); }
__device__ __forceinline__ unsigned xb_add(unsigned* p, unsigned v) { return __hip_atomic_fetch_add(p, v, __ATOMIC_RELAXED, __HIP_MEMORY_SCOPE_AGENT); }
__device__ __forceinline__ unsigned xb_xcc_id() { return (unsigned)__builtin_amdgcn_s_getreg((3 << 11) | 20) & 0xFu; }
#define XB_SPIN(cond, bar) do { unsigned _sp = 0; while (cond) { __builtin_amdgcn_s_sleep(1); \
    if ((++_sp & 255u) == 0u) { if (xb_ld(&(bar)[XB_TMO])) break; if (_sp > XB_SPIN_CAP) { atomicAdd(&(bar)[XB_TMO], 1u); break; } } } } while (0)
struct XcdBarrier { unsigned* bar; unsigned x; volatile LAS unsigned* st; };
__device__ __forceinline__ XcdBarrier xcd_barrier_post(unsigned* bar, volatile LAS unsigned* st) {
    XcdBarrier b; b.bar = bar; b.x = xb_xcc_id(); b.st = st;
    if (threadIdx.x == 0) (void)xb_add(&bar[XB_XCNT(b.x)], 1u);
    return b;
}
__device__ __forceinline__ void xcd_barrier_complete(unsigned* bar, unsigned x, unsigned& nloc, unsigned& nx) {
    const unsigned G = gridDim.x * gridDim.y * gridDim.z;
    unsigned sum, cnt, mine, sp = 0u;
    for (;;) {
        sum = 0u; cnt = 0u; mine = 0u;
#pragma unroll
        for (unsigned j = 0; j < 16; ++j) { const unsigned c = xb_ld(&bar[XB_XCNT(j)]); sum += c; cnt += (c > 0u) ? 1u : 0u; mine = (j == x) ? c : mine; }
        if (sum == G) break;
        __builtin_amdgcn_s_sleep(1);
        if ((++sp & 255u) == 0u) { if (xb_ld(&bar[XB_TMO])) break; if (sp > XB_SPIN_CAP) { atomicAdd(&bar[XB_TMO], 1u); break; } }
    }
    nloc = mine > 0u ? mine : 1u; nx = cnt > 0u ? cnt : 1u;
}
__device__ __forceinline__ void xcd_barrier(const XcdBarrier& b) {
    asm volatile("s_waitcnt vmcnt(0)" ::: "memory");
    __syncthreads();
    if (threadIdx.x == 0) {
        unsigned* bar = b.bar;
        __builtin_amdgcn_s_waitcnt(0);
        unsigned nloc = b.st[0], nx = b.st[1];
        if (nloc == 0u) { xcd_barrier_complete(bar, b.x, nloc, nx); b.st[0] = nloc; b.st[1] = nx; }
        const unsigned old = xb_add(&bar[XB_XSUB(b.x)], 1u);
        const unsigned gen = old / nloc;
        if (old + 1u == (gen + 1u) * nloc) {
            __builtin_amdgcn_fence(__ATOMIC_RELEASE, "agent");
            asm volatile("s_waitcnt vmcnt(0)" ::: "memory");
            const unsigned og = xb_add(&bar[XB_TOP], 1u);
            const unsigned tg = og / nx;
            if (og + 1u == (tg + 1u) * nx) xb_add(&bar[XB_TOPGEN], 1u);
            else XB_SPIN(xb_ld(&bar[XB_TOPGEN]) == tg, bar);
            __builtin_amdgcn_fence(__ATOMIC_ACQUIRE, "agent");
            xb_add(&bar[XB_XGEN(b.x)], 1u);
            asm volatile("s_waitcnt vmcnt(0)" ::: "memory");
        } else {
            XB_SPIN(xb_ld(&bar[XB_XGEN(b.x)]) == gen, bar);
            __builtin_amdgcn_fence(__ATOMIC_ACQUIRE, "agent");
            asm volatile("s_waitcnt vmcnt(0)" ::: "memory");
        }
    }
    __syncthreads();
}

template <bool COOP>
__global__ void __launch_bounds__(512, 2) mk_fwd(Params p) {
    extern __shared__ __attribute__((aligned(16))) unsigned char shm[];
    LAS unsigned char* lds = (LAS unsigned char*)shm;
    unsigned char* ws = p.ws;
    const int G = gridDim.x, c = blockIdx.x;
#ifndef PHMASK
#define PHMASK 0x3fff
#endif
#define PH(k) if (((PHMASK >> (k)) & 1) && p.ph_lo <= (k) && (k) < p.ph_hi)
    XcdBarrier xb{};
    if (COOP) { volatile LAS unsigned* st = (volatile LAS unsigned*)(lds + 131072);
        if (threadIdx.x == 0) { st[0] = 0u; st[1] = 0u; }
        __syncthreads();
        xb = xcd_barrier_post((unsigned*)(ws + O_BAR), st); }
#define SYNC(k) if (COOP) { if (p.ph_lo <= (k) && (k) + 1 < p.ph_hi) { xcd_barrier(xb); } }
    PH(0) phase0(p, shm);
    SYNC(0)
    PH(1) { SchedP1 S{(const char*)(ws + O_HB), (const char*)(ws + O_WINT), G, c}; EpiP1 E{(bf16_t*)p.out, (bf16_t*)(ws + O_VT), (const float*)(ws + O_RS)}; gemm_phase(lds, 1024, 1024, 1024, S, E); }
    SYNC(1)
    PH(3) { phase2(p, shm);
        asm volatile("s_waitcnt vmcnt(0)" ::: "memory"); __syncthreads();
        SchedP3 S{(const char*)(ws + O_WQ), (const char*)(ws + O_KW), (const char*)(ws + O_VT), (const char*)(ws + O_KWT), G, c};
        EpiP3 E{(bf16_t*)(ws + O_SS), (bf16_t*)(ws + O_KWT), (float*)(ws + O_DENI)}; gemm_phase(lds, 256, 256, 256, S, E); }
    SYNC(3)
    PH(4) phase4(p, shm);
    SYNC(4)
    PH(6) { { SchedP5 S{(const char*)(ws + O_SS), (const char*)(ws + O_VT), (const char*)(ws + O_WQ), (const char*)(ws + O_CINT), G, c};
            EpiP5 E{(bf16_t*)(ws + O_HM), (const float*)(ws + O_DENI), (const float*)(ws + O_DENX), (float*)(ws + O_HSS)}; gemm_phase(lds, 256, 256, 256, S, E); }
        { SchedP6 S{(const char*)(ws + O_HB), (const char*)(ws + O_WINT), G, c};
            EpiP6 E{(bf16_t*)(ws + O_HM), (float*)(ws + O_HSS), (const float*)(ws + O_RS), (bf16_t*)p.out}; gemm_phase(lds, 1024, 1024, 1024, S, E); } }
    SYNC(6)
    PH(7) phase7(p, shm);
    SYNC(7)
    PH(8) { SchedP8 S{(const char*)(ws + O_HB), (const char*)(ws + O_WINT), (const char*)(ws + O_HM), (const char*)(ws + O_UC), (const char*)(ws + O_WMT), (const char*)(ws + O_WCT), G, c};
        EpiP8 E{(bf16_t*)(ws + O_GMC), (bf16_t*)p.out + (size_t)T_ * 1024, (bf16_t*)(ws + O_MERGED), (const float*)(ws + O_RS)}; gemm_phase(lds, 1024, 1024, 1024, S, E); }
    SYNC(8)
    PH(9) { SchedN4 S{(const char*)(ws + O_MERGED), (const char*)(ws + O_WOT), (size_t)256 * 1024 * 2, (size_t)256 * 1024 * 2, G, c};
        EpiRes<true> E{(const void*)(ws + O_HB), (bf16_t*)(ws + O_X1B), (float*)(ws + O_SSQ1)}; gemm_phase(lds, 1024, 1024, 1024, S, E); }
    SYNC(9)
    PH(10) { { SchedP10 S{(const char*)(ws + O_X1B), (const char*)(ws + O_WGUT), G, c}; EpiP10 E{(const float*)(ws + O_SSQ1), (bf16_t*)(ws + O_HID)}; gemm_phase(lds, 1024, 1024, 1024, S, E); }
        { const int h = G >> 1; SchedPE S{(const char*)(ws + O_PB), (const char*)(ws + O_WPPT), h, c - h};
            EpiBf E{(bf16_t*)(ws + O_PE)}; if (c >= h) gemm_phase(lds, 256, 256, 256, S, E); } }
    SYNC(10)
    PH(11) { SchedN4 S{(const char*)(ws + O_HID), (const char*)(ws + O_WDT), (size_t)256 * DFF_ * 2, (size_t)256 * DFF_ * 2, G, c};
            EpiRes<true> E{(const void*)(ws + O_X1B), (bf16_t*)(ws + O_X2B), (float*)(ws + O_SSQ2)}; gemm_phase(lds, DFF_, DFF_, DFF_, S, E); }
    SYNC(11)
    PH(12) { SchedN4 S{(const char*)(ws + O_X2B), (const char*)(ws + O_WPGT), (size_t)256 * 1024 * 2, (size_t)256 * 1024 * 2, G, c};
        EpiP12 E{(const float*)(ws + O_SSQ2), (const bf16_t*)(ws + O_PE), (const bf16_t*)(ws + O_X2B), p.out, (float*)(ws + O_SSQ3), (unsigned*)(ws + O_BAR) + XCD_BAR_WORDS, p.in[22]}; gemm_phase(lds, 1024, 1024, 1024, S, E); }
#undef PH
#undef SYNC
}

extern "C" void kernel_launch(void* const* d_in, const int* in_sizes, int n_in, void* d_out, int out_size, void* d_ws, size_t ws_size, hipStream_t stream) {
    static int grid = 0;
    if (grid == 0) {
        if (n_in != 23 || out_size != T_ * D_ || ws_size < WS_NEED) { fprintf(stderr, "kernel_launch: unexpected shapes (n_in %d, out %d, ws %zu)\n", n_in, out_size, ws_size); grid = -1; return; }
        int dev = 0, cus = 0, per_cu = 0;
        hipGetDevice(&dev); hipDeviceGetAttribute(&cus, hipDeviceAttributeMultiprocessorCount, dev);
        hipFuncSetAttribute((const void*)mk_fwd<true>, hipFuncAttributeMaxDynamicSharedMemorySize, LDS_BYTES);
        hipFuncSetAttribute((const void*)mk_fwd<false>, hipFuncAttributeMaxDynamicSharedMemorySize, LDS_BYTES);
        hipOccupancyMaxActiveBlocksPerMultiprocessor(&per_cu, (const void*)mk_fwd<true>, 512, LDS_BYTES);
        if (per_cu < 1) { fprintf(stderr, "kernel_launch: occupancy query reports %d blocks per CU\n", per_cu); per_cu = 1; }
        (void)hipGetLastError();
        grid = cus;
        if (grid != 256) { fprintf(stderr, "kernel_launch: built for a 256-CU device (got %d CUs)\n", cus); grid = -1; return; }
    }
    if (grid < 0) return;
    Params p{};
    for (int i = 0; i < 23; ++i) p.in[i] = (const float*)d_in[i];
    p.out = (float*)d_out; p.ws = (unsigned char*)d_ws;
#if MK_MULTI
#ifndef PROBE_DUP
#define PROBE_DUP -1
#endif
    for (int k = 0; k < NPHASE; ++k) { p.ph_lo = k; p.ph_hi = k + 1; hipLaunchKernelGGL(mk_fwd<false>, dim3(grid), dim3(512), LDS_BYTES, stream, p);
        if (k == PROBE_DUP) hipLaunchKernelGGL(mk_fwd<false>, dim3(grid), dim3(512), LDS_BYTES, stream, p); }
#else
    p.ph_lo = 0; p.ph_hi = NPHASE;
    if (hipMemsetAsync((unsigned char*)d_ws + O_BAR, 0, (XCD_BAR_WORDS + 64 * 64) * 4, stream) != hipSuccess) { fprintf(stderr, "kernel_launch: memset of barrier words failed\n"); return; }
    void* args[] = {&p};
    hipError_t e = hipLaunchCooperativeKernel((const void*)mk_fwd<true>, dim3(grid), dim3(512), args, LDS_BYTES, stream);
    if (e != hipSuccess) fprintf(stderr, "cooperative launch failed: %s (grid %d)\n", hipGetErrorString(e), grid);
#endif
}
```

```cpp
#include <hip/hip_runtime.h>
#include <hip/hip_cooperative_groups.h>
#include <cstdio>
namespace cg = cooperative_groups;

#ifndef MK_MULTI
#define MK_MULTI 0
#endif

#define LAS __attribute__((address_space(3)))
typedef unsigned short bf16_t;
typedef short bf16x8 __attribute__((ext_vector_type(8)));
typedef float f32x4 __attribute__((ext_vector_type(4)));
typedef float f32x2 __attribute__((ext_vector_type(2)));
typedef unsigned u32x4 __attribute__((ext_vector_type(4)));
typedef unsigned u32x2 __attribute__((ext_vector_type(2)));

constexpr int T_ = 16384, D_ = 1024, NIN_ = 8200, DFF_ = 2816, SEQ_ = 2048;
constexpr float EPS_ = 1e-6f;
constexpr int BM = 256, BK = 64, HALF = 128, HTB = HALF * BK * 2, STAGE_BYTES = 8 * HTB;
constexpr int LDS_BYTES = 136 * 1024;
constexpr int NPHASE = 13;

constexpr size_t KiB = 1024, MiB = 1024 * 1024;
constexpr size_t O_WINT = 0, O_WMT = 16 * MiB, O_WCT = 18 * MiB, O_WOT = 20 * MiB, O_WPGT = 22 * MiB, O_WGUT = 24 * MiB, O_WDT = 35 * MiB, O_WPPT = 40 * MiB + 512 * KiB;
constexpr size_t O_IG = 41 * MiB, O_LF = O_IG + 256 * KiB, O_ZERO = O_LF + 256 * KiB;
constexpr size_t O_DENI = O_ZERO, O_HSS = O_DENI + 256 * KiB, O_SSQ1 = O_HSS + 256 * KiB, O_SSQ2 = O_SSQ1 + 64 * KiB, O_SSQ3 = O_SSQ2 + 64 * KiB, O_NSUM = O_SSQ3 + 64 * KiB;
constexpr size_t ZERO_BYTES = 960 * KiB;
constexpr size_t O_DENX = O_ZERO + ZERO_BYTES, O_EBL = O_DENX + 256 * KiB;
constexpr size_t O_RS = O_EBL + 4 * KiB;
constexpr size_t O_BAR = 43 * MiB;
constexpr size_t O_PB = 44 * MiB, O_HB = 52 * MiB, O_S1 = 84 * MiB, O_S2 = 116 * MiB, O_S3 = 148 * MiB, O_S4 = 180 * MiB, O_S5 = 212 * MiB, WS_NEED = 244 * MiB;
constexpr size_t O_PE = O_HB, O_VT = O_S1, O_U = O_S1, O_MERGED = O_S1, O_HID = O_S1, O_WQ = O_S2, O_GMC = O_S2, O_KW = O_S3, O_CINT = O_S3,
                 O_KWT = O_S4, O_HM = O_S4, O_X1B = O_S4, O_SS = O_S5, O_UC = O_S5, O_X2B = O_S5;

struct Params {
    const float* in[23];
    float* out;
    unsigned char* ws;
    int ph_lo, ph_hi;
};

__device__ __forceinline__ unsigned cvt_pk_bf16(float lo, float hi) { unsigned r; asm volatile("v_cvt_pk_bf16_f32 %0, %1, %2" : "=v"(r) : "v"(lo), "v"(hi)); return r; }
__device__ __forceinline__ float bf_lo(unsigned w) { return __uint_as_float(w << 16); }
__device__ __forceinline__ float bf_hi(unsigned w) { return __uint_as_float(w & 0xffff0000u); }
__device__ __forceinline__ float sigm(float x) { return __builtin_amdgcn_rcpf(1.0f + __builtin_amdgcn_exp2f(x * -1.4426950408889634f)); }
__device__ __forceinline__ float silu(float x) { return x * __builtin_amdgcn_rcpf(1.0f + __builtin_amdgcn_exp2f(x * -1.4426950408889634f)); }
__device__ __forceinline__ f32x4 exp2v(f32x4 t) { f32x4 e; e[0] = __builtin_amdgcn_exp2f(t[0]); e[1] = __builtin_amdgcn_exp2f(t[1]); e[2] = __builtin_amdgcn_exp2f(t[2]); e[3] = __builtin_amdgcn_exp2f(t[3]); return e; }
__device__ __forceinline__ f32x4 rcpv(f32x4 d) { f32x4 r; r[0] = __builtin_amdgcn_rcpf(d[0]); r[1] = __builtin_amdgcn_rcpf(d[1]); r[2] = __builtin_amdgcn_rcpf(d[2]); r[3] = __builtin_amdgcn_rcpf(d[3]); return r; }
__device__ __forceinline__ f32x4 sigm4(f32x4 x) { return rcpv(exp2v(x * -1.4426950408889634f) + 1.0f); }
__device__ __forceinline__ f32x4 silu4(f32x4 x) { return x * sigm4(x); }
__device__ __forceinline__ f32x2 silu2(f32x2 x) { const f32x2 t = x * -1.4426950408889634f; f32x2 d; d[0] = __builtin_amdgcn_exp2f(t[0]); d[1] = __builtin_amdgcn_exp2f(t[1]); d = d + 1.0f;
    f32x2 r; r[0] = __builtin_amdgcn_rcpf(d[0]); r[1] = __builtin_amdgcn_rcpf(d[1]); return x * r; }
__device__ __forceinline__ float wave_sum(float v) {
#pragma unroll
    for (int o = 32; o > 0; o >>= 1) v += __shfl_xor(v, o);
    return v;
}
__device__ __forceinline__ u32x4 pack8(const f32x4 a, const f32x4 b) { u32x4 w; w.x = cvt_pk_bf16(a[0], a[1]); w.y = cvt_pk_bf16(a[2], a[3]); w.z = cvt_pk_bf16(b[0], b[1]); w.w = cvt_pk_bf16(b[2], b[3]); return w; }
__device__ __forceinline__ void unpack8(const u32x4 w, f32x4& a, f32x4& b) { a[0] = bf_lo(w.x); a[1] = bf_hi(w.x); a[2] = bf_lo(w.y); a[3] = bf_hi(w.y); b[0] = bf_lo(w.z); b[1] = bf_hi(w.z); b[2] = bf_lo(w.w); b[3] = bf_hi(w.w); }

__host__ __device__ __forceinline__ int lds_byte(int r, int c) { const int st = (r >> 4) * 2 + (c >> 5), rr = r & 15, cc = c & 31, ob = rr * 64 + cc * 2; return st * 1024 + (ob ^ (((ob >> 9) & 1) << 5)); }
__host__ __device__ __forceinline__ void stage_rc(int b, int& R, int& C) { const int st = b / 1024, sb = b % 1024, swz = sb ^ (((sb >> 9) & 1) << 5); R = (st >> 1) * 16 + swz / 64; C = (st & 1) * 32 + (swz % 64) / 2; }
__host__ __device__ __forceinline__ int perm32(int rho) { const int n = rho >> 4, i = rho & 15; return 8 * (i >> 2) + 4 * n + (i & 3); }

struct Unit { const char* a; const char* b; int pm, pn, kind, cont; };
__device__ __forceinline__ void map_n4(int L, int& pm, int& pn) { const int x = L & 7, k = L >> 3; pm = x * 8 + (k & 7); pn = k >> 3; }

__device__ __forceinline__ void tile_order(int L, int nM, int nN, int& pm, int& pn) {
    const int nwg = nM * nN; int wgid = L;
    { const int q = nwg / 8, r = nwg % 8, xcd = wgid % 8, off = wgid / 8; wgid = (xcd < r ? xcd * (q + 1) : r * (q + 1) + (xcd - r) * q) + off; }
    const int nig = 8 * nN, gid = wgid / nig, fm = gid * 8, gsz = (nM - fm) < 8 ? (nM - fm) : 8;
    pm = fm + ((wgid % nig) % gsz); pn = (wgid % nig) / gsz;
}

template <class Epi, class Sched>
__device__ __forceinline__ void gemm_phase(LAS unsigned char* lds, const int K, const int lda, const int ldb, const Sched& S, const Epi& E) {
    const int tid = threadIdx.x, wid = __builtin_amdgcn_readfirstlane(tid >> 6), lane = tid & 63, wr = wid >> 2, wc = wid & 3, fr = lane & 15, fq = lane >> 4;
    const int nt = K / BK;
    unsigned voffA[2], voffB[2];
#pragma unroll
    for (int i = 0; i < 2; ++i) { int R, C; stage_rc(tid * 16 + i * 8192, R, C); const int Rb = (R & ~31) + perm32(R & 31);
        voffA[i] = (unsigned)(R * lda + C) * 2u; voffB[i] = (unsigned)(Rb * ldb + C) * 2u; }
    const size_t kstep = (size_t)(BK * 2);
    const size_t hstepA = (size_t)HALF * lda * 2, hstepB = (size_t)HALF * ldb * 2;
    const unsigned ldsw = (unsigned)wid * 1024u;
    const int aoff = lds_byte(wr * 64 + fr, fq * 8), boff = lds_byte(wc * 32 + fr, fq * 8);
#define PG8_SA(b, h) (((b) * 2 + (h)) * HTB)
#define PG8_SB(b, h) ((4 + (b) * 2 + (h)) * HTB)
#define PG8_STAGE(bufoff, gbase, voff) do { _Pragma("unroll") for (int _i = 0; _i < 2; ++_i) \
        __builtin_amdgcn_global_load_lds((const unsigned*)((const char*)(gbase) + (voff)[_i]), (LAS unsigned*)(lds + (bufoff) + ldsw + _i * 8192), 16, 0, 0); } while (0)
#define PG8_LDA(dst, b, h) do { _Pragma("unroll") for (int m = 0; m < 4; ++m) _Pragma("unroll") for (int k = 0; k < 2; ++k) dst[m][k] = *(const LAS bf16x8*)(lds + PG8_SA(b, h) + aoff + m * 2048 + k * 1024); } while (0)
#define PG8_LDB(dst, b, h) do { _Pragma("unroll") for (int n = 0; n < 2; ++n) _Pragma("unroll") for (int k = 0; k < 2; ++k) dst[n][k] = *(const LAS bf16x8*)(lds + PG8_SB(b, h) + boff + n * 2048 + k * 1024); } while (0)
#define PG8_MMA(ai, bj, At, Bt) do { __builtin_amdgcn_s_setprio(1); _Pragma("unroll") for (int m = 0; m < 4; ++m) _Pragma("unroll") for (int n = 0; n < 2; ++n) _Pragma("unroll") for (int k = 0; k < 2; ++k) \
        acc[ai][bj][m][n] = __builtin_amdgcn_mfma_f32_16x16x32_bf16(Bt[n][k], At[m][k], acc[ai][bj][m][n], 0, 0, 0); __builtin_amdgcn_s_setprio(0); } while (0)
#define PG8_WAIT_V(n) asm volatile("s_waitcnt vmcnt(" #n ")" ::: "memory")
#define PG8_WAIT_L(n) asm volatile("s_waitcnt lgkmcnt(" #n ")" ::: "memory")
#define PG8_BAR __builtin_amdgcn_s_barrier()
#define PG8_SCHED __builtin_amdgcn_sched_barrier(0)
#define PG8_ZERO() do { _Pragma("unroll") for (int a = 0; a < 2; ++a) _Pragma("unroll") for (int b = 0; b < 2; ++b) _Pragma("unroll") for (int m = 0; m < 4; ++m) _Pragma("unroll") for (int n = 0; n < 2; ++n) acc[a][b][m][n] = (f32x4){0.f, 0.f, 0.f, 0.f}; } while (0)
    Unit cur, nxt; int ui = 0;
    if (!S.next(0, cur)) return;
    E.pre(cur, wr, wc, fr, fq);
    f32x4 acc[2][2][4][2];
    PG8_ZERO();
    bf16x8 At[4][2], B0[2][2], B1[2][2];
    const char* cA = cur.a; const char* cB = cur.b;
    PG8_STAGE(PG8_SB(0, 0), cB, voffB); PG8_STAGE(PG8_SA(0, 0), cA, voffA); PG8_STAGE(PG8_SB(0, 1), cB + hstepB, voffB); PG8_STAGE(PG8_SA(0, 1), cA + hstepA, voffA);
    if (wr == 1) PG8_BAR;
    PG8_WAIT_V(4); PG8_BAR;
    PG8_STAGE(PG8_SB(1, 0), cB + kstep, voffB); PG8_STAGE(PG8_SA(1, 0), cA + kstep, voffA); PG8_STAGE(PG8_SB(1, 1), cB + hstepB + kstep, voffB);
    PG8_WAIT_V(6); PG8_BAR;
    for (;;) {
        const bool has_next = S.next(ui + 1, nxt);
        const char* nA = has_next ? nxt.a : cA; const char* nB = has_next ? nxt.b : cB;
#pragma unroll 1
        for (int t = 0; t < nt; t += 2) {
            const bool last = (t == nt - 2);
            const char* a1 = cA + (size_t)(t + 1) * kstep;
            const char* a2 = last ? nA : cA + (size_t)(t + 2) * kstep; const char* b2 = last ? nB : cB + (size_t)(t + 2) * kstep;
            const char* a3 = a2 + kstep; const char* b3 = b2 + kstep;
            PG8_LDB(B0, 0, 0); PG8_SCHED; PG8_LDA(At, 0, 0); PG8_STAGE(PG8_SA(1, 1), a1 + hstepA, voffA);
            PG8_WAIT_L(8); PG8_BAR; PG8_WAIT_L(0); PG8_MMA(0, 0, At, B0); PG8_BAR; PG8_SCHED;
            PG8_LDB(B1, 0, 1); PG8_STAGE(PG8_SB(0, 0), b2, voffB);
            PG8_BAR; PG8_WAIT_L(0); PG8_MMA(0, 1, At, B1); PG8_BAR;
            PG8_LDA(At, 0, 1); PG8_STAGE(PG8_SA(0, 0), a2, voffA);
            PG8_BAR; PG8_WAIT_L(0); PG8_MMA(1, 0, At, B0); PG8_BAR; PG8_SCHED;
            PG8_STAGE(PG8_SB(0, 1), b2 + hstepB, voffB);
            PG8_WAIT_V(6); PG8_BAR; PG8_MMA(1, 1, At, B1); PG8_BAR;
            PG8_LDB(B0, 1, 0); PG8_SCHED; PG8_LDA(At, 1, 0); PG8_STAGE(PG8_SA(0, 1), a2 + hstepA, voffA);
            PG8_WAIT_L(8); PG8_BAR; PG8_WAIT_L(0); PG8_MMA(0, 0, At, B0); PG8_BAR; PG8_SCHED;
            PG8_LDB(B1, 1, 1); PG8_STAGE(PG8_SB(1, 0), b3, voffB);
            PG8_BAR; PG8_WAIT_L(0); PG8_MMA(0, 1, At, B1); PG8_BAR;
            PG8_LDA(At, 1, 1); PG8_STAGE(PG8_SA(1, 0), a3, voffA);
            PG8_BAR; PG8_WAIT_L(0); PG8_MMA(1, 0, At, B0); PG8_BAR; PG8_SCHED;
            PG8_STAGE(PG8_SB(1, 1), b3 + hstepB, voffB);
            PG8_WAIT_V(6); PG8_BAR; PG8_MMA(1, 1, At, B1); PG8_BAR;
        }
        if (cur.cont) { E.mid(acc, cur, wr, wc, fr, fq); }
        else { if constexpr (!Epi::AFTER_DRAIN) E(acc, cur, wr, wc, fr, fq); if (!has_next) break; PG8_ZERO(); }
        cur = nxt; cA = nA; cB = nB; ++ui;
    }
    PG8_WAIT_V(0);
    if (wr == 0) PG8_BAR;
    PG8_BAR;
    if constexpr (Epi::AFTER_DRAIN) E(acc, cur, wr, wc, fr, fq);
#undef PG8_SA
#undef PG8_SB
#undef PG8_STAGE
#undef PG8_LDA
#undef PG8_LDB
#undef PG8_MMA
#undef PG8_WAIT_V
#undef PG8_WAIT_L
#undef PG8_BAR
#undef PG8_SCHED
#undef PG8_ZERO
}

typedef f32x4 Acc[2][2][4][2];
#define EPI_ROWS(ai, m) _Pragma("unroll") for (int ai = 0; ai < 2; ++ai) _Pragma("unroll") for (int m = 0; m < 4; ++m) if (epi_fence())
__device__ __forceinline__ bool epi_fence() { asm volatile("" ::: "memory"); return true; }
#define EPI_R8 _Pragma("unroll") for (int r8 = 0; r8 < 8; ++r8)
#define EPI_RL(ai, m) ((ai) * 128 + wr * 64 + (m) * 16 + fr)
#define EPI_CL(bj) ((bj) * 128 + wc * 32 + 8 * fq)

struct SchedP1 { const char* hb; const char* wint; int G, c;
    __device__ __forceinline__ bool next(int i, Unit& u) const {
        const int item = (i / 3) * G + c, r = i % 3; if (item >= 256) return false;
        const int b = item >> 5, h = (item >> 3) & 3, sc = item & 7; const int pt = b * 8 + sc;
        u.cont = 0;
        if (r < 2) { u.pm = pt; u.pn = r * 4 + h; u.kind = 0; u.a = hb + (size_t)pt * 256 * 1024 * 2; u.b = wint + (size_t)u.pn * 256 * 1024 * 2; }
        else { u.pm = h; u.pn = pt; u.kind = 1; u.a = wint + (size_t)(2048 + h * 256) * 1024 * 2; u.b = hb + (size_t)pt * 256 * 1024 * 2; }
        return true; } };
struct EpiP1 { static constexpr bool AFTER_DRAIN = false; bf16_t* qkpre; bf16_t* vt; const float* rsb;
    __device__ __forceinline__ void mid(Acc&, const Unit&, int, int, int, int) const {}
    __device__ __forceinline__ void pre(const Unit&, int, int, int, int) const {}
    __device__ __forceinline__ void operator()(Acc& acc, const Unit& u, int wr, int wc, int fr, int fq) const {
        if (u.kind == 0) {
            bf16_t* base = qkpre + (size_t)u.pm * 256 * 2048 + u.pn * 256; float rv[2][4];
#pragma unroll
            for (int ai = 0; ai < 2; ++ai)
#pragma unroll
                for (int m = 0; m < 4; ++m) rv[ai][m] = rsb[u.pm * 256 + EPI_RL(ai, m)];
            EPI_ROWS(ai, m) { bf16_t* rowp = base + (size_t)EPI_RL(ai, m) * 2048 + EPI_CL(0);
#pragma unroll
                for (int bj = 0; bj < 2; ++bj) *(u32x4*)(rowp + bj * 128) = pack8(acc[ai][bj][m][0] * rv[ai][m], acc[ai][bj][m][1] * rv[ai][m]); }
        } else {
            const int item = ((u.pn >> 3) * 4 + u.pm) * 8 + (u.pn & 7); bf16_t* base = vt + (size_t)item * 65536; f32x4 cv[2][2];
#pragma unroll
            for (int bj = 0; bj < 2; ++bj) { cv[bj][0] = *(const f32x4*)(rsb + u.pn * 256 + EPI_CL(bj)); cv[bj][1] = *(const f32x4*)(rsb + u.pn * 256 + EPI_CL(bj) + 4); }
            EPI_ROWS(ai, m) { bf16_t* rowp = base + (size_t)EPI_RL(ai, m) * 256 + EPI_CL(0);
#pragma unroll
                for (int bj = 0; bj < 2; ++bj) *(u32x4*)(rowp + bj * 128) = pack8(acc[ai][bj][m][0] * cv[bj][0], acc[ai][bj][m][1] * cv[bj][1]); }
        }
    } };

struct SchedP3 { const char* wq; const char* kw; const char* vt; const char* kwt; int G, c;
    __device__ __forceinline__ bool next(int i, Unit& u) const {
        const int L = i * G + c; if (L >= 512) return false;
        u.cont = 0; u.pn = 0;
        if (L < 256) { u.pm = L; u.kind = 0; u.a = wq + (size_t)L * 131072; u.b = kw + (size_t)L * 131072; }
        else { const int it = L - 256; u.pm = it; u.kind = 1; u.a = vt + (size_t)it * 131072; u.b = kwt + (size_t)it * 131072; }
        return true; } };
struct EpiP3 { static constexpr bool AFTER_DRAIN = false; bf16_t* s; bf16_t* lt; float* deni;
    __device__ __forceinline__ void mid(Acc&, const Unit&, int, int, int, int) const {}
    __device__ __forceinline__ void pre(const Unit&, int, int, int, int) const {}
    __device__ __forceinline__ void operator()(Acc& acc, const Unit& u, int wr, int wc, int fr, int fq) const {
        const int item = u.pm;
        if (u.kind == 0) {
            const int b = item >> 5, h = (item >> 3) & 3, sc = item & 7; const int tokb = b * SEQ_ + sc * 256;
            EPI_ROWS(ai, m) { int r = EPI_RL(ai, m); asm volatile("" : "+v"(r)); float rs = 0.f;
#pragma unroll
                for (int bj = 0; bj < 2; ++bj) { const int c0 = EPI_CL(bj); f32x4 v0 = acc[ai][bj][m][0], v1 = acc[ai][bj][m][1];
#pragma unroll
                    for (int j = 0; j < 4; ++j) { v0[j] = (c0 + j <= r) ? v0[j] : 0.f; v1[j] = (c0 + 4 + j <= r) ? v1[j] : 0.f; rs += v0[j] + v1[j]; }
                    *(u32x4*)(s + (size_t)item * 65536 + r * 256 + c0) = pack8(v0, v1); }
                rs += __shfl_xor(rs, 16); rs += __shfl_xor(rs, 32);
                if (fq == 0) unsafeAtomicAdd(deni + (size_t)(tokb + r) * 4 + h, rs); }
        } else {
            EPI_ROWS(ai, m) { bf16_t* rowp = lt + (size_t)item * 65536 + EPI_RL(ai, m) * 256 + EPI_CL(0);
#pragma unroll
                for (int bj = 0; bj < 2; ++bj) *(u32x4*)(rowp + bj * 128) = pack8(acc[ai][bj][m][0], acc[ai][bj][m][1]); }
        }
    } };

struct SchedP5 { const char* s; const char* vt; const char* wq; const char* cint; int G, c;
    __device__ __forceinline__ bool next(int i, Unit& u) const {
        const int item = (i >> 1) * G + c; if (item >= 256) return false;
        u.pm = item; u.pn = 0; u.kind = 0;
        if ((i & 1) == 0) { u.cont = 1; u.a = s + (size_t)item * 131072; u.b = vt + (size_t)item * 131072; }
        else { u.cont = 0; u.a = wq + (size_t)item * 131072; u.b = cint + (size_t)item * 131072; }
        return true; } };
struct EpiP5 { static constexpr bool AFTER_DRAIN = false; bf16_t* hm; const float* deni; const float* denx; float* hss;
    __device__ __forceinline__ void mid(Acc&, const Unit&, int, int, int, int) const {}
    __device__ __forceinline__ void pre(const Unit&, int, int, int, int) const {}
    __device__ __forceinline__ void operator()(Acc& acc, const Unit& u, int wr, int wc, int fr, int fq) const {
        const int item = u.pm; const int b = item >> 5, h = (item >> 3) & 3, sc = item & 7; const int tokb = b * SEQ_ + sc * 256;
        float dnv[2][4];
#pragma unroll
        for (int ai = 0; ai < 2; ++ai)
#pragma unroll
            for (int m = 0; m < 4; ++m) { const int t = tokb + EPI_RL(ai, m); dnv[ai][m] = deni[(size_t)t * 4 + h] + denx[(size_t)t * 4 + h]; }
        EPI_ROWS(ai, m) { const int t = tokb + EPI_RL(ai, m);
            const float den = dnv[ai][m]; const float inv = __builtin_amdgcn_rcpf(fmaxf(fabsf(den), 1.0f)); float ss = 0.f;
#pragma unroll
            for (int bj = 0; bj < 2; ++bj) { f32x4 v0 = acc[ai][bj][m][0] * inv, v1 = acc[ai][bj][m][1] * inv;
                { const f32x4 q = v0 * v0 + v1 * v1; ss += (q[0] + q[1]) + (q[2] + q[3]); }
                *(u32x4*)(hm + (size_t)t * 1024 + h * 256 + EPI_CL(bj)) = pack8(v0, v1); }
            ss += __shfl_xor(ss, 16); ss += __shfl_xor(ss, 32);
            if (fq == 0) unsafeAtomicAdd(hss + (size_t)t * 4 + h, ss); }
    } };

struct SchedP6 { const char* hb; const char* wint; int G, c;
    __device__ __forceinline__ bool next(int i, Unit& u) const {
        u.cont = 0;
        if (i == 0) { const int item = c; if (item >= 256) return false; const int b = item >> 5, h = (item >> 3) & 3, sc = item & 7;
            u.pm = b * 8 + sc; u.pn = h; u.kind = 0; u.a = hb + (size_t)u.pm * 256 * 1024 * 2; u.b = wint + (size_t)(3072 + h * 256) * 1024 * 2; return true; }
        const int L = (i - 1) * G + c; if (L >= 512) return false;
        int pm, pn; tile_order(L, 64, 8, pm, pn); u.pm = pm; u.pn = pn; u.kind = 1;
        u.a = hb + (size_t)pm * 256 * 1024 * 2; u.b = wint + (size_t)(4096 + pn * 256) * 1024 * 2; return true; } };
struct EpiP6 { static constexpr bool AFTER_DRAIN = false; bf16_t* hm; float* hss; const float* rsb; bf16_t* uu;
    __device__ __forceinline__ void mid(Acc&, const Unit&, int, int, int, int) const {}
    __device__ __forceinline__ void pre(const Unit&, int, int, int, int) const {}
    __device__ __forceinline__ void operator()(Acc& acc, const Unit& u, int wr, int wc, int fr, int fq) const {
        if (u.kind == 0) {
            float hsv[2][4], rxv[2][4];
#pragma unroll
            for (int ai = 0; ai < 2; ++ai)
#pragma unroll
                for (int m = 0; m < 4; ++m) rxv[ai][m] = rsb[u.pm * 256 + EPI_RL(ai, m)];
#pragma unroll
            for (int ai = 0; ai < 2; ++ai)
#pragma unroll
                for (int m = 0; m < 4; ++m) hsv[ai][m] = __hip_atomic_load(hss + (size_t)(u.pm * 256 + EPI_RL(ai, m)) * 4 + u.pn, __ATOMIC_RELAXED, __HIP_MEMORY_SCOPE_AGENT);
            u32x4 cur[2], nxt[2];
#pragma unroll
            for (int bj = 0; bj < 2; ++bj) cur[bj] = *(const u32x4*)(hm + (size_t)(u.pm * 256 + EPI_RL(0, 0)) * 1024 + u.pn * 256 + EPI_CL(bj));
            EPI_R8 { const int ai = r8 >> 2, m = r8 & 3; const int t = u.pm * 256 + EPI_RL(ai, m);
                if (r8 < 7) { const int tn = u.pm * 256 + EPI_RL((r8 + 1) >> 2, (r8 + 1) & 3);
#pragma unroll
                    for (int bj = 0; bj < 2; ++bj) nxt[bj] = *(const u32x4*)(hm + (size_t)tn * 1024 + u.pn * 256 + EPI_CL(bj)); }
                const float rsn = rsqrtf(hsv[ai][m] * (1.0f / 256.0f) + EPS_); const float rx = rxv[ai][m];
#pragma unroll
                for (int bj = 0; bj < 2; ++bj) { f32x4 h0, h1; unpack8(cur[bj], h0, h1);
                    const f32x4 o0 = h0 * rsn * sigm4(acc[ai][bj][m][0] * rx), o1 = h1 * rsn * sigm4(acc[ai][bj][m][1] * rx);
                    *(u32x4*)(hm + (size_t)t * 1024 + u.pn * 256 + EPI_CL(bj)) = pack8(o0, o1); }
                cur[0] = nxt[0]; cur[1] = nxt[1]; }
        } else {
            float rxv[2][4];
#pragma unroll
            for (int ai = 0; ai < 2; ++ai)
#pragma unroll
                for (int m = 0; m < 4; ++m) rxv[ai][m] = rsb[u.pm * 256 + EPI_RL(ai, m)];
            EPI_ROWS(ai, m) { const int t = u.pm * 256 + EPI_RL(ai, m); const float rx = rxv[ai][m];
                const f32x4 o0 = acc[ai][0][m][0] * rx * sigm4(acc[ai][1][m][0] * rx), o1 = acc[ai][0][m][1] * rx * sigm4(acc[ai][1][m][1] * rx);
                *(u32x4*)(uu + (size_t)t * 1024 + u.pn * 128 + wc * 32 + 8 * fq) = pack8(o0, o1); }
        }
    } };

struct SchedP8 { const char* hb; const char* wint; const char* hmg; const char* uc; const char* wmt; const char* wct; int G, c;
    __device__ __forceinline__ bool next(int i, Unit& u) const {
        const int L = (i >> 2) * G + c, r = i & 3; if (L >= 256) return false;
        int pn; map_n4(L, u.pm, pn); u.cont = 0;
        if (r < 2) { u.kind = 2; u.pn = 2 * pn + r; u.a = hb + (size_t)u.pm * 256 * 1024 * 2; u.b = wint + (size_t)(6144 + u.pn * 256) * 1024 * 2; }
        else if (r == 2) { u.kind = 0; u.pn = pn; u.a = hmg + (size_t)u.pm * 256 * 1024 * 2; u.b = wmt + (size_t)pn * 256 * 1024 * 2; }
        else { u.kind = 1; u.pn = pn; u.a = uc + (size_t)u.pm * 256 * 1024 * 2; u.b = wct + (size_t)pn * 256 * 1024 * 2; }
        return true; } };
struct EpiP8 { static constexpr bool AFTER_DRAIN = false; bf16_t* gmc; bf16_t* tmp; bf16_t* merged; const float* rsb;
    __device__ __forceinline__ void mid(Acc&, const Unit&, int, int, int, int) const {}
    __device__ __forceinline__ void pre(const Unit&, int, int, int, int) const {}
    __device__ __forceinline__ void operator()(Acc& acc, const Unit& u, int wr, int wc, int fr, int fq) const {
        if (u.kind == 2) {
            float rxv[2][4];
#pragma unroll
            for (int ai = 0; ai < 2; ++ai)
#pragma unroll
                for (int m = 0; m < 4; ++m) rxv[ai][m] = rsb[u.pm * 256 + EPI_RL(ai, m)];
            EPI_ROWS(ai, m) { const int t = u.pm * 256 + EPI_RL(ai, m); const float rx = rxv[ai][m], rxe = rx * -1.4426950408889634f;
                const f32x4 d0 = exp2v(acc[ai][1][m][0] * rxe) + 1.0f, d1 = exp2v(acc[ai][1][m][1] * rxe) + 1.0f;
                const f32x4 r0 = sigm4(acc[ai][0][m][0] * rx) * d0, r1 = sigm4(acc[ai][0][m][1] * rx) * d1, c0 = rcpv(d0), c1 = rcpv(d1);
                bf16_t* ptr = gmc + (size_t)t * 2048 + u.pn * 128 + wc * 32 + 8 * fq;
                *(u32x4*)ptr = pack8(r0, r1); *(u32x4*)(ptr + 1024) = pack8(c0, c1); }
        } else if (u.kind == 0) {
            u32x4 cur[2], nxt[2];
#pragma unroll
            for (int bj = 0; bj < 2; ++bj) cur[bj] = *(const u32x4*)(gmc + (size_t)(u.pm * 256 + EPI_RL(0, 0)) * 2048 + u.pn * 256 + EPI_CL(bj));
            EPI_R8 { const int ai = r8 >> 2, m = r8 & 3; const int t = u.pm * 256 + EPI_RL(ai, m);
                if (r8 < 7) { const int tn = u.pm * 256 + EPI_RL((r8 + 1) >> 2, (r8 + 1) & 3);
#pragma unroll
                    for (int bj = 0; bj < 2; ++bj) nxt[bj] = *(const u32x4*)(gmc + (size_t)tn * 2048 + u.pn * 256 + EPI_CL(bj)); }
#pragma unroll
                for (int bj = 0; bj < 2; ++bj) { const int c = u.pn * 256 + EPI_CL(bj); f32x4 a0, a1; unpack8(cur[bj], a0, a1);
                    *(u32x4*)(tmp + (size_t)t * 1024 + c) = pack8(acc[ai][bj][m][0] * a0, acc[ai][bj][m][1] * a1); }
                cur[0] = nxt[0]; cur[1] = nxt[1]; }
        } else {
            u32x4 cg[2], ct[2], ng[2], nt2[2];
#pragma unroll
            for (int bj = 0; bj < 2; ++bj) { const int t0 = u.pm * 256 + EPI_RL(0, 0); const int c = u.pn * 256 + EPI_CL(bj);
                cg[bj] = *(const u32x4*)(gmc + (size_t)t0 * 2048 + 1024 + c); ct[bj] = *(const u32x4*)(tmp + (size_t)t0 * 1024 + c); }
            EPI_R8 { const int ai = r8 >> 2, m = r8 & 3; const int t = u.pm * 256 + EPI_RL(ai, m);
                if (r8 < 7) { const int tn = u.pm * 256 + EPI_RL((r8 + 1) >> 2, (r8 + 1) & 3);
#pragma unroll
                    for (int bj = 0; bj < 2; ++bj) { const int c = u.pn * 256 + EPI_CL(bj); ng[bj] = *(const u32x4*)(gmc + (size_t)tn * 2048 + 1024 + c); nt2[bj] = *(const u32x4*)(tmp + (size_t)tn * 1024 + c); } }
#pragma unroll
                for (int bj = 0; bj < 2; ++bj) { const int c = u.pn * 256 + EPI_CL(bj); f32x4 b0, b1, t0, t1; unpack8(cg[bj], b0, b1); unpack8(ct[bj], t0, t1);
                    *(u32x4*)(merged + (size_t)t * 1024 + c) = pack8((acc[ai][bj][m][0] + t0) * b0, (acc[ai][bj][m][1] + t1) * b1); }
                cg[0] = ng[0]; cg[1] = ng[1]; ct[0] = nt2[0]; ct[1] = nt2[1]; }
        }
    } };

struct SchedN4 { const char* a; const char* bt; size_t astep, bstep; int G, c;
    __device__ __forceinline__ bool next(int i, Unit& u) const {
        const int L = i * G + c; if (L >= 256) return false;
        map_n4(L, u.pm, u.pn); u.kind = 0; u.cont = 0; u.a = a + (size_t)u.pm * astep; u.b = bt + (size_t)u.pn * bstep; return true; } };
struct SchedPE { const char* a; const char* bt; int G, c;
    __device__ __forceinline__ bool next(int i, Unit& u) const {
        const int L = i * G + c; if (L >= 256 || c < 0) return false;
        u.pm = L >> 2; u.pn = L & 3; u.kind = 0; u.cont = 0; u.a = a + (size_t)u.pm * 256 * 256 * 2; u.b = bt + (size_t)u.pn * 256 * 256 * 2; return true; } };
template <bool SRC_BF16> struct EpiRes { static constexpr bool AFTER_DRAIN = false; const void* src; bf16_t* dstb; float* ssq;
    __device__ __forceinline__ void mid(Acc&, const Unit&, int, int, int, int) const {}
    __device__ __forceinline__ void pre(const Unit& u, int wr, int wc, int fr, int fq) const {
        if (!SRC_BF16) {
            EPI_ROWS(ai, m) { const int t = u.pm * 256 + EPI_RL(ai, m);
#pragma unroll
                for (int bj = 0; bj < 2; ++bj) { const float v = *((const float*)src + (size_t)t * 1024 + u.pn * 256 + EPI_CL(bj)); asm volatile("" :: "v"(v)); } }
        }
    }
    __device__ __forceinline__ void operator()(Acc& acc, const Unit& u, int wr, int wc, int fr, int fq) const {
        f32x4 rb[3][2][2];
#define ERES_LOAD(dst, t_) do { _Pragma("unroll") for (int bj = 0; bj < 2; ++bj) { const size_t o_ = (size_t)(t_) * 1024 + u.pn * 256 + EPI_CL(bj); \
            if (SRC_BF16) dst[bj][0] = __builtin_bit_cast(f32x4, *(const u32x4*)((const bf16_t*)src + o_)); \
            else { dst[bj][0] = *(const f32x4*)((const float*)src + o_); dst[bj][1] = *(const f32x4*)((const float*)src + o_ + 4); } } } while (0)
        ERES_LOAD(rb[0], u.pm * 256 + EPI_RL(0, 0)); ERES_LOAD(rb[1], u.pm * 256 + EPI_RL(0, 1));
        EPI_R8 { const int ai = r8 >> 2, m = r8 & 3; const int t = u.pm * 256 + EPI_RL(ai, m); float ss = 0.f;
            if (r8 < 6) ERES_LOAD(rb[(r8 + 2) % 3], u.pm * 256 + EPI_RL((r8 + 2) >> 2, (r8 + 2) & 3));
#pragma unroll
            for (int bj = 0; bj < 2; ++bj) { const size_t o = (size_t)t * 1024 + u.pn * 256 + EPI_CL(bj); f32x4 v0, v1;
                if (SRC_BF16) unpack8(__builtin_bit_cast(u32x4, rb[r8 % 3][bj][0]), v0, v1); else { v0 = rb[r8 % 3][bj][0]; v1 = rb[r8 % 3][bj][1]; }
                v0 += acc[ai][bj][m][0]; v1 += acc[ai][bj][m][1];
                { const f32x4 q = v0 * v0 + v1 * v1; ss += (q[0] + q[1]) + (q[2] + q[3]); }
                *(u32x4*)(dstb + o) = pack8(v0, v1); }
            ss += __shfl_xor(ss, 16); ss += __shfl_xor(ss, 32);
            if (fq == 0) unsafeAtomicAdd(ssq + t, ss); }
#undef ERES_LOAD
    } };

struct SchedP10 { const char* x1b; const char* wgut; int G, c;
    __device__ __forceinline__ bool next(int i, Unit& u) const {
        const int L = i * G + c; if (L >= 1408) return false;
        int pm, pn; tile_order(L, 64, 22, pm, pn); u.pm = pm; u.pn = pn; u.kind = 0; u.cont = 0;
        u.a = x1b + (size_t)pm * 256 * 1024 * 2; u.b = wgut + (size_t)pn * 256 * 1024 * 2; return true; } };
struct EpiP10 { static constexpr bool AFTER_DRAIN = false; const float* ssq; bf16_t* hid;
    __device__ __forceinline__ void mid(Acc&, const Unit&, int, int, int, int) const {}
    __device__ __forceinline__ void pre(const Unit&, int, int, int, int) const {}
    __device__ __forceinline__ void operator()(Acc& acc, const Unit& u, int wr, int wc, int fr, int fq) const {
        float rsv[2][4];
#pragma unroll
        for (int ai = 0; ai < 2; ++ai)
#pragma unroll
            for (int m = 0; m < 4; ++m) rsv[ai][m] = ssq[u.pm * 256 + EPI_RL(ai, m)];
        EPI_ROWS(ai, m) { const int t = u.pm * 256 + EPI_RL(ai, m); const float rs = rsqrtf(rsv[ai][m] * (1.0f / 1024.0f) + EPS_);
            const f32x4 o0 = silu4(acc[ai][0][m][0] * rs) * (acc[ai][1][m][0] * rs), o1 = silu4(acc[ai][0][m][1] * rs) * (acc[ai][1][m][1] * rs);
            *(u32x4*)(hid + (size_t)t * DFF_ + u.pn * 128 + wc * 32 + 8 * fq) = pack8(o0, o1); }
    } };

struct EpiBf { static constexpr bool AFTER_DRAIN = false; bf16_t* o;
    __device__ __forceinline__ void mid(Acc&, const Unit&, int, int, int, int) const {}
    __device__ __forceinline__ void pre(const Unit&, int, int, int, int) const {}
    __device__ __forceinline__ void operator()(Acc& acc, const Unit& u, int wr, int wc, int fr, int fq) const {
        EPI_ROWS(ai, m) { bf16_t* rowp = o + (size_t)(u.pm * 256 + EPI_RL(ai, m)) * 1024 + u.pn * 256 + EPI_CL(0);
#pragma unroll
            for (int bj = 0; bj < 2; ++bj) *(u32x4*)(rowp + bj * 128) = pack8(acc[ai][bj][m][0], acc[ai][bj][m][1]); }
    } };

struct EpiP12 { static constexpr bool AFTER_DRAIN = true; const float* ssq2; const bf16_t* pe; const bf16_t* xin; float* out; float* ssq3; unsigned* done; const float* fg;
    __device__ __forceinline__ void mid(Acc&, const Unit&, int, int, int, int) const {}
    __device__ __forceinline__ void pre(const Unit&, int, int, int, int) const {}
    __device__ __forceinline__ void operator()(Acc& acc, const Unit& u, int wr, int wc, int fr, int fq) const {
        float rsv[2][4];
#pragma unroll
        for (int ai = 0; ai < 2; ++ai)
#pragma unroll
            for (int m = 0; m < 4; ++m) rsv[ai][m] = ssq2[u.pm * 256 + EPI_RL(ai, m)];
        { u32x4 cx[2], cp[2], nx[2], np[2];
#pragma unroll
            for (int bj = 0; bj < 2; ++bj) { const size_t o = (size_t)(u.pm * 256 + EPI_RL(0, 0)) * 1024 + u.pn * 256 + EPI_CL(bj); cx[bj] = *(const u32x4*)(xin + o); cp[bj] = *(const u32x4*)(pe + o); }
            EPI_R8 { const int ai = r8 >> 2, m = r8 & 3; const int t = u.pm * 256 + EPI_RL(ai, m); const float rs = rsqrtf(rsv[ai][m] * (1.0f / 1024.0f) + EPS_); float ss = 0.f;
                if (r8 < 7) {
#pragma unroll
                    for (int bj = 0; bj < 2; ++bj) { const size_t o = (size_t)(u.pm * 256 + EPI_RL((r8 + 1) >> 2, (r8 + 1) & 3)) * 1024 + u.pn * 256 + EPI_CL(bj); nx[bj] = *(const u32x4*)(xin + o); np[bj] = *(const u32x4*)(pe + o); } }
#pragma unroll
                for (int bj = 0; bj < 2; ++bj) { f32x4 p0, p1, v0, v1; unpack8(cp[bj], p0, p1); unpack8(cx[bj], v0, v1);
                    v0 += sigm4(acc[ai][bj][m][0] * rs) * p0; v1 += sigm4(acc[ai][bj][m][1] * rs) * p1;
                    { const f32x4 q = v0 * v0 + v1 * v1; ss += (q[0] + q[1]) + (q[2] + q[3]); }
                    acc[ai][bj][m][0] = v0; acc[ai][bj][m][1] = v1; }
                ss += __shfl_xor(ss, 16); ss += __shfl_xor(ss, 32);
                if (fq == 0) unsafeAtomicAdd(ssq3 + t, ss);
                cx[0] = nx[0]; cx[1] = nx[1]; cp[0] = np[0]; cp[1] = np[1]; } }
        asm volatile("s_waitcnt vmcnt(0)" ::: "memory");
        unsigned* cnt = done + 64 * u.pm;
        if ((threadIdx.x & 63) == 0) __hip_atomic_fetch_add(cnt, 1u, __ATOMIC_RELAXED, __HIP_MEMORY_SCOPE_AGENT);
        { unsigned sp = 0; while (__hip_atomic_load(cnt, __ATOMIC_RELAXED, __HIP_MEMORY_SCOPE_AGENT) < 32u) { __builtin_amdgcn_s_sleep(1); if (++sp > (1u << 22)) break; } }
#pragma unroll
        for (int ai = 0; ai < 2; ++ai)
#pragma unroll
            for (int m = 0; m < 4; ++m) rsv[ai][m] = __hip_atomic_load(ssq3 + u.pm * 256 + EPI_RL(ai, m), __ATOMIC_RELAXED, __HIP_MEMORY_SCOPE_AGENT);
        f32x4 gv[2][2];
#pragma unroll
        for (int bj = 0; bj < 2; ++bj) { const int cc = u.pn * 256 + EPI_CL(bj); gv[bj][0] = *(const f32x4*)(fg + cc); gv[bj][1] = *(const f32x4*)(fg + cc + 4); }
        EPI_ROWS(ai, m) { const int t = u.pm * 256 + EPI_RL(ai, m);
            const float rs = rsqrtf(rsv[ai][m] * (1.0f / 1024.0f) + EPS_);
#pragma unroll
            for (int bj = 0; bj < 2; ++bj) { const size_t o = (size_t)t * 1024 + u.pn * 256 + EPI_CL(bj);
                *(f32x4*)(out + o) = acc[ai][bj][m][0] * rs * gv[bj][0]; *(f32x4*)(out + o + 4) = acc[ai][bj][m][1] * rs * gv[bj][1]; } }
    } };

struct CvtTile { const float* src; int ld; const float* scale; bf16_t* dst; int dstld; };
__device__ __forceinline__ CvtTile cvt_tile_params(const Params& p, int tl) {
    const int NT0 = 2048, NT4 = NT0 + 1024, NT5 = NT4 + 1408, NT6 = NT5 + 704;
    unsigned char* ws = p.ws; CvtTile t; t.scale = nullptr;
    if (tl < NT0) { const int nb = tl >> 4, kb = tl & 15; const int n0 = nb * 64; int col;
        if (n0 < 4096) col = n0; else if (n0 < 6144) { const int j = (n0 - 4096) >> 8, r = (n0 - 4096) & 255; col = (r < 128) ? (4104 + 128 * j + r) : (5128 + 128 * j + r - 128); }
        else { const int j = (n0 - 6144) >> 8, r = (n0 - 6144) & 255; col = 6152 + ((r < 128) ? (128 * j + r) : (1024 + 128 * j + r - 128)); }
        t.src = p.in[3] + (size_t)kb * 64 * NIN_ + col; t.ld = NIN_; t.scale = p.in[2] + kb * 64; t.dst = (bf16_t*)(ws + O_WINT) + (size_t)n0 * 1024 + kb * 64; t.dstld = 1024; }
    else if (tl < NT4) { const int w = (tl - NT0) >> 8, l = (tl - NT0) & 255; const int nb = l >> 4, kb = l & 15;
        const float* base = w == 0 ? p.in[12] : (w == 1 ? p.in[13] : (w == 2 ? p.in[14] : p.in[20])); const size_t od = w == 0 ? O_WMT : (w == 1 ? O_WCT : (w == 2 ? O_WOT : O_WPGT));
        t.src = base + (size_t)kb * 64 * 1024 + nb * 64; t.ld = 1024; if (w == 3) t.scale = p.in[19] + kb * 64; if (w == 0) t.scale = p.in[7] + kb * 64; t.dst = (bf16_t*)(ws + od) + (size_t)nb * 64 * 1024 + kb * 64; t.dstld = 1024; }
    else if (tl < NT5) { const int l = tl - NT4; const int nb = l >> 4, kb = l & 15; const int n0 = nb * 64; const int j = n0 >> 8, r = n0 & 255;
        const float* base = (r < 128) ? p.in[16] : p.in[17]; const int col = 128 * j + (r & 127);
        t.src = base + (size_t)kb * 64 * DFF_ + col; t.ld = DFF_; t.scale = p.in[15] + kb * 64; t.dst = (bf16_t*)(ws + O_WGUT) + (size_t)n0 * 1024 + kb * 64; t.dstld = 1024; }
    else if (tl < NT6) { const int l = tl - NT5; const int nb = l / 44, kb = l % 44;
        t.src = p.in[18] + (size_t)kb * 64 * 1024 + nb * 64; t.ld = 1024; t.dst = (bf16_t*)(ws + O_WDT) + (size_t)nb * 64 * DFF_ + kb * 64; t.dstld = DFF_; }
    else { const int l = tl - NT6; const int nb = l >> 2, kb = l & 3;
        t.src = p.in[21] + (size_t)kb * 64 * 1024 + nb * 64; t.ld = 1024; t.dst = (bf16_t*)(ws + O_WPPT) + (size_t)nb * 64 * 256 + kb * 64; t.dstld = 256; }
    return t;
}
__device__ __forceinline__ void cvt_tile_load(const CvtTile& t, f32x4 (&v)[2]) {
    const int tid = threadIdx.x, kk = tid >> 4, c4 = (tid & 15) * 4;
#pragma unroll
    for (int pss = 0; pss < 2; ++pss) { const int k = kk + pss * 32; v[pss] = *(const f32x4*)(t.src + (size_t)k * t.ld + c4); if (t.scale) v[pss] = v[pss] * t.scale[k]; }
}

__device__ __forceinline__ void phase0(const Params& p, unsigned char* sm) {
    unsigned char* ws = p.ws;
    const int tid = threadIdx.x, lane = tid & 63, wid = tid >> 6;
    const size_t gtid = (size_t)blockIdx.x * 512 + tid, gthreads = (size_t)gridDim.x * 512;
    for (size_t i = gtid; i < ZERO_BYTES / 16; i += gthreads) ((u32x4*)(ws + O_ZERO))[i] = (u32x4){0u, 0u, 0u, 0u};
    { const float* pp = p.in[1]; bf16_t* pb = (bf16_t*)(ws + O_PB);
        for (size_t i = gtid; i < (size_t)T_ * 256 / 8; i += gthreads) { const f32x4 a = *(const f32x4*)(pp + i * 8), b = *(const f32x4*)(pp + i * 8 + 4); *(u32x4*)(pb + i * 8) = pack8(a, b); } }
    { const float* x = p.in[0]; const float* g = p.in[2]; const float* win = p.in[3]; const float* bif = p.in[4];
        float* wgT = (float*)sm;
        for (int idx = tid; idx < 8192; idx += 512) { const int k = idx >> 3, j = idx & 7; wgT[j * 1024 + k] = win[(size_t)k * NIN_ + 4096 + j] * g[k]; }
        __syncthreads();
        bf16_t* hb = (bf16_t*)(ws + O_HB); float* ig = (float*)(ws + O_IG); float* lf = (float*)(ws + O_LF);
        const int rstep = gridDim.x * 8; int row = blockIdx.x * 8 + wid;
        f32x4 xn[4];
#pragma unroll
        for (int i = 0; i < 4; ++i) xn[i] = (row < T_) ? *(const f32x4*)(x + (size_t)row * 1024 + i * 256 + lane * 4) : (f32x4){0.f, 0.f, 0.f, 0.f};
        for (; row < T_; row += rstep) {
            f32x4 xv[4]; float ss = 0.f;
#pragma unroll
            for (int i = 0; i < 4; ++i) { xv[i] = xn[i]; ss += xv[i][0] * xv[i][0] + xv[i][1] * xv[i][1] + xv[i][2] * xv[i][2] + xv[i][3] * xv[i][3]; }
            { const int nrow = row + rstep;
                if (nrow < T_) {
#pragma unroll
                    for (int i = 0; i < 4; ++i) xn[i] = *(const f32x4*)(x + (size_t)nrow * 1024 + i * 256 + lane * 4); } }
            ss = wave_sum(ss); const float rs = rsqrtf(ss * (1.0f / 1024.0f) + EPS_);
            float d[8];
#pragma unroll
            for (int j = 0; j < 8; ++j) d[j] = 0.f;
            if (lane == 0) ((float*)(ws + O_RS))[row] = rs;
#pragma unroll
            for (int i = 0; i < 4; ++i) { const f32x4 hn = xv[i] * rs;
                u32x2 w; w.x = cvt_pk_bf16(xv[i][0], xv[i][1]); w.y = cvt_pk_bf16(xv[i][2], xv[i][3]); *(u32x2*)(hb + (size_t)row * 1024 + i * 256 + lane * 4) = w;
#pragma unroll
                for (int j = 0; j < 8; ++j) { const f32x4 wv = *(const f32x4*)(wgT + j * 1024 + i * 256 + lane * 4); d[j] += hn[0] * wv[0] + hn[1] * wv[1] + hn[2] * wv[2] + hn[3] * wv[3]; } }
#pragma unroll
            for (int j = 0; j < 8; ++j) d[j] = wave_sum(d[j]);
            if (lane < 8) { float v = d[0];
#pragma unroll
                for (int j = 1; j < 8; ++j) v = (lane == j) ? d[j] : v;
                v += bif[lane];
                if (lane < 4) ig[(size_t)row * 4 + lane] = v;
                else { const float z = v; lf[(size_t)row * 4 + lane - 4] = fminf(z, 0.f) - log1pf(__expf(-fabsf(z))); } }
        }
        __syncthreads();
    }
    { const int NTILES = 2048 + 1024 + 1408 + 704 + 64; const int gs = gridDim.x;
        float* tl = (float*)sm;
        int t = blockIdx.x; CvtTile c0{}, c1{}; f32x4 v0[2], v1[2];
        if (t < NTILES) { c0 = cvt_tile_params(p, t); cvt_tile_load(c0, v0); }
        if (t + gs < NTILES) { c1 = cvt_tile_params(p, t + gs); cvt_tile_load(c1, v1); }
        for (; t < NTILES; t += gs) {
            { const int kk = tid >> 4, c4 = (tid & 15) * 4;
#pragma unroll
                for (int pss = 0; pss < 2; ++pss) { const int k = kk + pss * 32;
#pragma unroll
                    for (int j = 0; j < 4; ++j) tl[k * 65 + c4 + j] = v0[pss][j]; } }
            __syncthreads();
            const CvtTile done = c0; c0 = c1; v0[0] = v1[0]; v0[1] = v1[1];
            { const int tn = t + 2 * gs; if (tn < NTILES) { c1 = cvt_tile_params(p, tn); cvt_tile_load(c1, v1); } }
            { const int n = tid >> 3, k8 = (tid & 7) * 8; float e[8];
#pragma unroll
                for (int q = 0; q < 8; ++q) e[q] = tl[(k8 + q) * 65 + n];
                u32x4 w; w.x = cvt_pk_bf16(e[0], e[1]); w.y = cvt_pk_bf16(e[2], e[3]); w.z = cvt_pk_bf16(e[4], e[5]); w.w = cvt_pk_bf16(e[6], e[7]);
                *(u32x4*)(done.dst + (size_t)n * done.dstld + k8) = w; }
            __syncthreads();
        }
    }
}

__device__ __forceinline__ void phase2(const Params& p, unsigned char* sm) {
    unsigned char* ws = p.ws;
    const int tid = threadIdx.x, lane = tid & 63, wid = tid >> 6;
    float* rowfac = (float*)sm; float* colfac = rowfac + 256; float* wsum = colfac + 256;
    const float* ig = (const float*)(ws + O_IG); const float* lf = (const float*)(ws + O_LF);
    const bf16_t* qkpre = (const bf16_t*)p.out;
    const float* cw = p.in[5]; const float* cb = p.in[6];
    for (int item = blockIdx.x; item < 256; item += gridDim.x) {
        const int b = item >> 5, h = (item >> 3) & 3, sc = item & 7; const int tokb = b * SEQ_ + sc * 256;
        float v = 0.f, igv = 0.f;
        if (tid < 256) { v = lf[(size_t)(tokb + tid) * 4 + h]; igv = ig[(size_t)(tokb + tid) * 4 + h]; }
#pragma unroll
        for (int o = 1; o < 64; o <<= 1) { const float n = __shfl_up(v, o); if (lane >= o) v += n; }
        if (tid < 256 && lane == 63) wsum[wid] = v;
        __syncthreads();
        if (tid < 256) { float add = 0.f; for (int j = 0; j < wid; ++j) add += wsum[j]; v += add; rowfac[tid] = __expf(v); colfac[tid] = __expf(igv - v);
            if (tid == 255) ((float*)(ws + O_EBL))[item] = __expf(v); }
        __syncthreads();
#pragma unroll 1
        for (int qt = 0; qt < 4; ++qt) {
        const int cp = tid & 127, tg = tid >> 7; const int ch = 2 * cp; const int tl0 = qt * 64 + tg * 16; const int s0 = sc * 256 + tl0;
        { const int col = h * 256 + ch; f32x2 xx[19];
#pragma unroll
            for (int i = 0; i < 19; ++i) { const int s = s0 - 3 + i; unsigned w = 0u; if (s >= 0) w = *(const unsigned*)(qkpre + (size_t)(b * SEQ_ + s) * 2048 + col); xx[i] = (f32x2){bf_lo(w), bf_hi(w)}; }
            f32x2 wv[4];
#pragma unroll
            for (int k = 0; k < 4; ++k) wv[k] = *(const f32x2*)(cw + (size_t)k * 2048 + col);
            const f32x2 bv = *(const f32x2*)(cb + col);
            bf16_t* wq = (bf16_t*)(ws + O_WQ) + (size_t)item * 65536;
#pragma unroll
            for (int i = 0; i < 16; ++i) { f32x2 y = bv;
#pragma unroll
                for (int k = 0; k < 4; ++k) y = __builtin_elementwise_fma(xx[i + k], wv[k], y);
                const f32x2 o = silu2(y) * (rowfac[tl0 + i] * 0.0625f);
                *(unsigned*)(wq + (size_t)(tl0 + i) * 256 + ch) = cvt_pk_bf16(o[0], o[1]); } }
        { const int col = 1024 + h * 256 + ch; f32x2 xx[19];
#pragma unroll
            for (int i = 0; i < 19; ++i) { const int s = s0 - 3 + i; unsigned w = 0u; if (s >= 0) w = *(const unsigned*)(qkpre + (size_t)(b * SEQ_ + s) * 2048 + col); xx[i] = (f32x2){bf_lo(w), bf_hi(w)}; }
            f32x2 wv[4];
#pragma unroll
            for (int k = 0; k < 4; ++k) wv[k] = *(const f32x2*)(cw + (size_t)k * 2048 + col);
            const f32x2 bv = *(const f32x2*)(cb + col);
            bf16_t* kw = (bf16_t*)(ws + O_KW) + (size_t)item * 65536; bf16_t* kwt = (bf16_t*)(ws + O_KWT) + (size_t)item * 65536;
            float k0[16], k1[16]; f32x2 nn = {0.f, 0.f};
#pragma unroll
            for (int i = 0; i < 16; ++i) { f32x2 y = bv;
#pragma unroll
                for (int k = 0; k < 4; ++k) y = __builtin_elementwise_fma(xx[i + k], wv[k], y);
                const f32x2 o = silu2(y) * colfac[tl0 + i]; k0[i] = o[0]; k1[i] = o[1]; nn += o;
                *(unsigned*)(kw + (size_t)(tl0 + i) * 256 + ch) = cvt_pk_bf16(o[0], o[1]); }
            const float n0 = nn[0], n1 = nn[1];
            u32x4 a, c;
            a.x = cvt_pk_bf16(k0[0], k0[1]); a.y = cvt_pk_bf16(k0[2], k0[3]); a.z = cvt_pk_bf16(k0[4], k0[5]); a.w = cvt_pk_bf16(k0[6], k0[7]);
            c.x = cvt_pk_bf16(k0[8], k0[9]); c.y = cvt_pk_bf16(k0[10], k0[11]); c.z = cvt_pk_bf16(k0[12], k0[13]); c.w = cvt_pk_bf16(k0[14], k0[15]);
            *(u32x4*)(kwt + (size_t)ch * 256 + tl0) = a; *(u32x4*)(kwt + (size_t)ch * 256 + tl0 + 8) = c;
            a.x = cvt_pk_bf16(k1[0], k1[1]); a.y = cvt_pk_bf16(k1[2], k1[3]); a.z = cvt_pk_bf16(k1[4], k1[5]); a.w = cvt_pk_bf16(k1[6], k1[7]);
            c.x = cvt_pk_bf16(k1[8], k1[9]); c.y = cvt_pk_bf16(k1[10], k1[11]); c.z = cvt_pk_bf16(k1[12], k1[13]); c.w = cvt_pk_bf16(k1[14], k1[15]);
            *(u32x4*)(kwt + (size_t)(ch + 1) * 256 + tl0) = a; *(u32x4*)(kwt + (size_t)(ch + 1) * 256 + tl0 + 8) = c;
            float* nsum = (float*)(ws + O_NSUM) + (size_t)item * 256;
            unsafeAtomicAdd(nsum + ch, n0); unsafeAtomicAdd(nsum + ch + 1, n1); }
        }
        __syncthreads();
    }
}

__device__ __forceinline__ void phase4(const Params& p, unsigned char* sm) {
    unsigned char* ws = p.ws;
    const int tid = threadIdx.x;
    const float* ebl = (const float*)(ws + O_EBL);
    const bf16_t* lt = (const bf16_t*)(p.ws + O_KWT);
    bf16_t* cint = (bf16_t*)(ws + O_CINT);
    const size_t gtid = (size_t)blockIdx.x * 512 + tid, gthreads = (size_t)gridDim.x * 512;
#pragma unroll 2
    for (size_t g = gtid; g < (size_t)32 * 16384; g += gthreads) {
        const int bh = (int)(g >> 14), e4 = (int)(g & 16383);
        f32x4 c = {0.f, 0.f, 0.f, 0.f};
        u32x2 lw[7]; float eb[7];
#pragma unroll
        for (int sc = 0; sc < 7; ++sc) { lw[sc] = *(const u32x2*)(lt + (size_t)(bh * 8 + sc) * 65536 + e4 * 4); eb[sc] = ebl[bh * 8 + sc]; }
#pragma unroll
        for (int sc = 0; sc < 8; ++sc) { const int item = bh * 8 + sc;
            u32x2 w; w.x = cvt_pk_bf16(c[0], c[1]); w.y = cvt_pk_bf16(c[2], c[3]); *(u32x2*)(cint + (size_t)item * 65536 + e4 * 4) = w;
            if (sc < 7) { const f32x4 l = {bf_lo(lw[sc].x), bf_hi(lw[sc].x), bf_lo(lw[sc].y), bf_hi(lw[sc].y)}; c = (c + l) * eb[sc]; } }
    }
    float* nin = (float*)sm;
    const float* nsum = (const float*)(ws + O_NSUM);
    float* denx = (float*)(ws + O_DENX);
    for (int item = blockIdx.x; item < 256; item += gridDim.x) {
        const int b = item >> 5, h = (item >> 3) & 3, sc = item & 7; const int tokb = b * SEQ_ + sc * 256; const int bh = item >> 3;
        if (tid < 256) { float eb[7], ns[7];
#pragma unroll
            for (int j = 0; j < 7; ++j) { eb[j] = ebl[bh * 8 + j]; ns[j] = nsum[(size_t)(bh * 8 + j) * 256 + tid]; }
            float nv = 0.f;
#pragma unroll
            for (int j = 0; j < 7; ++j) if (j < sc) nv = eb[j] * (nv + ns[j]);
            nin[tid] = nv; }
        __syncthreads();
        const int tl = tid >> 1, half = tid & 1;
        const bf16_t* wq = (const bf16_t*)(ws + O_WQ) + (size_t)item * 65536 + (size_t)tl * 256 + half * 128;
        float d = 0.f;
#pragma unroll
        for (int i = 0; i < 16; ++i) { f32x4 a0, a1; unpack8(*(const u32x4*)(wq + i * 8), a0, a1); const float* nn = nin + half * 128 + i * 8;
            d += a0[0] * nn[0] + a0[1] * nn[1] + a0[2] * nn[2] + a0[3] * nn[3] + a1[0] * nn[4] + a1[1] * nn[5] + a1[2] * nn[6] + a1[3] * nn[7]; }
        d += __shfl_xor(d, 1);
        if (half == 0) denx[(size_t)(tokb + tl) * 4 + h] = d;
        __syncthreads();
    }
}

__device__ __forceinline__ void phase7(const Params& p, unsigned char* sm) {
    unsigned char* ws = p.ws;
    const int tid = threadIdx.x, lane = tid & 63, wid = tid >> 6;
    const bf16_t* uu = (const bf16_t*)p.out; bf16_t* uc = (bf16_t*)(ws + O_UC);
    const float* cw = p.in[8]; const float* cb = p.in[9]; const float* lg = p.in[10]; const float* lb = p.in[11];
    u32x4 pf[12];
#define P7_LOAD(tile_) do { const int t0_ = (tile_) * 16; const int b_ = t0_ / SEQ_, s0_ = t0_ % SEQ_; \
        _Pragma("unroll") for (int q = 0; q < 12; ++q) { const int idx = tid + q * 512; const int r = idx >> 7, c16 = idx & 127; const int s_ = s0_ - 30 + r; \
            pf[q] = (u32x4){0u, 0u, 0u, 0u}; if (idx < 46 * 128 && s_ >= 0) pf[q] = *(const u32x4*)(uu + (size_t)(b_ * SEQ_ + s_) * 1024 + c16 * 8); } } while (0)
    int tile = blockIdx.x;
    if (tile < 1024) P7_LOAD(tile);
    f32x2 wv[31];
#pragma unroll
    for (int k = 0; k < 31; ++k) wv[k] = *(const f32x2*)(cw + (size_t)k * 1024 + 2 * tid);
    const f32x2 bv = *(const f32x2*)(cb + 2 * tid);
    f32x4 lgv[4], lbv[4];
#pragma unroll
    for (int i = 0; i < 4; ++i) { lgv[i] = *(const f32x4*)(lg + i * 256 + lane * 4); lbv[i] = *(const f32x4*)(lb + i * 256 + lane * 4); }
    for (; tile < 1024; tile += gridDim.x) {
        const int t0 = tile * 16;
#pragma unroll
        for (int q = 0; q < 12; ++q) { const int idx = tid + q * 512; const int r = idx >> 7, c16 = idx & 127; if (idx < 46 * 128) *(u32x4*)(sm + r * 2048 + c16 * 16) = pf[q]; }
        __syncthreads();
        f32x2 yy[16];
        {
#pragma unroll
            for (int t = 0; t < 16; ++t) yy[t] = bv;
#pragma unroll
            for (int r = 0; r < 46; ++r) { const unsigned w = *(const unsigned*)(sm + r * 2048 + tid * 4); const f32x2 xx = {bf_lo(w), bf_hi(w)};
#pragma unroll
                for (int t = 0; t < 16; ++t) { const int k = r - t; if (k >= 0 && k <= 30) yy[t] = __builtin_elementwise_fma(wv[k], xx, yy[t]); }
                if ((r & 3) == 3) asm volatile("" ::: "memory"); }
        }
        __syncthreads();
#pragma unroll
        for (int t = 0; t < 16; ++t) *(f32x2*)(sm + t * 4096 + tid * 8) = yy[t];
        { const int tn = tile + gridDim.x; if (tn < 1024) P7_LOAD(tn); }
        __syncthreads();
#pragma unroll
        for (int tt = 0; tt < 2; ++tt) { const int t = wid * 2 + tt; f32x4 v[4]; float s1 = 0.f;
#pragma unroll
            for (int i = 0; i < 4; ++i) { v[i] = *(const f32x4*)(sm + t * 4096 + (i * 256 + lane * 4) * 4); s1 += v[i][0] + v[i][1] + v[i][2] + v[i][3]; }
            s1 = wave_sum(s1); const float mu = s1 * (1.0f / 1024.0f); float s2 = 0.f;
#pragma unroll
            for (int i = 0; i < 4; ++i) { v[i] = v[i] - mu; s2 += v[i][0] * v[i][0] + v[i][1] * v[i][1] + v[i][2] * v[i][2] + v[i][3] * v[i][3]; }
            s2 = wave_sum(s2); const float rstd = rsqrtf(s2 * (1.0f / 1024.0f) + EPS_);
#pragma unroll
            for (int i = 0; i < 4; ++i) { const int c = i * 256 + lane * 4; f32x4 z = v[i] * rstd * lgv[i] + lbv[i];
                z = silu4(z); u32x2 w; w.x = cvt_pk_bf16(z[0], z[1]); w.y = cvt_pk_bf16(z[2], z[3]); *(u32x2*)(uc + (size_t)(t0 + t) * 1024 + c) = w; } }
        __syncthreads();
    }
#undef P7_LOAD
}

__device__ __forceinline__ void phase13(const Params& p) {
    const float* ssq3 = (const float*)(p.ws + O_SSQ3); const float* fg = p.in[22];
    const size_t gtid = (size_t)blockIdx.x * 512 + threadIdx.x, gthreads = (size_t)gridDim.x * 512;
    for (size_t i = gtid; i < (size_t)T_ * 256; i += gthreads) { const int row = (int)(i >> 8), c = (int)(i & 255) * 4;
        const float rs = rsqrtf(ssq3[row] * (1.0f / 1024.0f) + EPS_); const f32x4 g = *(const f32x4*)(fg + c);
        f32x4 v = *(const f32x4*)(p.out + i * 4); v = v * rs * g; *(f32x4*)(p.out + i * 4) = v; }
}

#define XB_TMO      128
#define XB_XCNT(j)  (256  + 64 * (j))
#define XB_XSUB(j)  (1280 + 64 * (j))
#define XB_XGEN(j)  (2304 + 64 * (j))
#define XB_TOP      3328
#define XB_TOPGEN   3392
#define XCD_BAR_WORDS 3456
#define XB_SPIN_CAP (1u << 18)
__device__ __forceinline__ unsigned xb_ld(unsigned* p)              { return __hip_atomic_load(p, __ATOMIC_RELAXED, __HIP_MEMORY_SCOPE_AGENT); }
__device__ __forceinline__ unsigned xb_add(unsigned* p, unsigned v) { return __hip_atomic_fetch_add(p, v, __ATOMIC_RELAXED, __HIP_MEMORY_SCOPE_AGENT); }
__device__ __forceinline__ unsigned xb_xcc_id() { return (unsigned)__builtin_amdgcn_s_getreg((3 << 11) | 20) & 0xFu; }
#define XB_SPIN(cond, bar) do { unsigned _sp = 0; while (cond) { __builtin_amdgcn_s_sleep(1); \
    if ((++_sp & 255u) == 0u) { if (xb_ld(&(bar)[XB_TMO])) break; if (_sp > XB_SPIN_CAP) { atomicAdd(&(bar)[XB_TMO], 1u); break; } } } } while (0)
struct XcdBarrier { unsigned* bar; unsigned x; volatile LAS unsigned* st; };
__device__ __forceinline__ XcdBarrier xcd_barrier_post(unsigned* bar, volatile LAS unsigned* st) {
    XcdBarrier b; b.bar = bar; b.x = xb_xcc_id(); b.st = st;
    if (threadIdx.x == 0) (void)xb_add(&bar[XB_XCNT(b.x)], 1u);
    return b;
}
__device__ __forceinline__ void xcd_barrier_complete(unsigned* bar, unsigned x, unsigned& nloc, unsigned& nx) {
    const unsigned G = gridDim.x * gridDim.y * gridDim.z;
    unsigned sum, cnt, mine, sp = 0u;
    for (;;) {
        sum = 0u; cnt = 0u; mine = 0u;
#pragma unroll
        for (unsigned j = 0; j < 16; ++j) { const unsigned c = xb_ld(&bar[XB_XCNT(j)]); sum += c; cnt += (c > 0u) ? 1u : 0u; mine = (j == x) ? c : mine; }
        if (sum == G) break;
        __builtin_amdgcn_s_sleep(1);
        if ((++sp & 255u) == 0u) { if (xb_ld(&bar[XB_TMO])) break; if (sp > XB_SPIN_CAP) { atomicAdd(&bar[XB_TMO], 1u); break; } }
    }
    nloc = mine > 0u ? mine : 1u; nx = cnt > 0u ? cnt : 1u;
}
__device__ __forceinline__ void xcd_barrier(const XcdBarrier& b) {
    asm volatile("s_waitcnt vmcnt(0)" ::: "memory");
    __syncthreads();
    if (threadIdx.x == 0) {
        unsigned* bar = b.bar;
        __builtin_amdgcn_s_waitcnt(0);
        unsigned nloc = b.st[0], nx = b.st[1];
        if (nloc == 0u) { xcd_barrier_complete(bar, b.x, nloc, nx); b.st[0] = nloc; b.st[1] = nx; }
        const unsigned old = xb_add(&bar[XB_XSUB(b.x)], 1u);
        const unsigned gen = old / nloc;
        if (old + 1u == (gen + 1u) * nloc) {
            __builtin_amdgcn_fence(__ATOMIC_RELEASE, "agent");
            asm volatile("s_waitcnt vmcnt(0)" ::: "memory");
            const unsigned og = xb_add(&bar[XB_TOP], 1u);
            const unsigned tg = og / nx;
            if (og + 1u == (tg + 1u) * nx) xb_add(&bar[XB_TOPGEN], 1u);
            else XB_SPIN(xb_ld(&bar[XB_TOPGEN]) == tg, bar);
            __builtin_amdgcn_fence(__ATOMIC_ACQUIRE, "agent");
            xb_add(&bar[XB_XGEN(b.x)], 1u);
            asm volatile("s_waitcnt vmcnt(0)" ::: "memory");
        } else {
            XB_SPIN(xb_ld(&bar[XB_XGEN(b.x)]) == gen, bar);
            __builtin_amdgcn_fence(__ATOMIC_ACQUIRE, "agent");
            asm volatile("s_waitcnt vmcnt(0)" ::: "memory");
        }
    }
    __syncthreads();
}

template <bool COOP>
__global__ void __launch_bounds__(512, 2) mk_fwd(Params p) {
    extern __shared__ __attribute__((aligned(16))) unsigned char shm[];
    LAS unsigned char* lds = (LAS unsigned char*)shm;
    unsigned char* ws = p.ws;
    const int G = gridDim.x, c = blockIdx.x;
#ifndef PHMASK
#define PHMASK 0x3fff
#endif
#define PH(k) if (((PHMASK >> (k)) & 1) && p.ph_lo <= (k) && (k) < p.ph_hi)
    XcdBarrier xb{};
    if (COOP) { volatile LAS unsigned* st = (volatile LAS unsigned*)(lds + 131072);
        if (threadIdx.x == 0) { st[0] = 0u; st[1] = 0u; }
        __syncthreads();
        xb = xcd_barrier_post((unsigned*)(ws + O_BAR), st); }
#define SYNC(k) if (COOP) { if (p.ph_lo <= (k) && (k) + 1 < p.ph_hi) { xcd_barrier(xb); } }
    PH(0) phase0(p, shm);
    SYNC(0)
    PH(1) { SchedP1 S{(const char*)(ws + O_HB), (const char*)(ws + O_WINT), G, c}; EpiP1 E{(bf16_t*)p.out, (bf16_t*)(ws + O_VT), (const float*)(ws + O_RS)}; gemm_phase(lds, 1024, 1024, 1024, S, E); }
    SYNC(1)
    PH(3) { phase2(p, shm);
        asm volatile("s_waitcnt vmcnt(0)" ::: "memory"); __syncthreads();
        SchedP3 S{(const char*)(ws + O_WQ), (const char*)(ws + O_KW), (const char*)(ws + O_VT), (const char*)(ws + O_KWT), G, c};
        EpiP3 E{(bf16_t*)(ws + O_SS), (bf16_t*)(ws + O_KWT), (float*)(ws + O_DENI)}; gemm_phase(lds, 256, 256, 256, S, E); }
    SYNC(3)
    PH(4) phase4(p, shm);
    SYNC(4)
    PH(6) { { SchedP5 S{(const char*)(ws + O_SS), (const char*)(ws + O_VT), (const char*)(ws + O_WQ), (const char*)(ws + O_CINT), G, c};
            EpiP5 E{(bf16_t*)(ws + O_HM), (const float*)(ws + O_DENI), (const float*)(ws + O_DENX), (float*)(ws + O_HSS)}; gemm_phase(lds, 256, 256, 256, S, E); }
        { SchedP6 S{(const char*)(ws + O_HB), (const char*)(ws + O_WINT), G, c};
            EpiP6 E{(bf16_t*)(ws + O_HM), (float*)(ws + O_HSS), (const float*)(ws + O_RS), (bf16_t*)p.out}; gemm_phase(lds, 1024, 1024, 1024, S, E); } }
    SYNC(6)
    PH(7) phase7(p, shm);
    SYNC(7)
    PH(8) { SchedP8 S{(const char*)(ws + O_HB), (const char*)(ws + O_WINT), (const char*)(ws + O_HM), (const char*)(ws + O_UC), (const char*)(ws + O_WMT), (const char*)(ws + O_WCT), G, c};
        EpiP8 E{(bf16_t*)(ws + O_GMC), (bf16_t*)p.out + (size_t)T_ * 1024, (bf16_t*)(ws + O_MERGED), (const float*)(ws + O_RS)}; gemm_phase(lds, 1024, 1024, 1024, S, E); }
    SYNC(8)
    PH(9) { SchedN4 S{(const char*)(ws + O_MERGED), (const char*)(ws + O_WOT), (size_t)256 * 1024 * 2, (size_t)256 * 1024 * 2, G, c};
        EpiRes<true> E{(const void*)(ws + O_HB), (bf16_t*)(ws + O_X1B), (float*)(ws + O_SSQ1)}; gemm_phase(lds, 1024, 1024, 1024, S, E); }
    SYNC(9)
    PH(10) { { SchedP10 S{(const char*)(ws + O_X1B), (const char*)(ws + O_WGUT), G, c}; EpiP10 E{(const float*)(ws + O_SSQ1), (bf16_t*)(ws + O_HID)}; gemm_phase(lds, 1024, 1024, 1024, S, E); }
        { const int h = G >> 1; SchedPE S{(const char*)(ws + O_PB), (const char*)(ws + O_WPPT), h, c - h};
            EpiBf E{(bf16_t*)(ws + O_PE)}; if (c >= h) gemm_phase(lds, 256, 256, 256, S, E); } }
    SYNC(10)
    PH(11) { SchedN4 S{(const char*)(ws + O_HID), (const char*)(ws + O_WDT), (size_t)256 * DFF_ * 2, (size_t)256 * DFF_ * 2, G, c};
            EpiRes<true> E{(const void*)(ws + O_X1B), (bf16_t*)(ws + O_X2B), (float*)(ws + O_SSQ2)}; gemm_phase(lds, DFF_, DFF_, DFF_, S, E); }
    SYNC(11)
    PH(12) { SchedN4 S{(const char*)(ws + O_X2B), (const char*)(ws + O_WPGT), (size_t)256 * 1024 * 2, (size_t)256 * 1024 * 2, G, c};
        EpiP12 E{(const float*)(ws + O_SSQ2), (const bf16_t*)(ws + O_PE), (const bf16_t*)(ws + O_X2B), p.out, (float*)(ws + O_SSQ3), (unsigned*)(ws + O_BAR) + XCD_BAR_WORDS, p.in[22]}; gemm_phase(lds, 1024, 1024, 1024, S, E); }
#undef PH
#undef SYNC
}

extern "C" void kernel_launch(void* const* d_in, const int* in_sizes, int n_in, void* d_out, int out_size, void* d_ws, size_t ws_size, hipStream_t stream) {
    static int grid = 0;
    if (grid == 0) {
        if (n_in != 23 || out_size != T_ * D_ || ws_size < WS_NEED) { fprintf(stderr, "kernel_launch: unexpected shapes (n_in %d, out %d, ws %zu)\n", n_in, out_size, ws_size); grid = -1; return; }
        int dev = 0, cus = 0, per_cu = 0;
        hipGetDevice(&dev); hipDeviceGetAttribute(&cus, hipDeviceAttributeMultiprocessorCount, dev);
        hipFuncSetAttribute((const void*)mk_fwd<true>, hipFuncAttributeMaxDynamicSharedMemorySize, LDS_BYTES);
        hipFuncSetAttribute((const void*)mk_fwd<false>, hipFuncAttributeMaxDynamicSharedMemorySize, LDS_BYTES);
        hipOccupancyMaxActiveBlocksPerMultiprocessor(&per_cu, (const void*)mk_fwd<true>, 512, LDS_BYTES);
        if (per_cu < 1) { fprintf(stderr, "kernel_launch: occupancy query reports %d blocks per CU\n", per_cu); per_cu = 1; }
        (void)hipGetLastError();
        grid = cus;
        if (grid != 256) { fprintf(stderr, "kernel_launch: built for a 256-CU device (got %d CUs)\n", cus); grid = -1; return; }
    }
    if (grid < 0) return;
    Params p{};
    for (int i = 0; i < 23; ++i) p.in[i] = (const float*)d_in[i];
    p.out = (float*)d_out; p.ws = (unsigned char*)d_ws;
#if MK_MULTI
#ifndef PROBE_DUP
#define PROBE_DUP -1
#endif
    for (int k = 0; k < NPHASE; ++k) { p.ph_lo = k; p.ph_hi = k + 1; hipLaunchKernelGGL(mk_fwd<false>, dim3(grid), dim3(512), LDS_BYTES, stream, p);
        if (k == PROBE_DUP) hipLaunchKernelGGL(mk_fwd<false>, dim3(grid), dim3(512), LDS_BYTES, stream, p); }
#else
    p.ph_lo = 0; p.ph_hi = NPHASE;
    if (hipMemsetAsync((unsigned char*)d_ws + O_BAR, 0, (XCD_BAR_WORDS + 64 * 64) * 4, stream) != hipSuccess) { fprintf(stderr, "kernel_launch: memset of barrier words failed\n"); return; }
    void* args[] = {&p};
    hipError_t e = hipLaunchCooperativeKernel((const void*)mk_fwd<true>, dim3(grid), dim3(512), args, LDS_BYTES, stream);
    if (e != hipSuccess) fprintf(stderr, "cooperative launch failed: %s (grid %d)\n", hipGetErrorString(e), grid);
#endif
}
```

```cpp
#include <hip/hip_runtime.h>
#include <hip/hip_cooperative_groups.h>
#include <cstdio>
namespace cg = cooperative_groups;

#ifndef MK_MULTI
#define MK_MULTI 0
#endif

#define LAS __attribute__((address_space(3)))
typedef unsigned short bf16_t;
typedef short bf16x8 __attribute__((ext_vector_type(8)));
typedef float f32x4 __attribute__((ext_vector_type(4)));
typedef float f32x2 __attribute__((ext_vector_type(2)));
typedef unsigned u32x4 __attribute__((ext_vector_type(4)));
typedef unsigned u32x2 __attribute__((ext_vector_type(2)));

constexpr int T_ = 16384, D_ = 1024, NIN_ = 8200, DFF_ = 2816, SEQ_ = 2048;
constexpr float EPS_ = 1e-6f;
constexpr int BM = 256, BK = 64, HALF = 128, HTB = HALF * BK * 2, STAGE_BYTES = 8 * HTB;
constexpr int LDS_BYTES = 136 * 1024;
constexpr int NPHASE = 13;

constexpr size_t KiB = 1024, MiB = 1024 * 1024;
constexpr size_t O_WINT = 0, O_WMT = 16 * MiB, O_WCT = 18 * MiB, O_WOT = 20 * MiB, O_WPGT = 22 * MiB, O_WGUT = 24 * MiB, O_WDT = 35 * MiB, O_WPPT = 40 * MiB + 512 * KiB;
constexpr size_t O_IG = 41 * MiB, O_LF = O_IG + 256 * KiB, O_ZERO = O_LF + 256 * KiB;
constexpr size_t O_DENI = O_ZERO, O_HSS = O_DENI + 256 * KiB, O_SSQ1 = O_HSS + 256 * KiB, O_SSQ2 = O_SSQ1 + 64 * KiB, O_SSQ3 = O_SSQ2 + 64 * KiB, O_NSUM = O_SSQ3 + 64 * KiB;
constexpr size_t ZERO_BYTES = 960 * KiB;
constexpr size_t O_DENX = O_ZERO + ZERO_BYTES, O_EBL = O_DENX + 256 * KiB;
constexpr size_t O_RS = O_EBL + 4 * KiB;
constexpr size_t O_BAR = 43 * MiB;
constexpr size_t O_PB = 44 * MiB, O_HB = 52 * MiB, O_S1 = 84 * MiB, O_S2 = 116 * MiB, O_S3 = 148 * MiB, O_S4 = 180 * MiB, O_S5 = 212 * MiB, WS_NEED = 244 * MiB;
constexpr size_t O_PE = O_HB, O_VT = O_S1, O_U = O_S1, O_MERGED = O_S1, O_HID = O_S1, O_WQ = O_S2, O_GMC = O_S2, O_KW = O_S3, O_CINT = O_S3,
                 O_KWT = O_S4, O_HM = O_S4, O_X1B = O_S4, O_SS = O_S5, O_UC = O_S5, O_X2B = O_S5;

struct Params {
    const float* in[23];
    float* out;
    unsigned char* ws;
    int ph_lo, ph_hi;
};

__device__ __forceinline__ unsigned cvt_pk_bf16(float lo, float hi) { unsigned r; asm volatile("v_cvt_pk_bf16_f32 %0, %1, %2" : "=v"(r) : "v"(lo), "v"(hi)); return r; }
__device__ __forceinline__ float bf_lo(unsigned w) { return __uint_as_float(w << 16); }
__device__ __forceinline__ float bf_hi(unsigned w) { return __uint_as_float(w & 0xffff0000u); }
__device__ __forceinline__ float sigm(float x) { return __builtin_amdgcn_rcpf(1.0f + __builtin_amdgcn_exp2f(x * -1.4426950408889634f)); }
__device__ __forceinline__ float silu(float x) { return x * __builtin_amdgcn_rcpf(1.0f + __builtin_amdgcn_exp2f(x * -1.4426950408889634f)); }
__device__ __forceinline__ f32x4 exp2v(f32x4 t) { f32x4 e; e[0] = __builtin_amdgcn_exp2f(t[0]); e[1] = __builtin_amdgcn_exp2f(t[1]); e[2] = __builtin_amdgcn_exp2f(t[2]); e[3] = __builtin_amdgcn_exp2f(t[3]); return e; }
__device__ __forceinline__ f32x4 rcpv(f32x4 d) { f32x4 r; r[0] = __builtin_amdgcn_rcpf(d[0]); r[1] = __builtin_amdgcn_rcpf(d[1]); r[2] = __builtin_amdgcn_rcpf(d[2]); r[3] = __builtin_amdgcn_rcpf(d[3]); return r; }
__device__ __forceinline__ f32x4 sigm4(f32x4 x) { return rcpv(exp2v(x * -1.4426950408889634f) + 1.0f); }
__device__ __forceinline__ f32x4 silu4(f32x4 x) { return x * sigm4(x); }
__device__ __forceinline__ f32x2 silu2(f32x2 x) { const f32x2 t = x * -1.4426950408889634f; f32x2 d; d[0] = __builtin_amdgcn_exp2f(t[0]); d[1] = __builtin_amdgcn_exp2f(t[1]); d = d + 1.0f;
    f32x2 r; r[0] = __builtin_amdgcn_rcpf(d[0]); r[1] = __builtin_amdgcn_rcpf(d[1]); return x * r; }
#define WS_DPP(v, ctrl) ((v) + __int_as_float(__builtin_amdgcn_update_dpp(0, __float_as_int(v), (ctrl), 0xf, 0xf, false)))
__device__ __forceinline__ float wave_sum(float v) {
    v = WS_DPP(v, 0xB1);
    v = WS_DPP(v, 0x4E);
    v = WS_DPP(v, 0x141);
    v = WS_DPP(v, 0x140);
    const int iv = __float_as_int(v);
    return (__int_as_float(__builtin_amdgcn_readlane(iv, 0)) + __int_as_float(__builtin_amdgcn_readlane(iv, 16))) + (__int_as_float(__builtin_amdgcn_readlane(iv, 32)) + __int_as_float(__builtin_amdgcn_readlane(iv, 48)));
}
__device__ __forceinline__ u32x4 pack8(const f32x4 a, const f32x4 b) { u32x4 w; w.x = cvt_pk_bf16(a[0], a[1]); w.y = cvt_pk_bf16(a[2], a[3]); w.z = cvt_pk_bf16(b[0], b[1]); w.w = cvt_pk_bf16(b[2], b[3]); return w; }
__device__ __forceinline__ void unpack8(const u32x4 w, f32x4& a, f32x4& b) { a[0] = bf_lo(w.x); a[1] = bf_hi(w.x); a[2] = bf_lo(w.y); a[3] = bf_hi(w.y); b[0] = bf_lo(w.z); b[1] = bf_hi(w.z); b[2] = bf_lo(w.w); b[3] = bf_hi(w.w); }

__host__ __device__ __forceinline__ int lds_byte(int r, int c) { const int st = (r >> 4) * 2 + (c >> 5), rr = r & 15, cc = c & 31, ob = rr * 64 + cc * 2; return st * 1024 + (ob ^ (((ob >> 9) & 1) << 5)); }
__host__ __device__ __forceinline__ void stage_rc(int b, int& R, int& C) { const int st = b / 1024, sb = b % 1024, swz = sb ^ (((sb >> 9) & 1) << 5); R = (st >> 1) * 16 + swz / 64; C = (st & 1) * 32 + (swz % 64) / 2; }
__host__ __device__ __forceinline__ int perm32(int rho) { const int n = rho >> 4, i = rho & 15; return 8 * (i >> 2) + 4 * n + (i & 3); }

struct Unit { const char* a; const char* b; int pm, pn, kind, cont; };
__device__ __forceinline__ void map_n4(int L, int& pm, int& pn) { const int x = L & 7, k = L >> 3; pm = x * 8 + (k & 7); pn = k >> 3; }

__device__ __forceinline__ void tile_order(int L, int nM, int nN, int& pm, int& pn) {
    const int nwg = nM * nN; int wgid = L;
    { const int q = nwg / 8, r = nwg % 8, xcd = wgid % 8, off = wgid / 8; wgid = (xcd < r ? xcd * (q + 1) : r * (q + 1) + (xcd - r) * q) + off; }
    const int nig = 8 * nN, gid = wgid / nig, fm = gid * 8, gsz = (nM - fm) < 8 ? (nM - fm) : 8;
    pm = fm + ((wgid % nig) % gsz); pn = (wgid % nig) / gsz;
}

template <class Epi, class Sched>
__device__ __forceinline__ void gemm_phase(LAS unsigned char* lds, const int K, const int lda, const int ldb, const Sched& S, const Epi& E) {
    const int tid = threadIdx.x, wid = __builtin_amdgcn_readfirstlane(tid >> 6), lane = tid & 63, wr = wid >> 2, wc = wid & 3, fr = lane & 15, fq = lane >> 4;
    const int nt = K / BK;
    unsigned voffA[2], voffB[2];
#pragma unroll
    for (int i = 0; i < 2; ++i) { int R, C; stage_rc(tid * 16 + i * 8192, R, C); const int Rb = (R & ~31) + perm32(R & 31);
        voffA[i] = (unsigned)(R * lda + C) * 2u; voffB[i] = (unsigned)(Rb * ldb + C) * 2u; }
    const size_t kstep = (size_t)(BK * 2);
    const size_t hstepA = (size_t)HALF * lda * 2, hstepB = (size_t)HALF * ldb * 2;
    const unsigned ldsw = (unsigned)wid * 1024u;
    const int aoff = lds_byte(wr * 64 + fr, fq * 8), boff = lds_byte(wc * 32 + fr, fq * 8);
#define PG8_SA(b, h) (((b) * 2 + (h)) * HTB)
#define PG8_SB(b, h) ((4 + (b) * 2 + (h)) * HTB)
#define PG8_STAGE(bufoff, gbase, voff) do { _Pragma("unroll") for (int _i = 0; _i < 2; ++_i) \
        __builtin_amdgcn_global_load_lds((const unsigned*)((const char*)(gbase) + (voff)[_i]), (LAS unsigned*)(lds + (bufoff) + ldsw + _i * 8192), 16, 0, 0); } while (0)
#define PG8_LDA(dst, b, h) do { _Pragma("unroll") for (int m = 0; m < 4; ++m) _Pragma("unroll") for (int k = 0; k < 2; ++k) dst[m][k] = *(const LAS bf16x8*)(lds + PG8_SA(b, h) + aoff + m * 2048 + k * 1024); } while (0)
#define PG8_LDB(dst, b, h) do { _Pragma("unroll") for (int n = 0; n < 2; ++n) _Pragma("unroll") for (int k = 0; k < 2; ++k) dst[n][k] = *(const LAS bf16x8*)(lds + PG8_SB(b, h) + boff + n * 2048 + k * 1024); } while (0)
#define PG8_MMA(ai, bj, At, Bt) do { __builtin_amdgcn_s_setprio(1); _Pragma("unroll") for (int m = 0; m < 4; ++m) _Pragma("unroll") for (int n = 0; n < 2; ++n) _Pragma("unroll") for (int k = 0; k < 2; ++k) \
        acc[ai][bj][m][n] = __builtin_amdgcn_mfma_f32_16x16x32_bf16(Bt[n][k], At[m][k], acc[ai][bj][m][n], 0, 0, 0); __builtin_amdgcn_s_setprio(0); } while (0)
#define PG8_WAIT_V(n) asm volatile("s_waitcnt vmcnt(" #n ")" ::: "memory")
#define PG8_WAIT_L(n) asm volatile("s_waitcnt lgkmcnt(" #n ")" ::: "memory")
#define PG8_BAR __builtin_amdgcn_s_barrier()
#define PG8_SCHED __builtin_amdgcn_sched_barrier(0)
#define PG8_ZERO() do { _Pragma("unroll") for (int a = 0; a < 2; ++a) _Pragma("unroll") for (int b = 0; b < 2; ++b) _Pragma("unroll") for (int m = 0; m < 4; ++m) _Pragma("unroll") for (int n = 0; n < 2; ++n) acc[a][b][m][n] = (f32x4){0.f, 0.f, 0.f, 0.f}; } while (0)
    Unit cur, nxt; int ui = 0;
    if (!S.next(0, cur)) return;
    E.pre(cur, wr, wc, fr, fq);
    f32x4 acc[2][2][4][2];
    PG8_ZERO();
    bf16x8 At[4][2], B0[2][2], B1[2][2];
    const char* cA = cur.a; const char* cB = cur.b;
    PG8_STAGE(PG8_SB(0, 0), cB, voffB); PG8_STAGE(PG8_SA(0, 0), cA, voffA); PG8_STAGE(PG8_SB(0, 1), cB + hstepB, voffB); PG8_STAGE(PG8_SA(0, 1), cA + hstepA, voffA);
    if (wr == 1) PG8_BAR;
    PG8_WAIT_V(4); PG8_BAR;
    PG8_STAGE(PG8_SB(1, 0), cB + kstep, voffB); PG8_STAGE(PG8_SA(1, 0), cA + kstep, voffA); PG8_STAGE(PG8_SB(1, 1), cB + hstepB + kstep, voffB);
    PG8_WAIT_V(6); PG8_BAR;
    for (;;) {
        const bool has_next = S.next(ui + 1, nxt);
        const char* nA = has_next ? nxt.a : cA; const char* nB = has_next ? nxt.b : cB;
#pragma unroll 1
        for (int t = 0; t < nt; t += 2) {
            const bool last = (t == nt - 2);
            const char* a1 = cA + (size_t)(t + 1) * kstep;
            const char* a2 = last ? nA : cA + (size_t)(t + 2) * kstep; const char* b2 = last ? nB : cB + (size_t)(t + 2) * kstep;
            const char* a3 = a2 + kstep; const char* b3 = b2 + kstep;
            PG8_LDB(B0, 0, 0); PG8_SCHED; PG8_LDA(At, 0, 0); PG8_STAGE(PG8_SA(1, 1), a1 + hstepA, voffA);
            PG8_WAIT_L(8); PG8_BAR; PG8_WAIT_L(0); PG8_MMA(0, 0, At, B0); PG8_BAR; PG8_SCHED;
            PG8_LDB(B1, 0, 1); PG8_STAGE(PG8_SB(0, 0), b2, voffB);
            PG8_BAR; PG8_WAIT_L(0); PG8_MMA(0, 1, At, B1); PG8_BAR;
            PG8_LDA(At, 0, 1); PG8_STAGE(PG8_SA(0, 0), a2, voffA);
            PG8_BAR; PG8_WAIT_L(0); PG8_MMA(1, 0, At, B0); PG8_BAR; PG8_SCHED;
            PG8_STAGE(PG8_SB(0, 1), b2 + hstepB, voffB);
            PG8_WAIT_V(6); PG8_BAR; PG8_MMA(1, 1, At, B1); PG8_BAR;
            PG8_LDB(B0, 1, 0); PG8_SCHED; PG8_LDA(At, 1, 0); PG8_STAGE(PG8_SA(0, 1), a2 + hstepA, voffA);
            PG8_WAIT_L(8); PG8_BAR; PG8_WAIT_L(0); PG8_MMA(0, 0, At, B0); PG8_BAR; PG8_SCHED;
            PG8_LDB(B1, 1, 1); PG8_STAGE(PG8_SB(1, 0), b3, voffB);
            PG8_BAR; PG8_WAIT_L(0); PG8_MMA(0, 1, At, B1); PG8_BAR;
            PG8_LDA(At, 1, 1); PG8_STAGE(PG8_SA(1, 0), a3, voffA);
            PG8_BAR; PG8_WAIT_L(0); PG8_MMA(1, 0, At, B0); PG8_BAR; PG8_SCHED;
            PG8_STAGE(PG8_SB(1, 1), b3 + hstepB, voffB);
            PG8_WAIT_V(6); PG8_BAR; PG8_MMA(1, 1, At, B1); PG8_BAR;
        }
        if (cur.cont) { E.mid(acc, cur, wr, wc, fr, fq); }
        else { if constexpr (!Epi::AFTER_DRAIN) E(acc, cur, wr, wc, fr, fq); if (!has_next) break; PG8_ZERO(); }
        cur = nxt; cA = nA; cB = nB; ++ui;
    }
    PG8_WAIT_V(0);
    if (wr == 0) PG8_BAR;
    PG8_BAR;
    if constexpr (Epi::AFTER_DRAIN) E(acc, cur, wr, wc, fr, fq);
#undef PG8_SA
#undef PG8_SB
#undef PG8_STAGE
#undef PG8_LDA
#undef PG8_LDB
#undef PG8_MMA
#undef PG8_WAIT_V
#undef PG8_WAIT_L
#undef PG8_BAR
#undef PG8_SCHED
#undef PG8_ZERO
}

typedef f32x4 Acc[2][2][4][2];
#define EPI_ROWS(ai, m) _Pragma("unroll") for (int ai = 0; ai < 2; ++ai) _Pragma("unroll") for (int m = 0; m < 4; ++m) if (epi_fence())
__device__ __forceinline__ bool epi_fence() { asm volatile("" ::: "memory"); return true; }
#define EPI_R8 _Pragma("unroll") for (int r8 = 0; r8 < 8; ++r8)
#define EPI_RL(ai, m) ((ai) * 128 + wr * 64 + (m) * 16 + fr)
#define EPI_CL(bj) ((bj) * 128 + wc * 32 + 8 * fq)

struct SchedP1 { const char* hb; const char* wint; int G, c;
    __device__ __forceinline__ bool next(int i, Unit& u) const {
        const int item = (i / 3) * G + c, r = i % 3; if (item >= 256) return false;
        const int b = item >> 5, h = (item >> 3) & 3, sc = item & 7; const int pt = b * 8 + sc;
        u.cont = 0;
        if (r < 2) { u.pm = pt; u.pn = r * 4 + h; u.kind = 0; u.a = hb + (size_t)pt * 256 * 1024 * 2; u.b = wint + (size_t)u.pn * 256 * 1024 * 2; }
        else { u.pm = h; u.pn = pt; u.kind = 1; u.a = wint + (size_t)(2048 + h * 256) * 1024 * 2; u.b = hb + (size_t)pt * 256 * 1024 * 2; }
        return true; } };
struct EpiP1 { static constexpr bool AFTER_DRAIN = false; bf16_t* qkpre; bf16_t* vt; const float* rsb;
    __device__ __forceinline__ void mid(Acc&, const Unit&, int, int, int, int) const {}
    __device__ __forceinline__ void pre(const Unit&, int, int, int, int) const {}
    __device__ __forceinline__ void operator()(Acc& acc, const Unit& u, int wr, int wc, int fr, int fq) const {
        if (u.kind == 0) {
            bf16_t* base = qkpre + (size_t)u.pm * 256 * 2048 + u.pn * 256; float rv[2][4];
#pragma unroll
            for (int ai = 0; ai < 2; ++ai)
#pragma unroll
                for (int m = 0; m < 4; ++m) rv[ai][m] = rsb[u.pm * 256 + EPI_RL(ai, m)];
            EPI_ROWS(ai, m) { bf16_t* rowp = base + (size_t)EPI_RL(ai, m) * 2048 + EPI_CL(0);
#pragma unroll
                for (int bj = 0; bj < 2; ++bj) *(u32x4*)(rowp + bj * 128) = pack8(acc[ai][bj][m][0] * rv[ai][m], acc[ai][bj][m][1] * rv[ai][m]); }
        } else {
            const int item = ((u.pn >> 3) * 4 + u.pm) * 8 + (u.pn & 7); bf16_t* base = vt + (size_t)item * 65536; f32x4 cv[2][2];
#pragma unroll
            for (int bj = 0; bj < 2; ++bj) { cv[bj][0] = *(const f32x4*)(rsb + u.pn * 256 + EPI_CL(bj)); cv[bj][1] = *(const f32x4*)(rsb + u.pn * 256 + EPI_CL(bj) + 4); }
            EPI_ROWS(ai, m) { bf16_t* rowp = base + (size_t)EPI_RL(ai, m) * 256 + EPI_CL(0);
#pragma unroll
                for (int bj = 0; bj < 2; ++bj) *(u32x4*)(rowp + bj * 128) = pack8(acc[ai][bj][m][0] * cv[bj][0], acc[ai][bj][m][1] * cv[bj][1]); }
        }
    } };

struct SchedP3 { const char* wq; const char* kw; const char* vt; const char* kwt; int G, c;
    __device__ __forceinline__ bool next(int i, Unit& u) const {
        const int L = i * G + c; if (L >= 512) return false;
        u.cont = 0; u.pn = 0;
        if (L < 256) { u.pm = L; u.kind = 0; u.a = wq + (size_t)L * 131072; u.b = kw + (size_t)L * 131072; }
        else { const int it = L - 256; u.pm = it; u.kind = 1; u.a = vt + (size_t)it * 131072; u.b = kwt + (size_t)it * 131072; }
        return true; } };
struct EpiP3 { static constexpr bool AFTER_DRAIN = false; bf16_t* s; bf16_t* lt; float* deni;
    __device__ __forceinline__ void mid(Acc&, const Unit&, int, int, int, int) const {}
    __device__ __forceinline__ void pre(const Unit&, int, int, int, int) const {}
    __device__ __forceinline__ void operator()(Acc& acc, const Unit& u, int wr, int wc, int fr, int fq) const {
        const int item = u.pm;
        if (u.kind == 0) {
            const int b = item >> 5, h = (item >> 3) & 3, sc = item & 7; const int tokb = b * SEQ_ + sc * 256;
            EPI_ROWS(ai, m) { int r = EPI_RL(ai, m); asm volatile("" : "+v"(r)); float rs = 0.f;
#pragma unroll
                for (int bj = 0; bj < 2; ++bj) { const int c0 = EPI_CL(bj); f32x4 v0 = acc[ai][bj][m][0], v1 = acc[ai][bj][m][1];
#pragma unroll
                    for (int j = 0; j < 4; ++j) { v0[j] = (c0 + j <= r) ? v0[j] : 0.f; v1[j] = (c0 + 4 + j <= r) ? v1[j] : 0.f; rs += v0[j] + v1[j]; }
                    *(u32x4*)(s + (size_t)item * 65536 + r * 256 + c0) = pack8(v0, v1); }
                rs += __shfl_xor(rs, 16); rs += __shfl_xor(rs, 32);
                if (fq == 0) unsafeAtomicAdd(deni + (size_t)(tokb + r) * 4 + h, rs); }
        } else {
            EPI_ROWS(ai, m) { bf16_t* rowp = lt + (size_t)item * 65536 + EPI_RL(ai, m) * 256 + EPI_CL(0);
#pragma unroll
                for (int bj = 0; bj < 2; ++bj) *(u32x4*)(rowp + bj * 128) = pack8(acc[ai][bj][m][0], acc[ai][bj][m][1]); }
        }
    } };

struct SchedP5 { const char* s; const char* vt; const char* wq; const char* cint; int G, c;
    __device__ __forceinline__ bool next(int i, Unit& u) const {
        const int item = (i >> 1) * G + c; if (item >= 256) return false;
        u.pm = item; u.pn = 0; u.kind = 0;
        if ((i & 1) == 0) { u.cont = 1; u.a = s + (size_t)item * 131072; u.b = vt + (size_t)item * 131072; }
        else { u.cont = 0; u.a = wq + (size_t)item * 131072; u.b = cint + (size_t)item * 131072; }
        return true; } };
struct EpiP5 { static constexpr bool AFTER_DRAIN = false; bf16_t* hm; const float* deni; const float* denx; float* hss;
    __device__ __forceinline__ void mid(Acc&, const Unit&, int, int, int, int) const {}
    __device__ __forceinline__ void pre(const Unit&, int, int, int, int) const {}
    __device__ __forceinline__ void operator()(Acc& acc, const Unit& u, int wr, int wc, int fr, int fq) const {
        const int item = u.pm; const int b = item >> 5, h = (item >> 3) & 3, sc = item & 7; const int tokb = b * SEQ_ + sc * 256;
        float dnv[2][4];
#pragma unroll
        for (int ai = 0; ai < 2; ++ai)
#pragma unroll
            for (int m = 0; m < 4; ++m) { const int t = tokb + EPI_RL(ai, m); dnv[ai][m] = deni[(size_t)t * 4 + h] + denx[(size_t)t * 4 + h]; }
        EPI_ROWS(ai, m) { const int t = tokb + EPI_RL(ai, m);
            const float den = dnv[ai][m]; const float inv = __builtin_amdgcn_rcpf(fmaxf(fabsf(den), 1.0f)); float ss = 0.f;
#pragma unroll
            for (int bj = 0; bj < 2; ++bj) { f32x4 v0 = acc[ai][bj][m][0] * inv, v1 = acc[ai][bj][m][1] * inv;
                { const f32x4 q = v0 * v0 + v1 * v1; ss += (q[0] + q[1]) + (q[2] + q[3]); }
                *(u32x4*)(hm + (size_t)t * 1024 + h * 256 + EPI_CL(bj)) = pack8(v0, v1); }
            ss += __shfl_xor(ss, 16); ss += __shfl_xor(ss, 32);
            if (fq == 0) unsafeAtomicAdd(hss + (size_t)t * 4 + h, ss); }
    } };

struct SchedP6 { const char* hb; const char* wint; int G, c;
    __device__ __forceinline__ bool next(int i, Unit& u) const {
        u.cont = 0;
        if (i == 0) { const int item = c; if (item >= 256) return false; const int b = item >> 5, h = (item >> 3) & 3, sc = item & 7;
            u.pm = b * 8 + sc; u.pn = h; u.kind = 0; u.a = hb + (size_t)u.pm * 256 * 1024 * 2; u.b = wint + (size_t)(3072 + h * 256) * 1024 * 2; return true; }
        const int L = (i - 1) * G + c; if (L >= 512) return false;
        int pm, pn; tile_order(L, 64, 8, pm, pn); u.pm = pm; u.pn = pn; u.kind = 1;
        u.a = hb + (size_t)pm * 256 * 1024 * 2; u.b = wint + (size_t)(4096 + pn * 256) * 1024 * 2; return true; } };
struct EpiP6 { static constexpr bool AFTER_DRAIN = false; bf16_t* hm; float* hss; const float* rsb; bf16_t* uu;
    __device__ __forceinline__ void mid(Acc&, const Unit&, int, int, int, int) const {}
    __device__ __forceinline__ void pre(const Unit&, int, int, int, int) const {}
    __device__ __forceinline__ void operator()(Acc& acc, const Unit& u, int wr, int wc, int fr, int fq) const {
        if (u.kind == 0) {
            float hsv[2][4], rxv[2][4];
#pragma unroll
            for (int ai = 0; ai < 2; ++ai)
#pragma unroll
                for (int m = 0; m < 4; ++m) rxv[ai][m] = rsb[u.pm * 256 + EPI_RL(ai, m)];
#pragma unroll
            for (int ai = 0; ai < 2; ++ai)
#pragma unroll
                for (int m = 0; m < 4; ++m) hsv[ai][m] = __hip_atomic_load(hss + (size_t)(u.pm * 256 + EPI_RL(ai, m)) * 4 + u.pn, __ATOMIC_RELAXED, __HIP_MEMORY_SCOPE_AGENT);
            u32x4 cur[2], nxt[2];
#pragma unroll
            for (int bj = 0; bj < 2; ++bj) cur[bj] = *(const u32x4*)(hm + (size_t)(u.pm * 256 + EPI_RL(0, 0)) * 1024 + u.pn * 256 + EPI_CL(bj));
            EPI_R8 { const int ai = r8 >> 2, m = r8 & 3; const int t = u.pm * 256 + EPI_RL(ai, m);
                if (r8 < 7) { const int tn = u.pm * 256 + EPI_RL((r8 + 1) >> 2, (r8 + 1) & 3);
#pragma unroll
                    for (int bj = 0; bj < 2; ++bj) nxt[bj] = *(const u32x4*)(hm + (size_t)tn * 1024 + u.pn * 256 + EPI_CL(bj)); }
                const float rsn = rsqrtf(hsv[ai][m] * (1.0f / 256.0f) + EPS_); const float rx = rxv[ai][m];
#pragma unroll
                for (int bj = 0; bj < 2; ++bj) { f32x4 h0, h1; unpack8(cur[bj], h0, h1);
                    const f32x4 o0 = h0 * rsn * sigm4(acc[ai][bj][m][0] * rx), o1 = h1 * rsn * sigm4(acc[ai][bj][m][1] * rx);
                    *(u32x4*)(hm + (size_t)t * 1024 + u.pn * 256 + EPI_CL(bj)) = pack8(o0, o1); }
                cur[0] = nxt[0]; cur[1] = nxt[1]; }
        } else {
            float rxv[2][4];
#pragma unroll
            for (int ai = 0; ai < 2; ++ai)
#pragma unroll
                for (int m = 0; m < 4; ++m) rxv[ai][m] = rsb[u.pm * 256 + EPI_RL(ai, m)];
            EPI_ROWS(ai, m) { const int t = u.pm * 256 + EPI_RL(ai, m); const float rx = rxv[ai][m];
                const f32x4 o0 = acc[ai][0][m][0] * rx * sigm4(acc[ai][1][m][0] * rx), o1 = acc[ai][0][m][1] * rx * sigm4(acc[ai][1][m][1] * rx);
                *(u32x4*)(uu + (size_t)t * 1024 + u.pn * 128 + wc * 32 + 8 * fq) = pack8(o0, o1); }
        }
    } };

struct SchedP8 { const char* hb; const char* wint; const char* hmg; const char* uc; const char* wmt; const char* wct; int G, c;
    __device__ __forceinline__ bool next(int i, Unit& u) const {
        const int L = (i >> 2) * G + c, r = i & 3; if (L >= 256) return false;
        int pn; map_n4(L, u.pm, pn); u.cont = 0;
        if (r < 2) { u.kind = 2; u.pn = 2 * pn + r; u.a = hb + (size_t)u.pm * 256 * 1024 * 2; u.b = wint + (size_t)(6144 + u.pn * 256) * 1024 * 2; }
        else if (r == 2) { u.kind = 0; u.pn = pn; u.a = hmg + (size_t)u.pm * 256 * 1024 * 2; u.b = wmt + (size_t)pn * 256 * 1024 * 2; }
        else { u.kind = 1; u.pn = pn; u.a = uc + (size_t)u.pm * 256 * 1024 * 2; u.b = wct + (size_t)pn * 256 * 1024 * 2; }
        return true; } };
struct EpiP8 { static constexpr bool AFTER_DRAIN = false; bf16_t* gmc; bf16_t* tmp; bf16_t* merged; const float* rsb;
    __device__ __forceinline__ void mid(Acc&, const Unit&, int, int, int, int) const {}
    __device__ __forceinline__ void pre(const Unit&, int, int, int, int) const {}
    __device__ __forceinline__ void operator()(Acc& acc, const Unit& u, int wr, int wc, int fr, int fq) const {
        if (u.kind == 2) {
            float rxv[2][4];
#pragma unroll
            for (int ai = 0; ai < 2; ++ai)
#pragma unroll
                for (int m = 0; m < 4; ++m) rxv[ai][m] = rsb[u.pm * 256 + EPI_RL(ai, m)];
            EPI_ROWS(ai, m) { const int t = u.pm * 256 + EPI_RL(ai, m); const float rx = rxv[ai][m], rxe = rx * -1.4426950408889634f;
                const f32x4 d0 = exp2v(acc[ai][1][m][0] * rxe) + 1.0f, d1 = exp2v(acc[ai][1][m][1] * rxe) + 1.0f;
                const f32x4 r0 = sigm4(acc[ai][0][m][0] * rx) * d0, r1 = sigm4(acc[ai][0][m][1] * rx) * d1, c0 = rcpv(d0), c1 = rcpv(d1);
                bf16_t* ptr = gmc + (size_t)t * 2048 + u.pn * 128 + wc * 32 + 8 * fq;
                *(u32x4*)ptr = pack8(r0, r1); *(u32x4*)(ptr + 1024) = pack8(c0, c1); }
        } else if (u.kind == 0) {
            u32x4 cur[2], nxt[2];
#pragma unroll
            for (int bj = 0; bj < 2; ++bj) cur[bj] = *(const u32x4*)(gmc + (size_t)(u.pm * 256 + EPI_RL(0, 0)) * 2048 + u.pn * 256 + EPI_CL(bj));
            EPI_R8 { const int ai = r8 >> 2, m = r8 & 3; const int t = u.pm * 256 + EPI_RL(ai, m);
                if (r8 < 7) { const int tn = u.pm * 256 + EPI_RL((r8 + 1) >> 2, (r8 + 1) & 3);
#pragma unroll
                    for (int bj = 0; bj < 2; ++bj) nxt[bj] = *(const u32x4*)(gmc + (size_t)tn * 2048 + u.pn * 256 + EPI_CL(bj)); }
#pragma unroll
                for (int bj = 0; bj < 2; ++bj) { const int c = u.pn * 256 + EPI_CL(bj); f32x4 a0, a1; unpack8(cur[bj], a0, a1);
                    *(u32x4*)(tmp + (size_t)t * 1024 + c) = pack8(acc[ai][bj][m][0] * a0, acc[ai][bj][m][1] * a1); }
                cur[0] = nxt[0]; cur[1] = nxt[1]; }
        } else {
            u32x4 cg[2], ct[2], ng[2], nt2[2];
#pragma unroll
            for (int bj = 0; bj < 2; ++bj) { const int t0 = u.pm * 256 + EPI_RL(0, 0); const int c = u.pn * 256 + EPI_CL(bj);
                cg[bj] = *(const u32x4*)(gmc + (size_t)t0 * 2048 + 1024 + c); ct[bj] = *(const u32x4*)(tmp + (size_t)t0 * 1024 + c); }
            EPI_R8 { const int ai = r8 >> 2, m = r8 & 3; const int t = u.pm * 256 + EPI_RL(ai, m);
                if (r8 < 7) { const int tn = u.pm * 256 + EPI_RL((r8 + 1) >> 2, (r8 + 1) & 3);
#pragma unroll
                    for (int bj = 0; bj < 2; ++bj) { const int c = u.pn * 256 + EPI_CL(bj); ng[bj] = *(const u32x4*)(gmc + (size_t)tn * 2048 + 1024 + c); nt2[bj] = *(const u32x4*)(tmp + (size_t)tn * 1024 + c); } }
#pragma unroll
                for (int bj = 0; bj < 2; ++bj) { const int c = u.pn * 256 + EPI_CL(bj); f32x4 b0, b1, t0, t1; unpack8(cg[bj], b0, b1); unpack8(ct[bj], t0, t1);
                    *(u32x4*)(merged + (size_t)t * 1024 + c) = pack8((acc[ai][bj][m][0] + t0) * b0, (acc[ai][bj][m][1] + t1) * b1); }
                cg[0] = ng[0]; cg[1] = ng[1]; ct[0] = nt2[0]; ct[1] = nt2[1]; }
        }
    } };

struct SchedN4 { const char* a; const char* bt; size_t astep, bstep; int G, c;
    __device__ __forceinline__ bool next(int i, Unit& u) const {
        const int L = i * G + c; if (L >= 256) return false;
        map_n4(L, u.pm, u.pn); u.kind = 0; u.cont = 0; u.a = a + (size_t)u.pm * astep; u.b = bt + (size_t)u.pn * bstep; return true; } };
struct SchedPE { const char* a; const char* bt; int G, c;
    __device__ __forceinline__ bool next(int i, Unit& u) const {
        const int L = i * G + c; if (L >= 256 || c < 0) return false;
        u.pm = L >> 2; u.pn = L & 3; u.kind = 0; u.cont = 0; u.a = a + (size_t)u.pm * 256 * 256 * 2; u.b = bt + (size_t)u.pn * 256 * 256 * 2; return true; } };
template <bool SRC_BF16> struct EpiRes { static constexpr bool AFTER_DRAIN = false; const void* src; bf16_t* dstb; float* ssq;
    __device__ __forceinline__ void mid(Acc&, const Unit&, int, int, int, int) const {}
    __device__ __forceinline__ void pre(const Unit& u, int wr, int wc, int fr, int fq) const {
        if (!SRC_BF16) {
            EPI_ROWS(ai, m) { const int t = u.pm * 256 + EPI_RL(ai, m);
#pragma unroll
                for (int bj = 0; bj < 2; ++bj) { const float v = *((const float*)src + (size_t)t * 1024 + u.pn * 256 + EPI_CL(bj)); asm volatile("" :: "v"(v)); } }
        }
    }
    __device__ __forceinline__ void operator()(Acc& acc, const Unit& u, int wr, int wc, int fr, int fq) const {
        f32x4 rb[3][2][2];
#define ERES_LOAD(dst, t_) do { _Pragma("unroll") for (int bj = 0; bj < 2; ++bj) { const size_t o_ = (size_t)(t_) * 1024 + u.pn * 256 + EPI_CL(bj); \
            if (SRC_BF16) dst[bj][0] = __builtin_bit_cast(f32x4, *(const u32x4*)((const bf16_t*)src + o_)); \
            else { dst[bj][0] = *(const f32x4*)((const float*)src + o_); dst[bj][1] = *(const f32x4*)((const float*)src + o_ + 4); } } } while (0)
        ERES_LOAD(rb[0], u.pm * 256 + EPI_RL(0, 0)); ERES_LOAD(rb[1], u.pm * 256 + EPI_RL(0, 1));
        EPI_R8 { const int ai = r8 >> 2, m = r8 & 3; const int t = u.pm * 256 + EPI_RL(ai, m); float ss = 0.f;
            if (r8 < 6) ERES_LOAD(rb[(r8 + 2) % 3], u.pm * 256 + EPI_RL((r8 + 2) >> 2, (r8 + 2) & 3));
#pragma unroll
            for (int bj = 0; bj < 2; ++bj) { const size_t o = (size_t)t * 1024 + u.pn * 256 + EPI_CL(bj); f32x4 v0, v1;
                if (SRC_BF16) unpack8(__builtin_bit_cast(u32x4, rb[r8 % 3][bj][0]), v0, v1); else { v0 = rb[r8 % 3][bj][0]; v1 = rb[r8 % 3][bj][1]; }
                v0 += acc[ai][bj][m][0]; v1 += acc[ai][bj][m][1];
                { const f32x4 q = v0 * v0 + v1 * v1; ss += (q[0] + q[1]) + (q[2] + q[3]); }
                *(u32x4*)(dstb + o) = pack8(v0, v1); }
            ss += __shfl_xor(ss, 16); ss += __shfl_xor(ss, 32);
            if (fq == 0) unsafeAtomicAdd(ssq + t, ss); }
#undef ERES_LOAD
    } };

struct SchedP10 { const char* x1b; const char* wgut; int G, c;
    __device__ __forceinline__ bool next(int i, Unit& u) const {
        const int L = i * G + c; if (L >= 1408) return false;
        int pm, pn; tile_order(L, 64, 22, pm, pn); u.pm = pm; u.pn = pn; u.kind = 0; u.cont = 0;
        u.a = x1b + (size_t)pm * 256 * 1024 * 2; u.b = wgut + (size_t)pn * 256 * 1024 * 2; return true; } };
struct EpiP10 { static constexpr bool AFTER_DRAIN = false; const float* ssq; bf16_t* hid;
    __device__ __forceinline__ void mid(Acc&, const Unit&, int, int, int, int) const {}
    __device__ __forceinline__ void pre(const Unit&, int, int, int, int) const {}
    __device__ __forceinline__ void operator()(Acc& acc, const Unit& u, int wr, int wc, int fr, int fq) const {
        float rsv[2][4];
#pragma unroll
        for (int ai = 0; ai < 2; ++ai)
#pragma unroll
            for (int m = 0; m < 4; ++m) rsv[ai][m] = ssq[u.pm * 256 + EPI_RL(ai, m)];
        EPI_ROWS(ai, m) { const int t = u.pm * 256 + EPI_RL(ai, m); const float rs = rsqrtf(rsv[ai][m] * (1.0f / 1024.0f) + EPS_);
            const f32x4 o0 = silu4(acc[ai][0][m][0] * rs) * (acc[ai][1][m][0] * rs), o1 = silu4(acc[ai][0][m][1] * rs) * (acc[ai][1][m][1] * rs);
            *(u32x4*)(hid + (size_t)t * DFF_ + u.pn * 128 + wc * 32 + 8 * fq) = pack8(o0, o1); }
    } };

struct EpiBf { static constexpr bool AFTER_DRAIN = false; bf16_t* o;
    __device__ __forceinline__ void mid(Acc&, const Unit&, int, int, int, int) const {}
    __device__ __forceinline__ void pre(const Unit&, int, int, int, int) const {}
    __device__ __forceinline__ void operator()(Acc& acc, const Unit& u, int wr, int wc, int fr, int fq) const {
        EPI_ROWS(ai, m) { bf16_t* rowp = o + (size_t)(u.pm * 256 + EPI_RL(ai, m)) * 1024 + u.pn * 256 + EPI_CL(0);
#pragma unroll
            for (int bj = 0; bj < 2; ++bj) *(u32x4*)(rowp + bj * 128) = pack8(acc[ai][bj][m][0], acc[ai][bj][m][1]); }
    } };

struct EpiP12 { static constexpr bool AFTER_DRAIN = true; const float* ssq2; const bf16_t* pe; const bf16_t* xin; float* out; float* ssq3; unsigned* done; const float* fg;
    __device__ __forceinline__ void mid(Acc&, const Unit&, int, int, int, int) const {}
    __device__ __forceinline__ void pre(const Unit&, int, int, int, int) const {}
    __device__ __forceinline__ void operator()(Acc& acc, const Unit& u, int wr, int wc, int fr, int fq) const {
        float rsv[2][4];
#pragma unroll
        for (int ai = 0; ai < 2; ++ai)
#pragma unroll
            for (int m = 0; m < 4; ++m) rsv[ai][m] = ssq2[u.pm * 256 + EPI_RL(ai, m)];
        { u32x4 cx[2], cp[2], nx[2], np[2];
#pragma unroll
            for (int bj = 0; bj < 2; ++bj) { const size_t o = (size_t)(u.pm * 256 + EPI_RL(0, 0)) * 1024 + u.pn * 256 + EPI_CL(bj); cx[bj] = *(const u32x4*)(xin + o); cp[bj] = *(const u32x4*)(pe + o); }
            EPI_R8 { const int ai = r8 >> 2, m = r8 & 3; const int t = u.pm * 256 + EPI_RL(ai, m); const float rs = rsqrtf(rsv[ai][m] * (1.0f / 1024.0f) + EPS_); float ss = 0.f;
                if (r8 < 7) {
#pragma unroll
                    for (int bj = 0; bj < 2; ++bj) { const size_t o = (size_t)(u.pm * 256 + EPI_RL((r8 + 1) >> 2, (r8 + 1) & 3)) * 1024 + u.pn * 256 + EPI_CL(bj); nx[bj] = *(const u32x4*)(xin + o); np[bj] = *(const u32x4*)(pe + o); } }
#pragma unroll
                for (int bj = 0; bj < 2; ++bj) { f32x4 p0, p1, v0, v1; unpack8(cp[bj], p0, p1); unpack8(cx[bj], v0, v1);
                    v0 += sigm4(acc[ai][bj][m][0] * rs) * p0; v1 += sigm4(acc[ai][bj][m][1] * rs) * p1;
                    { const f32x4 q = v0 * v0 + v1 * v1; ss += (q[0] + q[1]) + (q[2] + q[3]); }
                    acc[ai][bj][m][0] = v0; acc[ai][bj][m][1] = v1; }
                ss += __shfl_xor(ss, 16); ss += __shfl_xor(ss, 32);
                if (fq == 0) unsafeAtomicAdd(ssq3 + t, ss);
                cx[0] = nx[0]; cx[1] = nx[1]; cp[0] = np[0]; cp[1] = np[1]; } }
        asm volatile("s_waitcnt vmcnt(0)" ::: "memory");
        unsigned* cnt = done + 64 * u.pm;
        if ((threadIdx.x & 63) == 0) __hip_atomic_fetch_add(cnt, 1u, __ATOMIC_RELAXED, __HIP_MEMORY_SCOPE_AGENT);
        { unsigned sp = 0; while (__hip_atomic_load(cnt, __ATOMIC_RELAXED, __HIP_MEMORY_SCOPE_AGENT) < 32u) { __builtin_amdgcn_s_sleep(1); if (++sp > (1u << 22)) break; } }
#pragma unroll
        for (int ai = 0; ai < 2; ++ai)
#pragma unroll
            for (int m = 0; m < 4; ++m) rsv[ai][m] = __hip_atomic_load(ssq3 + u.pm * 256 + EPI_RL(ai, m), __ATOMIC_RELAXED, __HIP_MEMORY_SCOPE_AGENT);
        f32x4 gv[2][2];
#pragma unroll
        for (int bj = 0; bj < 2; ++bj) { const int cc = u.pn * 256 + EPI_CL(bj); gv[bj][0] = *(const f32x4*)(fg + cc); gv[bj][1] = *(const f32x4*)(fg + cc + 4); }
        EPI_ROWS(ai, m) { const int t = u.pm * 256 + EPI_RL(ai, m);
            const float rs = rsqrtf(rsv[ai][m] * (1.0f / 1024.0f) + EPS_);
#pragma unroll
            for (int bj = 0; bj < 2; ++bj) { const size_t o = (size_t)t * 1024 + u.pn * 256 + EPI_CL(bj);
                *(f32x4*)(out + o) = acc[ai][bj][m][0] * rs * gv[bj][0]; *(f32x4*)(out + o + 4) = acc[ai][bj][m][1] * rs * gv[bj][1]; } }
    } };

struct CvtTile { const float* src; int ld; const float* scale; bf16_t* dst; int dstld; };
__device__ __forceinline__ CvtTile cvt_tile_params(const Params& p, int tl) {
    const int NT0 = 2048, NT4 = NT0 + 1024, NT5 = NT4 + 1408, NT6 = NT5 + 704;
    unsigned char* ws = p.ws; CvtTile t; t.scale = nullptr;
    if (tl < NT0) { const int nb = tl >> 4, kb = tl & 15; const int n0 = nb * 64; int col;
        if (n0 < 4096) col = n0; else if (n0 < 6144) { const int j = (n0 - 4096) >> 8, r = (n0 - 4096) & 255; col = (r < 128) ? (4104 + 128 * j + r) : (5128 + 128 * j + r - 128); }
        else { const int j = (n0 - 6144) >> 8, r = (n0 - 6144) & 255; col = 6152 + ((r < 128) ? (128 * j + r) : (1024 + 128 * j + r - 128)); }
        t.src = p.in[3] + (size_t)kb * 64 * NIN_ + col; t.ld = NIN_; t.scale = p.in[2] + kb * 64; t.dst = (bf16_t*)(ws + O_WINT) + (size_t)n0 * 1024 + kb * 64; t.dstld = 1024; }
    else if (tl < NT4) { const int w = (tl - NT0) >> 8, l = (tl - NT0) & 255; const int nb = l >> 4, kb = l & 15;
        const float* base = w == 0 ? p.in[12] : (w == 1 ? p.in[13] : (w == 2 ? p.in[14] : p.in[20])); const size_t od = w == 0 ? O_WMT : (w == 1 ? O_WCT : (w == 2 ? O_WOT : O_WPGT));
        t.src = base + (size_t)kb * 64 * 1024 + nb * 64; t.ld = 1024; if (w == 3) t.scale = p.in[19] + kb * 64; if (w == 0) t.scale = p.in[7] + kb * 64; t.dst = (bf16_t*)(ws + od) + (size_t)nb * 64 * 1024 + kb * 64; t.dstld = 1024; }
    else if (tl < NT5) { const int l = tl - NT4; const int nb = l >> 4, kb = l & 15; const int n0 = nb * 64; const int j = n0 >> 8, r = n0 & 255;
        const float* base = (r < 128) ? p.in[16] : p.in[17]; const int col = 128 * j + (r & 127);
        t.src = base + (size_t)kb * 64 * DFF_ + col; t.ld = DFF_; t.scale = p.in[15] + kb * 64; t.dst = (bf16_t*)(ws + O_WGUT) + (size_t)n0 * 1024 + kb * 64; t.dstld = 1024; }
    else if (tl < NT6) { const int l = tl - NT5; const int nb = l / 44, kb = l % 44;
        t.src = p.in[18] + (size_t)kb * 64 * 1024 + nb * 64; t.ld = 1024; t.dst = (bf16_t*)(ws + O_WDT) + (size_t)nb * 64 * DFF_ + kb * 64; t.dstld = DFF_; }
    else { const int l = tl - NT6; const int nb = l >> 2, kb = l & 3;
        t.src = p.in[21] + (size_t)kb * 64 * 1024 + nb * 64; t.ld = 1024; t.dst = (bf16_t*)(ws + O_WPPT) + (size_t)nb * 64 * 256 + kb * 64; t.dstld = 256; }
    return t;
}
__device__ __forceinline__ void cvt_tile_load(const CvtTile& t, f32x4 (&v)[2]) {
    const int tid = threadIdx.x, kk = tid >> 4, c4 = (tid & 15) * 4;
#pragma unroll
    for (int pss = 0; pss < 2; ++pss) { const int k = kk + pss * 32; v[pss] = *(const f32x4*)(t.src + (size_t)k * t.ld + c4); if (t.scale) v[pss] = v[pss] * t.scale[k]; }
}

__device__ __forceinline__ void phase0(const Params& p, unsigned char* sm) {
    unsigned char* ws = p.ws;
    const int tid = threadIdx.x, lane = tid & 63, wid = tid >> 6;
    const size_t gtid = (size_t)blockIdx.x * 512 + tid, gthreads = (size_t)gridDim.x * 512;
    for (size_t i = gtid; i < ZERO_BYTES / 16; i += gthreads) ((u32x4*)(ws + O_ZERO))[i] = (u32x4){0u, 0u, 0u, 0u};
    { const float* pp = p.in[1]; bf16_t* pb = (bf16_t*)(ws + O_PB);
        for (size_t i = gtid; i < (size_t)T_ * 256 / 8; i += gthreads) { const f32x4 a = *(const f32x4*)(pp + i * 8), b = *(const f32x4*)(pp + i * 8 + 4); *(u32x4*)(pb + i * 8) = pack8(a, b); } }
    { const float* x = p.in[0]; const float* g = p.in[2]; const float* win = p.in[3]; const float* bif = p.in[4];
        float* wgT = (float*)sm;
        for (int idx = tid; idx < 8192; idx += 512) { const int k = idx >> 3, j = idx & 7; wgT[j * 1024 + k] = win[(size_t)k * NIN_ + 4096 + j] * g[k]; }
        __syncthreads();
        bf16_t* hb = (bf16_t*)(ws + O_HB); float* ig = (float*)(ws + O_IG); float* lf = (float*)(ws + O_LF);
        const int rstep = gridDim.x * 8; int row = blockIdx.x * 8 + wid;
        f32x4 xn[4];
#pragma unroll
        for (int i = 0; i < 4; ++i) xn[i] = (row < T_) ? *(const f32x4*)(x + (size_t)row * 1024 + i * 256 + lane * 4) : (f32x4){0.f, 0.f, 0.f, 0.f};
        for (; row < T_; row += rstep) {
            f32x4 xv[4]; float ss = 0.f;
#pragma unroll
            for (int i = 0; i < 4; ++i) { xv[i] = xn[i]; ss += xv[i][0] * xv[i][0] + xv[i][1] * xv[i][1] + xv[i][2] * xv[i][2] + xv[i][3] * xv[i][3]; }
            { const int nrow = row + rstep;
                if (nrow < T_) {
#pragma unroll
                    for (int i = 0; i < 4; ++i) xn[i] = *(const f32x4*)(x + (size_t)nrow * 1024 + i * 256 + lane * 4); } }
            ss = wave_sum(ss); const float rs = rsqrtf(ss * (1.0f / 1024.0f) + EPS_);
            float d[8];
#pragma unroll
            for (int j = 0; j < 8; ++j) d[j] = 0.f;
            if (lane == 0) ((float*)(ws + O_RS))[row] = rs;
#pragma unroll
            for (int i = 0; i < 4; ++i) { const f32x4 hn = xv[i] * rs;
                u32x2 w; w.x = cvt_pk_bf16(xv[i][0], xv[i][1]); w.y = cvt_pk_bf16(xv[i][2], xv[i][3]); *(u32x2*)(hb + (size_t)row * 1024 + i * 256 + lane * 4) = w;
#pragma unroll
                for (int j = 0; j < 8; ++j) { const f32x4 wv = *(const f32x4*)(wgT + j * 1024 + i * 256 + lane * 4); d[j] += hn[0] * wv[0] + hn[1] * wv[1] + hn[2] * wv[2] + hn[3] * wv[3]; } }
#pragma unroll
            for (int j = 0; j < 8; ++j) d[j] = wave_sum(d[j]);
            if (lane < 8) { float v = d[0];
#pragma unroll
                for (int j = 1; j < 8; ++j) v = (lane == j) ? d[j] : v;
                v += bif[lane];
                if (lane < 4) ig[(size_t)row * 4 + lane] = v;
                else { const float z = v; lf[(size_t)row * 4 + lane - 4] = fminf(z, 0.f) - log1pf(__expf(-fabsf(z))); } }
        }
        __syncthreads();
    }
    { const int NTILES = 2048 + 1024 + 1408 + 704 + 64; const int gs = gridDim.x;
        float* tl = (float*)sm;
        int t = blockIdx.x; CvtTile c0{}, c1{}; f32x4 v0[2], v1[2];
        if (t < NTILES) { c0 = cvt_tile_params(p, t); cvt_tile_load(c0, v0); }
        if (t + gs < NTILES) { c1 = cvt_tile_params(p, t + gs); cvt_tile_load(c1, v1); }
        for (; t < NTILES; t += gs) {
            { const int kk = tid >> 4, c4 = (tid & 15) * 4;
#pragma unroll
                for (int pss = 0; pss < 2; ++pss) { const int k = kk + pss * 32;
#pragma unroll
                    for (int j = 0; j < 4; ++j) tl[k * 65 + c4 + j] = v0[pss][j]; } }
            __syncthreads();
            const CvtTile done = c0; c0 = c1; v0[0] = v1[0]; v0[1] = v1[1];
            { const int tn = t + 2 * gs; if (tn < NTILES) { c1 = cvt_tile_params(p, tn); cvt_tile_load(c1, v1); } }
            { const int n = tid >> 3, k8 = (tid & 7) * 8; float e[8];
#pragma unroll
                for (int q = 0; q < 8; ++q) e[q] = tl[(k8 + q) * 65 + n];
                u32x4 w; w.x = cvt_pk_bf16(e[0], e[1]); w.y = cvt_pk_bf16(e[2], e[3]); w.z = cvt_pk_bf16(e[4], e[5]); w.w = cvt_pk_bf16(e[6], e[7]);
                *(u32x4*)(done.dst + (size_t)n * done.dstld + k8) = w; }
            __syncthreads();
        }
    }
}

__device__ __forceinline__ void phase2(const Params& p, unsigned char* sm) {
    unsigned char* ws = p.ws;
    const int tid = threadIdx.x, lane = tid & 63, wid = tid >> 6;
    float* rowfac = (float*)sm; float* colfac = rowfac + 256; float* wsum = colfac + 256;
    const float* ig = (const float*)(ws + O_IG); const float* lf = (const float*)(ws + O_LF);
    const bf16_t* qkpre = (const bf16_t*)p.out;
    const float* cw = p.in[5]; const float* cb = p.in[6];
    for (int item = blockIdx.x; item < 256; item += gridDim.x) {
        const int b = item >> 5, h = (item >> 3) & 3, sc = item & 7; const int tokb = b * SEQ_ + sc * 256;
        float v = 0.f, igv = 0.f;
        if (tid < 256) { v = lf[(size_t)(tokb + tid) * 4 + h]; igv = ig[(size_t)(tokb + tid) * 4 + h]; }
#pragma unroll
        for (int o = 1; o < 64; o <<= 1) { const float n = __shfl_up(v, o); if (lane >= o) v += n; }
        if (tid < 256 && lane == 63) wsum[wid] = v;
        __syncthreads();
        if (tid < 256) { float add = 0.f; for (int j = 0; j < wid; ++j) add += wsum[j]; v += add; rowfac[tid] = __expf(v); colfac[tid] = __expf(igv - v);
            if (tid == 255) ((float*)(ws + O_EBL))[item] = __expf(v); }
        __syncthreads();
#pragma unroll 1
        for (int qt = 0; qt < 4; ++qt) {
        const int cp = tid & 127, tg = tid >> 7; const int ch = 2 * cp; const int tl0 = qt * 64 + tg * 16; const int s0 = sc * 256 + tl0;
        { const int col = h * 256 + ch; f32x2 xx[19];
#pragma unroll
            for (int i = 0; i < 19; ++i) { const int s = s0 - 3 + i; unsigned w = 0u; if (s >= 0) w = *(const unsigned*)(qkpre + (size_t)(b * SEQ_ + s) * 2048 + col); xx[i] = (f32x2){bf_lo(w), bf_hi(w)}; }
            f32x2 wv[4];
#pragma unroll
            for (int k = 0; k < 4; ++k) wv[k] = *(const f32x2*)(cw + (size_t)k * 2048 + col);
            const f32x2 bv = *(const f32x2*)(cb + col);
            bf16_t* wq = (bf16_t*)(ws + O_WQ) + (size_t)item * 65536;
#pragma unroll
            for (int i = 0; i < 16; ++i) { f32x2 y = bv;
#pragma unroll
                for (int k = 0; k < 4; ++k) y = __builtin_elementwise_fma(xx[i + k], wv[k], y);
                const f32x2 o = silu2(y) * (rowfac[tl0 + i] * 0.0625f);
                *(unsigned*)(wq + (size_t)(tl0 + i) * 256 + ch) = cvt_pk_bf16(o[0], o[1]); } }
        { const int col = 1024 + h * 256 + ch; f32x2 xx[19];
#pragma unroll
            for (int i = 0; i < 19; ++i) { const int s = s0 - 3 + i; unsigned w = 0u; if (s >= 0) w = *(const unsigned*)(qkpre + (size_t)(b * SEQ_ + s) * 2048 + col); xx[i] = (f32x2){bf_lo(w), bf_hi(w)}; }
            f32x2 wv[4];
#pragma unroll
            for (int k = 0; k < 4; ++k) wv[k] = *(const f32x2*)(cw + (size_t)k * 2048 + col);
            const f32x2 bv = *(const f32x2*)(cb + col);
            bf16_t* kw = (bf16_t*)(ws + O_KW) + (size_t)item * 65536; bf16_t* kwt = (bf16_t*)(ws + O_KWT) + (size_t)item * 65536;
            float k0[16], k1[16]; f32x2 nn = {0.f, 0.f};
#pragma unroll
            for (int i = 0; i < 16; ++i) { f32x2 y = bv;
#pragma unroll
                for (int k = 0; k < 4; ++k) y = __builtin_elementwise_fma(xx[i + k], wv[k], y);
                const f32x2 o = silu2(y) * colfac[tl0 + i]; k0[i] = o[0]; k1[i] = o[1]; nn += o;
                *(unsigned*)(kw + (size_t)(tl0 + i) * 256 + ch) = cvt_pk_bf16(o[0], o[1]); }
            const float n0 = nn[0], n1 = nn[1];
            u32x4 a, c;
            a.x = cvt_pk_bf16(k0[0], k0[1]); a.y = cvt_pk_bf16(k0[2], k0[3]); a.z = cvt_pk_bf16(k0[4], k0[5]); a.w = cvt_pk_bf16(k0[6], k0[7]);
            c.x = cvt_pk_bf16(k0[8], k0[9]); c.y = cvt_pk_bf16(k0[10], k0[11]); c.z = cvt_pk_bf16(k0[12], k0[13]); c.w = cvt_pk_bf16(k0[14], k0[15]);
            *(u32x4*)(kwt + (size_t)ch * 256 + tl0) = a; *(u32x4*)(kwt + (size_t)ch * 256 + tl0 + 8) = c;
            a.x = cvt_pk_bf16(k1[0], k1[1]); a.y = cvt_pk_bf16(k1[2], k1[3]); a.z = cvt_pk_bf16(k1[4], k1[5]); a.w = cvt_pk_bf16(k1[6], k1[7]);
            c.x = cvt_pk_bf16(k1[8], k1[9]); c.y = cvt_pk_bf16(k1[10], k1[11]); c.z = cvt_pk_bf16(k1[12], k1[13]); c.w = cvt_pk_bf16(k1[14], k1[15]);
            *(u32x4*)(kwt + (size_t)(ch + 1) * 256 + tl0) = a; *(u32x4*)(kwt + (size_t)(ch + 1) * 256 + tl0 + 8) = c;
            float* nsum = (float*)(ws + O_NSUM) + (size_t)item * 256;
            unsafeAtomicAdd(nsum + ch, n0); unsafeAtomicAdd(nsum + ch + 1, n1); }
        }
        __syncthreads();
    }
}

__device__ __forceinline__ void phase4(const Params& p, unsigned char* sm) {
    unsigned char* ws = p.ws;
    const int tid = threadIdx.x;
    const float* ebl = (const float*)(ws + O_EBL);
    const bf16_t* lt = (const bf16_t*)(p.ws + O_KWT);
    bf16_t* cint = (bf16_t*)(ws + O_CINT);
    const size_t gtid = (size_t)blockIdx.x * 512 + tid, gthreads = (size_t)gridDim.x * 512;
#pragma unroll 2
    for (size_t g = gtid; g < (size_t)32 * 16384; g += gthreads) {
        const int bh = (int)(g >> 14), e4 = (int)(g & 16383);
        f32x4 c = {0.f, 0.f, 0.f, 0.f};
        u32x2 lw[7]; float eb[7];
#pragma unroll
        for (int sc = 0; sc < 7; ++sc) { lw[sc] = *(const u32x2*)(lt + (size_t)(bh * 8 + sc) * 65536 + e4 * 4); eb[sc] = ebl[bh * 8 + sc]; }
#pragma unroll
        for (int sc = 0; sc < 8; ++sc) { const int item = bh * 8 + sc;
            u32x2 w; w.x = cvt_pk_bf16(c[0], c[1]); w.y = cvt_pk_bf16(c[2], c[3]); *(u32x2*)(cint + (size_t)item * 65536 + e4 * 4) = w;
            if (sc < 7) { const f32x4 l = {bf_lo(lw[sc].x), bf_hi(lw[sc].x), bf_lo(lw[sc].y), bf_hi(lw[sc].y)}; c = (c + l) * eb[sc]; } }
    }
    float* nin = (float*)sm;
    const float* nsum = (const float*)(ws + O_NSUM);
    float* denx = (float*)(ws + O_DENX);
    for (int item = blockIdx.x; item < 256; item += gridDim.x) {
        const int b = item >> 5, h = (item >> 3) & 3, sc = item & 7; const int tokb = b * SEQ_ + sc * 256; const int bh = item >> 3;
        if (tid < 256) { float eb[7], ns[7];
#pragma unroll
            for (int j = 0; j < 7; ++j) { eb[j] = ebl[bh * 8 + j]; ns[j] = nsum[(size_t)(bh * 8 + j) * 256 + tid]; }
            float nv = 0.f;
#pragma unroll
            for (int j = 0; j < 7; ++j) if (j < sc) nv = eb[j] * (nv + ns[j]);
            nin[tid] = nv; }
        __syncthreads();
        const int tl = tid >> 1, half = tid & 1;
        const bf16_t* wq = (const bf16_t*)(ws + O_WQ) + (size_t)item * 65536 + (size_t)tl * 256 + half * 128;
        float d = 0.f;
#pragma unroll
        for (int i = 0; i < 16; ++i) { f32x4 a0, a1; unpack8(*(const u32x4*)(wq + i * 8), a0, a1); const float* nn = nin + half * 128 + i * 8;
            d += a0[0] * nn[0] + a0[1] * nn[1] + a0[2] * nn[2] + a0[3] * nn[3] + a1[0] * nn[4] + a1[1] * nn[5] + a1[2] * nn[6] + a1[3] * nn[7]; }
        d += __shfl_xor(d, 1);
        if (half == 0) denx[(size_t)(tokb + tl) * 4 + h] = d;
        __syncthreads();
    }
}

__device__ __forceinline__ void phase7(const Params& p, unsigned char* sm) {
    unsigned char* ws = p.ws;
    const int tid = threadIdx.x, lane = tid & 63, wid = tid >> 6;
    const bf16_t* uu = (const bf16_t*)p.out; bf16_t* uc = (bf16_t*)(ws + O_UC);
    const float* cw = p.in[8]; const float* cb = p.in[9]; const float* lg = p.in[10]; const float* lb = p.in[11];
    u32x4 pf[12];
#define P7_LOAD(tile_) do { const int t0_ = (tile_) * 16; const int b_ = t0_ / SEQ_, s0_ = t0_ % SEQ_; \
        _Pragma("unroll") for (int q = 0; q < 12; ++q) { const int idx = tid + q * 512; const int r = idx >> 7, c16 = idx & 127; const int s_ = s0_ - 30 + r; \
            pf[q] = (u32x4){0u, 0u, 0u, 0u}; if (idx < 46 * 128 && s_ >= 0) pf[q] = *(const u32x4*)(uu + (size_t)(b_ * SEQ_ + s_) * 1024 + c16 * 8); } } while (0)
    int tile = blockIdx.x;
    if (tile < 1024) P7_LOAD(tile);
    f32x2 wv[31];
#pragma unroll
    for (int k = 0; k < 31; ++k) wv[k] = *(const f32x2*)(cw + (size_t)k * 1024 + 2 * tid);
    const f32x2 bv = *(const f32x2*)(cb + 2 * tid);
    f32x4 lgv[4], lbv[4];
#pragma unroll
    for (int i = 0; i < 4; ++i) { lgv[i] = *(const f32x4*)(lg + i * 256 + lane * 4); lbv[i] = *(const f32x4*)(lb + i * 256 + lane * 4); }
    for (; tile < 1024; tile += gridDim.x) {
        const int t0 = tile * 16;
#pragma unroll
        for (int q = 0; q < 12; ++q) { const int idx = tid + q * 512; const int r = idx >> 7, c16 = idx & 127; if (idx < 46 * 128) *(u32x4*)(sm + r * 2048 + c16 * 16) = pf[q]; }
        __syncthreads();
        f32x2 yy[16];
        {
#pragma unroll
            for (int t = 0; t < 16; ++t) yy[t] = bv;
#pragma unroll
            for (int r = 0; r < 46; ++r) { const unsigned w = *(const unsigned*)(sm + r * 2048 + tid * 4); const f32x2 xx = {bf_lo(w), bf_hi(w)};
#pragma unroll
                for (int t = 0; t < 16; ++t) { const int k = r - t; if (k >= 0 && k <= 30) yy[t] = __builtin_elementwise_fma(wv[k], xx, yy[t]); }
                if ((r & 3) == 3) asm volatile("" ::: "memory"); }
        }
        __syncthreads();
#pragma unroll
        for (int t = 0; t < 16; ++t) *(f32x2*)(sm + t * 4096 + tid * 8) = yy[t];
        { const int tn = tile + gridDim.x; if (tn < 1024) P7_LOAD(tn); }
        __syncthreads();
#pragma unroll
        for (int tt = 0; tt < 2; ++tt) { const int t = wid * 2 + tt; f32x4 v[4]; float s1 = 0.f;
#pragma unroll
            for (int i = 0; i < 4; ++i) { v[i] = *(const f32x4*)(sm + t * 4096 + (i * 256 + lane * 4) * 4); s1 += v[i][0] + v[i][1] + v[i][2] + v[i][3]; }
            s1 = wave_sum(s1); const float mu = s1 * (1.0f / 1024.0f); float s2 = 0.f;
#pragma unroll
            for (int i = 0; i < 4; ++i) { v[i] = v[i] - mu; s2 += v[i][0] * v[i][0] + v[i][1] * v[i][1] + v[i][2] * v[i][2] + v[i][3] * v[i][3]; }
            s2 = wave_sum(s2); const float rstd = rsqrtf(s2 * (1.0f / 1024.0f) + EPS_);
#pragma unroll
            for (int i = 0; i < 4; ++i) { const int c = i * 256 + lane * 4; f32x4 z = v[i] * rstd * lgv[i] + lbv[i];
                z = silu4(z); u32x2 w; w.x = cvt_pk_bf16(z[0], z[1]); w.y = cvt_pk_bf16(z[2], z[3]); *(u32x2*)(uc + (size_t)(t0 + t) * 1024 + c) = w; } }
        __syncthreads();
    }
#undef P7_LOAD
}

__device__ __forceinline__ void phase13(const Params& p) {
    const float* ssq3 = (const float*)(p.ws + O_SSQ3); const float* fg = p.in[22];
    const size_t gtid = (size_t)blockIdx.x * 512 + threadIdx.x, gthreads = (size_t)gridDim.x * 512;
    for (size_t i = gtid; i < (size_t)T_ * 256; i += gthreads) { const int row = (int)(i >> 8), c = (int)(i & 255) * 4;
        const float rs = rsqrtf(ssq3[row] * (1.0f / 1024.0f) + EPS_); const f32x4 g = *(const f32x4*)(fg + c);
        f32x4 v = *(const f32x4*)(p.out + i * 4); v = v * rs * g; *(f32x4*)(p.out + i * 4) = v; }
}

#define XB_TMO      128
#define XB_XCNT(j)  (256  + 64 * (j))
#define XB_XSUB(j)  (1280 + 64 * (j))
#define XB_XGEN(j)  (2304 + 64 * (j))
#define XB_TOP      3328
#define XB_TOPGEN   3392
#define XCD_BAR_WORDS 3456
#define XB_SPIN_CAP (1u << 18)
__device__ __forceinline__ unsigned xb_ld(unsigned* p)              { return __hip_atomic_load(p, __ATOMIC_RELAXED, __HIP_MEMORY_SCOPE_AGENT); }
__device__ __forceinline__ unsigned xb_add(unsigned* p, unsigned v) { return __hip_atomic_fetch_add(p, v, __ATOMIC_RELAXED, __HIP_MEMORY_SCOPE_AGENT); }
__device__ __forceinline__ unsigned xb_xcc_id() { return (unsigned)__builtin_amdgcn_s_getreg((3 << 11) | 20) & 0xFu; }
#define XB_SPIN(cond, bar) do { unsigned _sp = 0; while (cond) { __builtin_amdgcn_s_sleep(1); \
    if ((++_sp & 255u) == 0u) { if (xb_ld(&(bar)[XB_TMO])) break; if (_sp > XB_SPIN_CAP) { atomicAdd(&(bar)[XB_TMO], 1u); break; } } } } while (0)
struct XcdBarrier { unsigned* bar; unsigned x; volatile LAS unsigned* st; };
__device__ __forceinline__ XcdBarrier xcd_barrier_post(unsigned* bar, volatile LAS unsigned* st) {
    XcdBarrier b; b.bar = bar; b.x = xb_xcc_id(); b.st = st;
    if (threadIdx.x == 0) (void)xb_add(&bar[XB_XCNT(b.x)], 1u);
    return b;
}
__device__ __forceinline__ void xcd_barrier_complete(unsigned* bar, unsigned x, unsigned& nloc, unsigned& nx) {
    const unsigned G = gridDim.x * gridDim.y * gridDim.z;
    unsigned sum, cnt, mine, sp = 0u;
    for (;;) {
        sum = 0u; cnt = 0u; mine = 0u;
#pragma unroll
        for (unsigned j = 0; j < 16; ++j) { const unsigned c = xb_ld(&bar[XB_XCNT(j)]); sum += c; cnt += (c > 0u) ? 1u : 0u; mine = (j == x) ? c : mine; }
        if (sum == G) break;
        __builtin_amdgcn_s_sleep(1);
        if ((++sp & 255u) == 0u) { if (xb_ld(&bar[XB_TMO])) break; if (sp > XB_SPIN_CAP) { atomicAdd(&bar[XB_TMO], 1u); break; } }
    }
    nloc = mine > 0u ? mine : 1u; nx = cnt > 0u ? cnt : 1u;
}
__device__ __forceinline__ void xcd_barrier(const XcdBarrier& b) {
    asm volatile("s_waitcnt vmcnt(0)" ::: "memory");
    __syncthreads();
    if (threadIdx.x == 0) {
        unsigned* bar = b.bar;
        __builtin_amdgcn_s_waitcnt(0);
        unsigned nloc = b.st[0], nx = b.st[1];
        if (nloc == 0u) { xcd_barrier_complete(bar, b.x, nloc, nx); b.st[0] = nloc; b.st[1] = nx; }
        const unsigned old = xb_add(&bar[XB_XSUB(b.x)], 1u);
        const unsigned gen = old / nloc;
        if (old + 1u == (gen + 1u) * nloc) {
            __builtin_amdgcn_fence(__ATOMIC_RELEASE, "agent");
            asm volatile("s_waitcnt vmcnt(0)" ::: "memory");
            const unsigned og = xb_add(&bar[XB_TOP], 1u);
            const unsigned tg = og / nx;
            if (og + 1u == (tg + 1u) * nx) xb_add(&bar[XB_TOPGEN], 1u);
            else XB_SPIN(xb_ld(&bar[XB_TOPGEN]) == tg, bar);
            __builtin_amdgcn_fence(__ATOMIC_ACQUIRE, "agent");
            xb_add(&bar[XB_XGEN(b.x)], 1u);
            asm volatile("s_waitcnt vmcnt(0)" ::: "memory");
        } else {
            XB_SPIN(xb_ld(&bar[XB_XGEN(b.x)]) == gen, bar);
            __builtin_amdgcn_fence(__ATOMIC_ACQUIRE, "agent");
            asm volatile("s_waitcnt vmcnt(0)" ::: "memory");
        }
    }
    __syncthreads();
}

template <bool COOP>
__global__ void __launch_bounds__(512, 2) mk_fwd(Params p) {
    extern __shared__ __attribute__((aligned(16))) unsigned char shm[];
    LAS unsigned char* lds = (LAS unsigned char*)shm;
    unsigned char* ws = p.ws;
    const int G = gridDim.x, c = blockIdx.x;
#ifndef PHMASK
#define PHMASK 0x3fff
#endif
#define PH(k) if (((PHMASK >> (k)) & 1) && p.ph_lo <= (k) && (k) < p.ph_hi)
    XcdBarrier xb{};
    if (COOP) { volatile LAS unsigned* st = (volatile LAS unsigned*)(lds + 131072);
        if (threadIdx.x == 0) { st[0] = 0u; st[1] = 0u; }
        __syncthreads();
        xb = xcd_barrier_post((unsigned*)(ws + O_BAR), st); }
#define SYNC(k) if (COOP) { if (p.ph_lo <= (k) && (k) + 1 < p.ph_hi) { xcd_barrier(xb); } }
    PH(0) phase0(p, shm);
    SYNC(0)
    PH(1) { SchedP1 S{(const char*)(ws + O_HB), (const char*)(ws + O_WINT), G, c}; EpiP1 E{(bf16_t*)p.out, (bf16_t*)(ws + O_VT), (const float*)(ws + O_RS)}; gemm_phase(lds, 1024, 1024, 1024, S, E); }
    SYNC(1)
    PH(3) { phase2(p, shm);
        asm volatile("s_waitcnt vmcnt(0)" ::: "memory"); __syncthreads();
        SchedP3 S{(const char*)(ws + O_WQ), (const char*)(ws + O_KW), (const char*)(ws + O_VT), (const char*)(ws + O_KWT), G, c};
        EpiP3 E{(bf16_t*)(ws + O_SS), (bf16_t*)(ws + O_KWT), (float*)(ws + O_DENI)}; gemm_phase(lds, 256, 256, 256, S, E); }
    SYNC(3)
    PH(4) phase4(p, shm);
    SYNC(4)
    PH(6) { { SchedP5 S{(const char*)(ws + O_SS), (const char*)(ws + O_VT), (const char*)(ws + O_WQ), (const char*)(ws + O_CINT), G, c};
            EpiP5 E{(bf16_t*)(ws + O_HM), (const float*)(ws + O_DENI), (const float*)(ws + O_DENX), (float*)(ws + O_HSS)}; gemm_phase(lds, 256, 256, 256, S, E); }
        { SchedP6 S{(const char*)(ws + O_HB), (const char*)(ws + O_WINT), G, c};
            EpiP6 E{(bf16_t*)(ws + O_HM), (float*)(ws + O_HSS), (const float*)(ws + O_RS), (bf16_t*)p.out}; gemm_phase(lds, 1024, 1024, 1024, S, E); } }
    SYNC(6)
    PH(7) phase7(p, shm);
    SYNC(7)
    PH(8) { SchedP8 S{(const char*)(ws + O_HB), (const char*)(ws + O_WINT), (const char*)(ws + O_HM), (const char*)(ws + O_UC), (const char*)(ws + O_WMT), (const char*)(ws + O_WCT), G, c};
        EpiP8 E{(bf16_t*)(ws + O_GMC), (bf16_t*)p.out + (size_t)T_ * 1024, (bf16_t*)(ws + O_MERGED), (const float*)(ws + O_RS)}; gemm_phase(lds, 1024, 1024, 1024, S, E); }
    SYNC(8)
    PH(9) { SchedN4 S{(const char*)(ws + O_MERGED), (const char*)(ws + O_WOT), (size_t)256 * 1024 * 2, (size_t)256 * 1024 * 2, G, c};
        EpiRes<true> E{(const void*)(ws + O_HB), (bf16_t*)(ws + O_X1B), (float*)(ws + O_SSQ1)}; gemm_phase(lds, 1024, 1024, 1024, S, E); }
    SYNC(9)
    PH(10) { { SchedP10 S{(const char*)(ws + O_X1B), (const char*)(ws + O_WGUT), G, c}; EpiP10 E{(const float*)(ws + O_SSQ1), (bf16_t*)(ws + O_HID)}; gemm_phase(lds, 1024, 1024, 1024, S, E); }
        { const int h = G >> 1; SchedPE S{(const char*)(ws + O_PB), (const char*)(ws + O_WPPT), h, c - h};
            EpiBf E{(bf16_t*)(ws + O_PE)}; if (c >= h) gemm_phase(lds, 256, 256, 256, S, E); } }
    SYNC(10)
    PH(11) { SchedN4 S{(const char*)(ws + O_HID), (const char*)(ws + O_WDT), (size_t)256 * DFF_ * 2, (size_t)256 * DFF_ * 2, G, c};
            EpiRes<true> E{(const void*)(ws + O_X1B), (bf16_t*)(ws + O_X2B), (float*)(ws + O_SSQ2)}; gemm_phase(lds, DFF_, DFF_, DFF_, S, E); }
    SYNC(11)
    PH(12) { SchedN4 S{(const char*)(ws + O_X2B), (const char*)(ws + O_WPGT), (size_t)256 * 1024 * 2, (size_t)256 * 1024 * 2, G, c};
        EpiP12 E{(const float*)(ws + O_SSQ2), (const bf16_t*)(ws + O_PE), (const bf16_t*)(ws + O_X2B), p.out, (float*)(ws + O_SSQ3), (unsigned*)(ws + O_BAR) + XCD_BAR_WORDS, p.in[22]}; gemm_phase(lds, 1024, 1024, 1024, S, E); }
#undef PH
#undef SYNC
}

extern "C" void kernel_launch(void* const* d_in, const int* in_sizes, int n_in, void* d_out, int out_size, void* d_ws, size_t ws_size, hipStream_t stream) {
    static int grid = 0;
    if (grid == 0) {
        if (n_in != 23 || out_size != T_ * D_ || ws_size < WS_NEED) { fprintf(stderr, "kernel_launch: unexpected shapes (n_in %d, out %d, ws %zu)\n", n_in, out_size, ws_size); grid = -1; return; }
        int dev = 0, cus = 0, per_cu = 0;
        hipGetDevice(&dev); hipDeviceGetAttribute(&cus, hipDeviceAttributeMultiprocessorCount, dev);
        hipFuncSetAttribute((const void*)mk_fwd<true>, hipFuncAttributeMaxDynamicSharedMemorySize, LDS_BYTES);
        hipFuncSetAttribute((const void*)mk_fwd<false>, hipFuncAttributeMaxDynamicSharedMemorySize, LDS_BYTES);
        hipOccupancyMaxActiveBlocksPerMultiprocessor(&per_cu, (const void*)mk_fwd<true>, 512, LDS_BYTES);
        if (per_cu < 1) { fprintf(stderr, "kernel_launch: occupancy query reports %d blocks per CU\n", per_cu); per_cu = 1; }
        (void)hipGetLastError();
        grid = cus;
        if (grid != 256) { fprintf(stderr, "kernel_launch: built for a 256-CU device (got %d CUs)\n", cus); grid = -1; return; }
    }
    if (grid < 0) return;
    Params p{};
    for (int i = 0; i < 23; ++i) p.in[i] = (const float*)d_in[i];
    p.out = (float*)d_out; p.ws = (unsigned char*)d_ws;
#if MK_MULTI
#ifndef PROBE_DUP
#define PROBE_DUP -1
#endif
    for (int k = 0; k < NPHASE; ++k) { p.ph_lo = k; p.ph_hi = k + 1; hipLaunchKernelGGL(mk_fwd<false>, dim3(grid), dim3(512), LDS_BYTES, stream, p);
        if (k == PROBE_DUP) hipLaunchKernelGGL(mk_fwd<false>, dim3(grid), dim3(512), LDS_BYTES, stream, p); }
#else
    p.ph_lo = 0; p.ph_hi = NPHASE;
    if (hipMemsetAsync((unsigned char*)d_ws + O_BAR, 0, (XCD_BAR_WORDS + 64 * 64) * 4, stream) != hipSuccess) { fprintf(stderr, "kernel_launch: memset of barrier words failed\n"); return; }
    void* args[] = {&p};
    hipError_t e = hipLaunchCooperativeKernel((const void*)mk_fwd<true>, dim3(grid), dim3(512), args, LDS_BYTES, stream);
    if (e != hipSuccess) fprintf(stderr, "cooperative launch failed: %s (grid %d)\n", hipGetErrorString(e), grid);
#endif
}
```

```cpp
#include <hip/hip_runtime.h>
#include <hip/hip_cooperative_groups.h>
#include <cstdio>
namespace cg = cooperative_groups;

#ifndef MK_MULTI
#define MK_MULTI 0
#endif

#define LAS __attribute__((address_space(3)))
typedef unsigned short bf16_t;
typedef short bf16x8 __attribute__((ext_vector_type(8)));
typedef float f32x4 __attribute__((ext_vector_type(4)));
typedef float f32x2 __attribute__((ext_vector_type(2)));
typedef unsigned u32x4 __attribute__((ext_vector_type(4)));
typedef unsigned u32x2 __attribute__((ext_vector_type(2)));

constexpr int T_ = 16384, D_ = 1024, NIN_ = 8200, DFF_ = 2816, SEQ_ = 2048;
constexpr float EPS_ = 1e-6f;
constexpr int BM = 256, BK = 64, HALF = 128, HTB = HALF * BK * 2, STAGE_BYTES = 8 * HTB;
constexpr int LDS_BYTES = 160 * 1024;
constexpr int NPHASE = 13;

constexpr size_t KiB = 1024, MiB = 1024 * 1024;
constexpr size_t O_WINT = 0, O_WMT = 16 * MiB, O_WCT = 18 * MiB, O_WOT = 20 * MiB, O_WPGT = 22 * MiB, O_WGUT = 24 * MiB, O_WDT = 35 * MiB, O_WPPT = 40 * MiB + 512 * KiB;
constexpr size_t O_IG = 41 * MiB, O_LF = O_IG + 256 * KiB, O_ZERO = O_LF + 256 * KiB;
constexpr size_t O_DENI = O_ZERO, O_HSS = O_DENI + 256 * KiB, O_SSQ1 = O_HSS + 256 * KiB, O_SSQ2 = O_SSQ1 + 64 * KiB, O_SSQ3 = O_SSQ2 + 64 * KiB, O_NSUM = O_SSQ3 + 64 * KiB;
constexpr size_t ZERO_BYTES = 960 * KiB;
constexpr size_t O_DENX = O_ZERO + ZERO_BYTES, O_EBL = O_DENX + 256 * KiB;
constexpr size_t O_RS = O_EBL + 4 * KiB;
constexpr size_t O_BAR = 43 * MiB;
constexpr size_t O_PB = 44 * MiB, O_HB = 52 * MiB, O_S1 = 84 * MiB, O_S2 = 116 * MiB, O_S3 = 148 * MiB, O_S4 = 180 * MiB, O_S5 = 212 * MiB, WS_NEED = 244 * MiB;
constexpr size_t O_PE = O_HB, O_VT = O_S1, O_U = O_S1, O_MERGED = O_S1, O_HID = O_S1, O_WQ = O_S2, O_GMC = O_S2, O_KW = O_S3, O_CINT = O_S3,
                 O_KWT = O_S4, O_HM = O_S4, O_X1B = O_S4, O_SS = O_S5, O_UC = O_S5, O_X2B = O_S5;

struct Params {
    const float* in[23];
    float* out;
    unsigned char* ws;
    int ph_lo, ph_hi;
};

__device__ __forceinline__ unsigned cvt_pk_bf16(float lo, float hi) { unsigned r; asm volatile("v_cvt_pk_bf16_f32 %0, %1, %2" : "=v"(r) : "v"(lo), "v"(hi)); return r; }
__device__ __forceinline__ float bf_lo(unsigned w) { return __uint_as_float(w << 16); }
__device__ __forceinline__ float bf_hi(unsigned w) { return __uint_as_float(w & 0xffff0000u); }
__device__ __forceinline__ float sigm(float x) { return __builtin_amdgcn_rcpf(1.0f + __builtin_amdgcn_exp2f(x * -1.4426950408889634f)); }
__device__ __forceinline__ float silu(float x) { return x * __builtin_amdgcn_rcpf(1.0f + __builtin_amdgcn_exp2f(x * -1.4426950408889634f)); }
__device__ __forceinline__ f32x4 exp2v(f32x4 t) { f32x4 e; e[0] = __builtin_amdgcn_exp2f(t[0]); e[1] = __builtin_amdgcn_exp2f(t[1]); e[2] = __builtin_amdgcn_exp2f(t[2]); e[3] = __builtin_amdgcn_exp2f(t[3]); return e; }
__device__ __forceinline__ f32x4 rcpv(f32x4 d) { f32x4 r; r[0] = __builtin_amdgcn_rcpf(d[0]); r[1] = __builtin_amdgcn_rcpf(d[1]); r[2] = __builtin_amdgcn_rcpf(d[2]); r[3] = __builtin_amdgcn_rcpf(d[3]); return r; }
__device__ __forceinline__ f32x4 sigm4(f32x4 x) { return rcpv(exp2v(x * -1.4426950408889634f) + 1.0f); }
__device__ __forceinline__ f32x4 silu4(f32x4 x) { return x * sigm4(x); }
__device__ __forceinline__ f32x2 silu2(f32x2 x) { const f32x2 t = x * -1.4426950408889634f; f32x2 d; d[0] = __builtin_amdgcn_exp2f(t[0]); d[1] = __builtin_amdgcn_exp2f(t[1]); d = d + 1.0f;
    f32x2 r; r[0] = __builtin_amdgcn_rcpf(d[0]); r[1] = __builtin_amdgcn_rcpf(d[1]); return x * r; }
#define WS_DPP(v, ctrl) ((v) + __int_as_float(__builtin_amdgcn_update_dpp(0, __float_as_int(v), (ctrl), 0xf, 0xf, false)))
__device__ __forceinline__ float wave_sum(float v) {
    v = WS_DPP(v, 0xB1);
    v = WS_DPP(v, 0x4E);
    v = WS_DPP(v, 0x141);
    v = WS_DPP(v, 0x140);
    const int iv = __float_as_int(v);
    return (__int_as_float(__builtin_amdgcn_readlane(iv, 0)) + __int_as_float(__builtin_amdgcn_readlane(iv, 16))) + (__int_as_float(__builtin_amdgcn_readlane(iv, 32)) + __int_as_float(__builtin_amdgcn_readlane(iv, 48)));
}
__device__ __forceinline__ u32x4 pack8(const f32x4 a, const f32x4 b) { u32x4 w; w.x = cvt_pk_bf16(a[0], a[1]); w.y = cvt_pk_bf16(a[2], a[3]); w.z = cvt_pk_bf16(b[0], b[1]); w.w = cvt_pk_bf16(b[2], b[3]); return w; }
__device__ __forceinline__ void unpack8(const u32x4 w, f32x4& a, f32x4& b) { a[0] = bf_lo(w.x); a[1] = bf_hi(w.x); a[2] = bf_lo(w.y); a[3] = bf_hi(w.y); b[0] = bf_lo(w.z); b[1] = bf_hi(w.z); b[2] = bf_lo(w.w); b[3] = bf_hi(w.w); }

__host__ __device__ __forceinline__ int lds_byte(int r, int c) { const int st = (r >> 4) * 2 + (c >> 5), rr = r & 15, cc = c & 31, ob = rr * 64 + cc * 2; return st * 1024 + (ob ^ (((ob >> 9) & 1) << 5)); }
__host__ __device__ __forceinline__ void stage_rc(int b, int& R, int& C) { const int st = b / 1024, sb = b % 1024, swz = sb ^ (((sb >> 9) & 1) << 5); R = (st >> 1) * 16 + swz / 64; C = (st & 1) * 32 + (swz % 64) / 2; }
__host__ __device__ __forceinline__ int perm32(int rho) { const int n = rho >> 4, i = rho & 15; return 8 * (i >> 2) + 4 * n + (i & 3); }

struct Unit { const char* a; const char* b; int pm, pn, kind, cont; };
__device__ __forceinline__ void map_n4(int L, int& pm, int& pn) { const int x = L & 7, k = L >> 3; pm = x * 8 + (k & 7); pn = k >> 3; }

__device__ __forceinline__ void tile_order(int L, int nM, int nN, int& pm, int& pn) {
    const int nwg = nM * nN; int wgid = L;
    { const int q = nwg / 8, r = nwg % 8, xcd = wgid % 8, off = wgid / 8; wgid = (xcd < r ? xcd * (q + 1) : r * (q + 1) + (xcd - r) * q) + off; }
    const int nig = 8 * nN, gid = wgid / nig, fm = gid * 8, gsz = (nM - fm) < 8 ? (nM - fm) : 8;
    pm = fm + ((wgid % nig) % gsz); pn = (wgid % nig) / gsz;
}

template <class Epi, class Sched>
__device__ __forceinline__ void gemm_phase(LAS unsigned char* lds, const int K, const int lda, const int ldb, const Sched& S, const Epi& E) {
    const int tid = threadIdx.x, wid = __builtin_amdgcn_readfirstlane(tid >> 6), lane = tid & 63, wr = wid >> 2, wc = wid & 3, fr = lane & 15, fq = lane >> 4;
    const int nt = K / BK;
    unsigned voffA[2], voffB[2];
#pragma unroll
    for (int i = 0; i < 2; ++i) { int R, C; stage_rc(tid * 16 + i * 8192, R, C); const int Rb = (R & ~31) + perm32(R & 31);
        voffA[i] = (unsigned)(R * lda + C) * 2u; voffB[i] = (unsigned)(Rb * ldb + C) * 2u; }
    const size_t kstep = (size_t)(BK * 2);
    const size_t hstepA = (size_t)HALF * lda * 2, hstepB = (size_t)HALF * ldb * 2;
    const unsigned ldsw = (unsigned)wid * 1024u;
    const int aoff = lds_byte(wr * 64 + fr, fq * 8), boff = lds_byte(wc * 32 + fr, fq * 8);
#define PG8_SA(b, h) (((b) * 2 + (h)) * HTB)
#define PG8_SB(b, h) ((4 + (b) * 2 + (h)) * HTB)
#define PG8_STAGE(bufoff, gbase, voff) do { _Pragma("unroll") for (int _i = 0; _i < 2; ++_i) \
        __builtin_amdgcn_global_load_lds((const unsigned*)((const char*)(gbase) + (voff)[_i]), (LAS unsigned*)(lds + (bufoff) + ldsw + _i * 8192), 16, 0, 0); } while (0)
#define PG8_LDA(dst, b, h) do { _Pragma("unroll") for (int m = 0; m < 4; ++m) _Pragma("unroll") for (int k = 0; k < 2; ++k) dst[m][k] = *(const LAS bf16x8*)(lds + PG8_SA(b, h) + aoff + m * 2048 + k * 1024); } while (0)
#define PG8_LDB(dst, b, h) do { _Pragma("unroll") for (int n = 0; n < 2; ++n) _Pragma("unroll") for (int k = 0; k < 2; ++k) dst[n][k] = *(const LAS bf16x8*)(lds + PG8_SB(b, h) + boff + n * 2048 + k * 1024); } while (0)
#define PG8_MMA(ai, bj, At, Bt) do { __builtin_amdgcn_s_setprio(1); _Pragma("unroll") for (int m = 0; m < 4; ++m) _Pragma("unroll") for (int n = 0; n < 2; ++n) _Pragma("unroll") for (int k = 0; k < 2; ++k) \
        acc[ai][bj][m][n] = __builtin_amdgcn_mfma_f32_16x16x32_bf16(Bt[n][k], At[m][k], acc[ai][bj][m][n], 0, 0, 0); __builtin_amdgcn_s_setprio(0); } while (0)
#define PG8_WAIT_V(n) asm volatile("s_waitcnt vmcnt(" #n ")" ::: "memory")
#define PG8_WAIT_L(n) asm volatile("s_waitcnt lgkmcnt(" #n ")" ::: "memory")
#define PG8_BAR __builtin_amdgcn_s_barrier()
#define PG8_SCHED __builtin_amdgcn_sched_barrier(0)
#define PG8_ZERO() do { _Pragma("unroll") for (int a = 0; a < 2; ++a) _Pragma("unroll") for (int b = 0; b < 2; ++b) _Pragma("unroll") for (int m = 0; m < 4; ++m) _Pragma("unroll") for (int n = 0; n < 2; ++n) acc[a][b][m][n] = (f32x4){0.f, 0.f, 0.f, 0.f}; } while (0)
    Unit cur, nxt; int ui = 0;
    if (!S.next(0, cur)) return;
    E.pre(cur, wr, wc, fr, fq);
    f32x4 acc[2][2][4][2];
    PG8_ZERO();
    bf16x8 At[4][2], B0[2][2], B1[2][2];
    const char* cA = cur.a; const char* cB = cur.b;
    PG8_STAGE(PG8_SB(0, 0), cB, voffB); PG8_STAGE(PG8_SA(0, 0), cA, voffA); PG8_STAGE(PG8_SB(0, 1), cB + hstepB, voffB); PG8_STAGE(PG8_SA(0, 1), cA + hstepA, voffA);
    if (wr == 1) PG8_BAR;
    PG8_WAIT_V(4); PG8_BAR;
    PG8_STAGE(PG8_SB(1, 0), cB + kstep, voffB); PG8_STAGE(PG8_SA(1, 0), cA + kstep, voffA); PG8_STAGE(PG8_SB(1, 1), cB + hstepB + kstep, voffB);
    PG8_WAIT_V(6); PG8_BAR;
    for (;;) {
        const bool has_next = S.next(ui + 1, nxt);
        const char* nA = has_next ? nxt.a : cA; const char* nB = has_next ? nxt.b : cB;
#pragma unroll 1
        for (int t = 0; t < nt; t += 2) {
            const bool last = (t == nt - 2);
            const char* a1 = cA + (size_t)(t + 1) * kstep;
            const char* a2 = last ? nA : cA + (size_t)(t + 2) * kstep; const char* b2 = last ? nB : cB + (size_t)(t + 2) * kstep;
            const char* a3 = a2 + kstep; const char* b3 = b2 + kstep;
            PG8_LDB(B0, 0, 0); PG8_SCHED; PG8_LDA(At, 0, 0); PG8_STAGE(PG8_SA(1, 1), a1 + hstepA, voffA);
            PG8_WAIT_L(8); PG8_BAR; PG8_WAIT_L(0); PG8_MMA(0, 0, At, B0); PG8_BAR; PG8_SCHED;
            PG8_LDB(B1, 0, 1); PG8_STAGE(PG8_SB(0, 0), b2, voffB);
            PG8_BAR; PG8_WAIT_L(0); PG8_MMA(0, 1, At, B1); PG8_BAR;
            PG8_LDA(At, 0, 1); PG8_STAGE(PG8_SA(0, 0), a2, voffA);
            PG8_BAR; PG8_WAIT_L(0); PG8_MMA(1, 0, At, B0); PG8_BAR; PG8_SCHED;
            PG8_STAGE(PG8_SB(0, 1), b2 + hstepB, voffB);
            PG8_WAIT_V(6); PG8_BAR; PG8_MMA(1, 1, At, B1); PG8_BAR;
            PG8_LDB(B0, 1, 0); PG8_SCHED; PG8_LDA(At, 1, 0); PG8_STAGE(PG8_SA(0, 1), a2 + hstepA, voffA);
            PG8_WAIT_L(8); PG8_BAR; PG8_WAIT_L(0); PG8_MMA(0, 0, At, B0); PG8_BAR; PG8_SCHED;
            PG8_LDB(B1, 1, 1); PG8_STAGE(PG8_SB(1, 0), b3, voffB);
            PG8_BAR; PG8_WAIT_L(0); PG8_MMA(0, 1, At, B1); PG8_BAR;
            PG8_LDA(At, 1, 1); PG8_STAGE(PG8_SA(1, 0), a3, voffA);
            PG8_BAR; PG8_WAIT_L(0); PG8_MMA(1, 0, At, B0); PG8_BAR; PG8_SCHED;
            PG8_STAGE(PG8_SB(1, 1), b3 + hstepB, voffB);
            PG8_WAIT_V(6); PG8_BAR; PG8_MMA(1, 1, At, B1); PG8_BAR;
        }
        if (cur.cont) { E.mid(acc, cur, wr, wc, fr, fq); }
        else { if constexpr (!Epi::AFTER_DRAIN) E(acc, cur, wr, wc, fr, fq); if (!has_next) break; PG8_ZERO(); }
        cur = nxt; cA = nA; cB = nB; ++ui;
    }
    PG8_WAIT_V(0);
    if (wr == 0) PG8_BAR;
    PG8_BAR;
    if constexpr (Epi::AFTER_DRAIN) E(acc, cur, wr, wc, fr, fq);
#undef PG8_SA
#undef PG8_SB
#undef PG8_STAGE
#undef PG8_LDA
#undef PG8_LDB
#undef PG8_MMA
#undef PG8_WAIT_V
#undef PG8_WAIT_L
#undef PG8_BAR
#undef PG8_SCHED
#undef PG8_ZERO
}

typedef f32x4 Acc[2][2][4][2];
#define EPI_ROWS(ai, m) _Pragma("unroll") for (int ai = 0; ai < 2; ++ai) _Pragma("unroll") for (int m = 0; m < 4; ++m) if (epi_fence())
__device__ __forceinline__ bool epi_fence() { asm volatile("" ::: "memory"); return true; }
#define EPI_R8 _Pragma("unroll") for (int r8 = 0; r8 < 8; ++r8)
#define EPI_RL(ai, m) ((ai) * 128 + wr * 64 + (m) * 16 + fr)
#define EPI_CL(bj) ((bj) * 128 + wc * 32 + 8 * fq)

struct SchedP1 { const char* hb; const char* wint; int G, c;
    __device__ __forceinline__ bool next(int i, Unit& u) const {
        const int item = (i / 3) * G + c, r = i % 3; if (item >= 256) return false;
        const int b = item >> 5, h = (item >> 3) & 3, sc = item & 7; const int pt = b * 8 + sc;
        u.cont = 0;
        if (r < 2) { u.pm = pt; u.pn = r * 4 + h; u.kind = 0; u.a = hb + (size_t)pt * 256 * 1024 * 2; u.b = wint + (size_t)u.pn * 256 * 1024 * 2; }
        else { u.pm = h; u.pn = pt; u.kind = 1; u.a = wint + (size_t)(2048 + h * 256) * 1024 * 2; u.b = hb + (size_t)pt * 256 * 1024 * 2; }
        return true; } };
struct EpiP1 { static constexpr bool AFTER_DRAIN = false; bf16_t* qkpre; bf16_t* vt; const float* rsb;
    __device__ __forceinline__ void mid(Acc&, const Unit&, int, int, int, int) const {}
    __device__ __forceinline__ void pre(const Unit&, int, int, int, int) const {}
    __device__ __forceinline__ void operator()(Acc& acc, const Unit& u, int wr, int wc, int fr, int fq) const {
        if (u.kind == 0) {
            bf16_t* base = qkpre + (size_t)u.pm * 256 * 2048 + u.pn * 256; float rv[2][4];
#pragma unroll
            for (int ai = 0; ai < 2; ++ai)
#pragma unroll
                for (int m = 0; m < 4; ++m) rv[ai][m] = rsb[u.pm * 256 + EPI_RL(ai, m)];
            EPI_ROWS(ai, m) { bf16_t* rowp = base + (size_t)EPI_RL(ai, m) * 2048 + EPI_CL(0);
#pragma unroll
                for (int bj = 0; bj < 2; ++bj) *(u32x4*)(rowp + bj * 128) = pack8(acc[ai][bj][m][0] * rv[ai][m], acc[ai][bj][m][1] * rv[ai][m]); }
        } else {
            const int item = ((u.pn >> 3) * 4 + u.pm) * 8 + (u.pn & 7); bf16_t* base = vt + (size_t)item * 65536; f32x4 cv[2][2];
#pragma unroll
            for (int bj = 0; bj < 2; ++bj) { cv[bj][0] = *(const f32x4*)(rsb + u.pn * 256 + EPI_CL(bj)); cv[bj][1] = *(const f32x4*)(rsb + u.pn * 256 + EPI_CL(bj) + 4); }
            EPI_ROWS(ai, m) { bf16_t* rowp = base + (size_t)EPI_RL(ai, m) * 256 + EPI_CL(0);
#pragma unroll
                for (int bj = 0; bj < 2; ++bj) *(u32x4*)(rowp + bj * 128) = pack8(acc[ai][bj][m][0] * cv[bj][0], acc[ai][bj][m][1] * cv[bj][1]); }
        }
    } };

struct SchedP3 { const char* wq; const char* kw; const char* vt; const char* kwt; int G, c;
    __device__ __forceinline__ bool next(int i, Unit& u) const {
        const int L = i * G + c; if (L >= 512) return false;
        u.cont = 0; u.pn = 0;
        if (L < 256) { u.pm = L; u.kind = 0; u.a = wq + (size_t)L * 131072; u.b = kw + (size_t)L * 131072; }
        else { const int it = L - 256; u.pm = it; u.kind = 1; u.a = vt + (size_t)it * 131072; u.b = kwt + (size_t)it * 131072; }
        return true; } };
struct EpiP3 { static constexpr bool AFTER_DRAIN = false; bf16_t* s; bf16_t* lt; float* deni;
    __device__ __forceinline__ void mid(Acc&, const Unit&, int, int, int, int) const {}
    __device__ __forceinline__ void pre(const Unit&, int, int, int, int) const {}
    __device__ __forceinline__ void operator()(Acc& acc, const Unit& u, int wr, int wc, int fr, int fq) const {
        const int item = u.pm;
        if (u.kind == 0) {
            const int b = item >> 5, h = (item >> 3) & 3, sc = item & 7; const int tokb = b * SEQ_ + sc * 256;
            EPI_ROWS(ai, m) { int r = EPI_RL(ai, m); asm volatile("" : "+v"(r)); float rs = 0.f;
#pragma unroll
                for (int bj = 0; bj < 2; ++bj) { const int c0 = EPI_CL(bj); f32x4 v0 = acc[ai][bj][m][0], v1 = acc[ai][bj][m][1];
#pragma unroll
                    for (int j = 0; j < 4; ++j) { v0[j] = (c0 + j <= r) ? v0[j] : 0.f; v1[j] = (c0 + 4 + j <= r) ? v1[j] : 0.f; rs += v0[j] + v1[j]; }
                    *(u32x4*)(s + (size_t)item * 65536 + r * 256 + c0) = pack8(v0, v1); }
                rs += __shfl_xor(rs, 16); rs += __shfl_xor(rs, 32);
                if (fq == 0) unsafeAtomicAdd(deni + (size_t)(tokb + r) * 4 + h, rs); }
        } else {
            EPI_ROWS(ai, m) { bf16_t* rowp = lt + (size_t)item * 65536 + EPI_RL(ai, m) * 256 + EPI_CL(0);
#pragma unroll
                for (int bj = 0; bj < 2; ++bj) *(u32x4*)(rowp + bj * 128) = pack8(acc[ai][bj][m][0], acc[ai][bj][m][1]); }
        }
    } };

struct SchedP5 { const char* s; const char* vt; const char* wq; const char* cint; int G, c;
    __device__ __forceinline__ bool next(int i, Unit& u) const {
        const int item = (i >> 1) * G + c; if (item >= 256) return false;
        u.pm = item; u.pn = 0; u.kind = 0;
        if ((i & 1) == 0) { u.cont = 1; u.a = s + (size_t)item * 131072; u.b = vt + (size_t)item * 131072; }
        else { u.cont = 0; u.a = wq + (size_t)item * 131072; u.b = cint + (size_t)item * 131072; }
        return true; } };
struct EpiP5 { static constexpr bool AFTER_DRAIN = false; bf16_t* hm; const float* deni; const float* denx; float* hss;
    __device__ __forceinline__ void mid(Acc&, const Unit&, int, int, int, int) const {}
    __device__ __forceinline__ void pre(const Unit&, int, int, int, int) const {}
    __device__ __forceinline__ void operator()(Acc& acc, const Unit& u, int wr, int wc, int fr, int fq) const {
        const int item = u.pm; const int b = item >> 5, h = (item >> 3) & 3, sc = item & 7; const int tokb = b * SEQ_ + sc * 256;
        float dnv[2][4];
#pragma unroll
        for (int ai = 0; ai < 2; ++ai)
#pragma unroll
            for (int m = 0; m < 4; ++m) { const int t = tokb + EPI_RL(ai, m); dnv[ai][m] = deni[(size_t)t * 4 + h] + denx[(size_t)t * 4 + h]; }
        EPI_ROWS(ai, m) { const int t = tokb + EPI_RL(ai, m);
            const float den = dnv[ai][m]; const float inv = __builtin_amdgcn_rcpf(fmaxf(fabsf(den), 1.0f)); float ss = 0.f;
#pragma unroll
            for (int bj = 0; bj < 2; ++bj) { f32x4 v0 = acc[ai][bj][m][0] * inv, v1 = acc[ai][bj][m][1] * inv;
                { const f32x4 q = v0 * v0 + v1 * v1; ss += (q[0] + q[1]) + (q[2] + q[3]); }
                *(u32x4*)(hm + (size_t)t * 1024 + h * 256 + EPI_CL(bj)) = pack8(v0, v1); }
            ss += __shfl_xor(ss, 16); ss += __shfl_xor(ss, 32);
            if (fq == 0) unsafeAtomicAdd(hss + (size_t)t * 4 + h, ss); }
    } };

struct SchedP6 { const char* hb; const char* wint; int G, c;
    __device__ __forceinline__ bool next(int i, Unit& u) const {
        u.cont = 0;
        if (i == 0) { const int item = c; if (item >= 256) return false; const int b = item >> 5, h = (item >> 3) & 3, sc = item & 7;
            u.pm = b * 8 + sc; u.pn = h; u.kind = 0; u.a = hb + (size_t)u.pm * 256 * 1024 * 2; u.b = wint + (size_t)(3072 + h * 256) * 1024 * 2; return true; }
        const int L = (i - 1) * G + c; if (L >= 512) return false;
        int pm, pn; tile_order(L, 64, 8, pm, pn); u.pm = pm; u.pn = pn; u.kind = 1;
        u.a = hb + (size_t)pm * 256 * 1024 * 2; u.b = wint + (size_t)(4096 + pn * 256) * 1024 * 2; return true; } };
struct EpiP6 { static constexpr bool AFTER_DRAIN = false; bf16_t* hm; float* hss; const float* rsb; bf16_t* uu;
    __device__ __forceinline__ void mid(Acc&, const Unit&, int, int, int, int) const {}
    __device__ __forceinline__ void pre(const Unit&, int, int, int, int) const {}
    __device__ __forceinline__ void operator()(Acc& acc, const Unit& u, int wr, int wc, int fr, int fq) const {
        if (u.kind == 0) {
            float hsv[2][4], rxv[2][4];
#pragma unroll
            for (int ai = 0; ai < 2; ++ai)
#pragma unroll
                for (int m = 0; m < 4; ++m) rxv[ai][m] = rsb[u.pm * 256 + EPI_RL(ai, m)];
#pragma unroll
            for (int ai = 0; ai < 2; ++ai)
#pragma unroll
                for (int m = 0; m < 4; ++m) hsv[ai][m] = __hip_atomic_load(hss + (size_t)(u.pm * 256 + EPI_RL(ai, m)) * 4 + u.pn, __ATOMIC_RELAXED, __HIP_MEMORY_SCOPE_AGENT);
            u32x4 cur[2], nxt[2];
#pragma unroll
            for (int bj = 0; bj < 2; ++bj) cur[bj] = *(const u32x4*)(hm + (size_t)(u.pm * 256 + EPI_RL(0, 0)) * 1024 + u.pn * 256 + EPI_CL(bj));
            EPI_R8 { const int ai = r8 >> 2, m = r8 & 3; const int t = u.pm * 256 + EPI_RL(ai, m);
                if (r8 < 7) { const int tn = u.pm * 256 + EPI_RL((r8 + 1) >> 2, (r8 + 1) & 3);
#pragma unroll
                    for (int bj = 0; bj < 2; ++bj) nxt[bj] = *(const u32x4*)(hm + (size_t)tn * 1024 + u.pn * 256 + EPI_CL(bj)); }
                const float rsn = rsqrtf(hsv[ai][m] * (1.0f / 256.0f) + EPS_); const float rx = rxv[ai][m];
#pragma unroll
                for (int bj = 0; bj < 2; ++bj) { f32x4 h0, h1; unpack8(cur[bj], h0, h1);
                    const f32x4 o0 = h0 * rsn * sigm4(acc[ai][bj][m][0] * rx), o1 = h1 * rsn * sigm4(acc[ai][bj][m][1] * rx);
                    *(u32x4*)(hm + (size_t)t * 1024 + u.pn * 256 + EPI_CL(bj)) = pack8(o0, o1); }
                cur[0] = nxt[0]; cur[1] = nxt[1]; }
        } else {
            float rxv[2][4];
#pragma unroll
            for (int ai = 0; ai < 2; ++ai)
#pragma unroll
                for (int m = 0; m < 4; ++m) rxv[ai][m] = rsb[u.pm * 256 + EPI_RL(ai, m)];
            EPI_ROWS(ai, m) { const int t = u.pm * 256 + EPI_RL(ai, m); const float rx = rxv[ai][m];
                const f32x4 o0 = acc[ai][0][m][0] * rx * sigm4(acc[ai][1][m][0] * rx), o1 = acc[ai][0][m][1] * rx * sigm4(acc[ai][1][m][1] * rx);
                *(u32x4*)(uu + (size_t)t * 1024 + u.pn * 128 + wc * 32 + 8 * fq) = pack8(o0, o1); }
        }
    } };

struct SchedP8 { const char* hb; const char* wint; const char* hmg; const char* uc; const char* wmt; const char* wct; int G, c;
    __device__ __forceinline__ bool next(int i, Unit& u) const {
        const int L = (i >> 2) * G + c, r = i & 3; if (L >= 256) return false;
        int pn; map_n4(L, u.pm, pn); u.cont = 0;
        if (r < 2) { u.kind = 2; u.pn = 2 * pn + r; u.a = hb + (size_t)u.pm * 256 * 1024 * 2; u.b = wint + (size_t)(6144 + u.pn * 256) * 1024 * 2; }
        else if (r == 2) { u.kind = 0; u.pn = pn; u.a = hmg + (size_t)u.pm * 256 * 1024 * 2; u.b = wmt + (size_t)pn * 256 * 1024 * 2; }
        else { u.kind = 1; u.pn = pn; u.a = uc + (size_t)u.pm * 256 * 1024 * 2; u.b = wct + (size_t)pn * 256 * 1024 * 2; }
        return true; } };
struct EpiP8 { static constexpr bool AFTER_DRAIN = false; bf16_t* gmc; bf16_t* tmp; bf16_t* merged; const float* rsb;
    __device__ __forceinline__ void mid(Acc&, const Unit&, int, int, int, int) const {}
    __device__ __forceinline__ void pre(const Unit&, int, int, int, int) const {}
    __device__ __forceinline__ void operator()(Acc& acc, const Unit& u, int wr, int wc, int fr, int fq) const {
        if (u.kind == 2) {
            float rxv[2][4];
#pragma unroll
            for (int ai = 0; ai < 2; ++ai)
#pragma unroll
                for (int m = 0; m < 4; ++m) rxv[ai][m] = rsb[u.pm * 256 + EPI_RL(ai, m)];
            EPI_ROWS(ai, m) { const int t = u.pm * 256 + EPI_RL(ai, m); const float rx = rxv[ai][m], rxe = rx * -1.4426950408889634f;
                const f32x4 d0 = exp2v(acc[ai][1][m][0] * rxe) + 1.0f, d1 = exp2v(acc[ai][1][m][1] * rxe) + 1.0f;
                const f32x4 r0 = sigm4(acc[ai][0][m][0] * rx) * d0, r1 = sigm4(acc[ai][0][m][1] * rx) * d1, c0 = rcpv(d0), c1 = rcpv(d1);
                bf16_t* ptr = gmc + (size_t)t * 2048 + u.pn * 128 + wc * 32 + 8 * fq;
                *(u32x4*)ptr = pack8(r0, r1); *(u32x4*)(ptr + 1024) = pack8(c0, c1); }
        } else if (u.kind == 0) {
            u32x4 cur[2], nxt[2];
#pragma unroll
            for (int bj = 0; bj < 2; ++bj) cur[bj] = *(const u32x4*)(gmc + (size_t)(u.pm * 256 + EPI_RL(0, 0)) * 2048 + u.pn * 256 + EPI_CL(bj));
            EPI_R8 { const int ai = r8 >> 2, m = r8 & 3; const int t = u.pm * 256 + EPI_RL(ai, m);
                if (r8 < 7) { const int tn = u.pm * 256 + EPI_RL((r8 + 1) >> 2, (r8 + 1) & 3);
#pragma unroll
                    for (int bj = 0; bj < 2; ++bj) nxt[bj] = *(const u32x4*)(gmc + (size_t)tn * 2048 + u.pn * 256 + EPI_CL(bj)); }
#pragma unroll
                for (int bj = 0; bj < 2; ++bj) { const int c = u.pn * 256 + EPI_CL(bj); f32x4 a0, a1; unpack8(cur[bj], a0, a1);
                    *(u32x4*)(tmp + (size_t)t * 1024 + c) = pack8(acc[ai][bj][m][0] * a0, acc[ai][bj][m][1] * a1); }
                cur[0] = nxt[0]; cur[1] = nxt[1]; }
        } else {
            u32x4 cg[2], ct[2], ng[2], nt2[2];
#pragma unroll
            for (int bj = 0; bj < 2; ++bj) { const int t0 = u.pm * 256 + EPI_RL(0, 0); const int c = u.pn * 256 + EPI_CL(bj);
                cg[bj] = *(const u32x4*)(gmc + (size_t)t0 * 2048 + 1024 + c); ct[bj] = *(const u32x4*)(tmp + (size_t)t0 * 1024 + c); }
            EPI_R8 { const int ai = r8 >> 2, m = r8 & 3; const int t = u.pm * 256 + EPI_RL(ai, m);
                if (r8 < 7) { const int tn = u.pm * 256 + EPI_RL((r8 + 1) >> 2, (r8 + 1) & 3);
#pragma unroll
                    for (int bj = 0; bj < 2; ++bj) { const int c = u.pn * 256 + EPI_CL(bj); ng[bj] = *(const u32x4*)(gmc + (size_t)tn * 2048 + 1024 + c); nt2[bj] = *(const u32x4*)(tmp + (size_t)tn * 1024 + c); } }
#pragma unroll
                for (int bj = 0; bj < 2; ++bj) { const int c = u.pn * 256 + EPI_CL(bj); f32x4 b0, b1, t0, t1; unpack8(cg[bj], b0, b1); unpack8(ct[bj], t0, t1);
                    *(u32x4*)(merged + (size_t)t * 1024 + c) = pack8((acc[ai][bj][m][0] + t0) * b0, (acc[ai][bj][m][1] + t1) * b1); }
                cg[0] = ng[0]; cg[1] = ng[1]; ct[0] = nt2[0]; ct[1] = nt2[1]; }
        }
    } };

struct SchedN4 { const char* a; const char* bt; size_t astep, bstep; int G, c;
    __device__ __forceinline__ bool next(int i, Unit& u) const {
        const int L = i * G + c; if (L >= 256) return false;
        map_n4(L, u.pm, u.pn); u.kind = 0; u.cont = 0; u.a = a + (size_t)u.pm * astep; u.b = bt + (size_t)u.pn * bstep; return true; } };
struct SchedPE { const char* a; const char* bt; int G, c;
    __device__ __forceinline__ bool next(int i, Unit& u) const {
        const int L = i * G + c; if (L >= 256 || c < 0) return false;
        u.pm = L >> 2; u.pn = L & 3; u.kind = 0; u.cont = 0; u.a = a + (size_t)u.pm * 256 * 256 * 2; u.b = bt + (size_t)u.pn * 256 * 256 * 2; return true; } };
template <bool SRC_BF16> struct EpiRes { static constexpr bool AFTER_DRAIN = false; const void* src; bf16_t* dstb; float* ssq;
    __device__ __forceinline__ void mid(Acc&, const Unit&, int, int, int, int) const {}
    __device__ __forceinline__ void pre(const Unit& u, int wr, int wc, int fr, int fq) const {
        if (!SRC_BF16) {
            EPI_ROWS(ai, m) { const int t = u.pm * 256 + EPI_RL(ai, m);
#pragma unroll
                for (int bj = 0; bj < 2; ++bj) { const float v = *((const float*)src + (size_t)t * 1024 + u.pn * 256 + EPI_CL(bj)); asm volatile("" :: "v"(v)); } }
        }
    }
    __device__ __forceinline__ void operator()(Acc& acc, const Unit& u, int wr, int wc, int fr, int fq) const {
        f32x4 rb[3][2][2];
#define ERES_LOAD(dst, t_) do { _Pragma("unroll") for (int bj = 0; bj < 2; ++bj) { const size_t o_ = (size_t)(t_) * 1024 + u.pn * 256 + EPI_CL(bj); \
            if (SRC_BF16) dst[bj][0] = __builtin_bit_cast(f32x4, *(const u32x4*)((const bf16_t*)src + o_)); \
            else { dst[bj][0] = *(const f32x4*)((const float*)src + o_); dst[bj][1] = *(const f32x4*)((const float*)src + o_ + 4); } } } while (0)
        ERES_LOAD(rb[0], u.pm * 256 + EPI_RL(0, 0)); ERES_LOAD(rb[1], u.pm * 256 + EPI_RL(0, 1));
        EPI_R8 { const int ai = r8 >> 2, m = r8 & 3; const int t = u.pm * 256 + EPI_RL(ai, m); float ss = 0.f;
            if (r8 < 6) ERES_LOAD(rb[(r8 + 2) % 3], u.pm * 256 + EPI_RL((r8 + 2) >> 2, (r8 + 2) & 3));
#pragma unroll
            for (int bj = 0; bj < 2; ++bj) { const size_t o = (size_t)t * 1024 + u.pn * 256 + EPI_CL(bj); f32x4 v0, v1;
                if (SRC_BF16) unpack8(__builtin_bit_cast(u32x4, rb[r8 % 3][bj][0]), v0, v1); else { v0 = rb[r8 % 3][bj][0]; v1 = rb[r8 % 3][bj][1]; }
                v0 += acc[ai][bj][m][0]; v1 += acc[ai][bj][m][1];
                { const f32x4 q = v0 * v0 + v1 * v1; ss += (q[0] + q[1]) + (q[2] + q[3]); }
                *(u32x4*)(dstb + o) = pack8(v0, v1); }
            ss += __shfl_xor(ss, 16); ss += __shfl_xor(ss, 32);
            if (fq == 0) unsafeAtomicAdd(ssq + t, ss); }
#undef ERES_LOAD
    } };

struct SchedP10 { const char* x1b; const char* wgut; int G, c;
    __device__ __forceinline__ bool next(int i, Unit& u) const {
        const int L = i * G + c; if (L >= 1408) return false;
        int pm, pn; tile_order(L, 64, 22, pm, pn); u.pm = pm; u.pn = pn; u.kind = 0; u.cont = 0;
        u.a = x1b + (size_t)pm * 256 * 1024 * 2; u.b = wgut + (size_t)pn * 256 * 1024 * 2; return true; } };
struct EpiP10 { static constexpr bool AFTER_DRAIN = false; const float* ssq; bf16_t* hid;
    __device__ __forceinline__ void mid(Acc&, const Unit&, int, int, int, int) const {}
    __device__ __forceinline__ void pre(const Unit&, int, int, int, int) const {}
    __device__ __forceinline__ void operator()(Acc& acc, const Unit& u, int wr, int wc, int fr, int fq) const {
        float rsv[2][4];
#pragma unroll
        for (int ai = 0; ai < 2; ++ai)
#pragma unroll
            for (int m = 0; m < 4; ++m) rsv[ai][m] = ssq[u.pm * 256 + EPI_RL(ai, m)];
        EPI_ROWS(ai, m) { const int t = u.pm * 256 + EPI_RL(ai, m); const float rs = rsqrtf(rsv[ai][m] * (1.0f / 1024.0f) + EPS_);
            const f32x4 o0 = silu4(acc[ai][0][m][0] * rs) * (acc[ai][1][m][0] * rs), o1 = silu4(acc[ai][0][m][1] * rs) * (acc[ai][1][m][1] * rs);
            *(u32x4*)(hid + (size_t)t * DFF_ + u.pn * 128 + wc * 32 + 8 * fq) = pack8(o0, o1); }
    } };

struct EpiBf { static constexpr bool AFTER_DRAIN = false; bf16_t* o;
    __device__ __forceinline__ void mid(Acc&, const Unit&, int, int, int, int) const {}
    __device__ __forceinline__ void pre(const Unit&, int, int, int, int) const {}
    __device__ __forceinline__ void operator()(Acc& acc, const Unit& u, int wr, int wc, int fr, int fq) const {
        EPI_ROWS(ai, m) { bf16_t* rowp = o + (size_t)(u.pm * 256 + EPI_RL(ai, m)) * 1024 + u.pn * 256 + EPI_CL(0);
#pragma unroll
            for (int bj = 0; bj < 2; ++bj) *(u32x4*)(rowp + bj * 128) = pack8(acc[ai][bj][m][0], acc[ai][bj][m][1]); }
    } };

struct EpiP12 { static constexpr bool AFTER_DRAIN = true; const float* ssq2; const bf16_t* pe; const bf16_t* xin; float* out; float* ssq3; unsigned* done; const float* fg;
    __device__ __forceinline__ void mid(Acc&, const Unit&, int, int, int, int) const {}
    __device__ __forceinline__ void pre(const Unit&, int, int, int, int) const {}
    __device__ __forceinline__ void operator()(Acc& acc, const Unit& u, int wr, int wc, int fr, int fq) const {
        float rsv[2][4];
#pragma unroll
        for (int ai = 0; ai < 2; ++ai)
#pragma unroll
            for (int m = 0; m < 4; ++m) rsv[ai][m] = ssq2[u.pm * 256 + EPI_RL(ai, m)];
        { u32x4 cx[2], cp[2], nx[2], np[2];
#pragma unroll
            for (int bj = 0; bj < 2; ++bj) { const size_t o = (size_t)(u.pm * 256 + EPI_RL(0, 0)) * 1024 + u.pn * 256 + EPI_CL(bj); cx[bj] = *(const u32x4*)(xin + o); cp[bj] = *(const u32x4*)(pe + o); }
            EPI_R8 { const int ai = r8 >> 2, m = r8 & 3; const int t = u.pm * 256 + EPI_RL(ai, m); const float rs = rsqrtf(rsv[ai][m] * (1.0f / 1024.0f) + EPS_); float ss = 0.f;
                if (r8 < 7) {
#pragma unroll
                    for (int bj = 0; bj < 2; ++bj) { const size_t o = (size_t)(u.pm * 256 + EPI_RL((r8 + 1) >> 2, (r8 + 1) & 3)) * 1024 + u.pn * 256 + EPI_CL(bj); nx[bj] = *(const u32x4*)(xin + o); np[bj] = *(const u32x4*)(pe + o); } }
#pragma unroll
                for (int bj = 0; bj < 2; ++bj) { f32x4 p0, p1, v0, v1; unpack8(cp[bj], p0, p1); unpack8(cx[bj], v0, v1);
                    v0 += sigm4(acc[ai][bj][m][0] * rs) * p0; v1 += sigm4(acc[ai][bj][m][1] * rs) * p1;
                    { const f32x4 q = v0 * v0 + v1 * v1; ss += (q[0] + q[1]) + (q[2] + q[3]); }
                    acc[ai][bj][m][0] = v0; acc[ai][bj][m][1] = v1; }
                ss += __shfl_xor(ss, 16); ss += __shfl_xor(ss, 32);
                if (fq == 0) unsafeAtomicAdd(ssq3 + t, ss);
                cx[0] = nx[0]; cx[1] = nx[1]; cp[0] = np[0]; cp[1] = np[1]; } }
        asm volatile("s_waitcnt vmcnt(0)" ::: "memory");
        unsigned* cnt = done + 64 * u.pm;
        if ((threadIdx.x & 63) == 0) __hip_atomic_fetch_add(cnt, 1u, __ATOMIC_RELAXED, __HIP_MEMORY_SCOPE_AGENT);
        { unsigned sp = 0; while (__hip_atomic_load(cnt, __ATOMIC_RELAXED, __HIP_MEMORY_SCOPE_AGENT) < 32u) { __builtin_amdgcn_s_sleep(1); if (++sp > (1u << 22)) break; } }
#pragma unroll
        for (int ai = 0; ai < 2; ++ai)
#pragma unroll
            for (int m = 0; m < 4; ++m) rsv[ai][m] = __hip_atomic_load(ssq3 + u.pm * 256 + EPI_RL(ai, m), __ATOMIC_RELAXED, __HIP_MEMORY_SCOPE_AGENT);
        f32x4 gv[2][2];
#pragma unroll
        for (int bj = 0; bj < 2; ++bj) { const int cc = u.pn * 256 + EPI_CL(bj); gv[bj][0] = *(const f32x4*)(fg + cc); gv[bj][1] = *(const f32x4*)(fg + cc + 4); }
        EPI_ROWS(ai, m) { const int t = u.pm * 256 + EPI_RL(ai, m);
            const float rs = rsqrtf(rsv[ai][m] * (1.0f / 1024.0f) + EPS_);
#pragma unroll
            for (int bj = 0; bj < 2; ++bj) { const size_t o = (size_t)t * 1024 + u.pn * 256 + EPI_CL(bj);
                *(f32x4*)(out + o) = acc[ai][bj][m][0] * rs * gv[bj][0]; *(f32x4*)(out + o + 4) = acc[ai][bj][m][1] * rs * gv[bj][1]; } }
    } };

struct CvtTile { const float* src; int ld; const float* scale; bf16_t* dst; int dstld; };
__device__ __forceinline__ CvtTile cvt_tile_params(const Params& p, int tl) {
    const int NT0 = 2048, NT4 = NT0 + 1024, NT5 = NT4 + 1408, NT6 = NT5 + 704;
    unsigned char* ws = p.ws; CvtTile t; t.scale = nullptr;
    if (tl < NT0) { const int nb = tl >> 4, kb = tl & 15; const int n0 = nb * 64; int col;
        if (n0 < 4096) col = n0; else if (n0 < 6144) { const int j = (n0 - 4096) >> 8, r = (n0 - 4096) & 255; col = (r < 128) ? (4104 + 128 * j + r) : (5128 + 128 * j + r - 128); }
        else { const int j = (n0 - 6144) >> 8, r = (n0 - 6144) & 255; col = 6152 + ((r < 128) ? (128 * j + r) : (1024 + 128 * j + r - 128)); }
        t.src = p.in[3] + (size_t)kb * 64 * NIN_ + col; t.ld = NIN_; t.scale = p.in[2] + kb * 64; t.dst = (bf16_t*)(ws + O_WINT) + (size_t)n0 * 1024 + kb * 64; t.dstld = 1024; }
    else if (tl < NT4) { const int w = (tl - NT0) >> 8, l = (tl - NT0) & 255; const int nb = l >> 4, kb = l & 15;
        const float* base = w == 0 ? p.in[12] : (w == 1 ? p.in[13] : (w == 2 ? p.in[14] : p.in[20])); const size_t od = w == 0 ? O_WMT : (w == 1 ? O_WCT : (w == 2 ? O_WOT : O_WPGT));
        t.src = base + (size_t)kb * 64 * 1024 + nb * 64; t.ld = 1024; if (w == 3) t.scale = p.in[19] + kb * 64; if (w == 0) t.scale = p.in[7] + kb * 64; t.dst = (bf16_t*)(ws + od) + (size_t)nb * 64 * 1024 + kb * 64; t.dstld = 1024; }
    else if (tl < NT5) { const int l = tl - NT4; const int nb = l >> 4, kb = l & 15; const int n0 = nb * 64; const int j = n0 >> 8, r = n0 & 255;
        const float* base = (r < 128) ? p.in[16] : p.in[17]; const int col = 128 * j + (r & 127);
        t.src = base + (size_t)kb * 64 * DFF_ + col; t.ld = DFF_; t.scale = p.in[15] + kb * 64; t.dst = (bf16_t*)(ws + O_WGUT) + (size_t)n0 * 1024 + kb * 64; t.dstld = 1024; }
    else if (tl < NT6) { const int l = tl - NT5; const int nb = l / 44, kb = l % 44;
        t.src = p.in[18] + (size_t)kb * 64 * 1024 + nb * 64; t.ld = 1024; t.dst = (bf16_t*)(ws + O_WDT) + (size_t)nb * 64 * DFF_ + kb * 64; t.dstld = DFF_; }
    else { const int l = tl - NT6; const int nb = l >> 2, kb = l & 3;
        t.src = p.in[21] + (size_t)kb * 64 * 1024 + nb * 64; t.ld = 1024; t.dst = (bf16_t*)(ws + O_WPPT) + (size_t)nb * 64 * 256 + kb * 64; t.dstld = 256; }
    return t;
}
__device__ __forceinline__ void cvt_tile_load(const CvtTile& t, f32x4 (&v)[2]) {
    const int tid = threadIdx.x, kk = tid >> 4, c4 = (tid & 15) * 4;
#pragma unroll
    for (int pss = 0; pss < 2; ++pss) { const int k = kk + pss * 32; v[pss] = *(const f32x4*)(t.src + (size_t)k * t.ld + c4); if (t.scale) v[pss] = v[pss] * t.scale[k]; }
}

__device__ __forceinline__ void phase0(const Params& p, unsigned char* sm) {
    unsigned char* ws = p.ws;
    const int tid = threadIdx.x, lane = tid & 63, wid = tid >> 6;
    const size_t gtid = (size_t)blockIdx.x * 512 + tid, gthreads = (size_t)gridDim.x * 512;
    for (size_t i = gtid; i < ZERO_BYTES / 16; i += gthreads) ((u32x4*)(ws + O_ZERO))[i] = (u32x4){0u, 0u, 0u, 0u};
    { const float* pp = p.in[1]; bf16_t* pb = (bf16_t*)(ws + O_PB);
        for (size_t i = gtid; i < (size_t)T_ * 256 / 8; i += gthreads) { const f32x4 a = *(const f32x4*)(pp + i * 8), b = *(const f32x4*)(pp + i * 8 + 4); *(u32x4*)(pb + i * 8) = pack8(a, b); } }
    { const float* x = p.in[0]; const float* g = p.in[2]; const float* win = p.in[3]; const float* bif = p.in[4];
        float* wgT = (float*)sm;
        for (int idx = tid; idx < 8192; idx += 512) { const int k = idx >> 3, j = idx & 7; wgT[j * 1024 + k] = win[(size_t)k * NIN_ + 4096 + j] * g[k]; }
        __syncthreads();
        bf16_t* hb = (bf16_t*)(ws + O_HB); float* ig = (float*)(ws + O_IG); float* lf = (float*)(ws + O_LF);
        const int rstep = gridDim.x * 8; int row = blockIdx.x * 8 + wid;
        f32x4 xn[4];
#pragma unroll
        for (int i = 0; i < 4; ++i) xn[i] = (row < T_) ? *(const f32x4*)(x + (size_t)row * 1024 + i * 256 + lane * 4) : (f32x4){0.f, 0.f, 0.f, 0.f};
        for (; row < T_; row += rstep) {
            f32x4 xv[4]; float ss = 0.f;
#pragma unroll
            for (int i = 0; i < 4; ++i) { xv[i] = xn[i]; ss += xv[i][0] * xv[i][0] + xv[i][1] * xv[i][1] + xv[i][2] * xv[i][2] + xv[i][3] * xv[i][3]; }
            { const int nrow = row + rstep;
                if (nrow < T_) {
#pragma unroll
                    for (int i = 0; i < 4; ++i) xn[i] = *(const f32x4*)(x + (size_t)nrow * 1024 + i * 256 + lane * 4); } }
            ss = wave_sum(ss); const float rs = rsqrtf(ss * (1.0f / 1024.0f) + EPS_);
            float d[8];
#pragma unroll
            for (int j = 0; j < 8; ++j) d[j] = 0.f;
            if (lane == 0) ((float*)(ws + O_RS))[row] = rs;
#pragma unroll
            for (int i = 0; i < 4; ++i) { const f32x4 hn = xv[i] * rs;
                u32x2 w; w.x = cvt_pk_bf16(xv[i][0], xv[i][1]); w.y = cvt_pk_bf16(xv[i][2], xv[i][3]); *(u32x2*)(hb + (size_t)row * 1024 + i * 256 + lane * 4) = w;
#pragma unroll
                for (int j = 0; j < 8; ++j) { const f32x4 wv = *(const f32x4*)(wgT + j * 1024 + i * 256 + lane * 4); d[j] += hn[0] * wv[0] + hn[1] * wv[1] + hn[2] * wv[2] + hn[3] * wv[3]; } }
#pragma unroll
            for (int j = 0; j < 8; ++j) d[j] = wave_sum(d[j]);
            if (lane < 8) { float v = d[0];
#pragma unroll
                for (int j = 1; j < 8; ++j) v = (lane == j) ? d[j] : v;
                v += bif[lane];
                if (lane < 4) ig[(size_t)row * 4 + lane] = v;
                else { const float z = v; lf[(size_t)row * 4 + lane - 4] = fminf(z, 0.f) - log1pf(__expf(-fabsf(z))); } }
        }
        __syncthreads();
    }
    { const int NTILES = 2048 + 1024 + 1408 + 704 + 64; const int gs = gridDim.x;
        float* tl = (float*)sm;
        int t = blockIdx.x; CvtTile c0{}, c1{}; f32x4 v0[2], v1[2];
        if (t < NTILES) { c0 = cvt_tile_params(p, t); cvt_tile_load(c0, v0); }
        if (t + gs < NTILES) { c1 = cvt_tile_params(p, t + gs); cvt_tile_load(c1, v1); }
        for (; t < NTILES; t += gs) {
            { const int kk = tid >> 4, c4 = (tid & 15) * 4;
#pragma unroll
                for (int pss = 0; pss < 2; ++pss) { const int k = kk + pss * 32;
#pragma unroll
                    for (int j = 0; j < 4; ++j) tl[k * 65 + c4 + j] = v0[pss][j]; } }
            __syncthreads();
            const CvtTile done = c0; c0 = c1; v0[0] = v1[0]; v0[1] = v1[1];
            { const int tn = t + 2 * gs; if (tn < NTILES) { c1 = cvt_tile_params(p, tn); cvt_tile_load(c1, v1); } }
            { const int n = tid >> 3, k8 = (tid & 7) * 8; float e[8];
#pragma unroll
                for (int q = 0; q < 8; ++q) e[q] = tl[(k8 + q) * 65 + n];
                u32x4 w; w.x = cvt_pk_bf16(e[0], e[1]); w.y = cvt_pk_bf16(e[2], e[3]); w.z = cvt_pk_bf16(e[4], e[5]); w.w = cvt_pk_bf16(e[6], e[7]);
                *(u32x4*)(done.dst + (size_t)n * done.dstld + k8) = w; }
            __syncthreads();
        }
    }
}

__device__ __forceinline__ void phase2(const Params& p, unsigned char* sm) {
    unsigned char* ws = p.ws;
    const int tid = threadIdx.x, lane = tid & 63, wid = tid >> 6;
    float* rowfac = (float*)sm; float* colfac = rowfac + 256; float* wsum = colfac + 256;
    const float* ig = (const float*)(ws + O_IG); const float* lf = (const float*)(ws + O_LF);
    const bf16_t* qkpre = (const bf16_t*)p.out;
    const float* cw = p.in[5]; const float* cb = p.in[6];
    for (int item = blockIdx.x; item < 256; item += gridDim.x) {
        const int b = item >> 5, h = (item >> 3) & 3, sc = item & 7; const int tokb = b * SEQ_ + sc * 256;
        float v = 0.f, igv = 0.f;
        if (tid < 256) { v = lf[(size_t)(tokb + tid) * 4 + h]; igv = ig[(size_t)(tokb + tid) * 4 + h]; }
#pragma unroll
        for (int o = 1; o < 64; o <<= 1) { const float n = __shfl_up(v, o); if (lane >= o) v += n; }
        if (tid < 256 && lane == 63) wsum[wid] = v;
        __syncthreads();
        if (tid < 256) { float add = 0.f; for (int j = 0; j < wid; ++j) add += wsum[j]; v += add; rowfac[tid] = __expf(v); colfac[tid] = __expf(igv - v);
            if (tid == 255) ((float*)(ws + O_EBL))[item] = __expf(v); }
        __syncthreads();
#pragma unroll 1
        for (int qt = 0; qt < 4; ++qt) {
        const int cp = tid & 127, tg = tid >> 7; const int ch = 2 * cp; const int tl0 = qt * 64 + tg * 16; const int s0 = sc * 256 + tl0;
        { const int col = h * 256 + ch; f32x2 xx[19];
#pragma unroll
            for (int i = 0; i < 19; ++i) { const int s = s0 - 3 + i; unsigned w = 0u; if (s >= 0) w = *(const unsigned*)(qkpre + (size_t)(b * SEQ_ + s) * 2048 + col); xx[i] = (f32x2){bf_lo(w), bf_hi(w)}; }
            f32x2 wv[4];
#pragma unroll
            for (int k = 0; k < 4; ++k) wv[k] = *(const f32x2*)(cw + (size_t)k * 2048 + col);
            const f32x2 bv = *(const f32x2*)(cb + col);
            bf16_t* wq = (bf16_t*)(ws + O_WQ) + (size_t)item * 65536;
#pragma unroll
            for (int i = 0; i < 16; ++i) { f32x2 y = bv;
#pragma unroll
                for (int k = 0; k < 4; ++k) y = __builtin_elementwise_fma(xx[i + k], wv[k], y);
                const f32x2 o = silu2(y) * (rowfac[tl0 + i] * 0.0625f);
                *(unsigned*)(wq + (size_t)(tl0 + i) * 256 + ch) = cvt_pk_bf16(o[0], o[1]); } }
        { const int col = 1024 + h * 256 + ch; f32x2 xx[19];
#pragma unroll
            for (int i = 0; i < 19; ++i) { const int s = s0 - 3 + i; unsigned w = 0u; if (s >= 0) w = *(const unsigned*)(qkpre + (size_t)(b * SEQ_ + s) * 2048 + col); xx[i] = (f32x2){bf_lo(w), bf_hi(w)}; }
            f32x2 wv[4];
#pragma unroll
            for (int k = 0; k < 4; ++k) wv[k] = *(const f32x2*)(cw + (size_t)k * 2048 + col);
            const f32x2 bv = *(const f32x2*)(cb + col);
            bf16_t* kw = (bf16_t*)(ws + O_KW) + (size_t)item * 65536; bf16_t* kwt = (bf16_t*)(ws + O_KWT) + (size_t)item * 65536;
            float k0[16], k1[16]; f32x2 nn = {0.f, 0.f};
#pragma unroll
            for (int i = 0; i < 16; ++i) { f32x2 y = bv;
#pragma unroll
                for (int k = 0; k < 4; ++k) y = __builtin_elementwise_fma(xx[i + k], wv[k], y);
                const f32x2 o = silu2(y) * colfac[tl0 + i]; k0[i] = o[0]; k1[i] = o[1]; nn += o;
                *(unsigned*)(kw + (size_t)(tl0 + i) * 256 + ch) = cvt_pk_bf16(o[0], o[1]); }
            const float n0 = nn[0], n1 = nn[1];
            u32x4 a, c;
            a.x = cvt_pk_bf16(k0[0], k0[1]); a.y = cvt_pk_bf16(k0[2], k0[3]); a.z = cvt_pk_bf16(k0[4], k0[5]); a.w = cvt_pk_bf16(k0[6], k0[7]);
            c.x = cvt_pk_bf16(k0[8], k0[9]); c.y = cvt_pk_bf16(k0[10], k0[11]); c.z = cvt_pk_bf16(k0[12], k0[13]); c.w = cvt_pk_bf16(k0[14], k0[15]);
            *(u32x4*)(kwt + (size_t)ch * 256 + tl0) = a; *(u32x4*)(kwt + (size_t)ch * 256 + tl0 + 8) = c;
            a.x = cvt_pk_bf16(k1[0], k1[1]); a.y = cvt_pk_bf16(k1[2], k1[3]); a.z = cvt_pk_bf16(k1[4], k1[5]); a.w = cvt_pk_bf16(k1[6], k1[7]);
            c.x = cvt_pk_bf16(k1[8], k1[9]); c.y = cvt_pk_bf16(k1[10], k1[11]); c.z = cvt_pk_bf16(k1[12], k1[13]); c.w = cvt_pk_bf16(k1[14], k1[15]);
            *(u32x4*)(kwt + (size_t)(ch + 1) * 256 + tl0) = a; *(u32x4*)(kwt + (size_t)(ch + 1) * 256 + tl0 + 8) = c;
            float* nsum = (float*)(ws + O_NSUM) + (size_t)item * 256;
            unsafeAtomicAdd(nsum + ch, n0); unsafeAtomicAdd(nsum + ch + 1, n1); }
        }
        __syncthreads();
    }
}

__device__ __forceinline__ void phase4(const Params& p, unsigned char* sm) {
    unsigned char* ws = p.ws;
    const int tid = threadIdx.x;
    const float* ebl = (const float*)(ws + O_EBL);
    const bf16_t* lt = (const bf16_t*)(p.ws + O_KWT);
    bf16_t* cint = (bf16_t*)(ws + O_CINT);
    const size_t gtid = (size_t)blockIdx.x * 512 + tid, gthreads = (size_t)gridDim.x * 512;
#pragma unroll 2
    for (size_t g = gtid; g < (size_t)32 * 16384; g += gthreads) {
        const int bh = (int)(g >> 14), e4 = (int)(g & 16383);
        f32x4 c = {0.f, 0.f, 0.f, 0.f};
        u32x2 lw[7]; float eb[7];
#pragma unroll
        for (int sc = 0; sc < 7; ++sc) { lw[sc] = *(const u32x2*)(lt + (size_t)(bh * 8 + sc) * 65536 + e4 * 4); eb[sc] = ebl[bh * 8 + sc]; }
#pragma unroll
        for (int sc = 0; sc < 8; ++sc) { const int item = bh * 8 + sc;
            u32x2 w; w.x = cvt_pk_bf16(c[0], c[1]); w.y = cvt_pk_bf16(c[2], c[3]); *(u32x2*)(cint + (size_t)item * 65536 + e4 * 4) = w;
            if (sc < 7) { const f32x4 l = {bf_lo(lw[sc].x), bf_hi(lw[sc].x), bf_lo(lw[sc].y), bf_hi(lw[sc].y)}; c = (c + l) * eb[sc]; } }
    }
    float* nin = (float*)sm;
    const float* nsum = (const float*)(ws + O_NSUM);
    float* denx = (float*)(ws + O_DENX);
    for (int item = blockIdx.x; item < 256; item += gridDim.x) {
        const int b = item >> 5, h = (item >> 3) & 3, sc = item & 7; const int tokb = b * SEQ_ + sc * 256; const int bh = item >> 3;
        if (tid < 256) { float eb[7], ns[7];
#pragma unroll
            for (int j = 0; j < 7; ++j) { eb[j] = ebl[bh * 8 + j]; ns[j] = nsum[(size_t)(bh * 8 + j) * 256 + tid]; }
            float nv = 0.f;
#pragma unroll
            for (int j = 0; j < 7; ++j) if (j < sc) nv = eb[j] * (nv + ns[j]);
            nin[tid] = nv; }
        __syncthreads();
        const int tl = tid >> 1, half = tid & 1;
        const bf16_t* wq = (const bf16_t*)(ws + O_WQ) + (size_t)item * 65536 + (size_t)tl * 256 + half * 128;
        float d = 0.f;
#pragma unroll
        for (int i = 0; i < 16; ++i) { f32x4 a0, a1; unpack8(*(const u32x4*)(wq + i * 8), a0, a1); const float* nn = nin + half * 128 + i * 8;
            d += a0[0] * nn[0] + a0[1] * nn[1] + a0[2] * nn[2] + a0[3] * nn[3] + a1[0] * nn[4] + a1[1] * nn[5] + a1[2] * nn[6] + a1[3] * nn[7]; }
        d += __shfl_xor(d, 1);
        if (half == 0) denx[(size_t)(tokb + tl) * 4 + h] = d;
        __syncthreads();
    }
}

__device__ __forceinline__ void phase7(const Params& p, unsigned char* sm) {
    unsigned char* ws = p.ws;
    const int tid = threadIdx.x, lane = tid & 63, wid = tid >> 6;
    const bf16_t* uu = (const bf16_t*)p.out; bf16_t* uc = (bf16_t*)(ws + O_UC);
    const float* cw = p.in[8]; const float* cb = p.in[9]; const float* lg = p.in[10]; const float* lb = p.in[11];
    u32x4 pf[12];
#define P7_LOAD(tile_) do { const int t0_ = (tile_) * 16; const int b_ = t0_ / SEQ_, s0_ = t0_ % SEQ_; \
        _Pragma("unroll") for (int q = 0; q < 12; ++q) { const int idx = tid + q * 512; const int r = idx >> 7, c16 = idx & 127; const int s_ = s0_ - 30 + r; \
            pf[q] = (u32x4){0u, 0u, 0u, 0u}; if (idx < 46 * 128 && s_ >= 0) pf[q] = *(const u32x4*)(uu + (size_t)(b_ * SEQ_ + s_) * 1024 + c16 * 8); } } while (0)
    int tile = blockIdx.x;
    if (tile < 1024) P7_LOAD(tile);
    f32x2 wv[31];
#pragma unroll
    for (int k = 0; k < 31; ++k) wv[k] = *(const f32x2*)(cw + (size_t)k * 1024 + 2 * tid);
    const f32x2 bv = *(const f32x2*)(cb + 2 * tid);
    f32x4 lgv[4], lbv[4];
#pragma unroll
    for (int i = 0; i < 4; ++i) { lgv[i] = *(const f32x4*)(lg + i * 256 + lane * 4); lbv[i] = *(const f32x4*)(lb + i * 256 + lane * 4); }
    for (; tile < 1024; tile += gridDim.x) {
        const int t0 = tile * 16;
#pragma unroll
        for (int q = 0; q < 12; ++q) { const int idx = tid + q * 512; const int r = idx >> 7, c16 = idx & 127; if (idx < 46 * 128) *(u32x4*)(sm + r * 2048 + c16 * 16) = pf[q]; }
        __syncthreads();
        f32x2 yy[16];
        {
#pragma unroll
            for (int t = 0; t < 16; ++t) yy[t] = bv;
#pragma unroll
            for (int r = 0; r < 46; ++r) { const unsigned w = *(const unsigned*)(sm + r * 2048 + tid * 4); const f32x2 xx = {bf_lo(w), bf_hi(w)};
#pragma unroll
                for (int t = 0; t < 16; ++t) { const int k = r - t; if (k >= 0 && k <= 30) yy[t] = __builtin_elementwise_fma(wv[k], xx, yy[t]); }
                if ((r & 3) == 3) asm volatile("" ::: "memory"); }
        }
#pragma unroll
        for (int t = 0; t < 16; ++t) *(f32x2*)(sm + 94208 + t * 4096 + tid * 8) = yy[t];
        { const int tn = tile + gridDim.x; if (tn < 1024) P7_LOAD(tn); }
        __syncthreads();
#pragma unroll
        for (int tt = 0; tt < 2; ++tt) { const int t = wid * 2 + tt; f32x4 v[4]; float s1 = 0.f;
#pragma unroll
            for (int i = 0; i < 4; ++i) { v[i] = *(const f32x4*)(sm + 94208 + t * 4096 + (i * 256 + lane * 4) * 4); s1 += v[i][0] + v[i][1] + v[i][2] + v[i][3]; }
            s1 = wave_sum(s1); const float mu = s1 * (1.0f / 1024.0f); float s2 = 0.f;
#pragma unroll
            for (int i = 0; i < 4; ++i) { v[i] = v[i] - mu; s2 += v[i][0] * v[i][0] + v[i][1] * v[i][1] + v[i][2] * v[i][2] + v[i][3] * v[i][3]; }
            s2 = wave_sum(s2); const float rstd = rsqrtf(s2 * (1.0f / 1024.0f) + EPS_);
#pragma unroll
            for (int i = 0; i < 4; ++i) { const int c = i * 256 + lane * 4; f32x4 z = v[i] * rstd * lgv[i] + lbv[i];
                z = silu4(z); u32x2 w; w.x = cvt_pk_bf16(z[0], z[1]); w.y = cvt_pk_bf16(z[2], z[3]); *(u32x2*)(uc + (size_t)(t0 + t) * 1024 + c) = w; } }
    }
    __syncthreads();
#undef P7_LOAD
}

__device__ __forceinline__ void phase13(const Params& p) {
    const float* ssq3 = (const float*)(p.ws + O_SSQ3); const float* fg = p.in[22];
    const size_t gtid = (size_t)blockIdx.x * 512 + threadIdx.x, gthreads = (size_t)gridDim.x * 512;
    for (size_t i = gtid; i < (size_t)T_ * 256; i += gthreads) { const int row = (int)(i >> 8), c = (int)(i & 255) * 4;
        const float rs = rsqrtf(ssq3[row] * (1.0f / 1024.0f) + EPS_); const f32x4 g = *(const f32x4*)(fg + c);
        f32x4 v = *(const f32x4*)(p.out + i * 4); v = v * rs * g; *(f32x4*)(p.out + i * 4) = v; }
}

#define XB_TMO      128
#define XB_XCNT(j)  (256  + 64 * (j))
#define XB_XSUB(j)  (1280 + 64 * (j))
#define XB_XGEN(j)  (2304 + 64 * (j))
#define XB_TOP      3328
#define XB_TOPGEN   3392
#define XCD_BAR_WORDS 3456
#define XB_SPIN_CAP (1u << 18)
__device__ __forceinline__ unsigned xb_ld(unsigned* p)              { return __hip_atomic_load(p, __ATOMIC_RELAXED, __HIP_MEMORY_SCOPE_AGENT); }
__device__ __forceinline__ unsigned xb_add(unsigned* p, unsigned v) { return __hip_atomic_fetch_add(p, v, __ATOMIC_RELAXED, __HIP_MEMORY_SCOPE_AGENT); }
__device__ __forceinline__ unsigned xb_xcc_id() { return (unsigned)__builtin_amdgcn_s_getreg((3 << 11) | 20) & 0xFu; }
#define XB_SPIN(cond, bar) do { unsigned _sp = 0; while (cond) { __builtin_amdgcn_s_sleep(1); \
    if ((++_sp & 255u) == 0u) { if (xb_ld(&(bar)[XB_TMO])) break; if (_sp > XB_SPIN_CAP) { atomicAdd(&(bar)[XB_TMO], 1u); break; } } } } while (0)
struct XcdBarrier { unsigned* bar; unsigned x; volatile LAS unsigned* st; };
__device__ __forceinline__ XcdBarrier xcd_barrier_post(unsigned* bar, volatile LAS unsigned* st) {
    XcdBarrier b; b.bar = bar; b.x = xb_xcc_id(); b.st = st;
    if (threadIdx.x == 0) (void)xb_add(&bar[XB_XCNT(b.x)], 1u);
    return b;
}
__device__ __forceinline__ void xcd_barrier_complete(unsigned* bar, unsigned x, unsigned& nloc, unsigned& nx) {
    const unsigned G = gridDim.x * gridDim.y * gridDim.z;
    unsigned sum, cnt, mine, sp = 0u;
    for (;;) {
        sum = 0u; cnt = 0u; mine = 0u;
#pragma unroll
        for (unsigned j = 0; j < 16; ++j) { const unsigned c = xb_ld(&bar[XB_XCNT(j)]); sum += c; cnt += (c > 0u) ? 1u : 0u; mine = (j == x) ? c : mine; }
        if (sum == G) break;
        __builtin_amdgcn_s_sleep(1);
        if ((++sp & 255u) == 0u) { if (xb_ld(&bar[XB_TMO])) break; if (sp > XB_SPIN_CAP) { atomicAdd(&bar[XB_TMO], 1u); break; } }
    }
    nloc = mine > 0u ? mine : 1u; nx = cnt > 0u ? cnt : 1u;
}
__device__ __forceinline__ void xcd_barrier(const XcdBarrier& b) {
    asm volatile("s_waitcnt vmcnt(0)" ::: "memory");
    __syncthreads();
    if (threadIdx.x == 0) {
        unsigned* bar = b.bar;
        __builtin_amdgcn_s_waitcnt(0);
        unsigned nloc = b.st[0], nx = b.st[1];
        if (nloc == 0u) { xcd_barrier_complete(bar, b.x, nloc, nx); b.st[0] = nloc; b.st[1] = nx; }
        const unsigned old = xb_add(&bar[XB_XSUB(b.x)], 1u);
        const unsigned gen = old / nloc;
        if (old + 1u == (gen + 1u) * nloc) {
            __builtin_amdgcn_fence(__ATOMIC_RELEASE, "agent");
            asm volatile("s_waitcnt vmcnt(0)" ::: "memory");
            const unsigned og = xb_add(&bar[XB_TOP], 1u);
            const unsigned tg = og / nx;
            if (og + 1u == (tg + 1u) * nx) xb_add(&bar[XB_TOPGEN], 1u);
            else XB_SPIN(xb_ld(&bar[XB_TOPGEN]) == tg, bar);
            __builtin_amdgcn_fence(__ATOMIC_ACQUIRE, "agent");
            xb_add(&bar[XB_XGEN(b.x)], 1u);
            asm volatile("s_waitcnt vmcnt(0)" ::: "memory");
        } else {
            XB_SPIN(xb_ld(&bar[XB_XGEN(b.x)]) == gen, bar);
            __builtin_amdgcn_fence(__ATOMIC_ACQUIRE, "agent");
            asm volatile("s_waitcnt vmcnt(0)" ::: "memory");
        }
    }
    __syncthreads();
}

template <bool COOP>
__global__ void __launch_bounds__(512, 2) mk_fwd(Params p) {
    extern __shared__ __attribute__((aligned(16))) unsigned char shm[];
    LAS unsigned char* lds = (LAS unsigned char*)shm;
    unsigned char* ws = p.ws;
    const int G = gridDim.x, c = blockIdx.x;
#ifndef PHMASK
#define PHMASK 0x3fff
#endif
#define PH(k) if (((PHMASK >> (k)) & 1) && p.ph_lo <= (k) && (k) < p.ph_hi)
    XcdBarrier xb{};
    if (COOP) { volatile LAS unsigned* st = (volatile LAS unsigned*)(lds + 163824);
        if (threadIdx.x == 0) { st[0] = 0u; st[1] = 0u; }
        __syncthreads();
        xb = xcd_barrier_post((unsigned*)(ws + O_BAR), st); }
#define SYNC(k) if (COOP) { if (p.ph_lo <= (k) && (k) + 1 < p.ph_hi) { xcd_barrier(xb); } }
    PH(0) phase0(p, shm);
    SYNC(0)
    PH(1) { SchedP1 S{(const char*)(ws + O_HB), (const char*)(ws + O_WINT), G, c}; EpiP1 E{(bf16_t*)p.out, (bf16_t*)(ws + O_VT), (const float*)(ws + O_RS)}; gemm_phase(lds, 1024, 1024, 1024, S, E); }
    SYNC(1)
    PH(3) { phase2(p, shm);
        asm volatile("s_waitcnt vmcnt(0)" ::: "memory"); __syncthreads();
        SchedP3 S{(const char*)(ws + O_WQ), (const char*)(ws + O_KW), (const char*)(ws + O_VT), (const char*)(ws + O_KWT), G, c};
        EpiP3 E{(bf16_t*)(ws + O_SS), (bf16_t*)(ws + O_KWT), (float*)(ws + O_DENI)}; gemm_phase(lds, 256, 256, 256, S, E); }
    SYNC(3)
    PH(4) phase4(p, shm);
    SYNC(4)
    PH(6) { { SchedP5 S{(const char*)(ws + O_SS), (const char*)(ws + O_VT), (const char*)(ws + O_WQ), (const char*)(ws + O_CINT), G, c};
            EpiP5 E{(bf16_t*)(ws + O_HM), (const float*)(ws + O_DENI), (const float*)(ws + O_DENX), (float*)(ws + O_HSS)}; gemm_phase(lds, 256, 256, 256, S, E); }
        { SchedP6 S{(const char*)(ws + O_HB), (const char*)(ws + O_WINT), G, c};
            EpiP6 E{(bf16_t*)(ws + O_HM), (float*)(ws + O_HSS), (const float*)(ws + O_RS), (bf16_t*)p.out}; gemm_phase(lds, 1024, 1024, 1024, S, E); } }
    SYNC(6)
    PH(7) phase7(p, shm);
    SYNC(7)
    PH(8) { SchedP8 S{(const char*)(ws + O_HB), (const char*)(ws + O_WINT), (const char*)(ws + O_HM), (const char*)(ws + O_UC), (const char*)(ws + O_WMT), (const char*)(ws + O_WCT), G, c};
        EpiP8 E{(bf16_t*)(ws + O_GMC), (bf16_t*)p.out + (size_t)T_ * 1024, (bf16_t*)(ws + O_MERGED), (const float*)(ws + O_RS)}; gemm_phase(lds, 1024, 1024, 1024, S, E); }
    SYNC(8)
    PH(9) { SchedN4 S{(const char*)(ws + O_MERGED), (const char*)(ws + O_WOT), (size_t)256 * 1024 * 2, (size_t)256 * 1024 * 2, G, c};
        EpiRes<true> E{(const void*)(ws + O_HB), (bf16_t*)(ws + O_X1B), (float*)(ws + O_SSQ1)}; gemm_phase(lds, 1024, 1024, 1024, S, E); }
    SYNC(9)
    PH(10) { { SchedP10 S{(const char*)(ws + O_X1B), (const char*)(ws + O_WGUT), G, c}; EpiP10 E{(const float*)(ws + O_SSQ1), (bf16_t*)(ws + O_HID)}; gemm_phase(lds, 1024, 1024, 1024, S, E); }
        { const int h = G >> 1; SchedPE S{(const char*)(ws + O_PB), (const char*)(ws + O_WPPT), h, c - h};
            EpiBf E{(bf16_t*)(ws + O_PE)}; if (c >= h) gemm_phase(lds, 256, 256, 256, S, E); } }
    SYNC(10)
    PH(11) { SchedN4 S{(const char*)(ws + O_HID), (const char*)(ws + O_WDT), (size_t)256 * DFF_ * 2, (size_t)256 * DFF_ * 2, G, c};
            EpiRes<true> E{(const void*)(ws + O_X1B), (bf16_t*)(ws + O_X2B), (float*)(ws + O_SSQ2)}; gemm_phase(lds, DFF_, DFF_, DFF_, S, E); }
    SYNC(11)
    PH(12) { SchedN4 S{(const char*)(ws + O_X2B), (const char*)(ws + O_WPGT), (size_t)256 * 1024 * 2, (size_t)256 * 1024 * 2, G, c};
        EpiP12 E{(const float*)(ws + O_SSQ2), (const bf16_t*)(ws + O_PE), (const bf16_t*)(ws + O_X2B), p.out, (float*)(ws + O_SSQ3), (unsigned*)(ws + O_BAR) + XCD_BAR_WORDS, p.in[22]}; gemm_phase(lds, 1024, 1024, 1024, S, E); }
#undef PH
#undef SYNC
}

extern "C" void kernel_launch(void* const* d_in, const int* in_sizes, int n_in, void* d_out, int out_size, void* d_ws, size_t ws_size, hipStream_t stream) {
    static int grid = 0;
    if (grid == 0) {
        if (n_in != 23 || out_size != T_ * D_ || ws_size < WS_NEED) { fprintf(stderr, "kernel_launch: unexpected shapes (n_in %d, out %d, ws %zu)\n", n_in, out_size, ws_size); grid = -1; return; }
        int dev = 0, cus = 0, per_cu = 0;
        hipGetDevice(&dev); hipDeviceGetAttribute(&cus, hipDeviceAttributeMultiprocessorCount, dev);
        hipFuncSetAttribute((const void*)mk_fwd<true>, hipFuncAttributeMaxDynamicSharedMemorySize, LDS_BYTES);
        hipFuncSetAttribute((const void*)mk_fwd<false>, hipFuncAttributeMaxDynamicSharedMemorySize, LDS_BYTES);
        hipOccupancyMaxActiveBlocksPerMultiprocessor(&per_cu, (const void*)mk_fwd<true>, 512, LDS_BYTES);
        if (per_cu < 1) { fprintf(stderr, "kernel_launch: occupancy query reports %d blocks per CU\n", per_cu); per_cu = 1; }
        (void)hipGetLastError();
        grid = cus;
        if (grid != 256) { fprintf(stderr, "kernel_launch: built for a 256-CU device (got %d CUs)\n", cus); grid = -1; return; }
    }
    if (grid < 0) return;
    Params p{};
    for (int i = 0; i < 23; ++i) p.in[i] = (const float*)d_in[i];
    p.out = (float*)d_out; p.ws = (unsigned char*)d_ws;
#if MK_MULTI
#ifndef PROBE_DUP
#define PROBE_DUP -1
#endif
    for (int k = 0; k < NPHASE; ++k) { p.ph_lo = k; p.ph_hi = k + 1; hipLaunchKernelGGL(mk_fwd<false>, dim3(grid), dim3(512), LDS_BYTES, stream, p);
        if (k == PROBE_DUP) hipLaunchKernelGGL(mk_fwd<false>, dim3(grid), dim3(512), LDS_BYTES, stream, p); }
#else
    p.ph_lo = 0; p.ph_hi = NPHASE;
    if (hipMemsetAsync((unsigned char*)d_ws + O_BAR, 0, (XCD_BAR_WORDS + 64 * 64) * 4, stream) != hipSuccess) { fprintf(stderr, "kernel_launch: memset of barrier words failed\n"); return; }
    void* args[] = {&p};
    hipError_t e = hipLaunchCooperativeKernel((const void*)mk_fwd<true>, dim3(grid), dim3(512), args, LDS_BYTES, stream);
    if (e != hipSuccess) fprintf(stderr, "cooperative launch failed: %s (grid %d)\n", hipGetErrorString(e), grid);
#endif
}
```
